# Optimizing an MI355X kernel written in HIP

```python
import math
import jax, jax.numpy as jnp
from jax import lax
import numpy as np


D_MODEL = 1024
BATCH = 32
SEQ = 2048
DEPTH = 1

MEM_LEN = 256

DA_HEAD_DIM = 64
DA_V_DIM = 2 * DA_HEAD_DIM
DA_HEADS = D_MODEL // DA_V_DIM
DA_W = DA_HEADS * DA_V_DIM
QBLK = 128

ML_HEADS = 4
ML_HEAD_DIM = D_MODEL // ML_HEADS
ML_W = ML_HEADS * ML_HEAD_DIM
ML_CHUNK = 64
ML_CONV = 4

MA_HEADS = 4
MA_HEAD_DIM = D_MODEL // MA_HEADS
MA_W = MA_HEADS * MA_HEAD_DIM

N_BRANCH = 3

REL_BUCKETS = 32
REL_MAX_DIST = 128

N_EXPERTS = 256
TOP_K = 8
N_GROUP = 8
TOPK_GROUP = 4
D_EXPERT = 256
D_SHARED = 256
ROUTED_SCALE = 2.5
EXPERT_BLOCK = 128

DEEPNORM_ALPHA = (2.0 * DEPTH) ** 0.25
DEEPNORM_BETA = (8.0 * DEPTH) ** -0.25

SPLIT_SIZES = (DA_W, DA_W, DA_W, 2 * ML_W, ML_W, ML_W, ML_HEADS, ML_HEADS, MA_W, N_BRANCH * D_MODEL)
SPLIT_OFFSETS = tuple(sum(SPLIT_SIZES[:i]) for i in range(len(SPLIT_SIZES) + 1))
C_IN = SPLIT_OFFSETS[-1]

kernel_name = "hybrid_diffattn_mlstm_memxattn_moe_deepnorm"


def layer_norm(x, g, b, eps=1e-5):
    xf = x.astype(jnp.float32)
    mu = xf.mean(-1, keepdims=True)
    var = jnp.square(xf - mu).mean(-1, keepdims=True)
    return ((xf - mu) * lax.rsqrt(var + eps) * g + b).astype(x.dtype)


def rms_norm(x, g, eps=1e-5):
    xf = x.astype(jnp.float32)
    return (xf * lax.rsqrt(jnp.mean(xf * xf, -1, keepdims=True) + eps) * g).astype(x.dtype)


def head_layer_norm(x, g, eps=1e-5):
    xf = x.astype(jnp.float32)
    mu = xf.mean(-1, keepdims=True)
    var = jnp.square(xf - mu).mean(-1, keepdims=True)
    return ((xf - mu) * lax.rsqrt(var + eps) * g).astype(x.dtype)


def causal_depthwise_conv(u, w):
    k = w.shape[0]
    s = u.shape[1]
    up = jnp.pad(u, ((0, 0), (k - 1, 0), (0, 0)))
    out = up[:, 0:s] * w[0]
    for j in range(1, k):
        out = out + up[:, j:j + s] * w[j]
    return out


def t5_bucket(dist):
    n = jnp.maximum(dist, 0)
    max_exact = REL_BUCKETS // 2
    large = max_exact + (jnp.log(jnp.maximum(n, 1).astype(jnp.float32) / max_exact)
                         / math.log(REL_MAX_DIST / max_exact)
                         * (REL_BUCKETS - max_exact)).astype(jnp.int32)
    large = jnp.minimum(large, REL_BUCKETS - 1)
    return jnp.where(n < max_exact, n, large)


def differential_attention(q, k, v, rel_bias, lam, lam_init, subln_g):
    b, s = q.shape[:2]
    nqb = s // QBLK
    q = (q * DA_HEAD_DIM ** -0.5).transpose(0, 2, 3, 1, 4)
    k = k.transpose(0, 2, 3, 1, 4)
    v = v.transpose(0, 2, 1, 3)
    qb = q.reshape(b, DA_HEADS, 2, nqb, QBLK, DA_HEAD_DIM).transpose(3, 0, 1, 2, 4, 5)
    k_pos = jnp.arange(s)

    def block(args):
        qi, bi = args
        q_pos = bi * QBLK + jnp.arange(QBLK)
        dist = q_pos[:, None] - k_pos[None, :]
        bias = rel_bias[t5_bucket(dist)].astype(jnp.float32).transpose(2, 0, 1)
        logits = jnp.einsum('bhmqd,bhmkd->bhmqk', qi, k).astype(jnp.float32) + bias[None, :, None]
        logits = jnp.where(dist >= 0, logits, -jnp.inf)
        p = jax.nn.softmax(logits, axis=-1)
        a = p[:, :, 0] - lam * p[:, :, 1]
        return jnp.einsum('bhqk,bhkd->bhqd', a.astype(v.dtype), v)

    o = lax.map(block, (qb, jnp.arange(nqb)))
    o = o.transpose(1, 0, 3, 2, 4).reshape(b, s, DA_HEADS, DA_V_DIM)
    o = rms_norm(o, subln_g) * (1.0 - lam_init)
    return o.reshape(b, s, DA_W)


def mlstm_chunkwise(q, k, v, i_pre, f_pre):
    b, s, h, d = q.shape
    nc = s // ML_CHUNK

    def to_chunks(t):
        return t.astype(jnp.float32).reshape(b, nc, ML_CHUNK, h, d).transpose(1, 0, 3, 2, 4)

    def gate_chunks(t):
        return t.astype(jnp.float32).reshape(b, nc, ML_CHUNK, h).transpose(1, 0, 3, 2)

    qc = to_chunks(q)
    kc = to_chunks(k) * d ** -0.5
    vc = to_chunks(v)
    ic = gate_chunks(i_pre)
    fc = jax.nn.log_sigmoid(gate_chunks(f_pre))
    causal = jnp.tril(jnp.ones((ML_CHUNK, ML_CHUNK), bool))

    def step(carry, xs):
        c, n, m = carry
        qi, ki, vi, ii, fi = xs
        bcum = jnp.cumsum(fi, axis=-1)
        dmat = jnp.where(causal, bcum[..., :, None] - bcum[..., None, :] + ii[..., None, :], -jnp.inf)
        inter = bcum + m[..., None]
        m_row = jnp.maximum(inter, dmat.max(-1))
        w = jnp.exp(dmat - m_row[..., None]) * jnp.einsum('bhjd,bhsd->bhjs', qi, ki)
        inter_w = jnp.exp(inter - m_row)
        num = inter_w[..., None] * jnp.einsum('bhvk,bhjk->bhjv', c, qi) + jnp.einsum('bhjs,bhsv->bhjv', w, vi)
        den = inter_w * jnp.einsum('bhk,bhjk->bhj', n, qi) + w.sum(-1)
        hout = num / jnp.maximum(jnp.abs(den), jnp.exp(-m_row))[..., None]
        total = bcum[..., -1]
        g = total[..., None] - bcum + ii
        m_new = jnp.maximum(total + m, g.max(-1))
        decay = jnp.exp(total + m - m_new)
        ws = jnp.exp(g - m_new[..., None])
        c_new = decay[..., None, None] * c + jnp.einsum('bhsv,bhsk->bhvk', ws[..., None] * vi, ki)
        n_new = decay[..., None] * n + jnp.einsum('bhs,bhsk->bhk', ws, ki)
        return (c_new, n_new, m_new), hout

    init = (jnp.zeros((b, h, d, d), jnp.float32), jnp.zeros((b, h, d), jnp.float32),
            jnp.zeros((b, h), jnp.float32))
    _, hs = lax.scan(step, init, (qc, kc, vc, ic, fc))
    return hs.transpose(1, 0, 3, 2, 4).reshape(b, s, h, d)


def memory_attention(q, mem, w_mem_kv):
    b, s = q.shape[:2]
    kv = mem @ w_mem_kv
    k = kv[..., :MA_W].reshape(b, -1, MA_HEADS, MA_HEAD_DIM)
    v = kv[..., MA_W:].reshape(b, -1, MA_HEADS, MA_HEAD_DIM)
    logits = jnp.einsum('bshd,bmhd->bhsm', q * MA_HEAD_DIM ** -0.5, k).astype(jnp.float32)
    p = jax.nn.softmax(logits, axis=-1)
    o = jnp.einsum('bhsm,bmhd->bshd', p.astype(v.dtype), v)
    return o.reshape(b, s, MA_W)


def token_mixer(x, mem, rel_bias, w_in, b_in, conv_w, diff_lambda, subln_g, mlstm_norm_g,
                w_mem_kv, w_branch, w_out, layer_idx):
    b, s, _ = x.shape
    u = x @ w_in + b_in
    da_q, da_k, da_v, ml_qk, ml_v, ml_o, ml_i, ml_f, ma_q, gate_pre = [
        u[..., SPLIT_OFFSETS[i]:SPLIT_OFFSETS[i + 1]] for i in range(len(SPLIT_SIZES))]

    lam_init = 0.8 - 0.6 * math.exp(-0.3 * layer_idx)
    lv = diff_lambda.astype(jnp.float32)
    lam = jnp.exp(jnp.sum(lv[0] * lv[1])) - jnp.exp(jnp.sum(lv[2] * lv[3])) + lam_init
    y_a = differential_attention(da_q.reshape(b, s, DA_HEADS, 2, DA_HEAD_DIM),
                                 da_k.reshape(b, s, DA_HEADS, 2, DA_HEAD_DIM),
                                 da_v.reshape(b, s, DA_HEADS, DA_V_DIM),
                                 rel_bias, lam, lam_init, subln_g)

    ml_qk = jax.nn.silu(causal_depthwise_conv(ml_qk, conv_w))
    h_m = mlstm_chunkwise(ml_qk[..., :ML_W].reshape(b, s, ML_HEADS, ML_HEAD_DIM),
                          ml_qk[..., ML_W:].reshape(b, s, ML_HEADS, ML_HEAD_DIM),
                          ml_v.reshape(b, s, ML_HEADS, ML_HEAD_DIM), ml_i, ml_f)
    h_m = head_layer_norm(h_m, mlstm_norm_g.reshape(ML_HEADS, ML_HEAD_DIM)).astype(x.dtype)
    y_m = jax.nn.sigmoid(ml_o) * h_m.reshape(b, s, ML_W)

    y_c = memory_attention(ma_q.reshape(b, s, MA_HEADS, MA_HEAD_DIM), mem, w_mem_kv)

    ys = jnp.stack([y_a, y_m, y_c], axis=2)
    proj = jnp.einsum('bsnc,ncd->bsnd', ys, w_branch)
    gates = jax.nn.sigmoid(gate_pre.reshape(b, s, N_BRANCH, D_MODEL))
    merged = jnp.sum(gates * proj, axis=2)
    return merged @ w_out


def swiglu(h, wg, wu, wd):
    return (jax.nn.silu(h @ wg) * (h @ wu)) @ wd


def moe(h, w_router, router_bias, w_e_gate, w_e_up, w_e_down, w_s_gate, w_s_up, w_s_down):
    b, s, d = h.shape
    hf = h.reshape(b * s, d)
    t = hf.shape[0]
    scores = jax.nn.sigmoid((hf @ w_router).astype(jnp.float32))
    choice = scores + router_bias.astype(jnp.float32)
    grp = choice.reshape(t, N_GROUP, N_EXPERTS // N_GROUP)
    grp_score = lax.top_k(grp, 2)[0].sum(-1)
    _, top_g = lax.top_k(grp_score, TOPK_GROUP)
    gmask = jax.nn.one_hot(top_g, N_GROUP).sum(1) > 0
    choice = jnp.where(jnp.repeat(gmask, N_EXPERTS // N_GROUP, axis=1), choice, -jnp.inf)
    _, idx = lax.top_k(choice, TOP_K)
    wsel = jnp.take_along_axis(scores, idx, axis=1)
    wsel = wsel / (wsel.sum(-1, keepdims=True) + 1e-20) * ROUTED_SCALE

    n = t * TOP_K
    flat_e = idx.reshape(n)
    flat_w = wsel.reshape(n)
    order = jnp.argsort(flat_e)
    se = flat_e[order]
    stok = (order // TOP_K).astype(jnp.int32)
    sw = flat_w[order]
    counts = jnp.zeros((N_EXPERTS,), jnp.int32).at[flat_e].add(1)
    starts = jnp.cumsum(counts) - counts
    nblk = (counts + EXPERT_BLOCK - 1) // EXPERT_BLOCK
    blk_end = jnp.cumsum(nblk)
    pstart = (blk_end - nblk) * EXPERT_BLOCK
    dest = pstart[se] + jnp.arange(n, dtype=jnp.int32) - starts[se]
    nb = -(-n // EXPERT_BLOCK) + N_EXPERTS
    buf_tok = jnp.zeros((nb * EXPERT_BLOCK,), jnp.int32).at[dest].set(stok)
    buf_w = jnp.zeros((nb * EXPERT_BLOCK,), sw.dtype).at[dest].set(sw)
    block_e = jnp.minimum(jnp.searchsorted(blk_end, jnp.arange(nb), side='right'), N_EXPERTS - 1)

    def step(y, blk):
        tok, w, e = blk
        ob = swiglu(hf[tok], w_e_gate[e], w_e_up[e], w_e_down[e])
        return y.at[tok].add(ob * w[:, None].astype(ob.dtype)), None

    routed, _ = lax.scan(step, jnp.zeros_like(hf),
                         (buf_tok.reshape(nb, EXPERT_BLOCK), buf_w.reshape(nb, EXPERT_BLOCK), block_e))
    shared = swiglu(hf, w_s_gate, w_s_up, w_s_down)
    return (shared + routed).reshape(b, s, d)


def setup_inputs(seed: int = 0) -> dict:
    key = jax.random.key(seed)
    ks = iter(jax.random.split(key, 32))

    def nrm(shape, scale):
        return jax.random.normal(next(ks), shape, jnp.float32) * scale

    col_scale = np.ones((C_IN,), np.float32)
    col_scale[SPLIT_OFFSETS[2]:SPLIT_OFFSETS[3]] = DEEPNORM_BETA
    col_scale[SPLIT_OFFSETS[4]:SPLIT_OFFSETS[5]] = DEEPNORM_BETA
    f_bias = np.zeros((C_IN,), np.float32)
    f_bias[SPLIT_OFFSETS[7]:SPLIT_OFFSETS[8]] = np.linspace(3.0, 6.0, ML_HEADS)
    kv_scale = np.concatenate([np.ones((MA_W,), np.float32), np.full((MA_W,), DEEPNORM_BETA, np.float32)])

    x = nrm((BATCH, SEQ, D_MODEL), 1.0)
    mem = nrm((BATCH, MEM_LEN, D_MODEL), 1.0)
    rel_bias = nrm((REL_BUCKETS, DA_HEADS), 0.5)
    w_in = nrm((DEPTH, D_MODEL, C_IN), D_MODEL ** -0.5) * jnp.asarray(col_scale)
    b_in = nrm((DEPTH, C_IN), 0.02) + jnp.asarray(f_bias)
    conv_w = nrm((DEPTH, ML_CONV, 2 * ML_W), ML_CONV ** -0.5)
    diff_lambda = nrm((DEPTH, 4, DA_HEAD_DIM), 0.1)
    subln_g = 1.0 + nrm((DEPTH, DA_V_DIM), 0.02)
    mlstm_norm_g = 1.0 + nrm((DEPTH, ML_W), 0.02)
    w_mem_kv = nrm((DEPTH, D_MODEL, 2 * MA_W), D_MODEL ** -0.5) * jnp.asarray(kv_scale)
    w_branch = nrm((DEPTH, N_BRANCH, DA_W, D_MODEL), DA_W ** -0.5)
    w_out = nrm((DEPTH, D_MODEL, D_MODEL), D_MODEL ** -0.5 * DEEPNORM_BETA)
    ln1_g = 1.0 + nrm((DEPTH, D_MODEL), 0.02)
    ln1_b = nrm((DEPTH, D_MODEL), 0.02)
    w_router = nrm((DEPTH, D_MODEL, N_EXPERTS), D_MODEL ** -0.5)
    router_bias = nrm((DEPTH, N_EXPERTS), 0.01)
    w_e_gate = nrm((DEPTH, N_EXPERTS, D_MODEL, D_EXPERT), D_MODEL ** -0.5)
    w_e_up = nrm((DEPTH, N_EXPERTS, D_MODEL, D_EXPERT), D_MODEL ** -0.5)
    w_e_down = nrm((DEPTH, N_EXPERTS, D_EXPERT, D_MODEL), D_EXPERT ** -0.5 * DEEPNORM_BETA)
    w_s_gate = nrm((DEPTH, D_MODEL, D_SHARED), D_MODEL ** -0.5)
    w_s_up = nrm((DEPTH, D_MODEL, D_SHARED), D_MODEL ** -0.5)
    w_s_down = nrm((DEPTH, D_SHARED, D_MODEL), D_SHARED ** -0.5 * DEEPNORM_BETA)
    ln2_g = 1.0 + nrm((DEPTH, D_MODEL), 0.02)
    ln2_b = nrm((DEPTH, D_MODEL), 0.02)
    return {"x": x, "mem": mem, "rel_bias": rel_bias, "w_in": w_in, "b_in": b_in,
            "conv_w": conv_w, "diff_lambda": diff_lambda, "subln_g": subln_g,
            "mlstm_norm_g": mlstm_norm_g, "w_mem_kv": w_mem_kv, "w_branch": w_branch,
            "w_out": w_out, "ln1_g": ln1_g, "ln1_b": ln1_b, "w_router": w_router,
            "router_bias": router_bias, "w_e_gate": w_e_gate, "w_e_up": w_e_up,
            "w_e_down": w_e_down, "w_s_gate": w_s_gate, "w_s_up": w_s_up,
            "w_s_down": w_s_down, "ln2_g": ln2_g, "ln2_b": ln2_b}


def reference(x, mem, rel_bias, w_in, b_in, conv_w, diff_lambda, subln_g, mlstm_norm_g,
              w_mem_kv, w_branch, w_out, ln1_g, ln1_b, w_router, router_bias, w_e_gate,
              w_e_up, w_e_down, w_s_gate, w_s_up, w_s_down, ln2_g, ln2_b):
    for l in range(DEPTH):
        mix = token_mixer(x, mem, rel_bias, w_in[l], b_in[l], conv_w[l], diff_lambda[l],
                          subln_g[l], mlstm_norm_g[l], w_mem_kv[l], w_branch[l], w_out[l], l)
        x = layer_norm(DEEPNORM_ALPHA * x + mix, ln1_g[l], ln1_b[l])
        ffn = moe(x, w_router[l], router_bias[l], w_e_gate[l], w_e_up[l], w_e_down[l],
                  w_s_gate[l], w_s_up[l], w_s_down[l])
        x = layer_norm(DEEPNORM_ALPHA * x + ffn, ln2_g[l], ln2_b[l])
    return x
```

```cpp
#define ONE_LAUNCH 1
#include <hip/hip_runtime.h>
#include <cstdio>
#include <cstdint>
#define DI __device__ __forceinline__
#define LAS __attribute__((address_space(3)))
#define GAS __attribute__((address_space(1)))
typedef unsigned short bf16_t;
typedef short bf16x8 __attribute__((ext_vector_type(8)));
typedef float f32x4 __attribute__((ext_vector_type(4)));
typedef float f32x2 __attribute__((ext_vector_type(2)));
typedef unsigned u32x4 __attribute__((ext_vector_type(4)));
typedef unsigned u32x2 __attribute__((ext_vector_type(2)));

constexpr int T_ALL = 65536, DM = 1024, SEQ = 2048, NBATCH = 32, NGRP = 4, TG = T_ALL / NGRP, BG = NBATCH / NGRP;
constexpr int NU = 11264, CIN = 11272;
constexpr int UQ = 0, UK = 1024, UV = 2048, UMQ = 3072, UMK = 4096, UMV = 5120, UMO = 6144, UCQ = 7168, UGT = 8192;
constexpr int NEXP = 256, MAXRT = 2304, MAXTILES = MAXRT + 256, MAXSLOTS = MAXTILES * 256;
constexpr float ALPHA = 1.189207115002721f;
constexpr float LN_EPS = 1e-5f;

constexpr size_t MiB = 1ull << 20;
constexpr size_t WS_CTL = 0, CTL_BYTES = 1 * MiB;
constexpr size_t WS_MISC = 1 * MiB;
constexpr size_t WS_WIN = 2 * MiB, WS_WKV = 24 * MiB, WS_WBR = 28 * MiB, WS_WOUT = 34 * MiB, WS_WR = 36 * MiB;
constexpr size_t WS_GIF = 38 * MiB, WS_MEMB = 40 * MiB, WS_KVM = 56 * MiB, WS_X1B = 88 * MiB, WS_R = 216 * MiB;
constexpr size_t WS_XB = WS_R, WS_U = WS_R + 32 * MiB, WS_Y = WS_R + 384 * MiB, WS_F32 = WS_R + 480 * MiB, WS_MRG = WS_R + 544 * MiB, WS_Z = WS_R + 576 * MiB;
constexpr size_t WS_TKI = WS_R, WS_TKW = WS_R + 2 * MiB, WS_SLOTOF = WS_R + 4 * MiB, WS_TOKOF = WS_R + 6 * MiB, WS_WOF = WS_R + 9 * MiB;
constexpr size_t WS_LOGIT = WS_R + 16 * MiB, WS_WGU = WS_R + 80 * MiB, WS_WD = WS_R + 337 * MiB, WS_ACT = WS_R + 580 * MiB, WS_YCH = WS_R + 16 * MiB;
constexpr size_t WS_END = WS_R + 900 * MiB;
constexpr size_t MS_BIAS = 0, MS_LAM = 48 * 1024, MS_TBASE = 52 * 1024, MS_NT = 56 * 1024, MS_TILEE = 64 * 1024;
constexpr int CW_CNT = 1024, CW_CUR = 2048, CW_BAR = 8192;

constexpr int LDS_RING = 131072, LDS_MISC = LDS_RING + 320, LDS_BYTES = 147456;

DI float bf_lo(unsigned w) { return __uint_as_float(w << 16); }
DI float bf_hi(unsigned w) { return __uint_as_float(w & 0xffff0000u); }
DI float bf2f(bf16_t b) { return __uint_as_float((unsigned)b << 16); }
DI unsigned cvt_pk_bf16(float lo, float hi) { unsigned r; asm("v_cvt_pk_bf16_f32 %0, %1, %2" : "=v"(r) : "v"(lo), "v"(hi)); return r; }
DI float wave_sum(float v) {
#pragma unroll
    for (int o = 1; o < 64; o <<= 1) v += __shfl_xor(v, o);
    return v;
}
DI float wave_max(float v) {
#pragma unroll
    for (int o = 1; o < 64; o <<= 1) v = fmaxf(v, __shfl_xor(v, o));
    return v;
}
DI float sigm(float x) { return 1.f / (1.f + __expf(-x)); }
DI float silu(float x) { return x / (1.f + __expf(-x)); }
DI int tid_local() { int t = threadIdx.x; asm volatile("" : "+v"(t)); return t; }
#define LDS_WAIT() asm volatile("s_waitcnt lgkmcnt(0)" ::: "memory")
namespace pg8 {
constexpr int BM = 256, BK = 64, HALF = 128, HTB = HALF * BK * 2, STAGE_BYTES = 8 * HTB, NXCD = 8, WGM = 8;
__host__ __device__ __forceinline__ int lds_byte(int r, int c) { const int st = (r >> 4) * 2 + (c >> 5), rr = r & 15, cc = c & 31, ob = rr * 64 + cc * 2; return st * 1024 + (ob ^ (((ob >> 9) & 1) << 5)); }
__host__ __device__ __forceinline__ void stage_rc(int b, int& R, int& C) { const int st = b / 1024, sb = b % 1024, swz = sb ^ (((sb >> 9) & 1) << 5); R = (st >> 1) * 16 + swz / 64; C = (st & 1) * 32 + (swz % 64) / 2; }
__host__ __device__ __forceinline__ int perm32(int rho) { const int n = rho >> 4, i = rho & 15; return 8 * (i >> 2) + 4 * n + (i & 3); }

struct Unit { int pm, pn, pb, acol, aux; };
struct Gemm { const bf16_t* A; const bf16_t* Bt; int lda, ldb, K; const int* arow; };

struct StaticOrder {
    int nM, nN, nwg, G, c;
    DI void init(int M, int N, int G_, int c_) { nM = M / BM; nN = N / BM; nwg = nM * nN; G = G_; c = c_; }
    DI bool next(int i, Unit& u) const {
        const long L = (long)i * G + c; if (L >= nwg) return false;
        int wgid = (int)L; { const int q = nwg / NXCD, r = nwg % NXCD, xcd = wgid % NXCD, off = wgid / NXCD; wgid = (xcd < r ? xcd * (q + 1) : r * (q + 1) + (xcd - r) * q) + off; }
        const int nig = WGM * nN, gid = wgid / nig, fm = gid * WGM, gsz = (nM - fm) < WGM ? (nM - fm) : WGM;
        u.pm = fm + ((wgid % nig) % gsz); u.pn = (wgid % nig) / gsz; u.pb = u.pn; u.acol = 0; u.aux = 0; return true;
    }
};

template <class Epi, class Sched, bool ALIGN_EPI, bool GATHER = false>
DI void gemm_phase(LAS unsigned char* lds, const Gemm g, const Sched& S, const Epi& E) {
    const int tid = tid_local(), wid = __builtin_amdgcn_readfirstlane(tid >> 6), lane = tid & 63, wr = wid >> 2, wc = wid & 3, fr = lane & 15, fq = lane >> 4;
    const int nt = g.K / BK;
    int Ra[2], Ca[2], Rb[2];
#pragma unroll
    for (int i = 0; i < 2; ++i) { int R, C; stage_rc(tid * 16 + i * 8192, R, C); Ra[i] = R; Ca[i] = C; Rb[i] = (R & ~31) + perm32(R & 31); }
    const size_t kstep = (size_t)(BK * 2);
    const unsigned ldsw = (unsigned)wid * 1024u;
    const int aoff = lds_byte(wr * 64 + fr, fq * 8), boff = lds_byte(wc * 32 + fr, fq * 8);
#define PG8_SA(b, h) (((b) * 2 + (h)) * HTB)
#define PG8_SB(b, h) ((4 + (b) * 2 + (h)) * HTB)
#define PG8_STAGE(bufoff, gptr, offs) do { _Pragma("unroll") for (int _i = 0; _i < 2; ++_i) \
        __builtin_amdgcn_global_load_lds((const unsigned*)((gptr) + (offs)[_i]), (LAS unsigned*)(lds + (bufoff) + ldsw + _i * 8192), 16, 0, 0); } while (0)
#define PG8_LDA(dst, b, h) do { _Pragma("unroll") for (int m = 0; m < 4; ++m) _Pragma("unroll") for (int k = 0; k < 2; ++k) dst[m][k] = *(const LAS bf16x8*)(lds + PG8_SA(b, h) + aoff + m * 2048 + k * 1024); } while (0)
#define PG8_LDB(dst, b, h) do { _Pragma("unroll") for (int n = 0; n < 2; ++n) _Pragma("unroll") for (int k = 0; k < 2; ++k) dst[n][k] = *(const LAS bf16x8*)(lds + PG8_SB(b, h) + boff + n * 2048 + k * 1024); } while (0)
#define PG8_MMA(ai, bj, At, Bt) do { __builtin_amdgcn_s_setprio(1); _Pragma("unroll") for (int m = 0; m < 4; ++m) _Pragma("unroll") for (int n = 0; n < 2; ++n) _Pragma("unroll") for (int k = 0; k < 2; ++k) \
        acc[ai][bj][m][n] = __builtin_amdgcn_mfma_f32_16x16x32_bf16(Bt[n][k], At[m][k], acc[ai][bj][m][n], 0, 0, 0); __builtin_amdgcn_s_setprio(0); } while (0)
#define PG8_WAIT_V(n) asm volatile("s_waitcnt vmcnt(" #n ")" ::: "memory")
#define PG8_WAIT_L(n) asm volatile("s_waitcnt lgkmcnt(" #n ")" ::: "memory")
#define PG8_BAR __builtin_amdgcn_s_barrier()
#define PG8_SCHED __builtin_amdgcn_sched_barrier(0)
#define PG8_OFFS(u, oa) do { _Pragma("unroll") for (int h_ = 0; h_ < 2; ++h_) _Pragma("unroll") for (int i_ = 0; i_ < 2; ++i_) { \
        const int ar_ = g.arow[(u).pm * BM + h_ * HALF + Ra[i_]]; oa[h_][i_] = (unsigned)(ar_ * g.lda + (u).acol + Ca[i_]) * 2u; } } while (0)
    unsigned voffA[2], voffB[2];
#pragma unroll
    for (int i = 0; i < 2; ++i) { voffA[i] = (unsigned)(Ra[i] * g.lda + Ca[i]) * 2u; voffB[i] = (unsigned)(Rb[i] * g.ldb + Ca[i]) * 2u; }
    const size_t hstepA = (size_t)HALF * g.lda * 2, hstepB = (size_t)HALF * g.ldb * 2;
#define PG8_ABASE(u) ((const char*)g.A + (GATHER ? (size_t)0 : ((size_t)(u).pm * BM * g.lda + (u).acol) * 2))
#define PG8_BBASE(u) ((const char*)g.Bt + (size_t)(u).pb * BM * g.ldb * 2)
#define PG8_STAGE_A(bufoff, ab, oa, h) do { if constexpr (GATHER) { PG8_STAGE(bufoff, ab, (oa)[h]); } else { PG8_STAGE(bufoff, (ab) + (h) * hstepA, voffA); } } while (0)
#define PG8_STAGE_B(bufoff, bb, h) PG8_STAGE(bufoff, (bb) + (h) * hstepB, voffB)
    Unit cur, nxt; int ui = 0;
    if (!S.next(0, cur)) return;
    f32x4 acc[2][2][4][2];
#pragma unroll
    for (int a = 0; a < 2; ++a)
#pragma unroll
        for (int b = 0; b < 2; ++b)
#pragma unroll
            for (int m = 0; m < 4; ++m)
#pragma unroll
                for (int n = 0; n < 2; ++n) acc[a][b][m][n] = (f32x4){0.f, 0.f, 0.f, 0.f};
    bf16x8 At[4][2], B0[2][2], B1[2][2];
    unsigned oaC[2][2], oaN[2][2];
    if constexpr (GATHER) { PG8_OFFS(cur, oaC); }
    const char* cA = PG8_ABASE(cur); const char* cB = PG8_BBASE(cur);
    PG8_STAGE_B(PG8_SB(0, 0), cB, 0); PG8_STAGE_B(PG8_SB(0, 1), cB, 1); PG8_STAGE_A(PG8_SA(0, 0), cA, oaC, 0); PG8_STAGE_A(PG8_SA(0, 1), cA, oaC, 1);
    if (wr == 1) PG8_BAR;
    PG8_WAIT_V(2); PG8_BAR;
    PG8_STAGE_B(PG8_SB(1, 0), cB + kstep, 0); PG8_STAGE_A(PG8_SA(1, 0), cA + kstep, oaC, 0); PG8_STAGE_B(PG8_SB(1, 1), cB + kstep, 1);
    PG8_WAIT_V(6); PG8_BAR;
    for (;;) {
        const bool has_next = S.next(ui + 1, nxt);
        const char* nA = has_next ? PG8_ABASE(nxt) : cA; const char* nB = has_next ? PG8_BBASE(nxt) : cB;
        if constexpr (GATHER) {
            if (has_next) { PG8_OFFS(nxt, oaN); }
            else {
#pragma unroll
                for (int h_ = 0; h_ < 2; ++h_)
#pragma unroll
                    for (int i_ = 0; i_ < 2; ++i_) oaN[h_][i_] = oaC[h_][i_];
            }
        }
#pragma unroll 1
        for (int t = 0; t < nt; t += 2) {
            const bool last = (t == nt - 2);
            const char* a1 = cA + (size_t)(t + 1) * kstep;
            const char* a2 = last ? nA : cA + (size_t)(t + 2) * kstep; const char* b2 = last ? nB : cB + (size_t)(t + 2) * kstep;
            const char* a3 = a2 + kstep; const char* b3 = b2 + kstep;
            unsigned oa2[2][2];
            if constexpr (GATHER) {
#pragma unroll
                for (int h_ = 0; h_ < 2; ++h_)
#pragma unroll
                    for (int i_ = 0; i_ < 2; ++i_) oa2[h_][i_] = last ? oaN[h_][i_] : oaC[h_][i_];
            }
            PG8_LDB(B0, 0, 0); PG8_LDB(B1, 0, 1); PG8_SCHED; PG8_LDA(At, 0, 0); PG8_STAGE_A(PG8_SA(1, 1), a1, oaC, 1);
            PG8_WAIT_V(8); PG8_WAIT_L(0); PG8_BAR; PG8_MMA(0, 0, At, B0); PG8_MMA(0, 1, At, B1); PG8_BAR; PG8_SCHED;
            PG8_LDA(At, 0, 1); PG8_STAGE_B(PG8_SB(0, 0), b2, 0); PG8_STAGE_B(PG8_SB(0, 1), b2, 1); PG8_STAGE_A(PG8_SA(0, 0), a2, oa2, 0);
            PG8_WAIT_V(8); PG8_WAIT_L(0); PG8_BAR; PG8_MMA(1, 0, At, B0); PG8_MMA(1, 1, At, B1); PG8_BAR; PG8_SCHED;
            PG8_LDB(B0, 1, 0); PG8_LDB(B1, 1, 1); PG8_SCHED; PG8_LDA(At, 1, 0); PG8_STAGE_A(PG8_SA(0, 1), a2, oa2, 1);
            PG8_WAIT_V(8); PG8_WAIT_L(0); PG8_BAR; PG8_MMA(0, 0, At, B0); PG8_MMA(0, 1, At, B1); PG8_BAR; PG8_SCHED;
            PG8_LDA(At, 1, 1); PG8_STAGE_B(PG8_SB(1, 0), b3, 0); PG8_STAGE_B(PG8_SB(1, 1), b3, 1); PG8_STAGE_A(PG8_SA(1, 0), a3, oa2, 0);
            PG8_WAIT_V(8); PG8_WAIT_L(0); PG8_BAR; PG8_MMA(1, 0, At, B0); PG8_MMA(1, 1, At, B1); PG8_BAR; PG8_SCHED;
        }
        if constexpr (ALIGN_EPI) { if (wr == 0) PG8_BAR; }
        E(acc, cur, wr, wc, fr, fq);
        if (!has_next) break;
#pragma unroll
        for (int a = 0; a < 2; ++a)
#pragma unroll
            for (int b = 0; b < 2; ++b)
#pragma unroll
                for (int m = 0; m < 4; ++m)
#pragma unroll
                    for (int n = 0; n < 2; ++n) acc[a][b][m][n] = (f32x4){0.f, 0.f, 0.f, 0.f};
        cur = nxt; cA = nA; cB = nB; ++ui;
        if constexpr (GATHER) {
#pragma unroll
            for (int h_ = 0; h_ < 2; ++h_)
#pragma unroll
                for (int i_ = 0; i_ < 2; ++i_) oaC[h_][i_] = oaN[h_][i_];
        }
        if constexpr (ALIGN_EPI) { if (wr == 1) PG8_BAR; }
    }
    PG8_WAIT_V(0);
    if constexpr (!ALIGN_EPI) { if (wr == 0) PG8_BAR; }
    PG8_BAR;
#undef PG8_SA
#undef PG8_SB
#undef PG8_STAGE
#undef PG8_LDA
#undef PG8_LDB
#undef PG8_MMA
#undef PG8_WAIT_V
#undef PG8_WAIT_L
#undef PG8_BAR
#undef PG8_SCHED
#undef PG8_OFFS
#undef PG8_ABASE
#undef PG8_BBASE
#undef PG8_STAGE_A
#undef PG8_STAGE_B
}
}
using pg8::Unit; using pg8::BM; using pg8::HALF;

struct BranchOrder {
    int ntile, G, c;
    DI bool next(int i, Unit& u) const {
        const int L = (i / 3) * G + c; if (L >= ntile) return false;
        const int n = i % 3; u.pm = L >> 2; u.pn = L & 3; u.pb = n * 4 + u.pn; u.acol = n * 1024; u.aux = n; return true;
    }
};
struct ExpertGUOrder {
    const int* tile_e; int nunits, G, c;
    DI bool next(int i, Unit& u) const {
        const int L = i * G + c; if (L >= nunits) return false;
        const int t = L >> 1, hf = L & 1; const int e = tile_e[t];
        u.pm = t; u.pn = hf; u.pb = e * 2 + hf; u.acol = 0; u.aux = e; return true;
    }
};
struct ExpertDownOrder {
    const int* tile_e; int nunits, G, c, round;
    DI bool next(int i, Unit& u) const {
        const int L = i * G + c; if (L >= nunits) return false;
        const int e = tile_e[L];
        u.pm = L; u.pn = 0; u.pb = e * 4 + round; u.acol = 0; u.aux = e; return true;
    }
};

#define EPI_ARGS const f32x4 (&acc)[2][2][4][2], const Unit& u, int wr, int wc, int fr, int fq
DI u32x4 pack8(const f32x4 v0, const f32x4 v1) { u32x4 w; w.x = cvt_pk_bf16(v0[0], v0[1]); w.y = cvt_pk_bf16(v0[2], v0[3]); w.z = cvt_pk_bf16(v1[0], v1[1]); w.w = cvt_pk_bf16(v1[2], v1[3]); return w; }

struct EpiInProj {
    bf16_t* O; const float* bias;
    DI void operator()(EPI_ARGS) const {
        const int row0 = u.pm * BM + wr * 64 + fr, col0 = u.pn * BM + wc * 32 + 8 * fq;
        const float sc = (u.pn < 4) ? 0.125f : ((u.pn >= 28 && u.pn < 32) ? 0.0625f : 1.f);
        f32x4 bv[2][2];
#pragma unroll
        for (int bj = 0; bj < 2; ++bj)
#pragma unroll
            for (int n = 0; n < 2; ++n) bv[bj][n] = *(const f32x4*)(bias + col0 + bj * HALF + 4 * n);
#pragma unroll
        for (int ai = 0; ai < 2; ++ai)
#pragma unroll
            for (int m = 0; m < 4; ++m) { bf16_t* rowp = O + (size_t)(row0 + ai * HALF + m * 16) * NU + col0;
#pragma unroll
                for (int bj = 0; bj < 2; ++bj) *(u32x4*)(rowp + bj * HALF) = pack8((acc[ai][bj][m][0] + bv[bj][0]) * sc, (acc[ai][bj][m][1] + bv[bj][1]) * sc); }
    }
};
struct EpiPlain {
    bf16_t* O; int ldc;
    DI void operator()(EPI_ARGS) const {
        const int row0 = u.pm * BM + wr * 64 + fr, col0 = u.pn * BM + wc * 32 + 8 * fq;
#pragma unroll
        for (int ai = 0; ai < 2; ++ai)
#pragma unroll
            for (int m = 0; m < 4; ++m) { bf16_t* rowp = O + (size_t)(row0 + ai * HALF + m * 16) * ldc + col0;
#pragma unroll
                for (int bj = 0; bj < 2; ++bj) *(u32x4*)(rowp + bj * HALF) = pack8(acc[ai][bj][m][0], acc[ai][bj][m][1]); }
    }
};
struct EpiBranch {
    const bf16_t* U; float* F; bf16_t* M;
    DI void operator()(EPI_ARGS) const {
        const int row0 = u.pm * BM + wr * 64 + fr, col0 = u.pn * BM + wc * 32 + 8 * fq, n = u.aux;
#pragma unroll
        for (int ai = 0; ai < 2; ++ai)
#pragma unroll
            for (int m = 0; m < 4; ++m) { const size_t row = (size_t)(row0 + ai * HALF + m * 16);
#pragma unroll
                for (int bj = 0; bj < 2; ++bj) { const int col = col0 + bj * HALF;
                    const u32x4 gw = *(const u32x4*)(U + row * NU + UGT + n * 1024 + col);
                    f32x4 g0 = {sigm(bf_lo(gw.x)), sigm(bf_hi(gw.x)), sigm(bf_lo(gw.y)), sigm(bf_hi(gw.y))};
                    f32x4 g1 = {sigm(bf_lo(gw.z)), sigm(bf_hi(gw.z)), sigm(bf_lo(gw.w)), sigm(bf_hi(gw.w))};
                    f32x4 v0 = acc[ai][bj][m][0] * g0, v1 = acc[ai][bj][m][1] * g1;
                    float* fp = F + row * 1024 + col;
                    if (n > 0) { v0 += *(const f32x4*)fp; v1 += *(const f32x4*)(fp + 4); }
                    if (n < 2) { *(f32x4*)fp = v0; *(f32x4*)(fp + 4) = v1; }
                    else *(u32x4*)(M + row * 1024 + col) = pack8(v0, v1); }
                asm volatile("" ::: "memory"); }
    }
};
struct EpiOutProj {
    const float* X; float* Z;
    DI void operator()(EPI_ARGS) const {
        const int row0 = u.pm * BM + wr * 64 + fr, col0 = u.pn * BM + wc * 32 + 8 * fq;
#pragma unroll
        for (int ai = 0; ai < 2; ++ai)
#pragma unroll
            for (int m = 0; m < 4; ++m) { const size_t off = (size_t)(row0 + ai * HALF + m * 16) * 1024 + col0;
#pragma unroll
                for (int bj = 0; bj < 2; ++bj) { const float* xp = X + off + bj * HALF; float* zp = Z + off + bj * HALF;
                    *(f32x4*)zp = *(const f32x4*)xp * ALPHA + acc[ai][bj][m][0]; *(f32x4*)(zp + 4) = *(const f32x4*)(xp + 4) * ALPHA + acc[ai][bj][m][1]; }
                asm volatile("" ::: "memory"); }
    }
};
struct EpiF32 {
    float* O; int ldc;
    DI void operator()(EPI_ARGS) const {
        const int row0 = u.pm * BM + wr * 64 + fr, col0 = u.pn * BM + wc * 32 + 8 * fq;
#pragma unroll
        for (int ai = 0; ai < 2; ++ai)
#pragma unroll
            for (int m = 0; m < 4; ++m) { float* rowp = O + (size_t)(row0 + ai * HALF + m * 16) * ldc + col0;
#pragma unroll
                for (int bj = 0; bj < 2; ++bj) { *(f32x4*)(rowp + bj * HALF) = acc[ai][bj][m][0]; *(f32x4*)(rowp + bj * HALF + 4) = acc[ai][bj][m][1]; } }
    }
};
struct EpiGateUp {
    bf16_t* ACT;
    DI void operator()(EPI_ARGS) const {
        const int row0 = u.pm * BM + wr * 64 + fr, col0 = u.pn * HALF + wc * 32 + 8 * fq;
#pragma unroll
        for (int ai = 0; ai < 2; ++ai)
#pragma unroll
            for (int m = 0; m < 4; ++m) { f32x4 v[2];
#pragma unroll
                for (int n = 0; n < 2; ++n) { const f32x4 gt = acc[ai][0][m][n], up = acc[ai][1][m][n];
                    v[n] = (f32x4){silu(gt[0]) * up[0], silu(gt[1]) * up[1], silu(gt[2]) * up[2], silu(gt[3]) * up[3]}; }
                *(u32x4*)(ACT + (size_t)(row0 + ai * HALF + m * 16) * 256 + col0) = pack8(v[0], v[1]); }
    }
};
struct EpiDown {
    bf16_t* Y; const float* W;
    DI void operator()(EPI_ARGS) const {
        const int row0 = u.pm * BM + wr * 64 + fr, col0 = wc * 32 + 8 * fq;
#pragma unroll
        for (int ai = 0; ai < 2; ++ai)
#pragma unroll
            for (int m = 0; m < 4; ++m) { const int row = row0 + ai * HALF + m * 16; const float w = W[row];
#pragma unroll
                for (int bj = 0; bj < 2; ++bj) *(u32x4*)(Y + (size_t)row * 256 + col0 + bj * HALF) = pack8(acc[ai][bj][m][0] * w, acc[ai][bj][m][1] * w);
                asm volatile("" ::: "memory"); }
    }
};
#define RLX_AGENT __ATOMIC_RELAXED, __HIP_MEMORY_SCOPE_AGENT
#define XB_TMO      128
#define XB_XCNT(j)  (256  + 64 * (j))
#define XB_XSUB(j)  (1280 + 64 * (j))
#define XB_XGEN(j)  (2304 + 64 * (j))
#define XB_TOP      3328
#define XB_TOPGEN   3392
#define XCD_BAR_WORDS 3456
#define XB_SPIN_CAP (1u << 18)

__device__ __forceinline__ unsigned xb_ld(unsigned* p)              { return __hip_atomic_load(p, __ATOMIC_RELAXED, __HIP_MEMORY_SCOPE_AGENT); }
__device__ __forceinline__ unsigned xb_add(unsigned* p, unsigned v) { return __hip_atomic_fetch_add(p, v, __ATOMIC_RELAXED, __HIP_MEMORY_SCOPE_AGENT); }
__device__ __forceinline__ unsigned xb_xcc_id() { return (unsigned)__builtin_amdgcn_s_getreg((3 << 11) | 20) & 0xFu; }
#define XB_SPIN(cond, bar) do { unsigned _sp = 0; while (cond) { __builtin_amdgcn_s_sleep(1); \
    if ((++_sp & 255u) == 0u) { if (xb_ld(&(bar)[XB_TMO])) break; if (_sp > XB_SPIN_CAP) { atomicAdd(&(bar)[XB_TMO], 1u); break; } } } } while (0)

struct XcdBarrier {
    unsigned* bar; unsigned x;
    volatile LAS unsigned* st;
};

__device__ __forceinline__ XcdBarrier xcd_barrier_post(unsigned* bar, volatile LAS unsigned* st) {
    XcdBarrier b; b.bar = bar; b.x = xb_xcc_id(); b.st = st;
    if (threadIdx.x == 0) (void)xb_add(&bar[XB_XCNT(b.x)], 1u);
    return b;
}
__device__ __forceinline__ void xcd_barrier_complete(unsigned* bar, unsigned x, unsigned& nloc, unsigned& nx) {
    const unsigned G = gridDim.x * gridDim.y * gridDim.z;
    unsigned sum, cnt, mine, sp = 0u;
    for (;;) {
        sum = 0u; cnt = 0u; mine = 0u;
#pragma unroll
        for (unsigned j = 0; j < 16; ++j) { const unsigned c = xb_ld(&bar[XB_XCNT(j)]); sum += c; cnt += (c > 0u) ? 1u : 0u; mine = (j == x) ? c : mine; }
        if (sum == G) break;
        __builtin_amdgcn_s_sleep(1);
        if ((++sp & 255u) == 0u) { if (xb_ld(&bar[XB_TMO])) break; if (sp > XB_SPIN_CAP) { atomicAdd(&bar[XB_TMO], 1u); break; } }
    }
    nloc = mine > 0u ? mine : 1u; nx = cnt > 0u ? cnt : 1u;
}

__device__ __forceinline__ void xcd_barrier(const XcdBarrier& b) {
    asm volatile("s_waitcnt vmcnt(0)" ::: "memory");
    __syncthreads();
    if (threadIdx.x == 0) {
        unsigned* bar = b.bar;
        __builtin_amdgcn_s_waitcnt(0);
        unsigned nloc = b.st[0], nx = b.st[1];
        if (nloc == 0u) { xcd_barrier_complete(bar, b.x, nloc, nx); b.st[0] = nloc; b.st[1] = nx; }
        const unsigned old = xb_add(&bar[XB_XSUB(b.x)], 1u);
        const unsigned gen = old / nloc;
        if (old + 1u == (gen + 1u) * nloc) {
            __builtin_amdgcn_fence(__ATOMIC_RELEASE, "agent");
            asm volatile("s_waitcnt vmcnt(0)" ::: "memory");
            const unsigned og = xb_add(&bar[XB_TOP], 1u);
            const unsigned tg = og / nx;
            if (og + 1u == (tg + 1u) * nx) xb_add(&bar[XB_TOPGEN], 1u);
            else XB_SPIN(xb_ld(&bar[XB_TOPGEN]) == tg, bar);
            __builtin_amdgcn_fence(__ATOMIC_ACQUIRE, "agent");
            xb_add(&bar[XB_XGEN(b.x)], 1u);
            asm volatile("s_waitcnt vmcnt(0)" ::: "memory");
        } else {
            XB_SPIN(xb_ld(&bar[XB_XGEN(b.x)]) == gen, bar);
            __builtin_amdgcn_fence(__ATOMIC_ACQUIRE, "agent");
            asm volatile("s_waitcnt vmcnt(0)" ::: "memory");
        }
    }
    __syncthreads();
}

struct P {
    const float *x, *mem, *rel_bias, *w_in, *b_in, *conv_w, *diff_lambda, *subln_g, *mlstm_norm_g, *w_mem_kv, *w_branch, *w_out, *ln1_g, *ln1_b,
                *w_router, *router_bias, *w_e_gate, *w_e_up, *w_e_down, *w_s_gate, *w_s_up, *w_s_down, *ln2_g, *ln2_b;
    float* out; unsigned char* ws; int s_lo, s_hi;
};
typedef const P __attribute__((address_space(4)))* PP;
DI PP kargs() { PP k = (PP)__builtin_amdgcn_kernarg_segment_ptr(); asm volatile("" : "+s"(k)); return k; }
DI P load_args(PP k) { P r; const unsigned long long __attribute__((address_space(4)))* s = (const unsigned long long __attribute__((address_space(4)))*)k; unsigned long long* d = (unsigned long long*)&r;
#pragma unroll
    for (int i = 0; i < (int)(sizeof(P) / 8); ++i) d[i] = s[i];
    return r; }
#define WSP(T, off) ((T*)(p.ws + (off)))

DI void transpose_item(const float* W, int ldw, int src_col0, bf16_t* WT, int ldt, int dst_row0, int k0, LAS float* scr, int lane) {
#pragma unroll 8
    for (int i = 0; i < 32; ++i) { const int kk = 2 * i + (lane >> 5); scr[kk * 33 + (lane & 31)] = W[(size_t)(k0 + kk) * ldw + src_col0 + (lane & 31)]; }
    LDS_WAIT();
    const int c = lane & 7;
#pragma unroll
    for (int j = 0; j < 4; ++j) { const int n = (lane >> 3) + 8 * j; const LAS float* s = scr + (8 * c) * 33 + n;
        u32x4 o; o.x = cvt_pk_bf16(s[0 * 33], s[1 * 33]); o.y = cvt_pk_bf16(s[2 * 33], s[3 * 33]); o.z = cvt_pk_bf16(s[4 * 33], s[5 * 33]); o.w = cvt_pk_bf16(s[6 * 33], s[7 * 33]);
        *(u32x4*)(WT + (size_t)(dst_row0 + n) * ldt + k0 + 8 * c) = o; }
    LDS_WAIT();
}
DI void transpose_mat(const float* W, int ldw, int src_col0, int K, int N, bf16_t* WT, int ldt, int dst_row0, int gw, int NGW, LAS float* scr, int lane) {
    const int nblk = N / 32, items = (K / 64) * nblk;
    for (int it = gw; it < items; it += NGW) { const int kb = it / nblk, nb = it % nblk; transpose_item(W, ldw, src_col0 + nb * 32, WT, ldt, dst_row0 + nb * 32, kb * 64, scr, lane); }
}
DI void row_to_bf16(const float* src, bf16_t* dst, int lane) {
    const f32x4* s = (const f32x4*)src + lane; u32x2* d = (u32x2*)dst + lane;
#pragma unroll
    for (int j = 0; j < 4; ++j) { const f32x4 v = s[64 * j]; u32x2 o; o.x = cvt_pk_bf16(v[0], v[1]); o.y = cvt_pk_bf16(v[2], v[3]); d[64 * j] = o; }
}

DI void ph_prologue(PP pk_, LAS unsigned char* lds) { const P p = load_args(pk_);
    const int tid = tid_local(), lane = tid & 63, wave = tid >> 6, gw = blockIdx.x * 8 + wave, NGW = gridDim.x * 8;
    LAS float* scr = (LAS float*)(lds + wave * 16384);
    bf16_t* WinT = WSP(bf16_t, WS_WIN);
    transpose_mat(p.w_in, CIN, 0, 1024, 7168, WinT, 1024, 0, gw, NGW, scr, lane);
    transpose_mat(p.w_in, CIN, 7176, 1024, 4096, WinT, 1024, 7168, gw, NGW, scr, lane);
    transpose_mat(p.w_mem_kv, 2048, 0, 1024, 2048, WSP(bf16_t, WS_WKV), 1024, 0, gw, NGW, scr, lane);
    for (int n = 0; n < 3; ++n) transpose_mat(p.w_branch + (size_t)n * 1024 * 1024, 1024, 0, 1024, 1024, WSP(bf16_t, WS_WBR), 1024, n * 1024, gw, NGW, scr, lane);
    transpose_mat(p.w_out, 1024, 0, 1024, 1024, WSP(bf16_t, WS_WOUT), 1024, 0, gw, NGW, scr, lane);
    transpose_mat(p.w_router, 256, 0, 1024, 256, WSP(bf16_t, WS_WR), 1024, 0, gw, NGW, scr, lane);
    bf16_t* memb = WSP(bf16_t, WS_MEMB);
    for (int r = gw; r < NBATCH * 256; r += NGW) row_to_bf16(p.mem + (size_t)r * 1024, memb + (size_t)r * 1024, lane);
    float* bias = WSP(float, WS_MISC + MS_BIAS);
    for (int j = blockIdx.x * 512 + tid; j < NU; j += gridDim.x * 512) bias[j] = p.b_in[j + (j >= 7168 ? 8 : 0)];
    if (gw == 0) {
        const float* lv = p.diff_lambda;
        const float s1 = wave_sum(lv[lane] * lv[64 + lane]), s2 = wave_sum(lv[128 + lane] * lv[192 + lane]);
        if (lane == 0) *WSP(float, WS_MISC + MS_LAM) = expf(s1) - expf(s2) + 0.2f;
    }
}

DI void ph_xconv(PP pk_, int g, LAS unsigned char* lds) { const P p = load_args(pk_);
    const int tid = tid_local(), lane = tid & 63, wave = tid >> 6, gw = blockIdx.x * 8 + wave, NGW = gridDim.x * 8;
    LAS float* wg = (LAS float*)lds;
    for (int i = tid; i < 2048; i += 512) { const int c = i >> 1, hf = i & 1; *(LAS f32x4*)(wg + c * 8 + hf * 4) = *(const f32x4*)(p.w_in + (size_t)c * CIN + 7168 + hf * 4); }
    __syncthreads();
    bf16_t* xb = WSP(bf16_t, WS_XB); float* gif = WSP(float, WS_GIF);
    for (int r = gw; r < TG; r += NGW) {
        const size_t t = (size_t)g * TG + r;
        const f32x4* xr = (const f32x4*)(p.x + t * 1024) + lane; u32x2* d = (u32x2*)(xb + (size_t)r * 1024) + lane;
        float gs[8];
#pragma unroll
        for (int q = 0; q < 8; ++q) gs[q] = 0.f;
#pragma unroll
        for (int j = 0; j < 4; ++j) { const f32x4 v = xr[64 * j]; u32x2 o; o.x = cvt_pk_bf16(v[0], v[1]); o.y = cvt_pk_bf16(v[2], v[3]); d[64 * j] = o;
#pragma unroll
            for (int e = 0; e < 4; ++e) { const int c = 4 * lane + 256 * j + e; const f32x4 wl = *(const LAS f32x4*)(wg + c * 8), wh = *(const LAS f32x4*)(wg + c * 8 + 4);
                gs[0] += v[e] * wl[0]; gs[1] += v[e] * wl[1]; gs[2] += v[e] * wl[2]; gs[3] += v[e] * wl[3]; gs[4] += v[e] * wh[0]; gs[5] += v[e] * wh[1]; gs[6] += v[e] * wh[2]; gs[7] += v[e] * wh[3]; } }
        float mine = 0.f;
#pragma unroll
        for (int q = 0; q < 8; ++q) { const float s = wave_sum(gs[q]); if (lane == q) mine = s; }
        if (lane < 8) gif[t * 8 + lane] = mine + p.b_in[7168 + lane];
    }
    __syncthreads();
}

DI int t5_bucket(int n) { return n < 16 ? n : min(31, 16 + (int)(__log2f((float)n * 0.0625f) * (16.f / 3.f))); }

DI void attn_naive_item(PP pk_, int item, LAS unsigned char* lds) { const P p = load_args(pk_);
    const int tid = tid_local(), qr = tid >> 3, map = (tid >> 2) & 1, dc = tid & 3;
    const int qb = item & 31, h = (item >> 5) & 7, b = item >> 8, q0 = qb * 64, qi = q0 + qr;
    const bf16_t* U = WSP(bf16_t, WS_U); const size_t rbase = (size_t)b * SEQ;
    LAS float* bt = (LAS float*)(lds + 16384);
    if (tid <= 128) bt[tid] = p.rel_bias[t5_bucket(tid) * 8 + h];
    float q[64];
    { const u32x4* qp = (const u32x4*)(U + (rbase + qi) * NU + UQ + h * 128 + map * 64);
#pragma unroll
      for (int i = 0; i < 8; ++i) { const u32x4 w = qp[i]; q[8 * i] = bf_lo(w.x); q[8 * i + 1] = bf_hi(w.x); q[8 * i + 2] = bf_lo(w.y); q[8 * i + 3] = bf_hi(w.y); q[8 * i + 4] = bf_lo(w.z); q[8 * i + 5] = bf_hi(w.z); q[8 * i + 6] = bf_lo(w.w); q[8 * i + 7] = bf_hi(w.w); } }
    float o[32];
#pragma unroll
    for (int c = 0; c < 32; ++c) o[c] = 0.f;
    float mrun = -INFINITY, lrun = 0.f;
    const int ntile = q0 / 32 + 2;
    for (int kt = 0; kt < ntile; ++kt) {
        const int k0 = kt * 32;
        __syncthreads();
        { const int key = tid >> 4, pc = tid & 15; const bf16_t* urow = U + (rbase + k0 + key) * NU;
          *(LAS u32x4*)(lds + (pc >> 3) * 4096 + key * 128 + (pc & 7) * 16) = *(const u32x4*)(urow + UK + h * 128 + pc * 8);
          *(LAS u32x4*)(lds + 8192 + key * 256 + pc * 16) = *(const u32x4*)(urow + UV + h * 128 + pc * 8); }
        __syncthreads();
#pragma unroll 1
        for (int j = 0; j < 32; ++j) {
            const int dist = qi - (k0 + j);
            const LAS u32x4* kp = (const LAS u32x4*)(lds + map * 4096 + j * 128); float a = 0.f;
#pragma unroll
            for (int i = 0; i < 8; ++i) { const u32x4 w = kp[i]; a += q[8 * i] * bf_lo(w.x) + q[8 * i + 1] * bf_hi(w.x) + q[8 * i + 2] * bf_lo(w.y) + q[8 * i + 3] * bf_hi(w.y) + q[8 * i + 4] * bf_lo(w.z) + q[8 * i + 5] * bf_hi(w.z) + q[8 * i + 6] * bf_lo(w.w) + q[8 * i + 7] * bf_hi(w.w); }
            if (dist >= 0) {
                a += bt[min(dist, 128)];
                if (a > mrun) { const float sc = __expf(mrun - a); mrun = a; lrun *= sc;
#pragma unroll
                    for (int c = 0; c < 32; ++c) o[c] *= sc; }
                const float pj = __expf(a - mrun); lrun += pj; const LAS u32x4* vp = (const LAS u32x4*)(lds + 8192 + j * 256 + dc * 64);
#pragma unroll
                for (int i = 0; i < 4; ++i) { const u32x4 w = vp[i]; o[8 * i] += pj * bf_lo(w.x); o[8 * i + 1] += pj * bf_hi(w.x); o[8 * i + 2] += pj * bf_lo(w.y); o[8 * i + 3] += pj * bf_hi(w.y); o[8 * i + 4] += pj * bf_lo(w.z); o[8 * i + 5] += pj * bf_hi(w.z); o[8 * i + 6] += pj * bf_lo(w.w); o[8 * i + 7] += pj * bf_hi(w.w); }
            }
        }
    }
    const float lam = *WSP(float, WS_MISC + MS_LAM), inv = 1.f / lrun;
    float ss = 0.f;
#pragma unroll
    for (int c = 0; c < 32; ++c) { const float mine = o[c] * inv, other = __shfl_xor(mine, 4); o[c] = mine - lam * other; ss += o[c] * o[c]; }
    ss += __shfl_xor(ss, 1); ss += __shfl_xor(ss, 2);
    const float rs = rsqrtf(ss * (1.f / 128.f) + LN_EPS) * 0.8f;
    if (map == 0) { bf16_t* yp = WSP(bf16_t, WS_Y) + (rbase + qi) * 3072 + h * 128 + dc * 32; const float* gp = p.subln_g + dc * 32;
#pragma unroll
        for (int i = 0; i < 4; ++i) { u32x4 w; w.x = cvt_pk_bf16(o[8 * i] * rs * gp[8 * i], o[8 * i + 1] * rs * gp[8 * i + 1]); w.y = cvt_pk_bf16(o[8 * i + 2] * rs * gp[8 * i + 2], o[8 * i + 3] * rs * gp[8 * i + 3]);
            w.z = cvt_pk_bf16(o[8 * i + 4] * rs * gp[8 * i + 4], o[8 * i + 5] * rs * gp[8 * i + 5]); w.w = cvt_pk_bf16(o[8 * i + 6] * rs * gp[8 * i + 6], o[8 * i + 7] * rs * gp[8 * i + 7]); *(u32x4*)(yp + 8 * i) = w; } }
    __syncthreads();
}

DI void xattn_naive_item(PP pk_, int g, int item, LAS unsigned char* lds) { const P p = load_args(pk_);
    const int tid = tid_local(), lane = tid & 63, wave = tid >> 6;
    const int qb = item & 63, h = (item >> 6) & 3, b = item >> 8;
    const bf16_t* U = WSP(bf16_t, WS_U); const bf16_t* KV = WSP(bf16_t, WS_KVM) + (size_t)(g * BG + b) * 256 * 2048;
    const size_t r0 = (size_t)b * SEQ + qb * 32;
    LAS float* qs = (LAS float*)lds; LAS float* ps = (LAS float*)(lds + 32768);
    __syncthreads();
    for (int i = tid; i < 32 * 32; i += 512) { const int r = i >> 5, c8 = i & 31; const u32x4 w = *(const u32x4*)(U + (r0 + r) * NU + UCQ + h * 256 + c8 * 8); LAS float* d = qs + r * 256 + c8 * 8;
        d[0] = bf_lo(w.x); d[1] = bf_hi(w.x); d[2] = bf_lo(w.y); d[3] = bf_hi(w.y); d[4] = bf_lo(w.z); d[5] = bf_hi(w.z); d[6] = bf_lo(w.w); d[7] = bf_hi(w.w); }
    __syncthreads();
    const int mcol = tid & 255, rh = tid >> 8;
    { float a[16];
#pragma unroll
      for (int r = 0; r < 16; ++r) a[r] = 0.f;
      const bf16_t* kp = KV + (size_t)mcol * 2048 + h * 256;
      for (int d0 = 0; d0 < 256; d0 += 8) { const u32x4 w = *(const u32x4*)(kp + d0); float kv[8] = {bf_lo(w.x), bf_hi(w.x), bf_lo(w.y), bf_hi(w.y), bf_lo(w.z), bf_hi(w.z), bf_lo(w.w), bf_hi(w.w)};
#pragma unroll
          for (int r = 0; r < 16; ++r) { const LAS f32x4* qp = (const LAS f32x4*)(qs + (rh * 16 + r) * 256 + d0); const f32x4 qa = qp[0], qc = qp[1];
              a[r] += qa[0] * kv[0] + qa[1] * kv[1] + qa[2] * kv[2] + qa[3] * kv[3] + qc[0] * kv[4] + qc[1] * kv[5] + qc[2] * kv[6] + qc[3] * kv[7]; } }
#pragma unroll
      for (int r = 0; r < 16; ++r) ps[(rh * 16 + r) * 256 + mcol] = a[r]; }
    __syncthreads();
#pragma unroll
    for (int rr = 0; rr < 4; ++rr) { const int r = wave * 4 + rr; LAS f32x4* pr = (LAS f32x4*)(ps + r * 256) + lane; f32x4 v = *pr;
        const float mx = wave_max(fmaxf(fmaxf(v[0], v[1]), fmaxf(v[2], v[3])));
        v = (f32x4){__expf(v[0] - mx), __expf(v[1] - mx), __expf(v[2] - mx), __expf(v[3] - mx)};
        const float inv = 1.f / wave_sum((v[0] + v[1]) + (v[2] + v[3])); *pr = v * inv; }
    __syncthreads();
    { float a[16];
#pragma unroll
      for (int r = 0; r < 16; ++r) a[r] = 0.f;
      const bf16_t* vp = KV + 1024 + h * 256 + mcol;
      for (int m = 0; m < 256; ++m) { const float vv = bf2f(vp[(size_t)m * 2048]);
#pragma unroll
          for (int r = 0; r < 16; ++r) a[r] += ps[(rh * 16 + r) * 256 + m] * vv; }
      bf16_t* yp = WSP(bf16_t, WS_Y) + (r0 + rh * 16) * 3072 + 2048 + h * 256 + mcol;
#pragma unroll
      for (int r = 0; r < 16; ++r) yp[(size_t)r * 3072] = (bf16_t)(cvt_pk_bf16(a[r], 0.f) & 0xffffu); }
    __syncthreads();
}

DI void mlstm_naive_item(PP pk_, int g, int item, LAS unsigned char* lds) { const P p = load_args(pk_);
    const int tid = tid_local(), v = tid >> 3, kc = tid & 7;
    const int sl = item & 3, h = (item >> 2) & 3, b = item >> 4;
    const bf16_t* U = WSP(bf16_t, WS_U); const float* gif = WSP(float, WS_GIF); float* HT = WSP(float, WS_F32);
    const size_t rbase = (size_t)b * SEQ; const size_t tbase = ((size_t)g * BG + b) * SEQ;
    LAS bf16_t* qs = (LAS bf16_t*)lds; LAS bf16_t* ks = (LAS bf16_t*)(lds + 32768); LAS float* vs = (LAS float*)(lds + 65536); LAS float* gi = (LAS float*)(lds + 81920); LAS float* gf = (LAS float*)(lds + 82176);
    float C[32], nn[32];
#pragma unroll
    for (int i = 0; i < 32; ++i) { C[i] = 0.f; nn[i] = 0.f; }
    float mst = 0.f;
    for (int ch = 0; ch < SEQ / 64; ++ch) {
        __syncthreads();
        for (int i = tid; i < 2 * 64 * 32; i += 512) { const int isk = i >> 11, s = (i >> 5) & 63, c8 = i & 31; const int ts = ch * 64 + s; const int col = (isk ? UMK : UMQ) + h * 256 + c8 * 8;
            float a[8];
#pragma unroll
            for (int e = 0; e < 8; ++e) a[e] = 0.f;
#pragma unroll
            for (int j = 0; j < 4; ++j) { const int tt = ts - 3 + j; if (tt >= 0) { const u32x4 w = *(const u32x4*)(U + (rbase + tt) * NU + col); const float* cw = p.conv_w + j * 2048 + isk * 1024 + h * 256 + c8 * 8;
                    a[0] += cw[0] * bf_lo(w.x); a[1] += cw[1] * bf_hi(w.x); a[2] += cw[2] * bf_lo(w.y); a[3] += cw[3] * bf_hi(w.y); a[4] += cw[4] * bf_lo(w.z); a[5] += cw[5] * bf_hi(w.z); a[6] += cw[6] * bf_lo(w.w); a[7] += cw[7] * bf_hi(w.w); } }
            const float sc = isk ? 0.0625f : 1.f; u32x4 o; o.x = cvt_pk_bf16(silu(a[0]) * sc, silu(a[1]) * sc); o.y = cvt_pk_bf16(silu(a[2]) * sc, silu(a[3]) * sc); o.z = cvt_pk_bf16(silu(a[4]) * sc, silu(a[5]) * sc); o.w = cvt_pk_bf16(silu(a[6]) * sc, silu(a[7]) * sc);
            *(LAS u32x4*)((isk ? ks : qs) + s * 256 + c8 * 8) = o; }
        for (int i = tid; i < 64 * 64; i += 512) { const int s = i >> 6, c = i & 63; vs[i] = bf2f(U[(rbase + ch * 64 + s) * NU + UMV + h * 256 + sl * 64 + c]); }
        if (tid < 64) { gi[tid] = gif[(tbase + ch * 64 + tid) * 8 + h]; gf[tid] = gif[(tbase + ch * 64 + tid) * 8 + 4 + h]; }
        __syncthreads();
        for (int s = 0; s < 64; ++s) {
            const float ip = gi[s], fp = gf[s];
            const float fl = fminf(fp, 0.f) - log1pf(expf(-fabsf(fp)));
            const float mm = fmaxf(fl + mst, ip), fg = expf(fl + mst - mm), ig = expf(ip - mm); mst = mm;
            const float vv = vs[s * 64 + v] * ig;
            const LAS u32x4* kp = (const LAS u32x4*)(ks + s * 256 + kc * 32); const LAS u32x4* qp = (const LAS u32x4*)(qs + s * 256 + kc * 32);
            float num = 0.f, den = 0.f;
#pragma unroll
            for (int c4 = 0; c4 < 4; ++c4) { const u32x4 kw = kp[c4], qw = qp[c4];
#pragma unroll
                for (int e = 0; e < 4; ++e) { const float k0 = bf_lo(kw[e]), k1 = bf_hi(kw[e]), q0 = bf_lo(qw[e]), q1 = bf_hi(qw[e]); const int kk = c4 * 8 + 2 * e;
                    C[kk] = fg * C[kk] + vv * k0; nn[kk] = fg * nn[kk] + ig * k0; num += C[kk] * q0; den += nn[kk] * q0;
                    C[kk + 1] = fg * C[kk + 1] + vv * k1; nn[kk + 1] = fg * nn[kk + 1] + ig * k1; num += C[kk + 1] * q1; den += nn[kk + 1] * q1; } }
            num += __shfl_xor(num, 1); num += __shfl_xor(num, 2); num += __shfl_xor(num, 4);
            den += __shfl_xor(den, 1); den += __shfl_xor(den, 2); den += __shfl_xor(den, 4);
            if (kc == 0) HT[(rbase + ch * 64 + s) * 1024 + h * 256 + sl * 64 + v] = num / fmaxf(fabsf(den), expf(-mst));
        }
    }
    __syncthreads();
}

DI void ph_mix_naive(PP pk_, int g, LAS unsigned char* lds) { const P p = load_args(pk_);
    constexpr int N_ML = BG * 4 * 4, N_AT = BG * 8 * 32, N_XA = BG * 4 * 64;
    for (int it = blockIdx.x; it < N_ML + N_AT + N_XA; it += gridDim.x) {
        if (it < N_ML) mlstm_naive_item(pk_, g, it, lds);
        else if (it < N_ML + N_AT) attn_naive_item(pk_, N_AT - 1 - (it - N_ML), lds);
        else xattn_naive_item(pk_, g, it - N_ML - N_AT, lds);
    }
}

DI void ph_mlstm_out(PP pk_, int g, LAS unsigned char* lds) { const P p = load_args(pk_);
    const int tid = tid_local(), lane = tid & 63, wave = tid >> 6, gw = blockIdx.x * 8 + wave, NGW = gridDim.x * 8;
    const float* HT = WSP(float, WS_F32); const bf16_t* U = WSP(bf16_t, WS_U); bf16_t* Y = WSP(bf16_t, WS_Y);
    for (int it = gw; it < TG * 4; it += NGW) { const int r = it >> 2, h = it & 3;
        const f32x4 v = *((const f32x4*)(HT + (size_t)r * 1024 + h * 256) + lane);
        const float mu = wave_sum((v[0] + v[1]) + (v[2] + v[3])) * (1.f / 256.f); const f32x4 d = v - mu;
        const float rstd = rsqrtf(wave_sum((d[0] * d[0] + d[1] * d[1]) + (d[2] * d[2] + d[3] * d[3])) * (1.f / 256.f) + LN_EPS);
        const f32x4 gn = *((const f32x4*)(p.mlstm_norm_g + h * 256) + lane);
        const u32x2 ow = *((const u32x2*)(U + (size_t)r * NU + UMO + h * 256) + lane);
        u32x2 o; o.x = cvt_pk_bf16(d[0] * rstd * gn[0] * sigm(bf_lo(ow.x)), d[1] * rstd * gn[1] * sigm(bf_hi(ow.x))); o.y = cvt_pk_bf16(d[2] * rstd * gn[2] * sigm(bf_lo(ow.y)), d[3] * rstd * gn[3] * sigm(bf_hi(ow.y)));
        *((u32x2*)(Y + (size_t)r * 3072 + 1024 + h * 256) + lane) = o; }
}

DI void ph_ln1(PP pk_, int g, LAS unsigned char* lds) { const P p = load_args(pk_);
    const int tid = tid_local(), lane = tid & 63, wave = tid >> 6, gw = blockIdx.x * 8 + wave, NGW = gridDim.x * 8;
    const float* Z = WSP(float, WS_Z); bf16_t* X1 = WSP(bf16_t, WS_X1B) + (size_t)g * TG * 1024;
    for (int r = gw; r < TG; r += NGW) {
        const f32x4* zr = (const f32x4*)(Z + (size_t)r * 1024) + lane; f32x4 v[4]; float s = 0.f;
#pragma unroll
        for (int j = 0; j < 4; ++j) { v[j] = zr[64 * j]; s += (v[j][0] + v[j][1]) + (v[j][2] + v[j][3]); }
        const float mu = wave_sum(s) * (1.f / 1024.f); float s2 = 0.f;
#pragma unroll
        for (int j = 0; j < 4; ++j) { v[j] = v[j] - mu; s2 += (v[j][0] * v[j][0] + v[j][1] * v[j][1]) + (v[j][2] * v[j][2] + v[j][3] * v[j][3]); }
        const float rstd = rsqrtf(wave_sum(s2) * (1.f / 1024.f) + LN_EPS);
        u32x2* d = (u32x2*)(X1 + (size_t)r * 1024) + lane;
#pragma unroll
        for (int j = 0; j < 4; ++j) { const f32x4 gn = *((const f32x4*)p.ln1_g + lane + 64 * j), bb = *((const f32x4*)p.ln1_b + lane + 64 * j); const f32x4 o = v[j] * rstd * gn + bb;
            u32x2 w; w.x = cvt_pk_bf16(o[0], o[1]); w.y = cvt_pk_bf16(o[2], o[3]); d[64 * j] = w; }
    }
}
DI void ph_expert_weights(PP pk_, LAS unsigned char* lds) { const P p = load_args(pk_);
    const int tid = tid_local(), lane = tid & 63, wave = tid >> 6, gw = blockIdx.x * 8 + wave, NGW = gridDim.x * 8;
    LAS float* scr = (LAS float*)(lds + wave * 16384);
    bf16_t* WGU = WSP(bf16_t, WS_WGU); bf16_t* WD = WSP(bf16_t, WS_WD);
    for (int it = gw; it < 257 * 256; it += NGW) { const int e = it >> 8, r = it & 255, isup = r >> 7, kb = (r >> 3) & 15, nb = r & 7;
        const float* W = (e < 256) ? ((isup ? p.w_e_up : p.w_e_gate) + (size_t)e * 1024 * 256) : (isup ? p.w_s_up : p.w_s_gate);
        const int n0 = nb * 32, drow = (n0 >> 7) * 256 + (n0 & 127) + isup * 128;
        transpose_item(W, 256, n0, WGU + (size_t)e * 512 * 1024, 1024, drow, kb * 64, scr, lane); }
    for (int it = gw; it < 257 * 128; it += NGW) { const int e = it >> 7, r = it & 127, kb = r >> 5, nb = r & 31;
        const float* W = (e < 256) ? (p.w_e_down + (size_t)e * 256 * 1024) : p.w_s_down;
        transpose_item(W, 1024, nb * 32, WD + (size_t)e * 1024 * 256, 256, nb * 32, kb * 64, scr, lane); }
}

DI void ph_topk(PP pk_, LAS unsigned char* lds) { const P p = load_args(pk_);
    const int tid = tid_local(), lane = tid & 63, wave = tid >> 6, gw = blockIdx.x * 8 + wave, NGW = gridDim.x * 8;
    const float* LG = WSP(float, WS_LOGIT); int* TKI = WSP(int, WS_TKI); float* TKW = WSP(float, WS_TKW); unsigned* cnt = WSP(unsigned, WS_CTL) + CW_CNT;
    int* tokof = WSP(int, WS_TOKOF); float* wof = WSP(float, WS_WOF);
    for (int i = blockIdx.x * 512 + tid; i < MAXRT * 256; i += gridDim.x * 512) { tokof[i] = 0; wof[i] = 0.f; }
    const f32x4 rb = *((const f32x4*)p.router_bias + lane);
    for (int t = gw; t < T_ALL; t += NGW) {
        const f32x4 lg = *((const f32x4*)(LG + (size_t)t * 256) + lane);
        float sc[4], ch[4];
#pragma unroll
        for (int j = 0; j < 4; ++j) { sc[j] = 1.f / (1.f + expf(-lg[j])); ch[j] = sc[j] + rb[j]; }
        const float m01 = fmaxf(ch[0], ch[1]), n01 = fminf(ch[0], ch[1]), m23 = fmaxf(ch[2], ch[3]), n23 = fminf(ch[2], ch[3]);
        float a1 = fmaxf(m01, m23), a2 = fmaxf(fminf(m01, m23), fmaxf(n01, n23));
#pragma unroll
        for (int o = 1; o < 8; o <<= 1) { const float b1 = __shfl_xor(a1, o), b2 = __shfl_xor(a2, o); const float n1 = fmaxf(a1, b1), n2 = fmaxf(fminf(a1, b1), fmaxf(a2, b2)); a1 = n1; a2 = n2; }
        const float gs = a1 + a2; const int myg = lane >> 3; int rank = 0;
#pragma unroll
        for (int g2 = 0; g2 < 8; ++g2) { const float og = __shfl(gs, 8 * g2); rank += (og > gs || (og == gs && g2 < myg)) ? 1 : 0; }
        if (rank >= 4) { ch[0] = -INFINITY; ch[1] = -INFINITY; ch[2] = -INFINITY; ch[3] = -INFINITY; }
        int myidx = 0; float mys = 0.f, ssum = 0.f;
#pragma unroll
        for (int r = 0; r < 8; ++r) {
            float bv = ch[0]; int bi = 4 * lane;
#pragma unroll
            for (int j = 1; j < 4; ++j) if (ch[j] > bv) { bv = ch[j]; bi = 4 * lane + j; }
#pragma unroll
            for (int o = 32; o >= 1; o >>= 1) { const float ov = __shfl_xor(bv, o); const int oi = __shfl_xor(bi, o); if (ov > bv || (ov == bv && oi < bi)) { bv = ov; bi = oi; } }
            const int jl = bi & 3; const float scsel = jl == 0 ? sc[0] : (jl == 1 ? sc[1] : (jl == 2 ? sc[2] : sc[3]));
            const float sv = __shfl(scsel, bi >> 2);
            if ((bi >> 2) == lane) { if (jl == 0) ch[0] = -INFINITY; else if (jl == 1) ch[1] = -INFINITY; else if (jl == 2) ch[2] = -INFINITY; else ch[3] = -INFINITY; }
            ssum += sv; if (lane == r) { myidx = bi; mys = sv; }
        }
        if (lane < 8) { TKI[(size_t)t * 8 + lane] = myidx; TKW[(size_t)t * 8 + lane] = mys / (ssum + 1e-20f) * 2.5f; atomicAdd(cnt + myidx, 1u); }
    }
}

DI void ph_scan(PP pk_, LAS unsigned char* lds) { const P p = load_args(pk_);
    if (blockIdx.x != 0) return;
    const int tid = tid_local();
    const unsigned* cnt = WSP(unsigned, WS_CTL) + CW_CNT; int* tbase = WSP(int, WS_MISC + MS_TBASE); int* nt = WSP(int, WS_MISC + MS_NT); int* tile_e = WSP(int, WS_MISC + MS_TILEE);
    LAS int* sb = (LAS int*)lds;
    if (tid < 256) sb[tid] = (int)((cnt[tid] + 255u) >> 8);
    __syncthreads();
    if (tid == 0) { int a = 0; for (int e = 0; e < 256; ++e) { const int n = sb[e]; sb[e] = a; a += n; } sb[256] = a; }
    __syncthreads();
    const int nrt = sb[256];
    if (tid < 256) { const int b0 = sb[tid], b1 = sb[tid + 1]; tbase[tid] = b0; for (int t = b0; t < b1; ++t) tile_e[t] = tid; tile_e[nrt + tid] = 256; }
    if (tid == 0) { tbase[256] = nrt; nt[0] = nrt; nt[1] = nrt + 256; }
    __syncthreads();
}

DI void ph_slots(PP pk_, LAS unsigned char* lds) { const P p = load_args(pk_);
    const int tid = tid_local();
    const int* TKI = WSP(int, WS_TKI); const float* TKW = WSP(float, WS_TKW); unsigned* cur = WSP(unsigned, WS_CTL) + CW_CUR; const int* tbase = WSP(int, WS_MISC + MS_TBASE);
    int* tokof = WSP(int, WS_TOKOF); float* wof = WSP(float, WS_WOF); int* slotof = WSP(int, WS_SLOTOF);
    const int s0 = tbase[256] * 256;
    for (int i = blockIdx.x * 512 + tid; i < T_ALL * 8; i += gridDim.x * 512) { const int e = TKI[i]; const int slot = tbase[e] * 256 + (int)atomicAdd(cur + e, 1u); tokof[slot] = i >> 3; wof[slot] = TKW[i]; slotof[i] = slot; }
    for (int t = blockIdx.x * 512 + tid; t < T_ALL; t += gridDim.x * 512) { tokof[s0 + t] = t; wof[s0 + t] = 1.f; }
}

DI void ph_combine(PP pk_, int round, LAS unsigned char* lds) { const P p = load_args(pk_);
    const int tid = tid_local();
    const bf16_t* Y = WSP(bf16_t, WS_YCH); const bf16_t* X1 = WSP(bf16_t, WS_X1B); const int* slotof = WSP(int, WS_SLOTOF); const int s0 = WSP(int, WS_MISC + MS_TBASE)[256] * 256;
    for (int i = blockIdx.x * 512 + tid; i < T_ALL * 32; i += gridDim.x * 512) { const int t = i >> 5, c8 = (i & 31) * 8;
        const u32x4 xw = *(const u32x4*)(X1 + (size_t)t * 1024 + round * 256 + c8);
        float a[8] = {bf_lo(xw.x) * ALPHA, bf_hi(xw.x) * ALPHA, bf_lo(xw.y) * ALPHA, bf_hi(xw.y) * ALPHA, bf_lo(xw.z) * ALPHA, bf_hi(xw.z) * ALPHA, bf_lo(xw.w) * ALPHA, bf_hi(xw.w) * ALPHA};
#pragma unroll
        for (int k = 0; k < 9; ++k) { const int slot = k < 8 ? slotof[(size_t)t * 8 + k] : s0 + t; const u32x4 w = *(const u32x4*)(Y + (size_t)slot * 256 + c8);
            a[0] += bf_lo(w.x); a[1] += bf_hi(w.x); a[2] += bf_lo(w.y); a[3] += bf_hi(w.y); a[4] += bf_lo(w.z); a[5] += bf_hi(w.z); a[6] += bf_lo(w.w); a[7] += bf_hi(w.w); }
        float* op = p.out + (size_t)t * 1024 + round * 256 + c8; *(f32x4*)op = (f32x4){a[0], a[1], a[2], a[3]}; *(f32x4*)(op + 4) = (f32x4){a[4], a[5], a[6], a[7]}; }
}

DI void ph_ln2(PP pk_, LAS unsigned char* lds) { const P p = load_args(pk_);
    const int tid = tid_local(), lane = tid & 63, wave = tid >> 6, gw = blockIdx.x * 8 + wave, NGW = gridDim.x * 8;
    for (int r = gw; r < T_ALL; r += NGW) {
        f32x4* zr = (f32x4*)(p.out + (size_t)r * 1024) + lane; f32x4 v[4]; float s = 0.f;
#pragma unroll
        for (int j = 0; j < 4; ++j) { v[j] = zr[64 * j]; s += (v[j][0] + v[j][1]) + (v[j][2] + v[j][3]); }
        const float mu = wave_sum(s) * (1.f / 1024.f); float s2 = 0.f;
#pragma unroll
        for (int j = 0; j < 4; ++j) { v[j] = v[j] - mu; s2 += (v[j][0] * v[j][0] + v[j][1] * v[j][1]) + (v[j][2] * v[j][2] + v[j][3] * v[j][3]); }
        const float rstd = rsqrtf(wave_sum(s2) * (1.f / 1024.f) + LN_EPS);
#pragma unroll
        for (int j = 0; j < 4; ++j) { const f32x4 gn = *((const f32x4*)p.ln2_g + lane + 64 * j), bb = *((const f32x4*)p.ln2_b + lane + 64 * j); zr[64 * j] = v[j] * rstd * gn + bb; }
    }
}

__global__ void __launch_bounds__(512, 2) fwd(P p_unused) {
    extern __shared__ __attribute__((aligned(16))) unsigned char lds_raw[];
    LAS unsigned char* lds = (LAS unsigned char*)lds_raw;
    const int tid = threadIdx.x, G = gridDim.x, bid = blockIdx.x;
    volatile LAS unsigned* MISC = (volatile LAS unsigned*)(lds + LDS_MISC);
    if (tid < 32) MISC[tid] = 0u;
    __syncthreads();
    const int lo = kargs()->s_lo, hi = kargs()->s_hi;
    XcdBarrier bar; { unsigned* bw = (unsigned*)(kargs()->ws + WS_CTL) + CW_BAR; bar.bar = bw; bar.x = 0; bar.st = nullptr; if (hi - lo > 1) bar = xcd_barrier_post(bw, MISC + 8); }
    int s = 0;
#define STEP_BEGIN if (s >= lo && s < hi) { PP pk_ = kargs(); const P p = load_args(pk_);
#define STEP_END if (s + 1 < hi) xcd_barrier(bar); } ++s;

    STEP_BEGIN ph_prologue(pk_, lds); STEP_END
    for (int g = 0; g < NGRP; ++g) {
        STEP_BEGIN ph_xconv(pk_, g, lds); STEP_END
        STEP_BEGIN {
            pg8::Gemm gm{WSP(bf16_t, WS_XB), WSP(bf16_t, WS_WIN), 1024, 1024, 1024, nullptr}; pg8::StaticOrder S; S.init(TG, NU, G, bid);
            EpiInProj E{WSP(bf16_t, WS_U), WSP(float, WS_MISC + MS_BIAS)};
            pg8::gemm_phase<EpiInProj, pg8::StaticOrder, true>(lds, gm, S, E);
            if (g == 0) {
                pg8::Gemm gk{WSP(bf16_t, WS_MEMB), WSP(bf16_t, WS_WKV), 1024, 1024, 1024, nullptr}; pg8::StaticOrder S2; S2.init(NBATCH * 256, 2048, G, bid);
                EpiPlain E2{WSP(bf16_t, WS_KVM), 2048};
                pg8::gemm_phase<EpiPlain, pg8::StaticOrder, true>(lds, gk, S2, E2);
            }
        } STEP_END
        STEP_BEGIN ph_mix_naive(pk_, g, lds); STEP_END
        STEP_BEGIN ph_mlstm_out(pk_, g, lds); STEP_END
        STEP_BEGIN {
            pg8::Gemm gm{WSP(bf16_t, WS_Y), WSP(bf16_t, WS_WBR), 3072, 1024, 1024, nullptr}; BranchOrder S{(TG / 256) * 4, G, bid};
            EpiBranch E{WSP(bf16_t, WS_U), WSP(float, WS_F32), WSP(bf16_t, WS_MRG)};
            pg8::gemm_phase<EpiBranch, BranchOrder, true>(lds, gm, S, E);
        } STEP_END
        STEP_BEGIN {
            pg8::Gemm gm{WSP(bf16_t, WS_MRG), WSP(bf16_t, WS_WOUT), 1024, 1024, 1024, nullptr}; pg8::StaticOrder S; S.init(TG, 1024, G, bid);
            EpiOutProj E{p.x + (size_t)g * TG * 1024, WSP(float, WS_Z)};
            pg8::gemm_phase<EpiOutProj, pg8::StaticOrder, true>(lds, gm, S, E);
        } STEP_END
        STEP_BEGIN ph_ln1(pk_, g, lds); STEP_END
    }
    STEP_BEGIN {
        pg8::Gemm gm{WSP(bf16_t, WS_X1B), WSP(bf16_t, WS_WR), 1024, 1024, 1024, nullptr}; pg8::StaticOrder S; S.init(T_ALL, 256, G, bid);
        EpiF32 E{WSP(float, WS_LOGIT), 256};
        pg8::gemm_phase<EpiF32, pg8::StaticOrder, true>(lds, gm, S, E);
        ph_expert_weights(pk_, lds);
    } STEP_END
    STEP_BEGIN ph_topk(pk_, lds); STEP_END
    STEP_BEGIN ph_scan(pk_, lds); STEP_END
    STEP_BEGIN ph_slots(pk_, lds); STEP_END
    STEP_BEGIN {
        const int* ntp = WSP(int, WS_MISC + MS_NT);
        pg8::Gemm gm{WSP(bf16_t, WS_X1B), WSP(bf16_t, WS_WGU), 1024, 1024, 1024, WSP(int, WS_TOKOF)}; ExpertGUOrder S{WSP(int, WS_MISC + MS_TILEE), ntp[1] * 2, G, bid};
        EpiGateUp E{WSP(bf16_t, WS_ACT)};
        pg8::gemm_phase<EpiGateUp, ExpertGUOrder, true, true>(lds, gm, S, E);
    } STEP_END
    for (int r = 0; r < 4; ++r) {
        STEP_BEGIN {
            const int* ntp = WSP(int, WS_MISC + MS_NT);
            pg8::Gemm gm{WSP(bf16_t, WS_ACT), WSP(bf16_t, WS_WD), 256, 256, 256, nullptr}; ExpertDownOrder S{WSP(int, WS_MISC + MS_TILEE), ntp[1], G, bid, r};
            EpiDown E{WSP(bf16_t, WS_YCH), WSP(float, WS_WOF)};
            pg8::gemm_phase<EpiDown, ExpertDownOrder, true>(lds, gm, S, E);
        } STEP_END
        STEP_BEGIN ph_combine(pk_, r, lds); STEP_END
    }
    STEP_BEGIN ph_ln2(pk_, lds); STEP_END
}
constexpr int NSTEPS = 1 + NGRP * 7 + 5 + 8 + 1;

extern "C" void kernel_launch(void* const* d_in, const int* in_sizes, int n_in, void* d_out, int out_size, void* d_ws, size_t ws_size, hipStream_t stream) {
    static int grid = 0;
    if (grid == 0) {
        int dev = 0, cus = 0;
        if (hipGetDevice(&dev) != hipSuccess || hipDeviceGetAttribute(&cus, hipDeviceAttributeMultiprocessorCount, dev) != hipSuccess) { fprintf(stderr, "kernel_launch: device query failed\n"); grid = -1; return; }
        if (hipFuncSetAttribute((const void*)fwd, hipFuncAttributeMaxDynamicSharedMemorySize, LDS_BYTES) != hipSuccess) { fprintf(stderr, "kernel_launch: hipFuncSetAttribute failed\n"); grid = -1; return; }
        if (n_in != 24 || ws_size < WS_END) fprintf(stderr, "kernel_launch: n_in %d ws %zu (need %zu)\n", n_in, ws_size, (size_t)WS_END);
        grid = cus;
    }
    if (grid < 0) return;
    (void)hipMemsetAsync((char*)d_ws + WS_CTL, 0, CTL_BYTES, stream);
    P p{};
    const float** pp = (const float**)&p;
    for (int i = 0; i < 24; ++i) pp[i] = (const float*)d_in[i];
    p.out = (float*)d_out; p.ws = (unsigned char*)d_ws;
#ifndef ONE_LAUNCH
    for (int s = 0; s < NSTEPS; ++s) { p.s_lo = s; p.s_hi = s + 1; hipLaunchKernelGGL(fwd, dim3(grid), dim3(512), LDS_BYTES, stream, p); }
#else
    p.s_lo = 0; p.s_hi = NSTEPS; hipLaunchKernelGGL(fwd, dim3(grid), dim3(512), LDS_BYTES, stream, p);
#endif
}
```

```cpp
#define ONE_LAUNCH 1
#include <hip/hip_runtime.h>
#include <cstdio>
#include <cstdint>
#define DI __device__ __forceinline__
#define LAS __attribute__((address_space(3)))
#define GAS __attribute__((address_space(1)))
typedef unsigned short bf16_t;
typedef short bf16x8 __attribute__((ext_vector_type(8)));
typedef float f32x4 __attribute__((ext_vector_type(4)));
typedef float f32x2 __attribute__((ext_vector_type(2)));
typedef unsigned u32x4 __attribute__((ext_vector_type(4)));
typedef unsigned u32x2 __attribute__((ext_vector_type(2)));

constexpr int T_ALL = 65536, DM = 1024, SEQ = 2048, NBATCH = 32, NGRP = 4, TG = T_ALL / NGRP, BG = NBATCH / NGRP;
constexpr int NU = 11264, CIN = 11272;
constexpr int UQ = 0, UK = 1024, UV = 2048, UMQ = 3072, UMK = 4096, UMV = 5120, UMO = 6144, UCQ = 7168, UGT = 8192;
constexpr int NEXP = 256, MAXRT = 2304, MAXTILES = MAXRT + 256, MAXSLOTS = MAXTILES * 256;
constexpr float ALPHA = 1.189207115002721f;
constexpr float LN_EPS = 1e-5f;

constexpr size_t MiB = 1ull << 20;
constexpr size_t WS_CTL = 0, CTL_BYTES = 1 * MiB;
constexpr size_t WS_MISC = 1 * MiB;
constexpr size_t WS_WIN = 2 * MiB, WS_WKV = 24 * MiB, WS_WBR = 28 * MiB, WS_WOUT = 34 * MiB, WS_WR = 36 * MiB;
constexpr size_t WS_GIF = 38 * MiB, WS_MEMB = 40 * MiB, WS_KVM = 56 * MiB, WS_X1B = 88 * MiB, WS_R = 216 * MiB;
constexpr size_t WS_XB = WS_R, WS_U = WS_R + 32 * MiB, WS_Y = WS_R + 384 * MiB, WS_F32 = WS_R + 480 * MiB, WS_MRG = WS_R + 544 * MiB, WS_Z = WS_R + 576 * MiB;
constexpr size_t WS_TKI = WS_R, WS_TKW = WS_R + 2 * MiB, WS_SLOTOF = WS_R + 4 * MiB, WS_TOKOF = WS_R + 6 * MiB, WS_WOF = WS_R + 9 * MiB;
constexpr size_t WS_LOGIT = WS_R + 16 * MiB, WS_WGU = WS_R + 80 * MiB, WS_WD = WS_R + 337 * MiB, WS_ACT = WS_R + 580 * MiB, WS_YCH = WS_R + 16 * MiB;
constexpr size_t WS_END = WS_R + 900 * MiB;
constexpr size_t MS_BIAS = 0, MS_LAM = 48 * 1024, MS_TBASE = 52 * 1024, MS_NT = 56 * 1024, MS_TILEE = 64 * 1024;
constexpr int CW_CNT = 1024, CW_CUR = 2048, CW_BAR = 8192, CW_Q = 16384;

constexpr int LDS_RING = 131072, LDS_MISC = LDS_RING + 320, LDS_BYTES = 147456;

DI float bf_lo(unsigned w) { return __uint_as_float(w << 16); }
DI float bf_hi(unsigned w) { return __uint_as_float(w & 0xffff0000u); }
DI float bf2f(bf16_t b) { return __uint_as_float((unsigned)b << 16); }
DI unsigned cvt_pk_bf16(float lo, float hi) { unsigned r; asm("v_cvt_pk_bf16_f32 %0, %1, %2" : "=v"(r) : "v"(lo), "v"(hi)); return r; }
DI float wave_sum(float v) {
#pragma unroll
    for (int o = 1; o < 64; o <<= 1) v += __shfl_xor(v, o);
    return v;
}
DI float wave_max(float v) {
#pragma unroll
    for (int o = 1; o < 64; o <<= 1) v = fmaxf(v, __shfl_xor(v, o));
    return v;
}
DI float sigm(float x) { return 1.f / (1.f + __expf(-x)); }
DI float silu(float x) { return x / (1.f + __expf(-x)); }
DI int tid_local() { int t = threadIdx.x; asm volatile("" : "+v"(t)); return t; }
#define LDS_WAIT() asm volatile("s_waitcnt lgkmcnt(0)" ::: "memory")
namespace pg8 {
constexpr int BM = 256, BK = 64, HALF = 128, HTB = HALF * BK * 2, STAGE_BYTES = 8 * HTB, NXCD = 8, WGM = 8;
__host__ __device__ __forceinline__ int lds_byte(int r, int c) { const int st = (r >> 4) * 2 + (c >> 5), rr = r & 15, cc = c & 31, ob = rr * 64 + cc * 2; return st * 1024 + (ob ^ (((ob >> 9) & 1) << 5)); }
__host__ __device__ __forceinline__ void stage_rc(int b, int& R, int& C) { const int st = b / 1024, sb = b % 1024, swz = sb ^ (((sb >> 9) & 1) << 5); R = (st >> 1) * 16 + swz / 64; C = (st & 1) * 32 + (swz % 64) / 2; }
__host__ __device__ __forceinline__ int perm32(int rho) { const int n = rho >> 4, i = rho & 15; return 8 * (i >> 2) + 4 * n + (i & 3); }

struct Unit { int pm, pn, pb, acol, aux; };
struct Gemm { const bf16_t* A; const bf16_t* Bt; int lda, ldb, K; const int* arow; };

struct StaticOrder {
    int nM, nN, nwg, G, c;
    DI void init(int M, int N, int G_, int c_) { nM = M / BM; nN = N / BM; nwg = nM * nN; G = G_; c = c_; }
    DI bool next(int i, Unit& u) const {
        const long L = (long)i * G + c; if (L >= nwg) return false;
        int wgid = (int)L; { const int q = nwg / NXCD, r = nwg % NXCD, xcd = wgid % NXCD, off = wgid / NXCD; wgid = (xcd < r ? xcd * (q + 1) : r * (q + 1) + (xcd - r) * q) + off; }
        const int nig = WGM * nN, gid = wgid / nig, fm = gid * WGM, gsz = (nM - fm) < WGM ? (nM - fm) : WGM;
        u.pm = fm + ((wgid % nig) % gsz); u.pn = (wgid % nig) / gsz; u.pb = u.pn; u.acol = 0; u.aux = 0; return true;
    }
};

template <class Epi, class Sched, bool ALIGN_EPI, bool GATHER = false>
DI void gemm_phase(LAS unsigned char* lds, const Gemm g, const Sched& S, const Epi& E) {
    const int tid = tid_local(), wid = __builtin_amdgcn_readfirstlane(tid >> 6), lane = tid & 63, wr = wid >> 2, wc = wid & 3, fr = lane & 15, fq = lane >> 4;
    const int nt = g.K / BK;
    int Ra[2], Ca[2], Rb[2];
#pragma unroll
    for (int i = 0; i < 2; ++i) { int R, C; stage_rc(tid * 16 + i * 8192, R, C); Ra[i] = R; Ca[i] = C; Rb[i] = (R & ~31) + perm32(R & 31); }
    const size_t kstep = (size_t)(BK * 2);
    const unsigned ldsw = (unsigned)wid * 1024u;
    const int aoff = lds_byte(wr * 64 + fr, fq * 8), boff = lds_byte(wc * 32 + fr, fq * 8);
#define PG8_SA(b, h) (((b) * 2 + (h)) * HTB)
#define PG8_SB(b, h) ((4 + (b) * 2 + (h)) * HTB)
#define PG8_STAGE(bufoff, gptr, offs) do { _Pragma("unroll") for (int _i = 0; _i < 2; ++_i) \
        __builtin_amdgcn_global_load_lds((const unsigned*)((gptr) + (offs)[_i]), (LAS unsigned*)(lds + (bufoff) + ldsw + _i * 8192), 16, 0, 0); } while (0)
#define PG8_LDA(dst, b, h) do { _Pragma("unroll") for (int m = 0; m < 4; ++m) _Pragma("unroll") for (int k = 0; k < 2; ++k) dst[m][k] = *(const LAS bf16x8*)(lds + PG8_SA(b, h) + aoff + m * 2048 + k * 1024); } while (0)
#define PG8_LDB(dst, b, h) do { _Pragma("unroll") for (int n = 0; n < 2; ++n) _Pragma("unroll") for (int k = 0; k < 2; ++k) dst[n][k] = *(const LAS bf16x8*)(lds + PG8_SB(b, h) + boff + n * 2048 + k * 1024); } while (0)
#define PG8_MMA(ai, bj, At, Bt) do { __builtin_amdgcn_s_setprio(1); _Pragma("unroll") for (int m = 0; m < 4; ++m) _Pragma("unroll") for (int n = 0; n < 2; ++n) _Pragma("unroll") for (int k = 0; k < 2; ++k) \
        acc[ai][bj][m][n] = __builtin_amdgcn_mfma_f32_16x16x32_bf16(Bt[n][k], At[m][k], acc[ai][bj][m][n], 0, 0, 0); __builtin_amdgcn_s_setprio(0); } while (0)
#define PG8_WAIT_V(n) asm volatile("s_waitcnt vmcnt(" #n ")" ::: "memory")
#define PG8_WAIT_L(n) asm volatile("s_waitcnt lgkmcnt(" #n ")" ::: "memory")
#define PG8_BAR __builtin_amdgcn_s_barrier()
#define PG8_SCHED __builtin_amdgcn_sched_barrier(0)
#define PG8_OFFS(u, oa) do { _Pragma("unroll") for (int h_ = 0; h_ < 2; ++h_) _Pragma("unroll") for (int i_ = 0; i_ < 2; ++i_) { \
        const int ar_ = g.arow[(u).pm * BM + h_ * HALF + Ra[i_]]; oa[h_][i_] = (unsigned)(ar_ * g.lda + (u).acol + Ca[i_]) * 2u; } } while (0)
    unsigned voffA[2], voffB[2];
#pragma unroll
    for (int i = 0; i < 2; ++i) { voffA[i] = (unsigned)(Ra[i] * g.lda + Ca[i]) * 2u; voffB[i] = (unsigned)(Rb[i] * g.ldb + Ca[i]) * 2u; }
    const size_t hstepA = (size_t)HALF * g.lda * 2, hstepB = (size_t)HALF * g.ldb * 2;
#define PG8_ABASE(u) ((const char*)g.A + (GATHER ? (size_t)0 : ((size_t)(u).pm * BM * g.lda + (u).acol) * 2))
#define PG8_BBASE(u) ((const char*)g.Bt + (size_t)(u).pb * BM * g.ldb * 2)
#define PG8_STAGE_A(bufoff, ab, oa, h) do { if constexpr (GATHER) { PG8_STAGE(bufoff, ab, (oa)[h]); } else { PG8_STAGE(bufoff, (ab) + (h) * hstepA, voffA); } } while (0)
#define PG8_STAGE_B(bufoff, bb, h) PG8_STAGE(bufoff, (bb) + (h) * hstepB, voffB)
    Unit cur, nxt; int ui = 0;
    if (!S.next(0, cur)) return;
    f32x4 acc[2][2][4][2];
#pragma unroll
    for (int a = 0; a < 2; ++a)
#pragma unroll
        for (int b = 0; b < 2; ++b)
#pragma unroll
            for (int m = 0; m < 4; ++m)
#pragma unroll
                for (int n = 0; n < 2; ++n) acc[a][b][m][n] = (f32x4){0.f, 0.f, 0.f, 0.f};
    bf16x8 At[4][2], B0[2][2], B1[2][2];
    unsigned oaC[2][2], oaN[2][2];
    if constexpr (GATHER) { PG8_OFFS(cur, oaC); }
    const char* cA = PG8_ABASE(cur); const char* cB = PG8_BBASE(cur);
    PG8_STAGE_B(PG8_SB(0, 0), cB, 0); PG8_STAGE_B(PG8_SB(0, 1), cB, 1); PG8_STAGE_A(PG8_SA(0, 0), cA, oaC, 0); PG8_STAGE_A(PG8_SA(0, 1), cA, oaC, 1);
    if (wr == 1) PG8_BAR;
    PG8_WAIT_V(2); PG8_BAR;
    PG8_STAGE_B(PG8_SB(1, 0), cB + kstep, 0); PG8_STAGE_A(PG8_SA(1, 0), cA + kstep, oaC, 0); PG8_STAGE_B(PG8_SB(1, 1), cB + kstep, 1);
    PG8_WAIT_V(6); PG8_BAR;
    for (;;) {
        const bool has_next = S.next(ui + 1, nxt);
        const char* nA = has_next ? PG8_ABASE(nxt) : cA; const char* nB = has_next ? PG8_BBASE(nxt) : cB;
        if constexpr (GATHER) {
            if (has_next) { PG8_OFFS(nxt, oaN); }
            else {
#pragma unroll
                for (int h_ = 0; h_ < 2; ++h_)
#pragma unroll
                    for (int i_ = 0; i_ < 2; ++i_) oaN[h_][i_] = oaC[h_][i_];
            }
        }
#pragma unroll 1
        for (int t = 0; t < nt; t += 2) {
            const bool last = (t == nt - 2);
            const char* a1 = cA + (size_t)(t + 1) * kstep;
            const char* a2 = last ? nA : cA + (size_t)(t + 2) * kstep; const char* b2 = last ? nB : cB + (size_t)(t + 2) * kstep;
            const char* a3 = a2 + kstep; const char* b3 = b2 + kstep;
            unsigned oa2[2][2];
            if constexpr (GATHER) {
#pragma unroll
                for (int h_ = 0; h_ < 2; ++h_)
#pragma unroll
                    for (int i_ = 0; i_ < 2; ++i_) oa2[h_][i_] = last ? oaN[h_][i_] : oaC[h_][i_];
            }
            PG8_LDB(B0, 0, 0); PG8_LDB(B1, 0, 1); PG8_SCHED; PG8_LDA(At, 0, 0); PG8_STAGE_A(PG8_SA(1, 1), a1, oaC, 1);
            PG8_WAIT_V(8); PG8_WAIT_L(0); PG8_BAR; PG8_MMA(0, 0, At, B0); PG8_MMA(0, 1, At, B1); PG8_BAR; PG8_SCHED;
            PG8_LDA(At, 0, 1); PG8_STAGE_B(PG8_SB(0, 0), b2, 0); PG8_STAGE_B(PG8_SB(0, 1), b2, 1); PG8_STAGE_A(PG8_SA(0, 0), a2, oa2, 0);
            PG8_WAIT_V(8); PG8_WAIT_L(0); PG8_BAR; PG8_MMA(1, 0, At, B0); PG8_MMA(1, 1, At, B1); PG8_BAR; PG8_SCHED;
            PG8_LDB(B0, 1, 0); PG8_LDB(B1, 1, 1); PG8_SCHED; PG8_LDA(At, 1, 0); PG8_STAGE_A(PG8_SA(0, 1), a2, oa2, 1);
            PG8_WAIT_V(8); PG8_WAIT_L(0); PG8_BAR; PG8_MMA(0, 0, At, B0); PG8_MMA(0, 1, At, B1); PG8_BAR; PG8_SCHED;
            PG8_LDA(At, 1, 1); PG8_STAGE_B(PG8_SB(1, 0), b3, 0); PG8_STAGE_B(PG8_SB(1, 1), b3, 1); PG8_STAGE_A(PG8_SA(1, 0), a3, oa2, 0);
            PG8_WAIT_V(8); PG8_WAIT_L(0); PG8_BAR; PG8_MMA(1, 0, At, B0); PG8_MMA(1, 1, At, B1); PG8_BAR; PG8_SCHED;
        }
        if constexpr (ALIGN_EPI) { if (wr == 0) PG8_BAR; }
        E(acc, cur, wr, wc, fr, fq);
        if (!has_next) break;
#pragma unroll
        for (int a = 0; a < 2; ++a)
#pragma unroll
            for (int b = 0; b < 2; ++b)
#pragma unroll
                for (int m = 0; m < 4; ++m)
#pragma unroll
                    for (int n = 0; n < 2; ++n) acc[a][b][m][n] = (f32x4){0.f, 0.f, 0.f, 0.f};
        cur = nxt; cA = nA; cB = nB; ++ui;
        if constexpr (GATHER) {
#pragma unroll
            for (int h_ = 0; h_ < 2; ++h_)
#pragma unroll
                for (int i_ = 0; i_ < 2; ++i_) oaC[h_][i_] = oaN[h_][i_];
        }
        if constexpr (ALIGN_EPI) { if (wr == 1) PG8_BAR; }
    }
    PG8_WAIT_V(0);
    if constexpr (!ALIGN_EPI) { if (wr == 0) PG8_BAR; }
    PG8_BAR;
#undef PG8_SA
#undef PG8_SB
#undef PG8_STAGE
#undef PG8_LDA
#undef PG8_LDB
#undef PG8_MMA
#undef PG8_WAIT_V
#undef PG8_WAIT_L
#undef PG8_BAR
#undef PG8_SCHED
#undef PG8_OFFS
#undef PG8_ABASE
#undef PG8_BBASE
#undef PG8_STAGE_A
#undef PG8_STAGE_B
}
}
using pg8::Unit; using pg8::BM; using pg8::HALF;

struct BranchOrder {
    int ntile, G, c;
    DI bool next(int i, Unit& u) const {
        const int L = (i / 3) * G + c; if (L >= ntile) return false;
        const int n = i % 3; u.pm = L >> 2; u.pn = L & 3; u.pb = n * 4 + u.pn; u.acol = n * 1024; u.aux = n; return true;
    }
};
struct ExpertGUOrder {
    const int* tile_e; int nunits, G, c;
    DI bool next(int i, Unit& u) const {
        const int L = i * G + c; if (L >= nunits) return false;
        const int t = L >> 1, hf = L & 1; const int e = tile_e[t];
        u.pm = t; u.pn = hf; u.pb = e * 2 + hf; u.acol = 0; u.aux = e; return true;
    }
};
struct ExpertDownOrder {
    const int* tile_e; int nunits, G, c, round;
    DI bool next(int i, Unit& u) const {
        const int L = i * G + c; if (L >= nunits) return false;
        const int e = tile_e[L];
        u.pm = L; u.pn = 0; u.pb = e * 4 + round; u.acol = 0; u.aux = e; return true;
    }
};

#define EPI_ARGS const f32x4 (&acc)[2][2][4][2], const Unit& u, int wr, int wc, int fr, int fq
DI u32x4 pack8(const f32x4 v0, const f32x4 v1) { u32x4 w; w.x = cvt_pk_bf16(v0[0], v0[1]); w.y = cvt_pk_bf16(v0[2], v0[3]); w.z = cvt_pk_bf16(v1[0], v1[1]); w.w = cvt_pk_bf16(v1[2], v1[3]); return w; }

struct EpiInProj {
    bf16_t* O; const float* bias;
    DI void operator()(EPI_ARGS) const {
        const int row0 = u.pm * BM + wr * 64 + fr, col0 = u.pn * BM + wc * 32 + 8 * fq;
        const float sc = (u.pn < 4) ? 0.125f * 1.4426950408889634f : ((u.pn >= 28 && u.pn < 32) ? 0.0625f : 1.f);
        f32x4 bv[2][2];
#pragma unroll
        for (int bj = 0; bj < 2; ++bj)
#pragma unroll
            for (int n = 0; n < 2; ++n) bv[bj][n] = *(const f32x4*)(bias + col0 + bj * HALF + 4 * n);
#pragma unroll
        for (int ai = 0; ai < 2; ++ai)
#pragma unroll
            for (int m = 0; m < 4; ++m) { bf16_t* rowp = O + (size_t)(row0 + ai * HALF + m * 16) * NU + col0;
#pragma unroll
                for (int bj = 0; bj < 2; ++bj) *(u32x4*)(rowp + bj * HALF) = pack8((acc[ai][bj][m][0] + bv[bj][0]) * sc, (acc[ai][bj][m][1] + bv[bj][1]) * sc); }
    }
};
struct EpiPlain {
    bf16_t* O; int ldc;
    DI void operator()(EPI_ARGS) const {
        const int row0 = u.pm * BM + wr * 64 + fr, col0 = u.pn * BM + wc * 32 + 8 * fq;
#pragma unroll
        for (int ai = 0; ai < 2; ++ai)
#pragma unroll
            for (int m = 0; m < 4; ++m) { bf16_t* rowp = O + (size_t)(row0 + ai * HALF + m * 16) * ldc + col0;
#pragma unroll
                for (int bj = 0; bj < 2; ++bj) *(u32x4*)(rowp + bj * HALF) = pack8(acc[ai][bj][m][0], acc[ai][bj][m][1]); }
    }
};
struct EpiBranch {
    const bf16_t* U; float* F; bf16_t* M;
    DI void operator()(EPI_ARGS) const {
        const int row0 = u.pm * BM + wr * 64 + fr, col0 = u.pn * BM + wc * 32 + 8 * fq, n = u.aux;
#pragma unroll
        for (int ai = 0; ai < 2; ++ai)
#pragma unroll
            for (int m = 0; m < 4; ++m) { const size_t row = (size_t)(row0 + ai * HALF + m * 16);
#pragma unroll
                for (int bj = 0; bj < 2; ++bj) { const int col = col0 + bj * HALF;
                    const u32x4 gw = *(const u32x4*)(U + row * NU + UGT + n * 1024 + col);
                    f32x4 g0 = {sigm(bf_lo(gw.x)), sigm(bf_hi(gw.x)), sigm(bf_lo(gw.y)), sigm(bf_hi(gw.y))};
                    f32x4 g1 = {sigm(bf_lo(gw.z)), sigm(bf_hi(gw.z)), sigm(bf_lo(gw.w)), sigm(bf_hi(gw.w))};
                    f32x4 v0 = acc[ai][bj][m][0] * g0, v1 = acc[ai][bj][m][1] * g1;
                    float* fp = F + row * 1024 + col;
                    if (n > 0) { v0 += *(const f32x4*)fp; v1 += *(const f32x4*)(fp + 4); }
                    if (n < 2) { *(f32x4*)fp = v0; *(f32x4*)(fp + 4) = v1; }
                    else *(u32x4*)(M + row * 1024 + col) = pack8(v0, v1); }
                asm volatile("" ::: "memory"); }
    }
};
struct EpiOutProj {
    const float* X; float* Z;
    DI void operator()(EPI_ARGS) const {
        const int row0 = u.pm * BM + wr * 64 + fr, col0 = u.pn * BM + wc * 32 + 8 * fq;
#pragma unroll
        for (int ai = 0; ai < 2; ++ai)
#pragma unroll
            for (int m = 0; m < 4; ++m) { const size_t off = (size_t)(row0 + ai * HALF + m * 16) * 1024 + col0;
#pragma unroll
                for (int bj = 0; bj < 2; ++bj) { const float* xp = X + off + bj * HALF; float* zp = Z + off + bj * HALF;
                    *(f32x4*)zp = *(const f32x4*)xp * ALPHA + acc[ai][bj][m][0]; *(f32x4*)(zp + 4) = *(const f32x4*)(xp + 4) * ALPHA + acc[ai][bj][m][1]; }
                asm volatile("" ::: "memory"); }
    }
};
struct EpiF32 {
    float* O; int ldc;
    DI void operator()(EPI_ARGS) const {
        const int row0 = u.pm * BM + wr * 64 + fr, col0 = u.pn * BM + wc * 32 + 8 * fq;
#pragma unroll
        for (int ai = 0; ai < 2; ++ai)
#pragma unroll
            for (int m = 0; m < 4; ++m) { float* rowp = O + (size_t)(row0 + ai * HALF + m * 16) * ldc + col0;
#pragma unroll
                for (int bj = 0; bj < 2; ++bj) { *(f32x4*)(rowp + bj * HALF) = acc[ai][bj][m][0]; *(f32x4*)(rowp + bj * HALF + 4) = acc[ai][bj][m][1]; } }
    }
};
struct EpiGateUp {
    bf16_t* ACT;
    DI void operator()(EPI_ARGS) const {
        const int row0 = u.pm * BM + wr * 64 + fr, col0 = u.pn * HALF + wc * 32 + 8 * fq;
#pragma unroll
        for (int ai = 0; ai < 2; ++ai)
#pragma unroll
            for (int m = 0; m < 4; ++m) { f32x4 v[2];
#pragma unroll
                for (int n = 0; n < 2; ++n) { const f32x4 gt = acc[ai][0][m][n], up = acc[ai][1][m][n];
                    v[n] = (f32x4){silu(gt[0]) * up[0], silu(gt[1]) * up[1], silu(gt[2]) * up[2], silu(gt[3]) * up[3]}; }
                *(u32x4*)(ACT + (size_t)(row0 + ai * HALF + m * 16) * 256 + col0) = pack8(v[0], v[1]); }
    }
};
struct EpiDown {
    bf16_t* Y; const float* W;
    DI void operator()(EPI_ARGS) const {
        const int row0 = u.pm * BM + wr * 64 + fr, col0 = wc * 32 + 8 * fq;
#pragma unroll
        for (int ai = 0; ai < 2; ++ai)
#pragma unroll
            for (int m = 0; m < 4; ++m) { const int row = row0 + ai * HALF + m * 16; const float w = W[row];
#pragma unroll
                for (int bj = 0; bj < 2; ++bj) *(u32x4*)(Y + (size_t)row * 256 + col0 + bj * HALF) = pack8(acc[ai][bj][m][0] * w, acc[ai][bj][m][1] * w);
                asm volatile("" ::: "memory"); }
    }
};
#define RLX_AGENT __ATOMIC_RELAXED, __HIP_MEMORY_SCOPE_AGENT
#define XB_TMO      128
#define XB_XCNT(j)  (256  + 64 * (j))
#define XB_XSUB(j)  (1280 + 64 * (j))
#define XB_XGEN(j)  (2304 + 64 * (j))
#define XB_TOP      3328
#define XB_TOPGEN   3392
#define XCD_BAR_WORDS 3456
#define XB_SPIN_CAP (1u << 18)

__device__ __forceinline__ unsigned xb_ld(unsigned* p)              { return __hip_atomic_load(p, __ATOMIC_RELAXED, __HIP_MEMORY_SCOPE_AGENT); }
__device__ __forceinline__ unsigned xb_add(unsigned* p, unsigned v) { return __hip_atomic_fetch_add(p, v, __ATOMIC_RELAXED, __HIP_MEMORY_SCOPE_AGENT); }
__device__ __forceinline__ unsigned xb_xcc_id() { return (unsigned)__builtin_amdgcn_s_getreg((3 << 11) | 20) & 0xFu; }
#define XB_SPIN(cond, bar) do { unsigned _sp = 0; while (cond) { __builtin_amdgcn_s_sleep(1); \
    if ((++_sp & 255u) == 0u) { if (xb_ld(&(bar)[XB_TMO])) break; if (_sp > XB_SPIN_CAP) { atomicAdd(&(bar)[XB_TMO], 1u); break; } } } } while (0)

struct XcdBarrier {
    unsigned* bar; unsigned x;
    volatile LAS unsigned* st;
};

__device__ __forceinline__ XcdBarrier xcd_barrier_post(unsigned* bar, volatile LAS unsigned* st) {
    XcdBarrier b; b.bar = bar; b.x = xb_xcc_id(); b.st = st;
    if (threadIdx.x == 0) (void)xb_add(&bar[XB_XCNT(b.x)], 1u);
    return b;
}
__device__ __forceinline__ void xcd_barrier_complete(unsigned* bar, unsigned x, unsigned& nloc, unsigned& nx) {
    const unsigned G = gridDim.x * gridDim.y * gridDim.z;
    unsigned sum, cnt, mine, sp = 0u;
    for (;;) {
        sum = 0u; cnt = 0u; mine = 0u;
#pragma unroll
        for (unsigned j = 0; j < 16; ++j) { const unsigned c = xb_ld(&bar[XB_XCNT(j)]); sum += c; cnt += (c > 0u) ? 1u : 0u; mine = (j == x) ? c : mine; }
        if (sum == G) break;
        __builtin_amdgcn_s_sleep(1);
        if ((++sp & 255u) == 0u) { if (xb_ld(&bar[XB_TMO])) break; if (sp > XB_SPIN_CAP) { atomicAdd(&bar[XB_TMO], 1u); break; } }
    }
    nloc = mine > 0u ? mine : 1u; nx = cnt > 0u ? cnt : 1u;
}

__device__ __forceinline__ void xcd_barrier(const XcdBarrier& b) {
    asm volatile("s_waitcnt vmcnt(0)" ::: "memory");
    __syncthreads();
    if (threadIdx.x == 0) {
        unsigned* bar = b.bar;
        __builtin_amdgcn_s_waitcnt(0);
        unsigned nloc = b.st[0], nx = b.st[1];
        if (nloc == 0u) { xcd_barrier_complete(bar, b.x, nloc, nx); b.st[0] = nloc; b.st[1] = nx; }
        const unsigned old = xb_add(&bar[XB_XSUB(b.x)], 1u);
        const unsigned gen = old / nloc;
        if (old + 1u == (gen + 1u) * nloc) {
            __builtin_amdgcn_fence(__ATOMIC_RELEASE, "agent");
            asm volatile("s_waitcnt vmcnt(0)" ::: "memory");
            const unsigned og = xb_add(&bar[XB_TOP], 1u);
            const unsigned tg = og / nx;
            if (og + 1u == (tg + 1u) * nx) xb_add(&bar[XB_TOPGEN], 1u);
            else XB_SPIN(xb_ld(&bar[XB_TOPGEN]) == tg, bar);
            __builtin_amdgcn_fence(__ATOMIC_ACQUIRE, "agent");
            xb_add(&bar[XB_XGEN(b.x)], 1u);
            asm volatile("s_waitcnt vmcnt(0)" ::: "memory");
        } else {
            XB_SPIN(xb_ld(&bar[XB_XGEN(b.x)]) == gen, bar);
            __builtin_amdgcn_fence(__ATOMIC_ACQUIRE, "agent");
            asm volatile("s_waitcnt vmcnt(0)" ::: "memory");
        }
    }
    __syncthreads();
}

struct P {
    const float *x, *mem, *rel_bias, *w_in, *b_in, *conv_w, *diff_lambda, *subln_g, *mlstm_norm_g, *w_mem_kv, *w_branch, *w_out, *ln1_g, *ln1_b,
                *w_router, *router_bias, *w_e_gate, *w_e_up, *w_e_down, *w_s_gate, *w_s_up, *w_s_down, *ln2_g, *ln2_b;
    float* out; unsigned char* ws; int s_lo, s_hi;
};
typedef const P __attribute__((address_space(4)))* PP;
DI PP kargs() { PP k = (PP)__builtin_amdgcn_kernarg_segment_ptr(); asm volatile("" : "+s"(k)); return k; }
DI P load_args(PP k) { P r; const unsigned long long __attribute__((address_space(4)))* s = (const unsigned long long __attribute__((address_space(4)))*)k; unsigned long long* d = (unsigned long long*)&r;
#pragma unroll
    for (int i = 0; i < (int)(sizeof(P) / 8); ++i) d[i] = s[i];
    return r; }
#define WSP(T, off) ((T*)(p.ws + (off)))

DI void transpose_item(const float* W, int ldw, int src_col0, bf16_t* WT, int ldt, int dst_row0, int k0, LAS float* scr, int lane) {
#pragma unroll 8
    for (int i = 0; i < 32; ++i) { const int kk = 2 * i + (lane >> 5); scr[kk * 33 + (lane & 31)] = W[(size_t)(k0 + kk) * ldw + src_col0 + (lane & 31)]; }
    LDS_WAIT();
    const int c = lane & 7;
#pragma unroll
    for (int j = 0; j < 4; ++j) { const int n = (lane >> 3) + 8 * j; const LAS float* s = scr + (8 * c) * 33 + n;
        u32x4 o; o.x = cvt_pk_bf16(s[0 * 33], s[1 * 33]); o.y = cvt_pk_bf16(s[2 * 33], s[3 * 33]); o.z = cvt_pk_bf16(s[4 * 33], s[5 * 33]); o.w = cvt_pk_bf16(s[6 * 33], s[7 * 33]);
        *(u32x4*)(WT + (size_t)(dst_row0 + n) * ldt + k0 + 8 * c) = o; }
    LDS_WAIT();
}
DI void transpose_mat(const float* W, int ldw, int src_col0, int K, int N, bf16_t* WT, int ldt, int dst_row0, int gw, int NGW, LAS float* scr, int lane) {
    const int nblk = N / 32, items = (K / 64) * nblk;
    for (int it = gw; it < items; it += NGW) { const int kb = it / nblk, nb = it % nblk; transpose_item(W, ldw, src_col0 + nb * 32, WT, ldt, dst_row0 + nb * 32, kb * 64, scr, lane); }
}
DI void row_to_bf16(const float* src, bf16_t* dst, int lane) {
    const f32x4* s = (const f32x4*)src + lane; u32x2* d = (u32x2*)dst + lane;
#pragma unroll
    for (int j = 0; j < 4; ++j) { const f32x4 v = s[64 * j]; u32x2 o; o.x = cvt_pk_bf16(v[0], v[1]); o.y = cvt_pk_bf16(v[2], v[3]); d[64 * j] = o; }
}

DI void ph_prologue(PP pk_, LAS unsigned char* lds) { const P p = load_args(pk_);
    const int tid = tid_local(), lane = tid & 63, wave = tid >> 6, gw = blockIdx.x * 8 + wave, NGW = gridDim.x * 8;
    LAS float* scr = (LAS float*)(lds + wave * 16384);
    bf16_t* WinT = WSP(bf16_t, WS_WIN);
    transpose_mat(p.w_in, CIN, 0, 1024, 7168, WinT, 1024, 0, gw, NGW, scr, lane);
    transpose_mat(p.w_in, CIN, 7176, 1024, 4096, WinT, 1024, 7168, gw, NGW, scr, lane);
    transpose_mat(p.w_mem_kv, 2048, 0, 1024, 2048, WSP(bf16_t, WS_WKV), 1024, 0, gw, NGW, scr, lane);
    for (int n = 0; n < 3; ++n) transpose_mat(p.w_branch + (size_t)n * 1024 * 1024, 1024, 0, 1024, 1024, WSP(bf16_t, WS_WBR), 1024, n * 1024, gw, NGW, scr, lane);
    transpose_mat(p.w_out, 1024, 0, 1024, 1024, WSP(bf16_t, WS_WOUT), 1024, 0, gw, NGW, scr, lane);
    transpose_mat(p.w_router, 256, 0, 1024, 256, WSP(bf16_t, WS_WR), 1024, 0, gw, NGW, scr, lane);
    bf16_t* memb = WSP(bf16_t, WS_MEMB);
    for (int r = gw; r < NBATCH * 256; r += NGW) row_to_bf16(p.mem + (size_t)r * 1024, memb + (size_t)r * 1024, lane);
    float* bias = WSP(float, WS_MISC + MS_BIAS);
    for (int j = blockIdx.x * 512 + tid; j < NU; j += gridDim.x * 512) bias[j] = p.b_in[j + (j >= 7168 ? 8 : 0)];
    if (gw == 0) {
        const float* lv = p.diff_lambda;
        const float s1 = wave_sum(lv[lane] * lv[64 + lane]), s2 = wave_sum(lv[128 + lane] * lv[192 + lane]);
        if (lane == 0) *WSP(float, WS_MISC + MS_LAM) = expf(s1) - expf(s2) + 0.2f;
    }
}

DI void ph_xconv(PP pk_, int g, LAS unsigned char* lds) { const P p = load_args(pk_);
    const int tid = tid_local(), lane = tid & 63, wave = tid >> 6, gw = blockIdx.x * 8 + wave, NGW = gridDim.x * 8;
    LAS float* wg = (LAS float*)lds;
    for (int i = tid; i < 2048; i += 512) { const int c = i >> 1, hf = i & 1; *(LAS f32x4*)(wg + c * 8 + hf * 4) = *(const f32x4*)(p.w_in + (size_t)c * CIN + 7168 + hf * 4); }
    __syncthreads();
    bf16_t* xb = WSP(bf16_t, WS_XB); float* gif = WSP(float, WS_GIF);
    for (int r = gw; r < TG; r += NGW) {
        const size_t t = (size_t)g * TG + r;
        const f32x4* xr = (const f32x4*)(p.x + t * 1024) + lane; u32x2* d = (u32x2*)(xb + (size_t)r * 1024) + lane;
        float gs[8];
#pragma unroll
        for (int q = 0; q < 8; ++q) gs[q] = 0.f;
#pragma unroll
        for (int j = 0; j < 4; ++j) { const f32x4 v = xr[64 * j]; u32x2 o; o.x = cvt_pk_bf16(v[0], v[1]); o.y = cvt_pk_bf16(v[2], v[3]); d[64 * j] = o;
#pragma unroll
            for (int e = 0; e < 4; ++e) { const int c = 4 * lane + 256 * j + e; const f32x4 wl = *(const LAS f32x4*)(wg + c * 8), wh = *(const LAS f32x4*)(wg + c * 8 + 4);
                gs[0] += v[e] * wl[0]; gs[1] += v[e] * wl[1]; gs[2] += v[e] * wl[2]; gs[3] += v[e] * wl[3]; gs[4] += v[e] * wh[0]; gs[5] += v[e] * wh[1]; gs[6] += v[e] * wh[2]; gs[7] += v[e] * wh[3]; } }
        float mine = 0.f;
#pragma unroll
        for (int q = 0; q < 8; ++q) { const float s = wave_sum(gs[q]); if (lane == q) mine = s; }
        if (lane < 8) gif[t * 8 + lane] = mine + p.b_in[7168 + lane];
    }
    __syncthreads();
}

DI int t5_bucket(int n) { return n < 16 ? n : min(31, 16 + (int)(__log2f((float)n * 0.0625f) * (16.f / 3.f))); }

DI void attn_naive_item(PP pk_, int item, LAS unsigned char* lds) { const P p = load_args(pk_);
    const int tid = tid_local(), qr = tid >> 3, map = (tid >> 2) & 1, dc = tid & 3;
    const int qb = item & 31, h = (item >> 5) & 7, b = item >> 8, q0 = qb * 64, qi = q0 + qr;
    const bf16_t* U = WSP(bf16_t, WS_U); const size_t rbase = (size_t)b * SEQ;
    LAS float* bt = (LAS float*)(lds + 16384);
    if (tid <= 128) bt[tid] = p.rel_bias[t5_bucket(tid) * 8 + h] * 1.4426950408889634f;
    float q[64];
    { const u32x4* qp = (const u32x4*)(U + (rbase + qi) * NU + UQ + h * 128 + map * 64);
#pragma unroll
      for (int i = 0; i < 8; ++i) { const u32x4 w = qp[i]; q[8 * i] = bf_lo(w.x); q[8 * i + 1] = bf_hi(w.x); q[8 * i + 2] = bf_lo(w.y); q[8 * i + 3] = bf_hi(w.y); q[8 * i + 4] = bf_lo(w.z); q[8 * i + 5] = bf_hi(w.z); q[8 * i + 6] = bf_lo(w.w); q[8 * i + 7] = bf_hi(w.w); } }
    float o[32];
#pragma unroll
    for (int c = 0; c < 32; ++c) o[c] = 0.f;
    float mrun = -INFINITY, lrun = 0.f;
    const int ntile = q0 / 32 + 2;
    for (int kt = 0; kt < ntile; ++kt) {
        const int k0 = kt * 32;
        __syncthreads();
        { const int key = tid >> 4, pc = tid & 15; const bf16_t* urow = U + (rbase + k0 + key) * NU;
          *(LAS u32x4*)(lds + (pc >> 3) * 4096 + key * 128 + (pc & 7) * 16) = *(const u32x4*)(urow + UK + h * 128 + pc * 8);
          *(LAS u32x4*)(lds + 8192 + key * 256 + pc * 16) = *(const u32x4*)(urow + UV + h * 128 + pc * 8); }
        __syncthreads();
#pragma unroll 1
        for (int j = 0; j < 32; ++j) {
            const int dist = qi - (k0 + j);
            const LAS u32x4* kp = (const LAS u32x4*)(lds + map * 4096 + j * 128); float a = 0.f;
#pragma unroll
            for (int i = 0; i < 8; ++i) { const u32x4 w = kp[i]; a += q[8 * i] * bf_lo(w.x) + q[8 * i + 1] * bf_hi(w.x) + q[8 * i + 2] * bf_lo(w.y) + q[8 * i + 3] * bf_hi(w.y) + q[8 * i + 4] * bf_lo(w.z) + q[8 * i + 5] * bf_hi(w.z) + q[8 * i + 6] * bf_lo(w.w) + q[8 * i + 7] * bf_hi(w.w); }
            if (dist >= 0) {
                a += bt[min(dist, 128)];
                if (a > mrun) { const float sc = __builtin_amdgcn_exp2f(mrun - a); mrun = a; lrun *= sc;
#pragma unroll
                    for (int c = 0; c < 32; ++c) o[c] *= sc; }
                const float pj = __builtin_amdgcn_exp2f(a - mrun); lrun += pj; const LAS u32x4* vp = (const LAS u32x4*)(lds + 8192 + j * 256 + dc * 64);
#pragma unroll
                for (int i = 0; i < 4; ++i) { const u32x4 w = vp[i]; o[8 * i] += pj * bf_lo(w.x); o[8 * i + 1] += pj * bf_hi(w.x); o[8 * i + 2] += pj * bf_lo(w.y); o[8 * i + 3] += pj * bf_hi(w.y); o[8 * i + 4] += pj * bf_lo(w.z); o[8 * i + 5] += pj * bf_hi(w.z); o[8 * i + 6] += pj * bf_lo(w.w); o[8 * i + 7] += pj * bf_hi(w.w); }
            }
        }
    }
    const float lam = *WSP(float, WS_MISC + MS_LAM), inv = 1.f / lrun;
    float ss = 0.f;
#pragma unroll
    for (int c = 0; c < 32; ++c) { const float mine = o[c] * inv, other = __shfl_xor(mine, 4); o[c] = mine - lam * other; ss += o[c] * o[c]; }
    ss += __shfl_xor(ss, 1); ss += __shfl_xor(ss, 2);
    const float rs = rsqrtf(ss * (1.f / 128.f) + LN_EPS) * 0.8f;
    if (map == 0) { bf16_t* yp = WSP(bf16_t, WS_Y) + (rbase + qi) * 3072 + h * 128 + dc * 32; const float* gp = p.subln_g + dc * 32;
#pragma unroll
        for (int i = 0; i < 4; ++i) { u32x4 w; w.x = cvt_pk_bf16(o[8 * i] * rs * gp[8 * i], o[8 * i + 1] * rs * gp[8 * i + 1]); w.y = cvt_pk_bf16(o[8 * i + 2] * rs * gp[8 * i + 2], o[8 * i + 3] * rs * gp[8 * i + 3]);
            w.z = cvt_pk_bf16(o[8 * i + 4] * rs * gp[8 * i + 4], o[8 * i + 5] * rs * gp[8 * i + 5]); w.w = cvt_pk_bf16(o[8 * i + 6] * rs * gp[8 * i + 6], o[8 * i + 7] * rs * gp[8 * i + 7]); *(u32x4*)(yp + 8 * i) = w; } }
    __syncthreads();
}

DI void xattn_naive_item(PP pk_, int g, int item, LAS unsigned char* lds) { const P p = load_args(pk_);
    const int tid = tid_local(), lane = tid & 63, wave = tid >> 6;
    const int qb = item & 63, h = (item >> 6) & 3, b = item >> 8;
    const bf16_t* U = WSP(bf16_t, WS_U); const bf16_t* KV = WSP(bf16_t, WS_KVM) + (size_t)(g * BG + b) * 256 * 2048;
    const size_t r0 = (size_t)b * SEQ + qb * 32;
    LAS float* qs = (LAS float*)lds; LAS float* ps = (LAS float*)(lds + 32768);
    __syncthreads();
    for (int i = tid; i < 32 * 32; i += 512) { const int r = i >> 5, c8 = i & 31; const u32x4 w = *(const u32x4*)(U + (r0 + r) * NU + UCQ + h * 256 + c8 * 8); LAS float* d = qs + r * 256 + c8 * 8;
        d[0] = bf_lo(w.x); d[1] = bf_hi(w.x); d[2] = bf_lo(w.y); d[3] = bf_hi(w.y); d[4] = bf_lo(w.z); d[5] = bf_hi(w.z); d[6] = bf_lo(w.w); d[7] = bf_hi(w.w); }
    __syncthreads();
    const int mcol = tid & 255, rh = tid >> 8;
    { float a[16];
#pragma unroll
      for (int r = 0; r < 16; ++r) a[r] = 0.f;
      const bf16_t* kp = KV + (size_t)mcol * 2048 + h * 256;
      for (int d0 = 0; d0 < 256; d0 += 8) { const u32x4 w = *(const u32x4*)(kp + d0); float kv[8] = {bf_lo(w.x), bf_hi(w.x), bf_lo(w.y), bf_hi(w.y), bf_lo(w.z), bf_hi(w.z), bf_lo(w.w), bf_hi(w.w)};
#pragma unroll
          for (int r = 0; r < 16; ++r) { const LAS f32x4* qp = (const LAS f32x4*)(qs + (rh * 16 + r) * 256 + d0); const f32x4 qa = qp[0], qc = qp[1];
              a[r] += qa[0] * kv[0] + qa[1] * kv[1] + qa[2] * kv[2] + qa[3] * kv[3] + qc[0] * kv[4] + qc[1] * kv[5] + qc[2] * kv[6] + qc[3] * kv[7]; } }
#pragma unroll
      for (int r = 0; r < 16; ++r) ps[(rh * 16 + r) * 256 + mcol] = a[r]; }
    __syncthreads();
#pragma unroll
    for (int rr = 0; rr < 4; ++rr) { const int r = wave * 4 + rr; LAS f32x4* pr = (LAS f32x4*)(ps + r * 256) + lane; f32x4 v = *pr;
        const float mx = wave_max(fmaxf(fmaxf(v[0], v[1]), fmaxf(v[2], v[3])));
        v = (f32x4){__expf(v[0] - mx), __expf(v[1] - mx), __expf(v[2] - mx), __expf(v[3] - mx)};
        const float inv = 1.f / wave_sum((v[0] + v[1]) + (v[2] + v[3])); *pr = v * inv; }
    __syncthreads();
    { float a[16];
#pragma unroll
      for (int r = 0; r < 16; ++r) a[r] = 0.f;
      const bf16_t* vp = KV + 1024 + h * 256 + mcol;
      for (int m = 0; m < 256; ++m) { const float vv = bf2f(vp[(size_t)m * 2048]);
#pragma unroll
          for (int r = 0; r < 16; ++r) a[r] += ps[(rh * 16 + r) * 256 + m] * vv; }
      bf16_t* yp = WSP(bf16_t, WS_Y) + (r0 + rh * 16) * 3072 + 2048 + h * 256 + mcol;
#pragma unroll
      for (int r = 0; r < 16; ++r) yp[(size_t)r * 3072] = (bf16_t)(cvt_pk_bf16(a[r], 0.f) & 0xffffu); }
    __syncthreads();
}

DI void mlstm_naive_item(PP pk_, int g, int item, LAS unsigned char* lds) { const P p = load_args(pk_);
    const int tid = tid_local(), v = tid >> 3, kc = tid & 7;
    const int sl = item & 3, h = (item >> 2) & 3, b = item >> 4;
    const bf16_t* U = WSP(bf16_t, WS_U); const float* gif = WSP(float, WS_GIF); float* HT = WSP(float, WS_F32);
    const size_t rbase = (size_t)b * SEQ; const size_t tbase = ((size_t)g * BG + b) * SEQ;
    LAS bf16_t* qs = (LAS bf16_t*)lds; LAS bf16_t* ks = (LAS bf16_t*)(lds + 32768); LAS float* vs = (LAS float*)(lds + 65536); LAS float* gi = (LAS float*)(lds + 81920); LAS float* gf = (LAS float*)(lds + 82176);
    float C[32], nn[32];
#pragma unroll
    for (int i = 0; i < 32; ++i) { C[i] = 0.f; nn[i] = 0.f; }
    float mst = 0.f;
    for (int ch = 0; ch < SEQ / 64; ++ch) {
        __syncthreads();
        for (int i = tid; i < 2 * 64 * 32; i += 512) { const int isk = i >> 11, s = (i >> 5) & 63, c8 = i & 31; const int ts = ch * 64 + s; const int col = (isk ? UMK : UMQ) + h * 256 + c8 * 8;
            float a[8];
#pragma unroll
            for (int e = 0; e < 8; ++e) a[e] = 0.f;
#pragma unroll
            for (int j = 0; j < 4; ++j) { const int tt = ts - 3 + j; if (tt >= 0) { const u32x4 w = *(const u32x4*)(U + (rbase + tt) * NU + col); const float* cw = p.conv_w + j * 2048 + isk * 1024 + h * 256 + c8 * 8;
                    a[0] += cw[0] * bf_lo(w.x); a[1] += cw[1] * bf_hi(w.x); a[2] += cw[2] * bf_lo(w.y); a[3] += cw[3] * bf_hi(w.y); a[4] += cw[4] * bf_lo(w.z); a[5] += cw[5] * bf_hi(w.z); a[6] += cw[6] * bf_lo(w.w); a[7] += cw[7] * bf_hi(w.w); } }
            const float sc = isk ? 0.0625f : 1.f; u32x4 o; o.x = cvt_pk_bf16(silu(a[0]) * sc, silu(a[1]) * sc); o.y = cvt_pk_bf16(silu(a[2]) * sc, silu(a[3]) * sc); o.z = cvt_pk_bf16(silu(a[4]) * sc, silu(a[5]) * sc); o.w = cvt_pk_bf16(silu(a[6]) * sc, silu(a[7]) * sc);
            *(LAS u32x4*)((isk ? ks : qs) + s * 256 + c8 * 8) = o; }
        for (int i = tid; i < 64 * 64; i += 512) { const int s = i >> 6, c = i & 63; vs[i] = bf2f(U[(rbase + ch * 64 + s) * NU + UMV + h * 256 + sl * 64 + c]); }
        if (tid < 64) { gi[tid] = gif[(tbase + ch * 64 + tid) * 8 + h]; gf[tid] = gif[(tbase + ch * 64 + tid) * 8 + 4 + h]; }
        __syncthreads();
        for (int s = 0; s < 64; ++s) {
            const float ip = gi[s], fp = gf[s];
            const float fl = fminf(fp, 0.f) - log1pf(expf(-fabsf(fp)));
            const float mm = fmaxf(fl + mst, ip), fg = expf(fl + mst - mm), ig = expf(ip - mm); mst = mm;
            const float vv = vs[s * 64 + v] * ig;
            const LAS u32x4* kp = (const LAS u32x4*)(ks + s * 256 + kc * 32); const LAS u32x4* qp = (const LAS u32x4*)(qs + s * 256 + kc * 32);
            float num = 0.f, den = 0.f;
#pragma unroll
            for (int c4 = 0; c4 < 4; ++c4) { const u32x4 kw = kp[c4], qw = qp[c4];
#pragma unroll
                for (int e = 0; e < 4; ++e) { const float k0 = bf_lo(kw[e]), k1 = bf_hi(kw[e]), q0 = bf_lo(qw[e]), q1 = bf_hi(qw[e]); const int kk = c4 * 8 + 2 * e;
                    C[kk] = fg * C[kk] + vv * k0; nn[kk] = fg * nn[kk] + ig * k0; num += C[kk] * q0; den += nn[kk] * q0;
                    C[kk + 1] = fg * C[kk + 1] + vv * k1; nn[kk + 1] = fg * nn[kk + 1] + ig * k1; num += C[kk + 1] * q1; den += nn[kk + 1] * q1; } }
            num += __shfl_xor(num, 1); num += __shfl_xor(num, 2); num += __shfl_xor(num, 4);
            den += __shfl_xor(den, 1); den += __shfl_xor(den, 2); den += __shfl_xor(den, 4);
            if (kc == 0) HT[(rbase + ch * 64 + s) * 1024 + h * 256 + sl * 64 + v] = num / fmaxf(fabsf(den), expf(-mst));
        }
    }
    __syncthreads();
}

typedef float f32x16 __attribute__((ext_vector_type(16)));
typedef __bf16 bf16x2_t __attribute__((ext_vector_type(2)));
typedef short s16x4 __attribute__((ext_vector_type(4)));
constexpr float LOG2E = 1.4426950408889634f;
DI unsigned pk_bf16(float a, float b) { const f32x2 v = {a, b}; return __builtin_bit_cast(unsigned, __builtin_convertvector(v, bf16x2_t)); }
DI int crow(int reg, int hh) { return (reg & 3) + 8 * (reg >> 2) + 4 * hh; }
#define MFMA32(a, b, c) __builtin_amdgcn_mfma_f32_32x32x16_bf16((a), (b), (c), 0, 0, 0)
DI bf16x8 tr_pair(const LAS unsigned char* a0, const LAS unsigned char* a1) {
    const s16x4 lo = __builtin_amdgcn_ds_read_tr16_b64_v4i16((LAS s16x4*)a0), hi = __builtin_amdgcn_ds_read_tr16_b64_v4i16((LAS s16x4*)a1);
    return __builtin_shufflevector(lo, hi, 0, 1, 2, 3, 4, 5, 6, 7);
}
DI bf16x8 pack_half(const f32x16& x, int s2) {
    u32x4 w;
#pragma unroll
    for (int k = 0; k < 4; ++k) w[k] = pk_bf16(x[8 * s2 + 2 * k], x[8 * s2 + 2 * k + 1]);
    return __builtin_bit_cast(bf16x8, w);
}
DI int next_item(unsigned* ctr, LAS unsigned char* lds) {
    volatile LAS int* slot = (volatile LAS int*)(lds + LDS_MISC + 64);
    __syncthreads();
    if (threadIdx.x == 0) *slot = (int)__hip_atomic_fetch_add(ctr, 1u, __ATOMIC_RELAXED, __HIP_MEMORY_SCOPE_AGENT);
    __syncthreads();
    return *slot;
}

constexpr int AT_KPITCH = 144, AT_VPITCH = 320, AT_KBYTES = 64 * AT_KPITCH, AT_VOFF = 2 * AT_KBYTES, AT_BUF = AT_VOFF + 64 * AT_VPITCH, AT_BT = 2 * AT_BUF;
DI void attn_mfma_item(PP pk_, int item, LAS unsigned char* lds) { const P p = load_args(pk_);
    const int tid = tid_local(), lane = tid & 63, wave = __builtin_amdgcn_readfirstlane(tid >> 6), mp = wave & 1, rq = wave >> 1, hh = lane >> 5, r = lane & 31;
    const int qb = item & 15, h = (item >> 4) & 7, b = item >> 7;
    const int q0 = qb * 128, qw = q0 + rq * 32, nt = 2 * qb + 2;
    const bf16_t* U = WSP(bf16_t, WS_U); const size_t rbase = (size_t)b * SEQ;
    LAS float* bt = (LAS float*)(lds + AT_BT);
    __syncthreads();
    if (tid <= 128) bt[tid] = p.rel_bias[t5_bucket(tid) * 8 + h] * LOG2E;
    bf16x8 qf[4];
    { const bf16_t* qp = U + (rbase + qw + r) * NU + UQ + h * 128 + mp * 64 + 8 * hh;
#pragma unroll
      for (int s = 0; s < 4; ++s) qf[s] = *(const bf16x8*)(qp + 16 * s); }
    f32x16 O[4];
#pragma unroll
    for (int dt = 0; dt < 4; ++dt)
#pragma unroll
        for (int i = 0; i < 16; ++i) O[dt][i] = 0.f;
    float mrun = -INFINITY, lrun = 0.f;
    const int row0 = tid >> 4, c16 = tid & 15;
    const bf16_t* gk = U + (rbase + row0) * NU + UK + h * 128 + c16 * 8;
    const bf16_t* gv = U + (rbase + row0) * NU + UV + h * 128 + c16 * 8;
    const unsigned lk = (c16 >> 3) * AT_KBYTES + row0 * AT_KPITCH + (c16 & 7) * 16, lv = AT_VOFF + row0 * AT_VPITCH + c16 * 16;
    u32x4 st[4];
#define AT_LOAD(t_) do { const size_t o_ = (size_t)(t_) * 64 * NU; st[0] = *(const u32x4*)(gk + o_); st[1] = *(const u32x4*)(gk + o_ + (size_t)32 * NU); st[2] = *(const u32x4*)(gv + o_); st[3] = *(const u32x4*)(gv + o_ + (size_t)32 * NU); } while (0)
#define AT_STORE(bufp) do { *(LAS u32x4*)((bufp) + lk) = st[0]; *(LAS u32x4*)((bufp) + lk + 32 * AT_KPITCH) = st[1]; *(LAS u32x4*)((bufp) + lv) = st[2]; *(LAS u32x4*)((bufp) + lv + 32 * AT_VPITCH) = st[3]; } while (0)
    AT_LOAD(0); AT_STORE(lds); __syncthreads();
    const float cfar = bt[128];
    const unsigned ka = mp * AT_KBYTES + r * AT_KPITCH + hh * 16;
    const int i16 = lane & 15;
    const unsigned va = AT_VOFF + (4 * hh + (i16 >> 2)) * AT_VPITCH + (16 * ((lane >> 4) & 1) + 4 * (i16 & 3)) * 2;
    for (int t = 0; t < nt; ++t) {
        const int k0 = t * 64; LAS unsigned char* buf = lds + (t & 1) * AT_BUF;
        if (t + 1 < nt) AT_LOAD(t + 1);
        if (k0 <= qw + 31) {
            const bool far = (qw - k0 - 63) >= 128;
            f32x16 S[2];
#pragma unroll
            for (int sub = 0; sub < 2; ++sub)
#pragma unroll
                for (int i = 0; i < 16; ++i) S[sub][i] = far ? cfar : 0.f;
#pragma unroll
            for (int sub = 0; sub < 2; ++sub)
#pragma unroll
                for (int s = 0; s < 4; ++s) S[sub] = MFMA32(*(const LAS bf16x8*)(buf + ka + sub * 32 * AT_KPITCH + s * 32), qf[s], S[sub]);
            if (!far) {
#pragma unroll
                for (int sub = 0; sub < 2; ++sub)
#pragma unroll
                    for (int i = 0; i < 16; ++i) { const int dist = (qw + r) - (k0 + sub * 32 + crow(i, hh)); S[sub][i] = dist < 0 ? -INFINITY : S[sub][i] + bt[min(dist, 128)]; }
            }
            float mx = fmaxf(S[0][0], S[1][0]);
#pragma unroll
            for (int i = 1; i < 16; ++i) mx = fmaxf(mx, fmaxf(S[0][i], S[1][i]));
            mx = fmaxf(mx, __shfl_xor(mx, 32));
            const float mnew = fmaxf(mrun, mx), alpha = __builtin_amdgcn_exp2f(mrun - mnew); mrun = mnew; lrun *= alpha;
#pragma unroll
            for (int dt = 0; dt < 4; ++dt) O[dt] *= alpha;
#pragma unroll
            for (int sub = 0; sub < 2; ++sub)
#pragma unroll
                for (int i = 0; i < 16; ++i) { S[sub][i] = __builtin_amdgcn_exp2f(S[sub][i] - mnew); lrun += S[sub][i]; }
#pragma unroll
            for (int sub = 0; sub < 2; ++sub)
#pragma unroll
                for (int s2 = 0; s2 < 2; ++s2) { const bf16x8 pb = pack_half(S[sub], s2); const LAS unsigned char* vb = buf + va + (sub * 32 + 16 * s2) * AT_VPITCH;
#pragma unroll
                    for (int dt = 0; dt < 4; ++dt) O[dt] = MFMA32(tr_pair(vb + dt * 64, vb + dt * 64 + 8 * AT_VPITCH), pb, O[dt]); }
        }
        if (t + 1 < nt) AT_STORE(lds + ((t + 1) & 1) * AT_BUF);
        __syncthreads();
    }
#undef AT_LOAD
#undef AT_STORE
    const float inv = 1.f / (lrun + __shfl_xor(lrun, 32));
    LAS float* X = (LAS float*)lds;
    if (mp == 1) {
#pragma unroll
        for (int dt = 0; dt < 4; ++dt)
#pragma unroll
            for (int i = 0; i < 16; ++i) X[(rq * 64 + dt * 16 + i) * 64 + lane] = O[dt][i] * inv;
    }
    __syncthreads();
    if (mp == 0) {
        const float lam = *WSP(float, WS_MISC + MS_LAM); float ss = 0.f;
#pragma unroll
        for (int dt = 0; dt < 4; ++dt)
#pragma unroll
            for (int i = 0; i < 16; ++i) { const float v = O[dt][i] * inv - lam * X[(rq * 64 + dt * 16 + i) * 64 + lane]; O[dt][i] = v; ss += v * v; }
        ss += __shfl_xor(ss, 32);
        const float rs = rsqrtf(ss * (1.f / 128.f) + LN_EPS) * 0.8f;
        bf16_t* yp = WSP(bf16_t, WS_Y) + (rbase + qw + r) * 3072 + h * 128;
#pragma unroll
        for (int dt = 0; dt < 4; ++dt)
#pragma unroll
            for (int g4 = 0; g4 < 4; ++g4) { const int dv = dt * 32 + 8 * g4 + 4 * hh; const f32x4 gn = *(const f32x4*)(p.subln_g + dv);
                u32x2 w; w.x = pk_bf16(O[dt][4 * g4] * rs * gn[0], O[dt][4 * g4 + 1] * rs * gn[1]); w.y = pk_bf16(O[dt][4 * g4 + 2] * rs * gn[2], O[dt][4 * g4 + 3] * rs * gn[3]);
                *(u32x2*)(yp + dv) = w; }
    }
}
#ifndef ATTN_NAIVE
#define ATTN_NAIVE 0
#endif
DI void ph_mix(PP pk_, int g, LAS unsigned char* lds) { const P p = load_args(pk_);
    constexpr int N_ML = BG * 4 * 4, N_AT = ATTN_NAIVE ? BG * 8 * 32 : BG * 8 * 16, N_XA = BG * 4 * 64;
    unsigned* ctr = WSP(unsigned, WS_CTL) + CW_Q + 64 * g;
    for (;;) {
        const int it = next_item(ctr, lds);
        if (it >= N_ML + N_AT + N_XA) break;
        if (it < N_ML) mlstm_naive_item(pk_, g, it, lds);
        else if (it < N_ML + N_AT) { const int ix = it - N_ML;
            if (ATTN_NAIVE) attn_naive_item(pk_, N_AT - 1 - ix, lds);
            else attn_mfma_item(pk_, ((ix & 63) << 4) | (15 - (ix >> 6)), lds); }
        else xattn_naive_item(pk_, g, it - N_ML - N_AT, lds);
    }
}

DI void ph_mlstm_out(PP pk_, int g, LAS unsigned char* lds) { const P p = load_args(pk_);
    const int tid = tid_local(), lane = tid & 63, wave = tid >> 6, gw = blockIdx.x * 8 + wave, NGW = gridDim.x * 8;
    const float* HT = WSP(float, WS_F32); const bf16_t* U = WSP(bf16_t, WS_U); bf16_t* Y = WSP(bf16_t, WS_Y);
    for (int it = gw; it < TG * 4; it += NGW) { const int r = it >> 2, h = it & 3;
        const f32x4 v = *((const f32x4*)(HT + (size_t)r * 1024 + h * 256) + lane);
        const float mu = wave_sum((v[0] + v[1]) + (v[2] + v[3])) * (1.f / 256.f); const f32x4 d = v - mu;
        const float rstd = rsqrtf(wave_sum((d[0] * d[0] + d[1] * d[1]) + (d[2] * d[2] + d[3] * d[3])) * (1.f / 256.f) + LN_EPS);
        const f32x4 gn = *((const f32x4*)(p.mlstm_norm_g + h * 256) + lane);
        const u32x2 ow = *((const u32x2*)(U + (size_t)r * NU + UMO + h * 256) + lane);
        u32x2 o; o.x = cvt_pk_bf16(d[0] * rstd * gn[0] * sigm(bf_lo(ow.x)), d[1] * rstd * gn[1] * sigm(bf_hi(ow.x))); o.y = cvt_pk_bf16(d[2] * rstd * gn[2] * sigm(bf_lo(ow.y)), d[3] * rstd * gn[3] * sigm(bf_hi(ow.y)));
        *((u32x2*)(Y + (size_t)r * 3072 + 1024 + h * 256) + lane) = o; }
}

DI void ph_ln1(PP pk_, int g, LAS unsigned char* lds) { const P p = load_args(pk_);
    const int tid = tid_local(), lane = tid & 63, wave = tid >> 6, gw = blockIdx.x * 8 + wave, NGW = gridDim.x * 8;
    const float* Z = WSP(float, WS_Z); bf16_t* X1 = WSP(bf16_t, WS_X1B) + (size_t)g * TG * 1024;
    for (int r = gw; r < TG; r += NGW) {
        const f32x4* zr = (const f32x4*)(Z + (size_t)r * 1024) + lane; f32x4 v[4]; float s = 0.f;
#pragma unroll
        for (int j = 0; j < 4; ++j) { v[j] = zr[64 * j]; s += (v[j][0] + v[j][1]) + (v[j][2] + v[j][3]); }
        const float mu = wave_sum(s) * (1.f / 1024.f); float s2 = 0.f;
#pragma unroll
        for (int j = 0; j < 4; ++j) { v[j] = v[j] - mu; s2 += (v[j][0] * v[j][0] + v[j][1] * v[j][1]) + (v[j][2] * v[j][2] + v[j][3] * v[j][3]); }
        const float rstd = rsqrtf(wave_sum(s2) * (1.f / 1024.f) + LN_EPS);
        u32x2* d = (u32x2*)(X1 + (size_t)r * 1024) + lane;
#pragma unroll
        for (int j = 0; j < 4; ++j) { const f32x4 gn = *((const f32x4*)p.ln1_g + lane + 64 * j), bb = *((const f32x4*)p.ln1_b + lane + 64 * j); const f32x4 o = v[j] * rstd * gn + bb;
            u32x2 w; w.x = cvt_pk_bf16(o[0], o[1]); w.y = cvt_pk_bf16(o[2], o[3]); d[64 * j] = w; }
    }
}
DI void ph_expert_weights(PP pk_, LAS unsigned char* lds) { const P p = load_args(pk_);
    const int tid = tid_local(), lane = tid & 63, wave = tid >> 6, gw = blockIdx.x * 8 + wave, NGW = gridDim.x * 8;
    LAS float* scr = (LAS float*)(lds + wave * 16384);
    bf16_t* WGU = WSP(bf16_t, WS_WGU); bf16_t* WD = WSP(bf16_t, WS_WD);
    for (int it = gw; it < 257 * 256; it += NGW) { const int e = it >> 8, r = it & 255, isup = r >> 7, kb = (r >> 3) & 15, nb = r & 7;
        const float* W = (e < 256) ? ((isup ? p.w_e_up : p.w_e_gate) + (size_t)e * 1024 * 256) : (isup ? p.w_s_up : p.w_s_gate);
        const int n0 = nb * 32, drow = (n0 >> 7) * 256 + (n0 & 127) + isup * 128;
        transpose_item(W, 256, n0, WGU + (size_t)e * 512 * 1024, 1024, drow, kb * 64, scr, lane); }
    for (int it = gw; it < 257 * 128; it += NGW) { const int e = it >> 7, r = it & 127, kb = r >> 5, nb = r & 31;
        const float* W = (e < 256) ? (p.w_e_down + (size_t)e * 256 * 1024) : p.w_s_down;
        transpose_item(W, 1024, nb * 32, WD + (size_t)e * 1024 * 256, 256, nb * 32, kb * 64, scr, lane); }
}

DI void ph_topk(PP pk_, LAS unsigned char* lds) { const P p = load_args(pk_);
    const int tid = tid_local(), lane = tid & 63, wave = tid >> 6, gw = blockIdx.x * 8 + wave, NGW = gridDim.x * 8;
    const float* LG = WSP(float, WS_LOGIT); int* TKI = WSP(int, WS_TKI); float* TKW = WSP(float, WS_TKW); unsigned* cnt = WSP(unsigned, WS_CTL) + CW_CNT;
    int* tokof = WSP(int, WS_TOKOF); float* wof = WSP(float, WS_WOF);
    for (int i = blockIdx.x * 512 + tid; i < MAXRT * 256; i += gridDim.x * 512) { tokof[i] = 0; wof[i] = 0.f; }
    const f32x4 rb = *((const f32x4*)p.router_bias + lane);
    for (int t = gw; t < T_ALL; t += NGW) {
        const f32x4 lg = *((const f32x4*)(LG + (size_t)t * 256) + lane);
        float sc[4], ch[4];
#pragma unroll
        for (int j = 0; j < 4; ++j) { sc[j] = 1.f / (1.f + expf(-lg[j])); ch[j] = sc[j] + rb[j]; }
        const float m01 = fmaxf(ch[0], ch[1]), n01 = fminf(ch[0], ch[1]), m23 = fmaxf(ch[2], ch[3]), n23 = fminf(ch[2], ch[3]);
        float a1 = fmaxf(m01, m23), a2 = fmaxf(fminf(m01, m23), fmaxf(n01, n23));
#pragma unroll
        for (int o = 1; o < 8; o <<= 1) { const float b1 = __shfl_xor(a1, o), b2 = __shfl_xor(a2, o); const float n1 = fmaxf(a1, b1), n2 = fmaxf(fminf(a1, b1), fmaxf(a2, b2)); a1 = n1; a2 = n2; }
        const float gs = a1 + a2; const int myg = lane >> 3; int rank = 0;
#pragma unroll
        for (int g2 = 0; g2 < 8; ++g2) { const float og = __shfl(gs, 8 * g2); rank += (og > gs || (og == gs && g2 < myg)) ? 1 : 0; }
        if (rank >= 4) { ch[0] = -INFINITY; ch[1] = -INFINITY; ch[2] = -INFINITY; ch[3] = -INFINITY; }
        int myidx = 0; float mys = 0.f, ssum = 0.f;
#pragma unroll
        for (int r = 0; r < 8; ++r) {
            float bv = ch[0]; int bi = 4 * lane;
#pragma unroll
            for (int j = 1; j < 4; ++j) if (ch[j] > bv) { bv = ch[j]; bi = 4 * lane + j; }
#pragma unroll
            for (int o = 32; o >= 1; o >>= 1) { const float ov = __shfl_xor(bv, o); const int oi = __shfl_xor(bi, o); if (ov > bv || (ov == bv && oi < bi)) { bv = ov; bi = oi; } }
            const int jl = bi & 3; const float scsel = jl == 0 ? sc[0] : (jl == 1 ? sc[1] : (jl == 2 ? sc[2] : sc[3]));
            const float sv = __shfl(scsel, bi >> 2);
            if ((bi >> 2) == lane) { if (jl == 0) ch[0] = -INFINITY; else if (jl == 1) ch[1] = -INFINITY; else if (jl == 2) ch[2] = -INFINITY; else ch[3] = -INFINITY; }
            ssum += sv; if (lane == r) { myidx = bi; mys = sv; }
        }
        if (lane < 8) { TKI[(size_t)t * 8 + lane] = myidx; TKW[(size_t)t * 8 + lane] = mys / (ssum + 1e-20f) * 2.5f; atomicAdd(cnt + myidx, 1u); }
    }
}

DI void ph_scan(PP pk_, LAS unsigned char* lds) { const P p = load_args(pk_);
    if (blockIdx.x != 0) return;
    const int tid = tid_local();
    const unsigned* cnt = WSP(unsigned, WS_CTL) + CW_CNT; int* tbase = WSP(int, WS_MISC + MS_TBASE); int* nt = WSP(int, WS_MISC + MS_NT); int* tile_e = WSP(int, WS_MISC + MS_TILEE);
    LAS int* sb = (LAS int*)lds;
    if (tid < 256) sb[tid] = (int)((cnt[tid] + 255u) >> 8);
    __syncthreads();
    if (tid == 0) { int a = 0; for (int e = 0; e < 256; ++e) { const int n = sb[e]; sb[e] = a; a += n; } sb[256] = a; }
    __syncthreads();
    const int nrt = sb[256];
    if (tid < 256) { const int b0 = sb[tid], b1 = sb[tid + 1]; tbase[tid] = b0; for (int t = b0; t < b1; ++t) tile_e[t] = tid; tile_e[nrt + tid] = 256; }
    if (tid == 0) { tbase[256] = nrt; nt[0] = nrt; nt[1] = nrt + 256; }
    __syncthreads();
}

DI void ph_slots(PP pk_, LAS unsigned char* lds) { const P p = load_args(pk_);
    const int tid = tid_local();
    const int* TKI = WSP(int, WS_TKI); const float* TKW = WSP(float, WS_TKW); unsigned* cur = WSP(unsigned, WS_CTL) + CW_CUR; const int* tbase = WSP(int, WS_MISC + MS_TBASE);
    int* tokof = WSP(int, WS_TOKOF); float* wof = WSP(float, WS_WOF); int* slotof = WSP(int, WS_SLOTOF);
    const int s0 = tbase[256] * 256;
    for (int i = blockIdx.x * 512 + tid; i < T_ALL * 8; i += gridDim.x * 512) { const int e = TKI[i]; const int slot = tbase[e] * 256 + (int)atomicAdd(cur + e, 1u); tokof[slot] = i >> 3; wof[slot] = TKW[i]; slotof[i] = slot; }
    for (int t = blockIdx.x * 512 + tid; t < T_ALL; t += gridDim.x * 512) { tokof[s0 + t] = t; wof[s0 + t] = 1.f; }
}

DI void ph_combine(PP pk_, int round, LAS unsigned char* lds) { const P p = load_args(pk_);
    const int tid = tid_local();
    const bf16_t* Y = WSP(bf16_t, WS_YCH); const bf16_t* X1 = WSP(bf16_t, WS_X1B); const int* slotof = WSP(int, WS_SLOTOF); const int s0 = WSP(int, WS_MISC + MS_TBASE)[256] * 256;
    for (int i = blockIdx.x * 512 + tid; i < T_ALL * 32; i += gridDim.x * 512) { const int t = i >> 5, c8 = (i & 31) * 8;
        const u32x4 xw = *(const u32x4*)(X1 + (size_t)t * 1024 + round * 256 + c8);
        float a[8] = {bf_lo(xw.x) * ALPHA, bf_hi(xw.x) * ALPHA, bf_lo(xw.y) * ALPHA, bf_hi(xw.y) * ALPHA, bf_lo(xw.z) * ALPHA, bf_hi(xw.z) * ALPHA, bf_lo(xw.w) * ALPHA, bf_hi(xw.w) * ALPHA};
#pragma unroll
        for (int k = 0; k < 9; ++k) { const int slot = k < 8 ? slotof[(size_t)t * 8 + k] : s0 + t; const u32x4 w = *(const u32x4*)(Y + (size_t)slot * 256 + c8);
            a[0] += bf_lo(w.x); a[1] += bf_hi(w.x); a[2] += bf_lo(w.y); a[3] += bf_hi(w.y); a[4] += bf_lo(w.z); a[5] += bf_hi(w.z); a[6] += bf_lo(w.w); a[7] += bf_hi(w.w); }
        float* op = p.out + (size_t)t * 1024 + round * 256 + c8; *(f32x4*)op = (f32x4){a[0], a[1], a[2], a[3]}; *(f32x4*)(op + 4) = (f32x4){a[4], a[5], a[6], a[7]}; }
}

DI void ph_ln2(PP pk_, LAS unsigned char* lds) { const P p = load_args(pk_);
    const int tid = tid_local(), lane = tid & 63, wave = tid >> 6, gw = blockIdx.x * 8 + wave, NGW = gridDim.x * 8;
    for (int r = gw; r < T_ALL; r += NGW) {
        f32x4* zr = (f32x4*)(p.out + (size_t)r * 1024) + lane; f32x4 v[4]; float s = 0.f;
#pragma unroll
        for (int j = 0; j < 4; ++j) { v[j] = zr[64 * j]; s += (v[j][0] + v[j][1]) + (v[j][2] + v[j][3]); }
        const float mu = wave_sum(s) * (1.f / 1024.f); float s2 = 0.f;
#pragma unroll
        for (int j = 0; j < 4; ++j) { v[j] = v[j] - mu; s2 += (v[j][0] * v[j][0] + v[j][1] * v[j][1]) + (v[j][2] * v[j][2] + v[j][3] * v[j][3]); }
        const float rstd = rsqrtf(wave_sum(s2) * (1.f / 1024.f) + LN_EPS);
#pragma unroll
        for (int j = 0; j < 4; ++j) { const f32x4 gn = *((const f32x4*)p.ln2_g + lane + 64 * j), bb = *((const f32x4*)p.ln2_b + lane + 64 * j); zr[64 * j] = v[j] * rstd * gn + bb; }
    }
}

__global__ void __launch_bounds__(512, 2) fwd(P p_unused) {
    extern __shared__ __attribute__((aligned(16))) unsigned char lds_raw[];
    LAS unsigned char* lds = (LAS unsigned char*)lds_raw;
    const int tid = threadIdx.x, G = gridDim.x, bid = blockIdx.x;
    volatile LAS unsigned* MISC = (volatile LAS unsigned*)(lds + LDS_MISC);
    if (tid < 32) MISC[tid] = 0u;
    __syncthreads();
    const int lo = kargs()->s_lo, hi = kargs()->s_hi;
    XcdBarrier bar; { unsigned* bw = (unsigned*)(kargs()->ws + WS_CTL) + CW_BAR; bar.bar = bw; bar.x = 0; bar.st = nullptr; if (hi - lo > 1) bar = xcd_barrier_post(bw, MISC + 8); }
    int s = 0;
#define STEP_BEGIN if (s >= lo && s < hi) { PP pk_ = kargs(); const P p = load_args(pk_);
#define STEP_END if (s + 1 < hi) xcd_barrier(bar); } ++s;

    STEP_BEGIN ph_prologue(pk_, lds); STEP_END
    for (int g = 0; g < NGRP; ++g) {
        STEP_BEGIN ph_xconv(pk_, g, lds); STEP_END
        STEP_BEGIN {
            pg8::Gemm gm{WSP(bf16_t, WS_XB), WSP(bf16_t, WS_WIN), 1024, 1024, 1024, nullptr}; pg8::StaticOrder S; S.init(TG, NU, G, bid);
            EpiInProj E{WSP(bf16_t, WS_U), WSP(float, WS_MISC + MS_BIAS)};
            pg8::gemm_phase<EpiInProj, pg8::StaticOrder, true>(lds, gm, S, E);
            if (g == 0) {
                pg8::Gemm gk{WSP(bf16_t, WS_MEMB), WSP(bf16_t, WS_WKV), 1024, 1024, 1024, nullptr}; pg8::StaticOrder S2; S2.init(NBATCH * 256, 2048, G, bid);
                EpiPlain E2{WSP(bf16_t, WS_KVM), 2048};
                pg8::gemm_phase<EpiPlain, pg8::StaticOrder, true>(lds, gk, S2, E2);
            }
        } STEP_END
        STEP_BEGIN ph_mix(pk_, g, lds); STEP_END
        STEP_BEGIN ph_mlstm_out(pk_, g, lds); STEP_END
        STEP_BEGIN {
            pg8::Gemm gm{WSP(bf16_t, WS_Y), WSP(bf16_t, WS_WBR), 3072, 1024, 1024, nullptr}; BranchOrder S{(TG / 256) * 4, G, bid};
            EpiBranch E{WSP(bf16_t, WS_U), WSP(float, WS_F32), WSP(bf16_t, WS_MRG)};
            pg8::gemm_phase<EpiBranch, BranchOrder, true>(lds, gm, S, E);
        } STEP_END
        STEP_BEGIN {
            pg8::Gemm gm{WSP(bf16_t, WS_MRG), WSP(bf16_t, WS_WOUT), 1024, 1024, 1024, nullptr}; pg8::StaticOrder S; S.init(TG, 1024, G, bid);
            EpiOutProj E{p.x + (size_t)g * TG * 1024, WSP(float, WS_Z)};
            pg8::gemm_phase<EpiOutProj, pg8::StaticOrder, true>(lds, gm, S, E);
        } STEP_END
        STEP_BEGIN ph_ln1(pk_, g, lds); STEP_END
    }
    STEP_BEGIN {
        pg8::Gemm gm{WSP(bf16_t, WS_X1B), WSP(bf16_t, WS_WR), 1024, 1024, 1024, nullptr}; pg8::StaticOrder S; S.init(T_ALL, 256, G, bid);
        EpiF32 E{WSP(float, WS_LOGIT), 256};
        pg8::gemm_phase<EpiF32, pg8::StaticOrder, true>(lds, gm, S, E);
        ph_expert_weights(pk_, lds);
    } STEP_END
    STEP_BEGIN ph_topk(pk_, lds); STEP_END
    STEP_BEGIN ph_scan(pk_, lds); STEP_END
    STEP_BEGIN ph_slots(pk_, lds); STEP_END
    STEP_BEGIN {
        const int* ntp = WSP(int, WS_MISC + MS_NT);
        pg8::Gemm gm{WSP(bf16_t, WS_X1B), WSP(bf16_t, WS_WGU), 1024, 1024, 1024, WSP(int, WS_TOKOF)}; ExpertGUOrder S{WSP(int, WS_MISC + MS_TILEE), ntp[1] * 2, G, bid};
        EpiGateUp E{WSP(bf16_t, WS_ACT)};
        pg8::gemm_phase<EpiGateUp, ExpertGUOrder, true, true>(lds, gm, S, E);
    } STEP_END
    for (int r = 0; r < 4; ++r) {
        STEP_BEGIN {
            const int* ntp = WSP(int, WS_MISC + MS_NT);
            pg8::Gemm gm{WSP(bf16_t, WS_ACT), WSP(bf16_t, WS_WD), 256, 256, 256, nullptr}; ExpertDownOrder S{WSP(int, WS_MISC + MS_TILEE), ntp[1], G, bid, r};
            EpiDown E{WSP(bf16_t, WS_YCH), WSP(float, WS_WOF)};
            pg8::gemm_phase<EpiDown, ExpertDownOrder, true>(lds, gm, S, E);
        } STEP_END
        STEP_BEGIN ph_combine(pk_, r, lds); STEP_END
    }
    STEP_BEGIN ph_ln2(pk_, lds); STEP_END
}
constexpr int NSTEPS = 1 + NGRP * 7 + 5 + 8 + 1;

extern "C" void kernel_launch(void* const* d_in, const int* in_sizes, int n_in, void* d_out, int out_size, void* d_ws, size_t ws_size, hipStream_t stream) {
    static int grid = 0;
    if (grid == 0) {
        int dev = 0, cus = 0;
        if (hipGetDevice(&dev) != hipSuccess || hipDeviceGetAttribute(&cus, hipDeviceAttributeMultiprocessorCount, dev) != hipSuccess) { fprintf(stderr, "kernel_launch: device query failed\n"); grid = -1; return; }
        if (hipFuncSetAttribute((const void*)fwd, hipFuncAttributeMaxDynamicSharedMemorySize, LDS_BYTES) != hipSuccess) { fprintf(stderr, "kernel_launch: hipFuncSetAttribute failed\n"); grid = -1; return; }
        if (n_in != 24 || ws_size < WS_END) fprintf(stderr, "kernel_launch: n_in %d ws %zu (need %zu)\n", n_in, ws_size, (size_t)WS_END);
        grid = cus;
    }
    if (grid < 0) return;
    (void)hipMemsetAsync((char*)d_ws + WS_CTL, 0, CTL_BYTES, stream);
    P p{};
    const float** pp = (const float**)&p;
    for (int i = 0; i < 24; ++i) pp[i] = (const float*)d_in[i];
    p.out = (float*)d_out; p.ws = (unsigned char*)d_ws;
#ifndef ONE_LAUNCH
    for (int s = 0; s < NSTEPS; ++s) { p.s_lo = s; p.s_hi = s + 1; hipLaunchKernelGGL(fwd, dim3(grid), dim3(512), LDS_BYTES, stream, p); }
#else
    p.s_lo = 0; p.s_hi = NSTEPS; hipLaunchKernelGGL(fwd, dim3(grid), dim3(512), LDS_BYTES, stream, p);
#endif
}
```

```cpp
#define ONE_LAUNCH 1
#include <hip/hip_runtime.h>
#include <cstdio>
#include <cstdint>
#define DI __device__ __forceinline__
#define LAS __attribute__((address_space(3)))
#define GAS __attribute__((address_space(1)))
typedef unsigned short bf16_t;
typedef short bf16x8 __attribute__((ext_vector_type(8)));
typedef float f32x4 __attribute__((ext_vector_type(4)));
typedef float f32x2 __attribute__((ext_vector_type(2)));
typedef unsigned u32x4 __attribute__((ext_vector_type(4)));
typedef unsigned u32x2 __attribute__((ext_vector_type(2)));

constexpr int T_ALL = 65536, DM = 1024, SEQ = 2048, NBATCH = 32, NGRP = 4, TG = T_ALL / NGRP, BG = NBATCH / NGRP;
constexpr int NU = 11264, CIN = 11272;
constexpr int UQ = 0, UK = 1024, UV = 2048, UMQ = 3072, UMK = 4096, UMV = 5120, UMO = 6144, UCQ = 7168, UGT = 8192;
constexpr int NEXP = 256, MAXRT = 2304, MAXTILES = MAXRT + 256, MAXSLOTS = MAXTILES * 256;
constexpr float ALPHA = 1.189207115002721f;
constexpr float LN_EPS = 1e-5f;

constexpr size_t MiB = 1ull << 20;
constexpr size_t WS_CTL = 0, CTL_BYTES = 1 * MiB;
constexpr size_t WS_MISC = 1 * MiB;
constexpr size_t WS_WIN = 2 * MiB, WS_WKV = 24 * MiB, WS_WBR = 28 * MiB, WS_WOUT = 34 * MiB, WS_WR = 36 * MiB;
constexpr size_t WS_GIF = 38 * MiB, WS_MEMB = 40 * MiB, WS_KVM = 56 * MiB, WS_X1B = 88 * MiB, WS_R = 216 * MiB;
constexpr size_t WS_XB = WS_R, WS_U = WS_R + 32 * MiB, WS_Y = WS_R + 384 * MiB, WS_F32 = WS_R + 480 * MiB, WS_MRG = WS_R + 544 * MiB, WS_Z = WS_R + 576 * MiB;
constexpr size_t WS_TKI = WS_R, WS_TKW = WS_R + 2 * MiB, WS_SLOTOF = WS_R + 4 * MiB, WS_TOKOF = WS_R + 6 * MiB, WS_WOF = WS_R + 9 * MiB;
constexpr size_t WS_LOGIT = WS_R + 16 * MiB, WS_WGU = WS_R + 80 * MiB, WS_WD = WS_R + 337 * MiB, WS_ACT = WS_R + 580 * MiB, WS_YCH = WS_R + 16 * MiB;
constexpr size_t WS_END = WS_R + 900 * MiB;
constexpr size_t MS_BIAS = 0, MS_LAM = 48 * 1024, MS_TBASE = 52 * 1024, MS_NT = 56 * 1024, MS_TILEE = 64 * 1024;
constexpr int CW_CNT = 1024, CW_CUR = 2048, CW_BAR = 8192, CW_Q = 16384;

constexpr int LDS_RING = 131072, LDS_MISC = LDS_RING + 320, LDS_BYTES = 147456;

DI float bf_lo(unsigned w) { return __uint_as_float(w << 16); }
DI float bf_hi(unsigned w) { return __uint_as_float(w & 0xffff0000u); }
DI float bf2f(bf16_t b) { return __uint_as_float((unsigned)b << 16); }
DI unsigned cvt_pk_bf16(float lo, float hi) { unsigned r; asm("v_cvt_pk_bf16_f32 %0, %1, %2" : "=v"(r) : "v"(lo), "v"(hi)); return r; }
DI float wave_sum(float v) {
#pragma unroll
    for (int o = 1; o < 64; o <<= 1) v += __shfl_xor(v, o);
    return v;
}
DI float wave_max(float v) {
#pragma unroll
    for (int o = 1; o < 64; o <<= 1) v = fmaxf(v, __shfl_xor(v, o));
    return v;
}
DI float sigm(float x) { return 1.f / (1.f + __expf(-x)); }
DI float silu(float x) { return x / (1.f + __expf(-x)); }
DI int tid_local() { int t = threadIdx.x; asm volatile("" : "+v"(t)); return t; }
#define LDS_WAIT() asm volatile("s_waitcnt lgkmcnt(0)" ::: "memory")
namespace pg8 {
constexpr int BM = 256, BK = 64, HALF = 128, HTB = HALF * BK * 2, STAGE_BYTES = 8 * HTB, NXCD = 8, WGM = 8;
__host__ __device__ __forceinline__ int lds_byte(int r, int c) { const int st = (r >> 4) * 2 + (c >> 5), rr = r & 15, cc = c & 31, ob = rr * 64 + cc * 2; return st * 1024 + (ob ^ (((ob >> 9) & 1) << 5)); }
__host__ __device__ __forceinline__ void stage_rc(int b, int& R, int& C) { const int st = b / 1024, sb = b % 1024, swz = sb ^ (((sb >> 9) & 1) << 5); R = (st >> 1) * 16 + swz / 64; C = (st & 1) * 32 + (swz % 64) / 2; }
__host__ __device__ __forceinline__ int perm32(int rho) { const int n = rho >> 4, i = rho & 15; return 8 * (i >> 2) + 4 * n + (i & 3); }

struct Unit { int pm, pn, pb, acol, aux; };
struct Gemm { const bf16_t* A; const bf16_t* Bt; int lda, ldb, K; const int* arow; };

struct StaticOrder {
    int nM, nN, nwg, G, c;
    DI void init(int M, int N, int G_, int c_) { nM = M / BM; nN = N / BM; nwg = nM * nN; G = G_; c = c_; }
    DI bool next(int i, Unit& u) const {
        const long L = (long)i * G + c; if (L >= nwg) return false;
        int wgid = (int)L; { const int q = nwg / NXCD, r = nwg % NXCD, xcd = wgid % NXCD, off = wgid / NXCD; wgid = (xcd < r ? xcd * (q + 1) : r * (q + 1) + (xcd - r) * q) + off; }
        const int nig = WGM * nN, gid = wgid / nig, fm = gid * WGM, gsz = (nM - fm) < WGM ? (nM - fm) : WGM;
        u.pm = fm + ((wgid % nig) % gsz); u.pn = (wgid % nig) / gsz; u.pb = u.pn; u.acol = 0; u.aux = 0; return true;
    }
};

template <class Epi, class Sched, bool ALIGN_EPI, bool GATHER = false>
DI void gemm_phase(LAS unsigned char* lds, const Gemm g, const Sched& S, const Epi& E) {
    const int tid = tid_local(), wid = __builtin_amdgcn_readfirstlane(tid >> 6), lane = tid & 63, wr = wid >> 2, wc = wid & 3, fr = lane & 15, fq = lane >> 4;
    const int nt = g.K / BK;
    int Ra[2], Ca[2], Rb[2];
#pragma unroll
    for (int i = 0; i < 2; ++i) { int R, C; stage_rc(tid * 16 + i * 8192, R, C); Ra[i] = R; Ca[i] = C; Rb[i] = (R & ~31) + perm32(R & 31); }
    const size_t kstep = (size_t)(BK * 2);
    const unsigned ldsw = (unsigned)wid * 1024u;
    const int aoff = lds_byte(wr * 64 + fr, fq * 8), boff = lds_byte(wc * 32 + fr, fq * 8);
#define PG8_SA(b, h) (((b) * 2 + (h)) * HTB)
#define PG8_SB(b, h) ((4 + (b) * 2 + (h)) * HTB)
#define PG8_STAGE(bufoff, gptr, offs) do { _Pragma("unroll") for (int _i = 0; _i < 2; ++_i) \
        __builtin_amdgcn_global_load_lds((const unsigned*)((gptr) + (offs)[_i]), (LAS unsigned*)(lds + (bufoff) + ldsw + _i * 8192), 16, 0, 0); } while (0)
#define PG8_LDA(dst, b, h) do { _Pragma("unroll") for (int m = 0; m < 4; ++m) _Pragma("unroll") for (int k = 0; k < 2; ++k) dst[m][k] = *(const LAS bf16x8*)(lds + PG8_SA(b, h) + aoff + m * 2048 + k * 1024); } while (0)
#define PG8_LDB(dst, b, h) do { _Pragma("unroll") for (int n = 0; n < 2; ++n) _Pragma("unroll") for (int k = 0; k < 2; ++k) dst[n][k] = *(const LAS bf16x8*)(lds + PG8_SB(b, h) + boff + n * 2048 + k * 1024); } while (0)
#define PG8_MMA(ai, bj, At, Bt) do { __builtin_amdgcn_s_setprio(1); _Pragma("unroll") for (int m = 0; m < 4; ++m) _Pragma("unroll") for (int n = 0; n < 2; ++n) _Pragma("unroll") for (int k = 0; k < 2; ++k) \
        acc[ai][bj][m][n] = __builtin_amdgcn_mfma_f32_16x16x32_bf16(Bt[n][k], At[m][k], acc[ai][bj][m][n], 0, 0, 0); __builtin_amdgcn_s_setprio(0); } while (0)
#define PG8_WAIT_V(n) asm volatile("s_waitcnt vmcnt(" #n ")" ::: "memory")
#define PG8_WAIT_L(n) asm volatile("s_waitcnt lgkmcnt(" #n ")" ::: "memory")
#define PG8_BAR __builtin_amdgcn_s_barrier()
#define PG8_SCHED __builtin_amdgcn_sched_barrier(0)
#define PG8_OFFS(u, oa) do { _Pragma("unroll") for (int h_ = 0; h_ < 2; ++h_) _Pragma("unroll") for (int i_ = 0; i_ < 2; ++i_) { \
        const int ar_ = g.arow[(u).pm * BM + h_ * HALF + Ra[i_]]; oa[h_][i_] = (unsigned)(ar_ * g.lda + (u).acol + Ca[i_]) * 2u; } } while (0)
    unsigned voffA[2], voffB[2];
#pragma unroll
    for (int i = 0; i < 2; ++i) { voffA[i] = (unsigned)(Ra[i] * g.lda + Ca[i]) * 2u; voffB[i] = (unsigned)(Rb[i] * g.ldb + Ca[i]) * 2u; }
    const size_t hstepA = (size_t)HALF * g.lda * 2, hstepB = (size_t)HALF * g.ldb * 2;
#define PG8_ABASE(u) ((const char*)g.A + (GATHER ? (size_t)0 : ((size_t)(u).pm * BM * g.lda + (u).acol) * 2))
#define PG8_BBASE(u) ((const char*)g.Bt + (size_t)(u).pb * BM * g.ldb * 2)
#define PG8_STAGE_A(bufoff, ab, oa, h) do { if constexpr (GATHER) { PG8_STAGE(bufoff, ab, (oa)[h]); } else { PG8_STAGE(bufoff, (ab) + (h) * hstepA, voffA); } } while (0)
#define PG8_STAGE_B(bufoff, bb, h) PG8_STAGE(bufoff, (bb) + (h) * hstepB, voffB)
    Unit cur, nxt; int ui = 0;
    if (!S.next(0, cur)) return;
    f32x4 acc[2][2][4][2];
#pragma unroll
    for (int a = 0; a < 2; ++a)
#pragma unroll
        for (int b = 0; b < 2; ++b)
#pragma unroll
            for (int m = 0; m < 4; ++m)
#pragma unroll
                for (int n = 0; n < 2; ++n) acc[a][b][m][n] = (f32x4){0.f, 0.f, 0.f, 0.f};
    bf16x8 At[4][2], B0[2][2], B1[2][2];
    unsigned oaC[2][2], oaN[2][2];
    if constexpr (GATHER) { PG8_OFFS(cur, oaC); }
    const char* cA = PG8_ABASE(cur); const char* cB = PG8_BBASE(cur);
    PG8_STAGE_B(PG8_SB(0, 0), cB, 0); PG8_STAGE_B(PG8_SB(0, 1), cB, 1); PG8_STAGE_A(PG8_SA(0, 0), cA, oaC, 0); PG8_STAGE_A(PG8_SA(0, 1), cA, oaC, 1);
    if (wr == 1) PG8_BAR;
    PG8_WAIT_V(2); PG8_BAR;
    PG8_STAGE_B(PG8_SB(1, 0), cB + kstep, 0); PG8_STAGE_A(PG8_SA(1, 0), cA + kstep, oaC, 0); PG8_STAGE_B(PG8_SB(1, 1), cB + kstep, 1);
    PG8_WAIT_V(6); PG8_BAR;
    for (;;) {
        const bool has_next = S.next(ui + 1, nxt);
        const char* nA = has_next ? PG8_ABASE(nxt) : cA; const char* nB = has_next ? PG8_BBASE(nxt) : cB;
        if constexpr (GATHER) {
            if (has_next) { PG8_OFFS(nxt, oaN); }
            else {
#pragma unroll
                for (int h_ = 0; h_ < 2; ++h_)
#pragma unroll
                    for (int i_ = 0; i_ < 2; ++i_) oaN[h_][i_] = oaC[h_][i_];
            }
        }
#pragma unroll 1
        for (int t = 0; t < nt; t += 2) {
            const bool last = (t == nt - 2);
            const char* a1 = cA + (size_t)(t + 1) * kstep;
            const char* a2 = last ? nA : cA + (size_t)(t + 2) * kstep; const char* b2 = last ? nB : cB + (size_t)(t + 2) * kstep;
            const char* a3 = a2 + kstep; const char* b3 = b2 + kstep;
            unsigned oa2[2][2];
            if constexpr (GATHER) {
#pragma unroll
                for (int h_ = 0; h_ < 2; ++h_)
#pragma unroll
                    for (int i_ = 0; i_ < 2; ++i_) oa2[h_][i_] = last ? oaN[h_][i_] : oaC[h_][i_];
            }
            PG8_LDB(B0, 0, 0); PG8_LDB(B1, 0, 1); PG8_SCHED; PG8_LDA(At, 0, 0); PG8_STAGE_A(PG8_SA(1, 1), a1, oaC, 1);
            PG8_WAIT_V(8); PG8_WAIT_L(0); PG8_BAR; PG8_MMA(0, 0, At, B0); PG8_MMA(0, 1, At, B1); PG8_BAR; PG8_SCHED;
            PG8_LDA(At, 0, 1); PG8_STAGE_B(PG8_SB(0, 0), b2, 0); PG8_STAGE_B(PG8_SB(0, 1), b2, 1); PG8_STAGE_A(PG8_SA(0, 0), a2, oa2, 0);
            PG8_WAIT_V(8); PG8_WAIT_L(0); PG8_BAR; PG8_MMA(1, 0, At, B0); PG8_MMA(1, 1, At, B1); PG8_BAR; PG8_SCHED;
            PG8_LDB(B0, 1, 0); PG8_LDB(B1, 1, 1); PG8_SCHED; PG8_LDA(At, 1, 0); PG8_STAGE_A(PG8_SA(0, 1), a2, oa2, 1);
            PG8_WAIT_V(8); PG8_WAIT_L(0); PG8_BAR; PG8_MMA(0, 0, At, B0); PG8_MMA(0, 1, At, B1); PG8_BAR; PG8_SCHED;
            PG8_LDA(At, 1, 1); PG8_STAGE_B(PG8_SB(1, 0), b3, 0); PG8_STAGE_B(PG8_SB(1, 1), b3, 1); PG8_STAGE_A(PG8_SA(1, 0), a3, oa2, 0);
            PG8_WAIT_V(8); PG8_WAIT_L(0); PG8_BAR; PG8_MMA(1, 0, At, B0); PG8_MMA(1, 1, At, B1); PG8_BAR; PG8_SCHED;
        }
        if constexpr (ALIGN_EPI) { if (wr == 0) PG8_BAR; }
        E(acc, cur, wr, wc, fr, fq);
        if (!has_next) break;
#pragma unroll
        for (int a = 0; a < 2; ++a)
#pragma unroll
            for (int b = 0; b < 2; ++b)
#pragma unroll
                for (int m = 0; m < 4; ++m)
#pragma unroll
                    for (int n = 0; n < 2; ++n) acc[a][b][m][n] = (f32x4){0.f, 0.f, 0.f, 0.f};
        cur = nxt; cA = nA; cB = nB; ++ui;
        if constexpr (GATHER) {
#pragma unroll
            for (int h_ = 0; h_ < 2; ++h_)
#pragma unroll
                for (int i_ = 0; i_ < 2; ++i_) oaC[h_][i_] = oaN[h_][i_];
        }
        if constexpr (ALIGN_EPI) { if (wr == 1) PG8_BAR; }
    }
    PG8_WAIT_V(0);
    if constexpr (!ALIGN_EPI) { if (wr == 0) PG8_BAR; }
    PG8_BAR;
#undef PG8_SA
#undef PG8_SB
#undef PG8_STAGE
#undef PG8_LDA
#undef PG8_LDB
#undef PG8_MMA
#undef PG8_WAIT_V
#undef PG8_WAIT_L
#undef PG8_BAR
#undef PG8_SCHED
#undef PG8_OFFS
#undef PG8_ABASE
#undef PG8_BBASE
#undef PG8_STAGE_A
#undef PG8_STAGE_B
}
}
using pg8::Unit; using pg8::BM; using pg8::HALF;

struct BranchOrder {
    int ntile, G, c;
    DI bool next(int i, Unit& u) const {
        const int L = (i / 3) * G + c; if (L >= ntile) return false;
        const int n = i % 3; u.pm = L >> 2; u.pn = L & 3; u.pb = n * 4 + u.pn; u.acol = n * 1024; u.aux = n; return true;
    }
};
struct ExpertGUOrder {
    const int* tile_e; int nunits, G, c;
    DI bool next(int i, Unit& u) const {
        const int L = i * G + c; if (L >= nunits) return false;
        const int t = L >> 1, hf = L & 1; const int e = tile_e[t];
        u.pm = t; u.pn = hf; u.pb = e * 2 + hf; u.acol = 0; u.aux = e; return true;
    }
};
struct ExpertDownOrder {
    const int* tile_e; int nunits, G, c, round;
    DI bool next(int i, Unit& u) const {
        const int L = i * G + c; if (L >= nunits) return false;
        const int e = tile_e[L];
        u.pm = L; u.pn = 0; u.pb = e * 4 + round; u.acol = 0; u.aux = e; return true;
    }
};

#define EPI_ARGS const f32x4 (&acc)[2][2][4][2], const Unit& u, int wr, int wc, int fr, int fq
DI u32x4 pack8(const f32x4 v0, const f32x4 v1) { u32x4 w; w.x = cvt_pk_bf16(v0[0], v0[1]); w.y = cvt_pk_bf16(v0[2], v0[3]); w.z = cvt_pk_bf16(v1[0], v1[1]); w.w = cvt_pk_bf16(v1[2], v1[3]); return w; }

struct EpiInProj {
    bf16_t* O; const float* bias;
    DI void operator()(EPI_ARGS) const {
        const int row0 = u.pm * BM + wr * 64 + fr, col0 = u.pn * BM + wc * 32 + 8 * fq;
        const float sc = (u.pn < 4) ? 0.125f * 1.4426950408889634f : ((u.pn >= 28 && u.pn < 32) ? 0.0625f : 1.f);
        f32x4 bv[2][2];
#pragma unroll
        for (int bj = 0; bj < 2; ++bj)
#pragma unroll
            for (int n = 0; n < 2; ++n) bv[bj][n] = *(const f32x4*)(bias + col0 + bj * HALF + 4 * n);
#pragma unroll
        for (int ai = 0; ai < 2; ++ai)
#pragma unroll
            for (int m = 0; m < 4; ++m) { bf16_t* rowp = O + (size_t)(row0 + ai * HALF + m * 16) * NU + col0;
#pragma unroll
                for (int bj = 0; bj < 2; ++bj) *(u32x4*)(rowp + bj * HALF) = pack8((acc[ai][bj][m][0] + bv[bj][0]) * sc, (acc[ai][bj][m][1] + bv[bj][1]) * sc); }
    }
};
struct EpiPlain {
    bf16_t* O; int ldc;
    DI void operator()(EPI_ARGS) const {
        const int row0 = u.pm * BM + wr * 64 + fr, col0 = u.pn * BM + wc * 32 + 8 * fq;
#pragma unroll
        for (int ai = 0; ai < 2; ++ai)
#pragma unroll
            for (int m = 0; m < 4; ++m) { bf16_t* rowp = O + (size_t)(row0 + ai * HALF + m * 16) * ldc + col0;
#pragma unroll
                for (int bj = 0; bj < 2; ++bj) *(u32x4*)(rowp + bj * HALF) = pack8(acc[ai][bj][m][0], acc[ai][bj][m][1]); }
    }
};
struct EpiBranch {
    const bf16_t* U; float* F; bf16_t* M;
    DI void operator()(EPI_ARGS) const {
        const int row0 = u.pm * BM + wr * 64 + fr, col0 = u.pn * BM + wc * 32 + 8 * fq, n = u.aux;
#pragma unroll
        for (int ai = 0; ai < 2; ++ai)
#pragma unroll
            for (int m = 0; m < 4; ++m) { const size_t row = (size_t)(row0 + ai * HALF + m * 16);
#pragma unroll
                for (int bj = 0; bj < 2; ++bj) { const int col = col0 + bj * HALF;
                    const u32x4 gw = *(const u32x4*)(U + row * NU + UGT + n * 1024 + col);
                    f32x4 g0 = {sigm(bf_lo(gw.x)), sigm(bf_hi(gw.x)), sigm(bf_lo(gw.y)), sigm(bf_hi(gw.y))};
                    f32x4 g1 = {sigm(bf_lo(gw.z)), sigm(bf_hi(gw.z)), sigm(bf_lo(gw.w)), sigm(bf_hi(gw.w))};
                    f32x4 v0 = acc[ai][bj][m][0] * g0, v1 = acc[ai][bj][m][1] * g1;
                    float* fp = F + row * 1024 + col;
                    if (n > 0) { v0 += *(const f32x4*)fp; v1 += *(const f32x4*)(fp + 4); }
                    if (n < 2) { *(f32x4*)fp = v0; *(f32x4*)(fp + 4) = v1; }
                    else *(u32x4*)(M + row * 1024 + col) = pack8(v0, v1); }
                asm volatile("" ::: "memory"); }
    }
};
struct EpiOutProj {
    const float* X; float* Z;
    DI void operator()(EPI_ARGS) const {
        const int row0 = u.pm * BM + wr * 64 + fr, col0 = u.pn * BM + wc * 32 + 8 * fq;
#pragma unroll
        for (int ai = 0; ai < 2; ++ai)
#pragma unroll
            for (int m = 0; m < 4; ++m) { const size_t off = (size_t)(row0 + ai * HALF + m * 16) * 1024 + col0;
#pragma unroll
                for (int bj = 0; bj < 2; ++bj) { const float* xp = X + off + bj * HALF; float* zp = Z + off + bj * HALF;
                    *(f32x4*)zp = *(const f32x4*)xp * ALPHA + acc[ai][bj][m][0]; *(f32x4*)(zp + 4) = *(const f32x4*)(xp + 4) * ALPHA + acc[ai][bj][m][1]; }
                asm volatile("" ::: "memory"); }
    }
};
struct EpiF32 {
    float* O; int ldc;
    DI void operator()(EPI_ARGS) const {
        const int row0 = u.pm * BM + wr * 64 + fr, col0 = u.pn * BM + wc * 32 + 8 * fq;
#pragma unroll
        for (int ai = 0; ai < 2; ++ai)
#pragma unroll
            for (int m = 0; m < 4; ++m) { float* rowp = O + (size_t)(row0 + ai * HALF + m * 16) * ldc + col0;
#pragma unroll
                for (int bj = 0; bj < 2; ++bj) { *(f32x4*)(rowp + bj * HALF) = acc[ai][bj][m][0]; *(f32x4*)(rowp + bj * HALF + 4) = acc[ai][bj][m][1]; } }
    }
};
struct EpiGateUp {
    bf16_t* ACT;
    DI void operator()(EPI_ARGS) const {
        const int row0 = u.pm * BM + wr * 64 + fr, col0 = u.pn * HALF + wc * 32 + 8 * fq;
#pragma unroll
        for (int ai = 0; ai < 2; ++ai)
#pragma unroll
            for (int m = 0; m < 4; ++m) { f32x4 v[2];
#pragma unroll
                for (int n = 0; n < 2; ++n) { const f32x4 gt = acc[ai][0][m][n], up = acc[ai][1][m][n];
                    v[n] = (f32x4){silu(gt[0]) * up[0], silu(gt[1]) * up[1], silu(gt[2]) * up[2], silu(gt[3]) * up[3]}; }
                *(u32x4*)(ACT + (size_t)(row0 + ai * HALF + m * 16) * 256 + col0) = pack8(v[0], v[1]); }
    }
};
struct EpiDown {
    bf16_t* Y; const float* W;
    DI void operator()(EPI_ARGS) const {
        const int row0 = u.pm * BM + wr * 64 + fr, col0 = wc * 32 + 8 * fq;
#pragma unroll
        for (int ai = 0; ai < 2; ++ai)
#pragma unroll
            for (int m = 0; m < 4; ++m) { const int row = row0 + ai * HALF + m * 16; const float w = W[row];
#pragma unroll
                for (int bj = 0; bj < 2; ++bj) *(u32x4*)(Y + (size_t)row * 256 + col0 + bj * HALF) = pack8(acc[ai][bj][m][0] * w, acc[ai][bj][m][1] * w);
                asm volatile("" ::: "memory"); }
    }
};
#define RLX_AGENT __ATOMIC_RELAXED, __HIP_MEMORY_SCOPE_AGENT
#define XB_TMO      128
#define XB_XCNT(j)  (256  + 64 * (j))
#define XB_XSUB(j)  (1280 + 64 * (j))
#define XB_XGEN(j)  (2304 + 64 * (j))
#define XB_TOP      3328
#define XB_TOPGEN   3392
#define XCD_BAR_WORDS 3456
#define XB_SPIN_CAP (1u << 18)

__device__ __forceinline__ unsigned xb_ld(unsigned* p)              { return __hip_atomic_load(p, __ATOMIC_RELAXED, __HIP_MEMORY_SCOPE_AGENT); }
__device__ __forceinline__ unsigned xb_add(unsigned* p, unsigned v) { return __hip_atomic_fetch_add(p, v, __ATOMIC_RELAXED, __HIP_MEMORY_SCOPE_AGENT); }
__device__ __forceinline__ unsigned xb_xcc_id() { return (unsigned)__builtin_amdgcn_s_getreg((3 << 11) | 20) & 0xFu; }
#define XB_SPIN(cond, bar) do { unsigned _sp = 0; while (cond) { __builtin_amdgcn_s_sleep(1); \
    if ((++_sp & 255u) == 0u) { if (xb_ld(&(bar)[XB_TMO])) break; if (_sp > XB_SPIN_CAP) { atomicAdd(&(bar)[XB_TMO], 1u); break; } } } } while (0)

struct XcdBarrier {
    unsigned* bar; unsigned x;
    volatile LAS unsigned* st;
};

__device__ __forceinline__ XcdBarrier xcd_barrier_post(unsigned* bar, volatile LAS unsigned* st) {
    XcdBarrier b; b.bar = bar; b.x = xb_xcc_id(); b.st = st;
    if (threadIdx.x == 0) (void)xb_add(&bar[XB_XCNT(b.x)], 1u);
    return b;
}
__device__ __forceinline__ void xcd_barrier_complete(unsigned* bar, unsigned x, unsigned& nloc, unsigned& nx) {
    const unsigned G = gridDim.x * gridDim.y * gridDim.z;
    unsigned sum, cnt, mine, sp = 0u;
    for (;;) {
        sum = 0u; cnt = 0u; mine = 0u;
#pragma unroll
        for (unsigned j = 0; j < 16; ++j) { const unsigned c = xb_ld(&bar[XB_XCNT(j)]); sum += c; cnt += (c > 0u) ? 1u : 0u; mine = (j == x) ? c : mine; }
        if (sum == G) break;
        __builtin_amdgcn_s_sleep(1);
        if ((++sp & 255u) == 0u) { if (xb_ld(&bar[XB_TMO])) break; if (sp > XB_SPIN_CAP) { atomicAdd(&bar[XB_TMO], 1u); break; } }
    }
    nloc = mine > 0u ? mine : 1u; nx = cnt > 0u ? cnt : 1u;
}

__device__ __forceinline__ void xcd_barrier(const XcdBarrier& b) {
    asm volatile("s_waitcnt vmcnt(0)" ::: "memory");
    __syncthreads();
    if (threadIdx.x == 0) {
        unsigned* bar = b.bar;
        __builtin_amdgcn_s_waitcnt(0);
        unsigned nloc = b.st[0], nx = b.st[1];
        if (nloc == 0u) { xcd_barrier_complete(bar, b.x, nloc, nx); b.st[0] = nloc; b.st[1] = nx; }
        const unsigned old = xb_add(&bar[XB_XSUB(b.x)], 1u);
        const unsigned gen = old / nloc;
        if (old + 1u == (gen + 1u) * nloc) {
            __builtin_amdgcn_fence(__ATOMIC_RELEASE, "agent");
            asm volatile("s_waitcnt vmcnt(0)" ::: "memory");
            const unsigned og = xb_add(&bar[XB_TOP], 1u);
            const unsigned tg = og / nx;
            if (og + 1u == (tg + 1u) * nx) xb_add(&bar[XB_TOPGEN], 1u);
            else XB_SPIN(xb_ld(&bar[XB_TOPGEN]) == tg, bar);
            __builtin_amdgcn_fence(__ATOMIC_ACQUIRE, "agent");
            xb_add(&bar[XB_XGEN(b.x)], 1u);
            asm volatile("s_waitcnt vmcnt(0)" ::: "memory");
        } else {
            XB_SPIN(xb_ld(&bar[XB_XGEN(b.x)]) == gen, bar);
            __builtin_amdgcn_fence(__ATOMIC_ACQUIRE, "agent");
            asm volatile("s_waitcnt vmcnt(0)" ::: "memory");
        }
    }
    __syncthreads();
}

struct P {
    const float *x, *mem, *rel_bias, *w_in, *b_in, *conv_w, *diff_lambda, *subln_g, *mlstm_norm_g, *w_mem_kv, *w_branch, *w_out, *ln1_g, *ln1_b,
                *w_router, *router_bias, *w_e_gate, *w_e_up, *w_e_down, *w_s_gate, *w_s_up, *w_s_down, *ln2_g, *ln2_b;
    float* out; unsigned char* ws; int s_lo, s_hi;
};
typedef const P __attribute__((address_space(4)))* PP;
DI PP kargs() { PP k = (PP)__builtin_amdgcn_kernarg_segment_ptr(); asm volatile("" : "+s"(k)); return k; }
DI P load_args(PP k) { P r; const unsigned long long __attribute__((address_space(4)))* s = (const unsigned long long __attribute__((address_space(4)))*)k; unsigned long long* d = (unsigned long long*)&r;
#pragma unroll
    for (int i = 0; i < (int)(sizeof(P) / 8); ++i) d[i] = s[i];
    return r; }
#define WSP(T, off) ((T*)(p.ws + (off)))

DI void transpose_item(const float* W, int ldw, int src_col0, bf16_t* WT, int ldt, int dst_row0, int k0, LAS float* scr, int lane) {
#pragma unroll 8
    for (int i = 0; i < 32; ++i) { const int kk = 2 * i + (lane >> 5); scr[kk * 33 + (lane & 31)] = W[(size_t)(k0 + kk) * ldw + src_col0 + (lane & 31)]; }
    LDS_WAIT();
    const int c = lane & 7;
#pragma unroll
    for (int j = 0; j < 4; ++j) { const int n = (lane >> 3) + 8 * j; const LAS float* s = scr + (8 * c) * 33 + n;
        u32x4 o; o.x = cvt_pk_bf16(s[0 * 33], s[1 * 33]); o.y = cvt_pk_bf16(s[2 * 33], s[3 * 33]); o.z = cvt_pk_bf16(s[4 * 33], s[5 * 33]); o.w = cvt_pk_bf16(s[6 * 33], s[7 * 33]);
        *(u32x4*)(WT + (size_t)(dst_row0 + n) * ldt + k0 + 8 * c) = o; }
    LDS_WAIT();
}
DI void transpose_mat(const float* W, int ldw, int src_col0, int K, int N, bf16_t* WT, int ldt, int dst_row0, int gw, int NGW, LAS float* scr, int lane) {
    const int nblk = N / 32, items = (K / 64) * nblk;
    for (int it = gw; it < items; it += NGW) { const int kb = it / nblk, nb = it % nblk; transpose_item(W, ldw, src_col0 + nb * 32, WT, ldt, dst_row0 + nb * 32, kb * 64, scr, lane); }
}
DI void row_to_bf16(const float* src, bf16_t* dst, int lane) {
    const f32x4* s = (const f32x4*)src + lane; u32x2* d = (u32x2*)dst + lane;
#pragma unroll
    for (int j = 0; j < 4; ++j) { const f32x4 v = s[64 * j]; u32x2 o; o.x = cvt_pk_bf16(v[0], v[1]); o.y = cvt_pk_bf16(v[2], v[3]); d[64 * j] = o; }
}

DI void ph_prologue(PP pk_, LAS unsigned char* lds) { const P p = load_args(pk_);
    const int tid = tid_local(), lane = tid & 63, wave = tid >> 6, gw = blockIdx.x * 8 + wave, NGW = gridDim.x * 8;
    LAS float* scr = (LAS float*)(lds + wave * 16384);
    bf16_t* WinT = WSP(bf16_t, WS_WIN);
    transpose_mat(p.w_in, CIN, 0, 1024, 7168, WinT, 1024, 0, gw, NGW, scr, lane);
    transpose_mat(p.w_in, CIN, 7176, 1024, 4096, WinT, 1024, 7168, gw, NGW, scr, lane);
    transpose_mat(p.w_mem_kv, 2048, 0, 1024, 2048, WSP(bf16_t, WS_WKV), 1024, 0, gw, NGW, scr, lane);
    for (int n = 0; n < 3; ++n) transpose_mat(p.w_branch + (size_t)n * 1024 * 1024, 1024, 0, 1024, 1024, WSP(bf16_t, WS_WBR), 1024, n * 1024, gw, NGW, scr, lane);
    transpose_mat(p.w_out, 1024, 0, 1024, 1024, WSP(bf16_t, WS_WOUT), 1024, 0, gw, NGW, scr, lane);
    transpose_mat(p.w_router, 256, 0, 1024, 256, WSP(bf16_t, WS_WR), 1024, 0, gw, NGW, scr, lane);
    bf16_t* memb = WSP(bf16_t, WS_MEMB);
    for (int r = gw; r < NBATCH * 256; r += NGW) row_to_bf16(p.mem + (size_t)r * 1024, memb + (size_t)r * 1024, lane);
    float* bias = WSP(float, WS_MISC + MS_BIAS);
    for (int j = blockIdx.x * 512 + tid; j < NU; j += gridDim.x * 512) bias[j] = p.b_in[j + (j >= 7168 ? 8 : 0)];
    if (gw == 0) {
        const float* lv = p.diff_lambda;
        const float s1 = wave_sum(lv[lane] * lv[64 + lane]), s2 = wave_sum(lv[128 + lane] * lv[192 + lane]);
        if (lane == 0) *WSP(float, WS_MISC + MS_LAM) = expf(s1) - expf(s2) + 0.2f;
    }
}

DI void ph_xconv(PP pk_, int g, LAS unsigned char* lds) { const P p = load_args(pk_);
    const int tid = tid_local(), lane = tid & 63, wave = tid >> 6, gw = blockIdx.x * 8 + wave, NGW = gridDim.x * 8;
    LAS float* wg = (LAS float*)lds;
    for (int i = tid; i < 2048; i += 512) { const int c = i >> 1, hf = i & 1; *(LAS f32x4*)(wg + c * 8 + hf * 4) = *(const f32x4*)(p.w_in + (size_t)c * CIN + 7168 + hf * 4); }
    __syncthreads();
    bf16_t* xb = WSP(bf16_t, WS_XB); float* gif = WSP(float, WS_GIF);
    for (int r = gw; r < TG; r += NGW) {
        const size_t t = (size_t)g * TG + r;
        const f32x4* xr = (const f32x4*)(p.x + t * 1024) + lane; u32x2* d = (u32x2*)(xb + (size_t)r * 1024) + lane;
        float gs[8];
#pragma unroll
        for (int q = 0; q < 8; ++q) gs[q] = 0.f;
#pragma unroll
        for (int j = 0; j < 4; ++j) { const f32x4 v = xr[64 * j]; u32x2 o; o.x = cvt_pk_bf16(v[0], v[1]); o.y = cvt_pk_bf16(v[2], v[3]); d[64 * j] = o;
#pragma unroll
            for (int e = 0; e < 4; ++e) { const int c = 4 * lane + 256 * j + e; const f32x4 wl = *(const LAS f32x4*)(wg + c * 8), wh = *(const LAS f32x4*)(wg + c * 8 + 4);
                gs[0] += v[e] * wl[0]; gs[1] += v[e] * wl[1]; gs[2] += v[e] * wl[2]; gs[3] += v[e] * wl[3]; gs[4] += v[e] * wh[0]; gs[5] += v[e] * wh[1]; gs[6] += v[e] * wh[2]; gs[7] += v[e] * wh[3]; } }
        float mine = 0.f;
#pragma unroll
        for (int q = 0; q < 8; ++q) { const float s = wave_sum(gs[q]); if (lane == q) mine = s; }
        if (lane < 8) gif[t * 8 + lane] = mine + p.b_in[7168 + lane];
    }
    __syncthreads();
}

DI int t5_bucket(int n) { return n < 16 ? n : min(31, 16 + (int)(__log2f((float)n * 0.0625f) * (16.f / 3.f))); }

DI void attn_naive_item(PP pk_, int item, LAS unsigned char* lds) { const P p = load_args(pk_);
    const int tid = tid_local(), qr = tid >> 3, map = (tid >> 2) & 1, dc = tid & 3;
    const int qb = item & 31, h = (item >> 5) & 7, b = item >> 8, q0 = qb * 64, qi = q0 + qr;
    const bf16_t* U = WSP(bf16_t, WS_U); const size_t rbase = (size_t)b * SEQ;
    LAS float* bt = (LAS float*)(lds + 16384);
    if (tid <= 128) bt[tid] = p.rel_bias[t5_bucket(tid) * 8 + h] * 1.4426950408889634f;
    float q[64];
    { const u32x4* qp = (const u32x4*)(U + (rbase + qi) * NU + UQ + h * 128 + map * 64);
#pragma unroll
      for (int i = 0; i < 8; ++i) { const u32x4 w = qp[i]; q[8 * i] = bf_lo(w.x); q[8 * i + 1] = bf_hi(w.x); q[8 * i + 2] = bf_lo(w.y); q[8 * i + 3] = bf_hi(w.y); q[8 * i + 4] = bf_lo(w.z); q[8 * i + 5] = bf_hi(w.z); q[8 * i + 6] = bf_lo(w.w); q[8 * i + 7] = bf_hi(w.w); } }
    float o[32];
#pragma unroll
    for (int c = 0; c < 32; ++c) o[c] = 0.f;
    float mrun = -INFINITY, lrun = 0.f;
    const int ntile = q0 / 32 + 2;
    for (int kt = 0; kt < ntile; ++kt) {
        const int k0 = kt * 32;
        __syncthreads();
        { const int key = tid >> 4, pc = tid & 15; const bf16_t* urow = U + (rbase + k0 + key) * NU;
          *(LAS u32x4*)(lds + (pc >> 3) * 4096 + key * 128 + (pc & 7) * 16) = *(const u32x4*)(urow + UK + h * 128 + pc * 8);
          *(LAS u32x4*)(lds + 8192 + key * 256 + pc * 16) = *(const u32x4*)(urow + UV + h * 128 + pc * 8); }
        __syncthreads();
#pragma unroll 1
        for (int j = 0; j < 32; ++j) {
            const int dist = qi - (k0 + j);
            const LAS u32x4* kp = (const LAS u32x4*)(lds + map * 4096 + j * 128); float a = 0.f;
#pragma unroll
            for (int i = 0; i < 8; ++i) { const u32x4 w = kp[i]; a += q[8 * i] * bf_lo(w.x) + q[8 * i + 1] * bf_hi(w.x) + q[8 * i + 2] * bf_lo(w.y) + q[8 * i + 3] * bf_hi(w.y) + q[8 * i + 4] * bf_lo(w.z) + q[8 * i + 5] * bf_hi(w.z) + q[8 * i + 6] * bf_lo(w.w) + q[8 * i + 7] * bf_hi(w.w); }
            if (dist >= 0) {
                a += bt[min(dist, 128)];
                if (a > mrun) { const float sc = __builtin_amdgcn_exp2f(mrun - a); mrun = a; lrun *= sc;
#pragma unroll
                    for (int c = 0; c < 32; ++c) o[c] *= sc; }
                const float pj = __builtin_amdgcn_exp2f(a - mrun); lrun += pj; const LAS u32x4* vp = (const LAS u32x4*)(lds + 8192 + j * 256 + dc * 64);
#pragma unroll
                for (int i = 0; i < 4; ++i) { const u32x4 w = vp[i]; o[8 * i] += pj * bf_lo(w.x); o[8 * i + 1] += pj * bf_hi(w.x); o[8 * i + 2] += pj * bf_lo(w.y); o[8 * i + 3] += pj * bf_hi(w.y); o[8 * i + 4] += pj * bf_lo(w.z); o[8 * i + 5] += pj * bf_hi(w.z); o[8 * i + 6] += pj * bf_lo(w.w); o[8 * i + 7] += pj * bf_hi(w.w); }
            }
        }
    }
    const float lam = *WSP(float, WS_MISC + MS_LAM), inv = 1.f / lrun;
    float ss = 0.f;
#pragma unroll
    for (int c = 0; c < 32; ++c) { const float mine = o[c] * inv, other = __shfl_xor(mine, 4); o[c] = mine - lam * other; ss += o[c] * o[c]; }
    ss += __shfl_xor(ss, 1); ss += __shfl_xor(ss, 2);
    const float rs = rsqrtf(ss * (1.f / 128.f) + LN_EPS) * 0.8f;
    if (map == 0) { bf16_t* yp = WSP(bf16_t, WS_Y) + (rbase + qi) * 3072 + h * 128 + dc * 32; const float* gp = p.subln_g + dc * 32;
#pragma unroll
        for (int i = 0; i < 4; ++i) { u32x4 w; w.x = cvt_pk_bf16(o[8 * i] * rs * gp[8 * i], o[8 * i + 1] * rs * gp[8 * i + 1]); w.y = cvt_pk_bf16(o[8 * i + 2] * rs * gp[8 * i + 2], o[8 * i + 3] * rs * gp[8 * i + 3]);
            w.z = cvt_pk_bf16(o[8 * i + 4] * rs * gp[8 * i + 4], o[8 * i + 5] * rs * gp[8 * i + 5]); w.w = cvt_pk_bf16(o[8 * i + 6] * rs * gp[8 * i + 6], o[8 * i + 7] * rs * gp[8 * i + 7]); *(u32x4*)(yp + 8 * i) = w; } }
    __syncthreads();
}

DI void xattn_naive_item(PP pk_, int g, int item, LAS unsigned char* lds) { const P p = load_args(pk_);
    const int tid = tid_local(), lane = tid & 63, wave = tid >> 6;
    const int qb = item & 63, h = (item >> 6) & 3, b = item >> 8;
    const bf16_t* U = WSP(bf16_t, WS_U); const bf16_t* KV = WSP(bf16_t, WS_KVM) + (size_t)(g * BG + b) * 256 * 2048;
    const size_t r0 = (size_t)b * SEQ + qb * 32;
    LAS float* qs = (LAS float*)lds; LAS float* ps = (LAS float*)(lds + 32768);
    __syncthreads();
    for (int i = tid; i < 32 * 32; i += 512) { const int r = i >> 5, c8 = i & 31; const u32x4 w = *(const u32x4*)(U + (r0 + r) * NU + UCQ + h * 256 + c8 * 8); LAS float* d = qs + r * 256 + c8 * 8;
        d[0] = bf_lo(w.x); d[1] = bf_hi(w.x); d[2] = bf_lo(w.y); d[3] = bf_hi(w.y); d[4] = bf_lo(w.z); d[5] = bf_hi(w.z); d[6] = bf_lo(w.w); d[7] = bf_hi(w.w); }
    __syncthreads();
    const int mcol = tid & 255, rh = tid >> 8;
    { float a[16];
#pragma unroll
      for (int r = 0; r < 16; ++r) a[r] = 0.f;
      const bf16_t* kp = KV + (size_t)mcol * 2048 + h * 256;
      for (int d0 = 0; d0 < 256; d0 += 8) { const u32x4 w = *(const u32x4*)(kp + d0); float kv[8] = {bf_lo(w.x), bf_hi(w.x), bf_lo(w.y), bf_hi(w.y), bf_lo(w.z), bf_hi(w.z), bf_lo(w.w), bf_hi(w.w)};
#pragma unroll
          for (int r = 0; r < 16; ++r) { const LAS f32x4* qp = (const LAS f32x4*)(qs + (rh * 16 + r) * 256 + d0); const f32x4 qa = qp[0], qc = qp[1];
              a[r] += qa[0] * kv[0] + qa[1] * kv[1] + qa[2] * kv[2] + qa[3] * kv[3] + qc[0] * kv[4] + qc[1] * kv[5] + qc[2] * kv[6] + qc[3] * kv[7]; } }
#pragma unroll
      for (int r = 0; r < 16; ++r) ps[(rh * 16 + r) * 256 + mcol] = a[r]; }
    __syncthreads();
#pragma unroll
    for (int rr = 0; rr < 4; ++rr) { const int r = wave * 4 + rr; LAS f32x4* pr = (LAS f32x4*)(ps + r * 256) + lane; f32x4 v = *pr;
        const float mx = wave_max(fmaxf(fmaxf(v[0], v[1]), fmaxf(v[2], v[3])));
        v = (f32x4){__expf(v[0] - mx), __expf(v[1] - mx), __expf(v[2] - mx), __expf(v[3] - mx)};
        const float inv = 1.f / wave_sum((v[0] + v[1]) + (v[2] + v[3])); *pr = v * inv; }
    __syncthreads();
    { float a[16];
#pragma unroll
      for (int r = 0; r < 16; ++r) a[r] = 0.f;
      const bf16_t* vp = KV + 1024 + h * 256 + mcol;
      for (int m = 0; m < 256; ++m) { const float vv = bf2f(vp[(size_t)m * 2048]);
#pragma unroll
          for (int r = 0; r < 16; ++r) a[r] += ps[(rh * 16 + r) * 256 + m] * vv; }
      bf16_t* yp = WSP(bf16_t, WS_Y) + (r0 + rh * 16) * 3072 + 2048 + h * 256 + mcol;
#pragma unroll
      for (int r = 0; r < 16; ++r) yp[(size_t)r * 3072] = (bf16_t)(cvt_pk_bf16(a[r], 0.f) & 0xffffu); }
    __syncthreads();
}

DI void mlstm_naive_item(PP pk_, int g, int item, LAS unsigned char* lds) { const P p = load_args(pk_);
    const int tid = tid_local(), v = tid >> 3, kc = tid & 7;
    const int sl = item & 3, h = (item >> 2) & 3, b = item >> 4;
    const bf16_t* U = WSP(bf16_t, WS_U); const float* gif = WSP(float, WS_GIF); float* HT = WSP(float, WS_F32);
    const size_t rbase = (size_t)b * SEQ; const size_t tbase = ((size_t)g * BG + b) * SEQ;
    LAS bf16_t* qs = (LAS bf16_t*)lds; LAS bf16_t* ks = (LAS bf16_t*)(lds + 32768); LAS float* vs = (LAS float*)(lds + 65536); LAS float* gi = (LAS float*)(lds + 81920); LAS float* gf = (LAS float*)(lds + 82176);
    float C[32], nn[32];
#pragma unroll
    for (int i = 0; i < 32; ++i) { C[i] = 0.f; nn[i] = 0.f; }
    float mst = 0.f;
    for (int ch = 0; ch < SEQ / 64; ++ch) {
        __syncthreads();
        for (int i = tid; i < 2 * 64 * 32; i += 512) { const int isk = i >> 11, s = (i >> 5) & 63, c8 = i & 31; const int ts = ch * 64 + s; const int col = (isk ? UMK : UMQ) + h * 256 + c8 * 8;
            float a[8];
#pragma unroll
            for (int e = 0; e < 8; ++e) a[e] = 0.f;
#pragma unroll
            for (int j = 0; j < 4; ++j) { const int tt = ts - 3 + j; if (tt >= 0) { const u32x4 w = *(const u32x4*)(U + (rbase + tt) * NU + col); const float* cw = p.conv_w + j * 2048 + isk * 1024 + h * 256 + c8 * 8;
                    a[0] += cw[0] * bf_lo(w.x); a[1] += cw[1] * bf_hi(w.x); a[2] += cw[2] * bf_lo(w.y); a[3] += cw[3] * bf_hi(w.y); a[4] += cw[4] * bf_lo(w.z); a[5] += cw[5] * bf_hi(w.z); a[6] += cw[6] * bf_lo(w.w); a[7] += cw[7] * bf_hi(w.w); } }
            const float sc = isk ? 0.0625f : 1.f; u32x4 o; o.x = cvt_pk_bf16(silu(a[0]) * sc, silu(a[1]) * sc); o.y = cvt_pk_bf16(silu(a[2]) * sc, silu(a[3]) * sc); o.z = cvt_pk_bf16(silu(a[4]) * sc, silu(a[5]) * sc); o.w = cvt_pk_bf16(silu(a[6]) * sc, silu(a[7]) * sc);
            *(LAS u32x4*)((isk ? ks : qs) + s * 256 + c8 * 8) = o; }
        for (int i = tid; i < 64 * 64; i += 512) { const int s = i >> 6, c = i & 63; vs[i] = bf2f(U[(rbase + ch * 64 + s) * NU + UMV + h * 256 + sl * 64 + c]); }
        if (tid < 64) { gi[tid] = gif[(tbase + ch * 64 + tid) * 8 + h]; gf[tid] = gif[(tbase + ch * 64 + tid) * 8 + 4 + h]; }
        __syncthreads();
        for (int s = 0; s < 64; ++s) {
            const float ip = gi[s], fp = gf[s];
            const float fl = fminf(fp, 0.f) - log1pf(expf(-fabsf(fp)));
            const float mm = fmaxf(fl + mst, ip), fg = expf(fl + mst - mm), ig = expf(ip - mm); mst = mm;
            const float vv = vs[s * 64 + v] * ig;
            const LAS u32x4* kp = (const LAS u32x4*)(ks + s * 256 + kc * 32); const LAS u32x4* qp = (const LAS u32x4*)(qs + s * 256 + kc * 32);
            float num = 0.f, den = 0.f;
#pragma unroll
            for (int c4 = 0; c4 < 4; ++c4) { const u32x4 kw = kp[c4], qw = qp[c4];
#pragma unroll
                for (int e = 0; e < 4; ++e) { const float k0 = bf_lo(kw[e]), k1 = bf_hi(kw[e]), q0 = bf_lo(qw[e]), q1 = bf_hi(qw[e]); const int kk = c4 * 8 + 2 * e;
                    C[kk] = fg * C[kk] + vv * k0; nn[kk] = fg * nn[kk] + ig * k0; num += C[kk] * q0; den += nn[kk] * q0;
                    C[kk + 1] = fg * C[kk + 1] + vv * k1; nn[kk + 1] = fg * nn[kk + 1] + ig * k1; num += C[kk + 1] * q1; den += nn[kk + 1] * q1; } }
            num += __shfl_xor(num, 1); num += __shfl_xor(num, 2); num += __shfl_xor(num, 4);
            den += __shfl_xor(den, 1); den += __shfl_xor(den, 2); den += __shfl_xor(den, 4);
            if (kc == 0) HT[(rbase + ch * 64 + s) * 1024 + h * 256 + sl * 64 + v] = num / fmaxf(fabsf(den), expf(-mst));
        }
    }
    __syncthreads();
}

typedef float f32x16 __attribute__((ext_vector_type(16)));
typedef __bf16 bf16x2_t __attribute__((ext_vector_type(2)));
typedef short s16x4 __attribute__((ext_vector_type(4)));
constexpr float LOG2E = 1.4426950408889634f;
DI unsigned pk_bf16(float a, float b) { const f32x2 v = {a, b}; return __builtin_bit_cast(unsigned, __builtin_convertvector(v, bf16x2_t)); }
DI int crow(int reg, int hh) { return (reg & 3) + 8 * (reg >> 2) + 4 * hh; }
#define MFMA32(a, b, c) __builtin_amdgcn_mfma_f32_32x32x16_bf16((a), (b), (c), 0, 0, 0)
DI bf16x8 tr_pair(const LAS unsigned char* a0, const LAS unsigned char* a1) {
    const s16x4 lo = __builtin_amdgcn_ds_read_tr16_b64_v4i16((LAS s16x4*)a0), hi = __builtin_amdgcn_ds_read_tr16_b64_v4i16((LAS s16x4*)a1);
    return __builtin_shufflevector(lo, hi, 0, 1, 2, 3, 4, 5, 6, 7);
}
DI bf16x8 pack_half(const f32x16& x, int s2) {
    u32x4 w;
#pragma unroll
    for (int k = 0; k < 4; ++k) w[k] = pk_bf16(x[8 * s2 + 2 * k], x[8 * s2 + 2 * k + 1]);
    return __builtin_bit_cast(bf16x8, w);
}
DI int next_item(unsigned* ctr, LAS unsigned char* lds) {
    volatile LAS int* slot = (volatile LAS int*)(lds + LDS_MISC + 64);
    __syncthreads();
    if (threadIdx.x == 0) *slot = (int)__hip_atomic_fetch_add(ctr, 1u, __ATOMIC_RELAXED, __HIP_MEMORY_SCOPE_AGENT);
    __syncthreads();
    return *slot;
}

constexpr int AT_KPITCH = 144, AT_VPITCH = 320, AT_KBYTES = 64 * AT_KPITCH, AT_VOFF = 2 * AT_KBYTES, AT_BUF = AT_VOFF + 64 * AT_VPITCH, AT_BT = 2 * AT_BUF;
DI void attn_mfma_item(PP pk_, int item, LAS unsigned char* lds) { const P p = load_args(pk_);
    const int tid = tid_local(), lane = tid & 63, wave = __builtin_amdgcn_readfirstlane(tid >> 6), mp = wave & 1, rq = wave >> 1, hh = lane >> 5, r = lane & 31;
    const int qb = item & 15, h = (item >> 4) & 7, b = item >> 7;
    const int q0 = qb * 128, qw = q0 + rq * 32, nt = 2 * qb + 2;
    const bf16_t* U = WSP(bf16_t, WS_U); const size_t rbase = (size_t)b * SEQ;
    LAS float* bt = (LAS float*)(lds + AT_BT);
    __syncthreads();
    if (tid <= 128) bt[tid] = p.rel_bias[t5_bucket(tid) * 8 + h] * LOG2E;
    bf16x8 qf[4];
    { const bf16_t* qp = U + (rbase + qw + r) * NU + UQ + h * 128 + mp * 64 + 8 * hh;
#pragma unroll
      for (int s = 0; s < 4; ++s) qf[s] = *(const bf16x8*)(qp + 16 * s); }
    f32x16 O[4];
#pragma unroll
    for (int dt = 0; dt < 4; ++dt)
#pragma unroll
        for (int i = 0; i < 16; ++i) O[dt][i] = 0.f;
    float mrun = -INFINITY, lrun = 0.f;
    const int row0 = tid >> 4, c16 = tid & 15;
    const bf16_t* gk = U + (rbase + row0) * NU + UK + h * 128 + c16 * 8;
    const bf16_t* gv = U + (rbase + row0) * NU + UV + h * 128 + c16 * 8;
    const unsigned lk = (c16 >> 3) * AT_KBYTES + row0 * AT_KPITCH + (c16 & 7) * 16, lv = AT_VOFF + row0 * AT_VPITCH + c16 * 16;
    u32x4 st[4];
#define AT_LOAD(t_) do { const size_t o_ = (size_t)(t_) * 64 * NU; st[0] = *(const u32x4*)(gk + o_); st[1] = *(const u32x4*)(gk + o_ + (size_t)32 * NU); st[2] = *(const u32x4*)(gv + o_); st[3] = *(const u32x4*)(gv + o_ + (size_t)32 * NU); } while (0)
#define AT_STORE(bufp) do { *(LAS u32x4*)((bufp) + lk) = st[0]; *(LAS u32x4*)((bufp) + lk + 32 * AT_KPITCH) = st[1]; *(LAS u32x4*)((bufp) + lv) = st[2]; *(LAS u32x4*)((bufp) + lv + 32 * AT_VPITCH) = st[3]; } while (0)
    AT_LOAD(0); AT_STORE(lds); __syncthreads();
    const float cfar = bt[128];
    const unsigned ka = mp * AT_KBYTES + r * AT_KPITCH + hh * 16;
    const int i16 = lane & 15;
    const unsigned va = AT_VOFF + (4 * hh + (i16 >> 2)) * AT_VPITCH + (16 * ((lane >> 4) & 1) + 4 * (i16 & 3)) * 2;
    for (int t = 0; t < nt; ++t) {
        const int k0 = t * 64; LAS unsigned char* buf = lds + (t & 1) * AT_BUF;
        if (t + 1 < nt) AT_LOAD(t + 1);
        if (k0 <= qw + 31) {
            const bool far = (qw - k0 - 63) >= 128;
            f32x16 S[2];
#pragma unroll
            for (int sub = 0; sub < 2; ++sub)
#pragma unroll
                for (int i = 0; i < 16; ++i) S[sub][i] = far ? cfar : 0.f;
#pragma unroll
            for (int sub = 0; sub < 2; ++sub)
#pragma unroll
                for (int s = 0; s < 4; ++s) S[sub] = MFMA32(*(const LAS bf16x8*)(buf + ka + sub * 32 * AT_KPITCH + s * 32), qf[s], S[sub]);
            if (!far) {
#pragma unroll
                for (int sub = 0; sub < 2; ++sub)
#pragma unroll
                    for (int i = 0; i < 16; ++i) { const int dist = (qw + r) - (k0 + sub * 32 + crow(i, hh)); S[sub][i] = dist < 0 ? -INFINITY : S[sub][i] + bt[min(dist, 128)]; }
            }
            float mx = fmaxf(S[0][0], S[1][0]);
#pragma unroll
            for (int i = 1; i < 16; ++i) mx = fmaxf(mx, fmaxf(S[0][i], S[1][i]));
            mx = fmaxf(mx, __shfl_xor(mx, 32));
            const float mnew = fmaxf(mrun, mx), alpha = __builtin_amdgcn_exp2f(mrun - mnew); mrun = mnew; lrun *= alpha;
#pragma unroll
            for (int dt = 0; dt < 4; ++dt) O[dt] *= alpha;
#pragma unroll
            for (int sub = 0; sub < 2; ++sub)
#pragma unroll
                for (int i = 0; i < 16; ++i) { S[sub][i] = __builtin_amdgcn_exp2f(S[sub][i] - mnew); lrun += S[sub][i]; }
#pragma unroll
            for (int sub = 0; sub < 2; ++sub)
#pragma unroll
                for (int s2 = 0; s2 < 2; ++s2) { const bf16x8 pb = pack_half(S[sub], s2); const LAS unsigned char* vb = buf + va + (sub * 32 + 16 * s2) * AT_VPITCH;
#pragma unroll
                    for (int dt = 0; dt < 4; ++dt) O[dt] = MFMA32(tr_pair(vb + dt * 64, vb + dt * 64 + 8 * AT_VPITCH), pb, O[dt]); }
        }
        if (t + 1 < nt) AT_STORE(lds + ((t + 1) & 1) * AT_BUF);
        __syncthreads();
    }
#undef AT_LOAD
#undef AT_STORE
    const float inv = 1.f / (lrun + __shfl_xor(lrun, 32));
    LAS float* X = (LAS float*)lds;
    if (mp == 1) {
#pragma unroll
        for (int dt = 0; dt < 4; ++dt)
#pragma unroll
            for (int i = 0; i < 16; ++i) X[(rq * 64 + dt * 16 + i) * 64 + lane] = O[dt][i] * inv;
    }
    __syncthreads();
    if (mp == 0) {
        const float lam = *WSP(float, WS_MISC + MS_LAM); float ss = 0.f;
#pragma unroll
        for (int dt = 0; dt < 4; ++dt)
#pragma unroll
            for (int i = 0; i < 16; ++i) { const float v = O[dt][i] * inv - lam * X[(rq * 64 + dt * 16 + i) * 64 + lane]; O[dt][i] = v; ss += v * v; }
        ss += __shfl_xor(ss, 32);
        const float rs = rsqrtf(ss * (1.f / 128.f) + LN_EPS) * 0.8f;
        bf16_t* yp = WSP(bf16_t, WS_Y) + (rbase + qw + r) * 3072 + h * 128;
#pragma unroll
        for (int dt = 0; dt < 4; ++dt)
#pragma unroll
            for (int g4 = 0; g4 < 4; ++g4) { const int dv = dt * 32 + 8 * g4 + 4 * hh; const f32x4 gn = *(const f32x4*)(p.subln_g + dv);
                u32x2 w; w.x = pk_bf16(O[dt][4 * g4] * rs * gn[0], O[dt][4 * g4 + 1] * rs * gn[1]); w.y = pk_bf16(O[dt][4 * g4 + 2] * rs * gn[2], O[dt][4 * g4 + 3] * rs * gn[3]);
                *(u32x2*)(yp + dv) = w; }
    }
}
constexpr int ML_QP = 528, ML_KP = 576, ML_VP = 576, ML_WP = 144;
constexpr int ML_Q = 0, ML_K = ML_Q + 64 * ML_QP, ML_V = ML_K + 64 * ML_KP, ML_W = ML_V + 64 * ML_VP, ML_TAB = ML_W + 64 * ML_WP;
constexpr int T_BCUM = 0, T_A = 256, T_MROW = 512, T_IW = 768, T_WS = 1024, T_RS = 1280, T_ND = 2304, T_GI = 2560, T_GF = 2816, T_N = 3072, T_SC = 4096, T_INVD = 4352;
static_assert(ML_TAB + 4608 <= LDS_RING, "mLSTM LDS map");
DI void mlstm_mfma_item(PP pk_, int g, int item, LAS unsigned char* lds) { const P p = load_args(pk_);
    const int tid0 = tid_local(), w = __builtin_amdgcn_readfirstlane(tid0 >> 6);
    const int h = item & 3, b = item >> 2;
    const bf16_t* U = WSP(bf16_t, WS_U); const float* gif = WSP(float, WS_GIF); bf16_t* Y = WSP(bf16_t, WS_Y);
    const size_t rbase = (size_t)b * SEQ, tbase = ((size_t)g * BG + b) * SEQ;
    LAS unsigned char* TB = lds + ML_TAB;
#define TABF(off) ((LAS float*)(TB + (off)))
    f32x16 C[8];
#pragma unroll
    for (int kt = 0; kt < 8; ++kt)
#pragma unroll
        for (int i = 0; i < 16; ++i) C[kt][i] = 0.f;
    float mst = 0.f;
    __syncthreads();
    if (tid0 < 256) TABF(T_N)[tid0] = 0.f;
    for (int ch = 0; ch < SEQ / 64; ++ch) {
        int tid = tid0; asm volatile("" : "+v"(tid));
        const int lane = tid & 63, hh = lane >> 5, r = lane & 31, i16 = lane & 15, l4 = lane >> 4;
        __syncthreads();
        {
#pragma unroll 1
            for (int it = 0; it < 8; ++it) { const int pc = tid + 512 * it, isk = pc >> 11, s = (pc >> 5) & 63, c8 = pc & 31; const int ts = ch * 64 + s;
                const int col = (isk ? UMK : UMQ) + h * 256 + c8 * 8;
                float a[8];
#pragma unroll
                for (int e = 0; e < 8; ++e) a[e] = 0.f;
#pragma unroll
                for (int j = 0; j < 4; ++j) { const int tt = ts - 3 + j; if (tt >= 0) { const u32x4 x = *(const u32x4*)(U + (rbase + tt) * NU + col);
                        const float* cwp = p.conv_w + j * 2048 + isk * 1024 + h * 256 + c8 * 8; const f32x4 c0 = *(const f32x4*)cwp, c1 = *(const f32x4*)(cwp + 4);
                        a[0] += c0[0] * bf_lo(x.x); a[1] += c0[1] * bf_hi(x.x); a[2] += c0[2] * bf_lo(x.y); a[3] += c0[3] * bf_hi(x.y);
                        a[4] += c1[0] * bf_lo(x.z); a[5] += c1[1] * bf_hi(x.z); a[6] += c1[2] * bf_lo(x.w); a[7] += c1[3] * bf_hi(x.w); } }
                const float sc = isk ? 0.0625f : 1.f;
                u32x4 o; o.x = pk_bf16(silu(a[0]) * sc, silu(a[1]) * sc); o.y = pk_bf16(silu(a[2]) * sc, silu(a[3]) * sc); o.z = pk_bf16(silu(a[4]) * sc, silu(a[5]) * sc); o.w = pk_bf16(silu(a[6]) * sc, silu(a[7]) * sc);
                *(LAS u32x4*)(lds + (isk ? ML_K + s * ML_KP : ML_Q + s * ML_QP) + c8 * 16) = o; }
#pragma unroll
            for (int i = 0; i < 4; ++i) { const int pc = tid + 512 * i, s = pc >> 5, cc = pc & 31; *(LAS u32x4*)(lds + ML_V + s * ML_VP + cc * 16) = *(const u32x4*)(U + (rbase + ch * 64 + s) * NU + UMV + h * 256 + cc * 8); }
            if (tid < 64) { TABF(T_GI)[tid] = gif[(tbase + ch * 64 + tid) * 8 + h]; TABF(T_GF)[tid] = gif[(tbase + ch * 64 + tid) * 8 + 4 + h]; }
        }
        __syncthreads();
        if (w == 0) {
            const float ip = TABF(T_GI)[lane], fp = TABF(T_GF)[lane];
            float bc = fminf(fp, 0.f) - log1pf(expf(-fabsf(fp)));
#pragma unroll
            for (int o = 1; o < 64; o <<= 1) { const float t = __shfl_up(bc, o); if (lane >= o) bc += t; }
            const float aa = ip - bc; float pm = aa;
#pragma unroll
            for (int o = 1; o < 64; o <<= 1) { const float t = __shfl_up(pm, o); if (lane >= o) pm = fmaxf(pm, t); }
            const float mrow = bc + fmaxf(mst, pm), iw = expf(bc + mst - mrow);
            const float total = __shfl(bc, 63), amax = __shfl(pm, 63), mnew = total + fmaxf(mst, amax), decay = expf(total + mst - mnew), ws = expf(total + aa - mnew);
            TABF(T_BCUM)[lane] = bc; TABF(T_A)[lane] = aa; TABF(T_MROW)[lane] = mrow; TABF(T_IW)[lane] = iw; TABF(T_WS)[lane] = ws;
            if (lane == 0) TABF(T_SC)[1] = decay;
            mst = mnew;
        }
        f32x4 S2[2];
#pragma unroll
        for (int tt = 0; tt < 2; ++tt) { const int tile = 2 * w + tt, jt = tile >> 2, st = tile & 3; f32x4 s = {0.f, 0.f, 0.f, 0.f};
            const LAS unsigned char* qa = lds + ML_Q + (jt * 16 + i16) * ML_QP + l4 * 16; const LAS unsigned char* ka = lds + ML_K + (st * 16 + i16) * ML_KP + l4 * 16;
#pragma unroll
            for (int c = 0; c < 8; ++c) s = __builtin_amdgcn_mfma_f32_16x16x32_bf16(*(const LAS bf16x8*)(qa + c * 64), *(const LAS bf16x8*)(ka + c * 64), s, 0, 0, 0);
            S2[tt] = s; }
        { const f32x4 nv = *(const LAS f32x4*)(TABF(T_N) + 4 * lane);
#pragma unroll
          for (int jj = 0; jj < 8; ++jj) { const int j = 8 * w + jj; const u32x2 qw = *(const LAS u32x2*)(lds + ML_Q + j * ML_QP + lane * 8);
              const float d = wave_sum(bf_lo(qw.x) * nv[0] + bf_hi(qw.x) * nv[1] + bf_lo(qw.y) * nv[2] + bf_hi(qw.y) * nv[3]); if (lane == 0) TABF(T_ND)[j] = d; } }
        __syncthreads();
#pragma unroll
        for (int tt = 0; tt < 2; ++tt) { const int tile = 2 * w + tt, jt = tile >> 2, st = tile & 3, s = st * 16 + i16; const float as = TABF(T_A)[s];
#pragma unroll
            for (int rg = 0; rg < 4; ++rg) { const int j = jt * 16 + l4 * 4 + rg;
                float val = s <= j ? __expf(TABF(T_BCUM)[j] + as - TABF(T_MROW)[j]) * S2[tt][rg] : 0.f;
                *(LAS bf16_t*)(lds + ML_W + j * ML_WP + s * 2) = (bf16_t)(pk_bf16(val, 0.f) & 0xffffu);
                val += __shfl_xor(val, 1); val += __shfl_xor(val, 2); val += __shfl_xor(val, 4); val += __shfl_xor(val, 8);
                if (i16 == 0) TABF(T_RS)[j * 4 + st] = val; } }
        __syncthreads();
        if (tid < 64) { const int j = tid; const f32x4 rs = *(const LAS f32x4*)(TABF(T_RS) + 4 * j);
            const float den = TABF(T_IW)[j] * TABF(T_ND)[j] + ((rs[0] + rs[1]) + (rs[2] + rs[3]));
            TABF(T_INVD)[j] = 1.f / fmaxf(fabsf(den), expf(-TABF(T_MROW)[j])); }
        f32x16 acc[2];
#pragma unroll
        for (int jt2 = 0; jt2 < 2; ++jt2)
#pragma unroll
            for (int i = 0; i < 16; ++i) acc[jt2][i] = 0.f;
#pragma unroll
        for (int kt = 0; kt < 8; ++kt) { __builtin_amdgcn_sched_barrier(0);
#pragma unroll
            for (int s = 0; s < 2; ++s) { const bf16x8 bfr = pack_half(C[kt], s);
#pragma unroll
                for (int jt2 = 0; jt2 < 2; ++jt2) { const LAS unsigned char* qa = lds + ML_Q + (jt2 * 32 + r) * ML_QP + (kt * 32 + 16 * s + 4 * hh) * 2;
                    const s16x4 lo = *(const LAS s16x4*)qa, hi = *(const LAS s16x4*)(qa + 16);
                    acc[jt2] = MFMA32(__builtin_shufflevector(lo, hi, 0, 1, 2, 3, 4, 5, 6, 7), bfr, acc[jt2]); } } }
        __builtin_amdgcn_sched_barrier(0);
#pragma unroll
        for (int jt2 = 0; jt2 < 2; ++jt2)
#pragma unroll
            for (int i = 0; i < 16; ++i) acc[jt2][i] *= TABF(T_IW)[jt2 * 32 + crow(i, hh)];
        const unsigned vtr = ML_V + (8 * hh + (i16 >> 2)) * ML_VP + (32 * w + 16 * (l4 & 1) + 4 * (i16 & 3)) * 2;
#pragma unroll
        for (int ks = 0; ks < 4; ++ks) { const bf16x8 bv = tr_pair(lds + vtr + 16 * ks * ML_VP, lds + vtr + (16 * ks + 4) * ML_VP);
#pragma unroll
            for (int jt2 = 0; jt2 < 2; ++jt2) acc[jt2] = MFMA32(*(const LAS bf16x8*)(lds + ML_W + (jt2 * 32 + r) * ML_WP + (16 * ks + 8 * hh) * 2), bv, acc[jt2]); }
        __syncthreads();
#pragma unroll
        for (int jt2 = 0; jt2 < 2; ++jt2)
#pragma unroll
            for (int i = 0; i < 16; ++i) { const int j = jt2 * 32 + crow(i, hh); *(LAS bf16_t*)(lds + ML_Q + j * 512 + (32 * w + r) * 2) = (bf16_t)(pk_bf16(acc[jt2][i] * TABF(T_INVD)[j], 0.f) & 0xffffu); }
        const float decay = TABF(T_SC)[1];
        if (tid < 256) { float nn = TABF(T_N)[tid] * decay;
#pragma unroll 8
            for (int s = 0; s < 64; ++s) nn += TABF(T_WS)[s] * bf2f(*(const LAS bf16_t*)(lds + ML_K + s * ML_KP + tid * 2));
            TABF(T_N)[tid] = nn; }
#pragma unroll
        for (int kt = 0; kt < 8; ++kt) C[kt] *= decay;
        const unsigned ktr = ML_K + (8 * hh + (i16 >> 2)) * ML_KP + (16 * (l4 & 1) + 4 * (i16 & 3)) * 2;
#pragma unroll
        for (int ks = 0; ks < 4; ++ks) { __builtin_amdgcn_sched_barrier(0); const bf16x8 bv = tr_pair(lds + vtr + 16 * ks * ML_VP, lds + vtr + (16 * ks + 4) * ML_VP);
            const u32x4 bw = __builtin_bit_cast(u32x4, bv); const f32x4 w0 = *(const LAS f32x4*)(TABF(T_WS) + 16 * ks + 8 * hh), w1 = *(const LAS f32x4*)(TABF(T_WS) + 16 * ks + 8 * hh + 4);
            u32x4 sw; sw.x = pk_bf16(bf_lo(bw.x) * w0[0], bf_hi(bw.x) * w0[1]); sw.y = pk_bf16(bf_lo(bw.y) * w0[2], bf_hi(bw.y) * w0[3]); sw.z = pk_bf16(bf_lo(bw.z) * w1[0], bf_hi(bw.z) * w1[1]); sw.w = pk_bf16(bf_lo(bw.w) * w1[2], bf_hi(bw.w) * w1[3]);
            const bf16x8 bs = __builtin_bit_cast(bf16x8, sw);
#pragma unroll
            for (int kt = 0; kt < 8; ++kt) C[kt] = MFMA32(tr_pair(lds + ktr + 16 * ks * ML_KP + kt * 64, lds + ktr + (16 * ks + 4) * ML_KP + kt * 64), bs, C[kt]); }
        __syncthreads();
#pragma unroll
        for (int jj = 0; jj < 8; ++jj) { const int j = 8 * w + jj; const u32x2 hw = *(const LAS u32x2*)(lds + ML_Q + j * 512 + lane * 8);
            const f32x4 v = {bf_lo(hw.x), bf_hi(hw.x), bf_lo(hw.y), bf_hi(hw.y)};
            const float mu = wave_sum((v[0] + v[1]) + (v[2] + v[3])) * (1.f / 256.f); const f32x4 d = v - mu;
            const float rstd = rsqrtf(wave_sum((d[0] * d[0] + d[1] * d[1]) + (d[2] * d[2] + d[3] * d[3])) * (1.f / 256.f) + LN_EPS);
            const size_t row = rbase + ch * 64 + j;
            const f32x4 gn = *((const f32x4*)(p.mlstm_norm_g + h * 256) + lane);
            const u32x2 ow = *((const u32x2*)(U + row * NU + UMO + h * 256) + lane);
            u32x2 o; o.x = pk_bf16(d[0] * rstd * gn[0] * sigm(bf_lo(ow.x)), d[1] * rstd * gn[1] * sigm(bf_hi(ow.x))); o.y = pk_bf16(d[2] * rstd * gn[2] * sigm(bf_lo(ow.y)), d[3] * rstd * gn[3] * sigm(bf_hi(ow.y)));
            *((u32x2*)(Y + row * 3072 + 1024 + h * 256) + lane) = o; }
    }
#undef TABF
}
#ifndef ATTN_NAIVE
#define ATTN_NAIVE 0
#endif
#ifndef MLSTM_NAIVE
#define MLSTM_NAIVE 0
#endif
DI void ph_mix(PP pk_, int g, LAS unsigned char* lds) { const P p = load_args(pk_);
    constexpr int N_ML = MLSTM_NAIVE ? BG * 4 * 4 : BG * 4, N_AT = ATTN_NAIVE ? BG * 8 * 32 : BG * 8 * 16, N_XA = BG * 4 * 64;
    unsigned* ctr = WSP(unsigned, WS_CTL) + CW_Q + 64 * g;
    for (;;) {
        const int it = next_item(ctr, lds);
        if (it >= N_ML + N_AT + N_XA) break;
        if (it < N_ML) { if (MLSTM_NAIVE) mlstm_naive_item(pk_, g, it, lds); else mlstm_mfma_item(pk_, g, it, lds); }
        else if (it < N_ML + N_AT) { const int ix = it - N_ML;
            if (ATTN_NAIVE) attn_naive_item(pk_, N_AT - 1 - ix, lds);
            else attn_mfma_item(pk_, ((ix & 63) << 4) | (15 - (ix >> 6)), lds); }
        else xattn_naive_item(pk_, g, it - N_ML - N_AT, lds);
    }
}

DI void ph_mlstm_out(PP pk_, int g, LAS unsigned char* lds) { const P p = load_args(pk_);
    const int tid = tid_local(), lane = tid & 63, wave = tid >> 6, gw = blockIdx.x * 8 + wave, NGW = gridDim.x * 8;
    const float* HT = WSP(float, WS_F32); const bf16_t* U = WSP(bf16_t, WS_U); bf16_t* Y = WSP(bf16_t, WS_Y);
    for (int it = gw; it < TG * 4; it += NGW) { const int r = it >> 2, h = it & 3;
        const f32x4 v = *((const f32x4*)(HT + (size_t)r * 1024 + h * 256) + lane);
        const float mu = wave_sum((v[0] + v[1]) + (v[2] + v[3])) * (1.f / 256.f); const f32x4 d = v - mu;
        const float rstd = rsqrtf(wave_sum((d[0] * d[0] + d[1] * d[1]) + (d[2] * d[2] + d[3] * d[3])) * (1.f / 256.f) + LN_EPS);
        const f32x4 gn = *((const f32x4*)(p.mlstm_norm_g + h * 256) + lane);
        const u32x2 ow = *((const u32x2*)(U + (size_t)r * NU + UMO + h * 256) + lane);
        u32x2 o; o.x = cvt_pk_bf16(d[0] * rstd * gn[0] * sigm(bf_lo(ow.x)), d[1] * rstd * gn[1] * sigm(bf_hi(ow.x))); o.y = cvt_pk_bf16(d[2] * rstd * gn[2] * sigm(bf_lo(ow.y)), d[3] * rstd * gn[3] * sigm(bf_hi(ow.y)));
        *((u32x2*)(Y + (size_t)r * 3072 + 1024 + h * 256) + lane) = o; }
}

DI void ph_ln1(PP pk_, int g, LAS unsigned char* lds) { const P p = load_args(pk_);
    const int tid = tid_local(), lane = tid & 63, wave = tid >> 6, gw = blockIdx.x * 8 + wave, NGW = gridDim.x * 8;
    const float* Z = WSP(float, WS_Z); bf16_t* X1 = WSP(bf16_t, WS_X1B) + (size_t)g * TG * 1024;
    for (int r = gw; r < TG; r += NGW) {
        const f32x4* zr = (const f32x4*)(Z + (size_t)r * 1024) + lane; f32x4 v[4]; float s = 0.f;
#pragma unroll
        for (int j = 0; j < 4; ++j) { v[j] = zr[64 * j]; s += (v[j][0] + v[j][1]) + (v[j][2] + v[j][3]); }
        const float mu = wave_sum(s) * (1.f / 1024.f); float s2 = 0.f;
#pragma unroll
        for (int j = 0; j < 4; ++j) { v[j] = v[j] - mu; s2 += (v[j][0] * v[j][0] + v[j][1] * v[j][1]) + (v[j][2] * v[j][2] + v[j][3] * v[j][3]); }
        const float rstd = rsqrtf(wave_sum(s2) * (1.f / 1024.f) + LN_EPS);
        u32x2* d = (u32x2*)(X1 + (size_t)r * 1024) + lane;
#pragma unroll
        for (int j = 0; j < 4; ++j) { const f32x4 gn = *((const f32x4*)p.ln1_g + lane + 64 * j), bb = *((const f32x4*)p.ln1_b + lane + 64 * j); const f32x4 o = v[j] * rstd * gn + bb;
            u32x2 w; w.x = cvt_pk_bf16(o[0], o[1]); w.y = cvt_pk_bf16(o[2], o[3]); d[64 * j] = w; }
    }
}
DI void ph_expert_weights(PP pk_, LAS unsigned char* lds) { const P p = load_args(pk_);
    const int tid = tid_local(), lane = tid & 63, wave = tid >> 6, gw = blockIdx.x * 8 + wave, NGW = gridDim.x * 8;
    LAS float* scr = (LAS float*)(lds + wave * 16384);
    bf16_t* WGU = WSP(bf16_t, WS_WGU); bf16_t* WD = WSP(bf16_t, WS_WD);
    for (int it = gw; it < 257 * 256; it += NGW) { const int e = it >> 8, r = it & 255, isup = r >> 7, kb = (r >> 3) & 15, nb = r & 7;
        const float* W = (e < 256) ? ((isup ? p.w_e_up : p.w_e_gate) + (size_t)e * 1024 * 256) : (isup ? p.w_s_up : p.w_s_gate);
        const int n0 = nb * 32, drow = (n0 >> 7) * 256 + (n0 & 127) + isup * 128;
        transpose_item(W, 256, n0, WGU + (size_t)e * 512 * 1024, 1024, drow, kb * 64, scr, lane); }
    for (int it = gw; it < 257 * 128; it += NGW) { const int e = it >> 7, r = it & 127, kb = r >> 5, nb = r & 31;
        const float* W = (e < 256) ? (p.w_e_down + (size_t)e * 256 * 1024) : p.w_s_down;
        transpose_item(W, 1024, nb * 32, WD + (size_t)e * 1024 * 256, 256, nb * 32, kb * 64, scr, lane); }
}

DI void ph_topk(PP pk_, LAS unsigned char* lds) { const P p = load_args(pk_);
    const int tid = tid_local(), lane = tid & 63, wave = tid >> 6, gw = blockIdx.x * 8 + wave, NGW = gridDim.x * 8;
    const float* LG = WSP(float, WS_LOGIT); int* TKI = WSP(int, WS_TKI); float* TKW = WSP(float, WS_TKW); unsigned* cnt = WSP(unsigned, WS_CTL) + CW_CNT;
    int* tokof = WSP(int, WS_TOKOF); float* wof = WSP(float, WS_WOF);
    for (int i = blockIdx.x * 512 + tid; i < MAXRT * 256; i += gridDim.x * 512) { tokof[i] = 0; wof[i] = 0.f; }
    const f32x4 rb = *((const f32x4*)p.router_bias + lane);
    for (int t = gw; t < T_ALL; t += NGW) {
        const f32x4 lg = *((const f32x4*)(LG + (size_t)t * 256) + lane);
        float sc[4], ch[4];
#pragma unroll
        for (int j = 0; j < 4; ++j) { sc[j] = 1.f / (1.f + expf(-lg[j])); ch[j] = sc[j] + rb[j]; }
        const float m01 = fmaxf(ch[0], ch[1]), n01 = fminf(ch[0], ch[1]), m23 = fmaxf(ch[2], ch[3]), n23 = fminf(ch[2], ch[3]);
        float a1 = fmaxf(m01, m23), a2 = fmaxf(fminf(m01, m23), fmaxf(n01, n23));
#pragma unroll
        for (int o = 1; o < 8; o <<= 1) { const float b1 = __shfl_xor(a1, o), b2 = __shfl_xor(a2, o); const float n1 = fmaxf(a1, b1), n2 = fmaxf(fminf(a1, b1), fmaxf(a2, b2)); a1 = n1; a2 = n2; }
        const float gs = a1 + a2; const int myg = lane >> 3; int rank = 0;
#pragma unroll
        for (int g2 = 0; g2 < 8; ++g2) { const float og = __shfl(gs, 8 * g2); rank += (og > gs || (og == gs && g2 < myg)) ? 1 : 0; }
        if (rank >= 4) { ch[0] = -INFINITY; ch[1] = -INFINITY; ch[2] = -INFINITY; ch[3] = -INFINITY; }
        int myidx = 0; float mys = 0.f, ssum = 0.f;
#pragma unroll
        for (int r = 0; r < 8; ++r) {
            float bv = ch[0]; int bi = 4 * lane;
#pragma unroll
            for (int j = 1; j < 4; ++j) if (ch[j] > bv) { bv = ch[j]; bi = 4 * lane + j; }
#pragma unroll
            for (int o = 32; o >= 1; o >>= 1) { const float ov = __shfl_xor(bv, o); const int oi = __shfl_xor(bi, o); if (ov > bv || (ov == bv && oi < bi)) { bv = ov; bi = oi; } }
            const int jl = bi & 3; const float scsel = jl == 0 ? sc[0] : (jl == 1 ? sc[1] : (jl == 2 ? sc[2] : sc[3]));
            const float sv = __shfl(scsel, bi >> 2);
            if ((bi >> 2) == lane) { if (jl == 0) ch[0] = -INFINITY; else if (jl == 1) ch[1] = -INFINITY; else if (jl == 2) ch[2] = -INFINITY; else ch[3] = -INFINITY; }
            ssum += sv; if (lane == r) { myidx = bi; mys = sv; }
        }
        if (lane < 8) { TKI[(size_t)t * 8 + lane] = myidx; TKW[(size_t)t * 8 + lane] = mys / (ssum + 1e-20f) * 2.5f; atomicAdd(cnt + myidx, 1u); }
    }
}

DI void ph_scan(PP pk_, LAS unsigned char* lds) { const P p = load_args(pk_);
    if (blockIdx.x != 0) return;
    const int tid = tid_local();
    const unsigned* cnt = WSP(unsigned, WS_CTL) + CW_CNT; int* tbase = WSP(int, WS_MISC + MS_TBASE); int* nt = WSP(int, WS_MISC + MS_NT); int* tile_e = WSP(int, WS_MISC + MS_TILEE);
    LAS int* sb = (LAS int*)lds;
    if (tid < 256) sb[tid] = (int)((cnt[tid] + 255u) >> 8);
    __syncthreads();
    if (tid == 0) { int a = 0; for (int e = 0; e < 256; ++e) { const int n = sb[e]; sb[e] = a; a += n; } sb[256] = a; }
    __syncthreads();
    const int nrt = sb[256];
    if (tid < 256) { const int b0 = sb[tid], b1 = sb[tid + 1]; tbase[tid] = b0; for (int t = b0; t < b1; ++t) tile_e[t] = tid; tile_e[nrt + tid] = 256; }
    if (tid == 0) { tbase[256] = nrt; nt[0] = nrt; nt[1] = nrt + 256; }
    __syncthreads();
}

DI void ph_slots(PP pk_, LAS unsigned char* lds) { const P p = load_args(pk_);
    const int tid = tid_local();
    const int* TKI = WSP(int, WS_TKI); const float* TKW = WSP(float, WS_TKW); unsigned* cur = WSP(unsigned, WS_CTL) + CW_CUR; const int* tbase = WSP(int, WS_MISC + MS_TBASE);
    int* tokof = WSP(int, WS_TOKOF); float* wof = WSP(float, WS_WOF); int* slotof = WSP(int, WS_SLOTOF);
    const int s0 = tbase[256] * 256;
    for (int i = blockIdx.x * 512 + tid; i < T_ALL * 8; i += gridDim.x * 512) { const int e = TKI[i]; const int slot = tbase[e] * 256 + (int)atomicAdd(cur + e, 1u); tokof[slot] = i >> 3; wof[slot] = TKW[i]; slotof[i] = slot; }
    for (int t = blockIdx.x * 512 + tid; t < T_ALL; t += gridDim.x * 512) { tokof[s0 + t] = t; wof[s0 + t] = 1.f; }
}

DI void ph_combine(PP pk_, int round, LAS unsigned char* lds) { const P p = load_args(pk_);
    const int tid = tid_local();
    const bf16_t* Y = WSP(bf16_t, WS_YCH); const bf16_t* X1 = WSP(bf16_t, WS_X1B); const int* slotof = WSP(int, WS_SLOTOF); const int s0 = WSP(int, WS_MISC + MS_TBASE)[256] * 256;
    for (int i = blockIdx.x * 512 + tid; i < T_ALL * 32; i += gridDim.x * 512) { const int t = i >> 5, c8 = (i & 31) * 8;
        const u32x4 xw = *(const u32x4*)(X1 + (size_t)t * 1024 + round * 256 + c8);
        float a[8] = {bf_lo(xw.x) * ALPHA, bf_hi(xw.x) * ALPHA, bf_lo(xw.y) * ALPHA, bf_hi(xw.y) * ALPHA, bf_lo(xw.z) * ALPHA, bf_hi(xw.z) * ALPHA, bf_lo(xw.w) * ALPHA, bf_hi(xw.w) * ALPHA};
#pragma unroll
        for (int k = 0; k < 9; ++k) { const int slot = k < 8 ? slotof[(size_t)t * 8 + k] : s0 + t; const u32x4 w = *(const u32x4*)(Y + (size_t)slot * 256 + c8);
            a[0] += bf_lo(w.x); a[1] += bf_hi(w.x); a[2] += bf_lo(w.y); a[3] += bf_hi(w.y); a[4] += bf_lo(w.z); a[5] += bf_hi(w.z); a[6] += bf_lo(w.w); a[7] += bf_hi(w.w); }
        float* op = p.out + (size_t)t * 1024 + round * 256 + c8; *(f32x4*)op = (f32x4){a[0], a[1], a[2], a[3]}; *(f32x4*)(op + 4) = (f32x4){a[4], a[5], a[6], a[7]}; }
}

DI void ph_ln2(PP pk_, LAS unsigned char* lds) { const P p = load_args(pk_);
    const int tid = tid_local(), lane = tid & 63, wave = tid >> 6, gw = blockIdx.x * 8 + wave, NGW = gridDim.x * 8;
    for (int r = gw; r < T_ALL; r += NGW) {
        f32x4* zr = (f32x4*)(p.out + (size_t)r * 1024) + lane; f32x4 v[4]; float s = 0.f;
#pragma unroll
        for (int j = 0; j < 4; ++j) { v[j] = zr[64 * j]; s += (v[j][0] + v[j][1]) + (v[j][2] + v[j][3]); }
        const float mu = wave_sum(s) * (1.f / 1024.f); float s2 = 0.f;
#pragma unroll
        for (int j = 0; j < 4; ++j) { v[j] = v[j] - mu; s2 += (v[j][0] * v[j][0] + v[j][1] * v[j][1]) + (v[j][2] * v[j][2] + v[j][3] * v[j][3]); }
        const float rstd = rsqrtf(wave_sum(s2) * (1.f / 1024.f) + LN_EPS);
#pragma unroll
        for (int j = 0; j < 4; ++j) { const f32x4 gn = *((const f32x4*)p.ln2_g + lane + 64 * j), bb = *((const f32x4*)p.ln2_b + lane + 64 * j); zr[64 * j] = v[j] * rstd * gn + bb; }
    }
}

__global__ void __launch_bounds__(512, 2) fwd(P p_unused) {
    extern __shared__ __attribute__((aligned(16))) unsigned char lds_raw[];
    LAS unsigned char* lds = (LAS unsigned char*)lds_raw;
    const int tid = threadIdx.x, G = gridDim.x, bid = blockIdx.x;
    volatile LAS unsigned* MISC = (volatile LAS unsigned*)(lds + LDS_MISC);
    if (tid < 32) MISC[tid] = 0u;
    __syncthreads();
    const int lo = kargs()->s_lo, hi = kargs()->s_hi;
    XcdBarrier bar; { unsigned* bw = (unsigned*)(kargs()->ws + WS_CTL) + CW_BAR; bar.bar = bw; bar.x = 0; bar.st = nullptr; if (hi - lo > 1) bar = xcd_barrier_post(bw, MISC + 8); }
    int s = 0;
#define STEP_BEGIN if (s >= lo && s < hi) { PP pk_ = kargs(); const P p = load_args(pk_);
#define STEP_END if (s + 1 < hi) xcd_barrier(bar); } ++s;

    STEP_BEGIN ph_prologue(pk_, lds); STEP_END
    for (int g = 0; g < NGRP; ++g) {
        STEP_BEGIN ph_xconv(pk_, g, lds); STEP_END
        STEP_BEGIN {
            pg8::Gemm gm{WSP(bf16_t, WS_XB), WSP(bf16_t, WS_WIN), 1024, 1024, 1024, nullptr}; pg8::StaticOrder S; S.init(TG, NU, G, bid);
            EpiInProj E{WSP(bf16_t, WS_U), WSP(float, WS_MISC + MS_BIAS)};
            pg8::gemm_phase<EpiInProj, pg8::StaticOrder, true>(lds, gm, S, E);
            if (g == 0) {
                pg8::Gemm gk{WSP(bf16_t, WS_MEMB), WSP(bf16_t, WS_WKV), 1024, 1024, 1024, nullptr}; pg8::StaticOrder S2; S2.init(NBATCH * 256, 2048, G, bid);
                EpiPlain E2{WSP(bf16_t, WS_KVM), 2048};
                pg8::gemm_phase<EpiPlain, pg8::StaticOrder, true>(lds, gk, S2, E2);
            }
        } STEP_END
        STEP_BEGIN ph_mix(pk_, g, lds); STEP_END
        STEP_BEGIN if (MLSTM_NAIVE) ph_mlstm_out(pk_, g, lds); STEP_END
        STEP_BEGIN {
            pg8::Gemm gm{WSP(bf16_t, WS_Y), WSP(bf16_t, WS_WBR), 3072, 1024, 1024, nullptr}; BranchOrder S{(TG / 256) * 4, G, bid};
            EpiBranch E{WSP(bf16_t, WS_U), WSP(float, WS_F32), WSP(bf16_t, WS_MRG)};
            pg8::gemm_phase<EpiBranch, BranchOrder, true>(lds, gm, S, E);
        } STEP_END
        STEP_BEGIN {
            pg8::Gemm gm{WSP(bf16_t, WS_MRG), WSP(bf16_t, WS_WOUT), 1024, 1024, 1024, nullptr}; pg8::StaticOrder S; S.init(TG, 1024, G, bid);
            EpiOutProj E{p.x + (size_t)g * TG * 1024, WSP(float, WS_Z)};
            pg8::gemm_phase<EpiOutProj, pg8::StaticOrder, true>(lds, gm, S, E);
        } STEP_END
        STEP_BEGIN ph_ln1(pk_, g, lds); STEP_END
    }
    STEP_BEGIN {
        pg8::Gemm gm{WSP(bf16_t, WS_X1B), WSP(bf16_t, WS_WR), 1024, 1024, 1024, nullptr}; pg8::StaticOrder S; S.init(T_ALL, 256, G, bid);
        EpiF32 E{WSP(float, WS_LOGIT), 256};
        pg8::gemm_phase<EpiF32, pg8::StaticOrder, true>(lds, gm, S, E);
        ph_expert_weights(pk_, lds);
    } STEP_END
    STEP_BEGIN ph_topk(pk_, lds); STEP_END
    STEP_BEGIN ph_scan(pk_, lds); STEP_END
    STEP_BEGIN ph_slots(pk_, lds); STEP_END
    STEP_BEGIN {
        const int* ntp = WSP(int, WS_MISC + MS_NT);
        pg8::Gemm gm{WSP(bf16_t, WS_X1B), WSP(bf16_t, WS_WGU), 1024, 1024, 1024, WSP(int, WS_TOKOF)}; ExpertGUOrder S{WSP(int, WS_MISC + MS_TILEE), ntp[1] * 2, G, bid};
        EpiGateUp E{WSP(bf16_t, WS_ACT)};
        pg8::gemm_phase<EpiGateUp, ExpertGUOrder, true, true>(lds, gm, S, E);
    } STEP_END
    for (int r = 0; r < 4; ++r) {
        STEP_BEGIN {
            const int* ntp = WSP(int, WS_MISC + MS_NT);
            pg8::Gemm gm{WSP(bf16_t, WS_ACT), WSP(bf16_t, WS_WD), 256, 256, 256, nullptr}; ExpertDownOrder S{WSP(int, WS_MISC + MS_TILEE), ntp[1], G, bid, r};
            EpiDown E{WSP(bf16_t, WS_YCH), WSP(float, WS_WOF)};
            pg8::gemm_phase<EpiDown, ExpertDownOrder, true>(lds, gm, S, E);
        } STEP_END
        STEP_BEGIN ph_combine(pk_, r, lds); STEP_END
    }
    STEP_BEGIN ph_ln2(pk_, lds); STEP_END
}
constexpr int NSTEPS = 1 + NGRP * 7 + 5 + 8 + 1;

extern "C" void kernel_launch(void* const* d_in, const int* in_sizes, int n_in, void* d_out, int out_size, void* d_ws, size_t ws_size, hipStream_t stream) {
    static int grid = 0;
    if (grid == 0) {
        int dev = 0, cus = 0;
        if (hipGetDevice(&dev) != hipSuccess || hipDeviceGetAttribute(&cus, hipDeviceAttributeMultiprocessorCount, dev) != hipSuccess) { fprintf(stderr, "kernel_launch: device query failed\n"); grid = -1; return; }
        if (hipFuncSetAttribute((const void*)fwd, hipFuncAttributeMaxDynamicSharedMemorySize, LDS_BYTES) != hipSuccess) { fprintf(stderr, "kernel_launch: hipFuncSetAttribute failed\n"); grid = -1; return; }
        if (n_in != 24 || ws_size < WS_END) fprintf(stderr, "kernel_launch: n_in %d ws %zu (need %zu)\n", n_in, ws_size, (size_t)WS_END);
        grid = cus;
    }
    if (grid < 0) return;
    (void)hipMemsetAsync((char*)d_ws + WS_CTL, 0, CTL_BYTES, stream);
    P p{};
    const float** pp = (const float**)&p;
    for (int i = 0; i < 24; ++i) pp[i] = (const float*)d_in[i];
    p.out = (float*)d_out; p.ws = (unsigned char*)d_ws;
#ifndef ONE_LAUNCH
    for (int s = 0; s < NSTEPS; ++s) { p.s_lo = s; p.s_hi = s + 1; hipLaunchKernelGGL(fwd, dim3(grid), dim3(512), LDS_BYTES, stream, p); }
#else
    p.s_lo = 0; p.s_hi = NSTEPS; hipLaunchKernelGGL(fwd, dim3(grid), dim3(512), LDS_BYTES, stream, p);
#endif
}
```

```cpp
#define ONE_LAUNCH 1
#include <hip/hip_runtime.h>
#include <cstdio>
#include <cstdint>
#define DI __device__ __forceinline__
#define LAS __attribute__((address_space(3)))
#define GAS __attribute__((address_space(1)))
typedef unsigned short bf16_t;
typedef short bf16x8 __attribute__((ext_vector_type(8)));
typedef float f32x4 __attribute__((ext_vector_type(4)));
typedef float f32x2 __attribute__((ext_vector_type(2)));
typedef unsigned u32x4 __attribute__((ext_vector_type(4)));
typedef unsigned u32x2 __attribute__((ext_vector_type(2)));

constexpr int T_ALL = 65536, DM = 1024, SEQ = 2048, NBATCH = 32, NGRP = 4, TG = T_ALL / NGRP, BG = NBATCH / NGRP;
constexpr int NU = 11264, CIN = 11272;
constexpr int UQ = 0, UK = 1024, UV = 2048, UMQ = 3072, UMK = 4096, UMV = 5120, UMO = 6144, UCQ = 7168, UGT = 8192;
constexpr int NEXP = 256, MAXRT = 2304, MAXTILES = MAXRT + 256, MAXSLOTS = MAXTILES * 256;
constexpr float ALPHA = 1.189207115002721f;
constexpr float LN_EPS = 1e-5f;

constexpr size_t MiB = 1ull << 20;
constexpr size_t WS_CTL = 0, CTL_BYTES = 1 * MiB;
constexpr size_t WS_MISC = 1 * MiB;
constexpr size_t WS_WIN = 2 * MiB, WS_WKV = 24 * MiB, WS_WBR = 28 * MiB, WS_WOUT = 34 * MiB, WS_WR = 36 * MiB;
constexpr size_t WS_GIF = 38 * MiB, WS_MEMB = 40 * MiB, WS_KVM = 56 * MiB, WS_X1B = 88 * MiB, WS_R = 216 * MiB;
constexpr size_t WS_XB = WS_R, WS_U = WS_R + 32 * MiB, WS_Y = WS_R + 384 * MiB, WS_F32 = WS_R + 480 * MiB, WS_MRG = WS_R + 544 * MiB, WS_Z = WS_R + 576 * MiB, WS_QKC = WS_R + 640 * MiB;
constexpr size_t WS_TKI = WS_R, WS_TKW = WS_R + 2 * MiB, WS_SLOTOF = WS_R + 4 * MiB, WS_TOKOF = WS_R + 6 * MiB, WS_WOF = WS_R + 9 * MiB;
constexpr size_t WS_LOGIT = WS_R + 16 * MiB, WS_WGU = WS_R + 80 * MiB, WS_WD = WS_R + 337 * MiB, WS_ACT = WS_R + 580 * MiB, WS_YCH = WS_R + 16 * MiB;
constexpr size_t WS_END = WS_R + 900 * MiB;
constexpr size_t MS_BIAS = 0, MS_LAM = 48 * 1024, MS_TBASE = 52 * 1024, MS_NT = 56 * 1024, MS_TILEE = 64 * 1024;
constexpr int CW_CNT = 1024, CW_CUR = 2048, CW_BAR = 8192, CW_Q = 16384;

constexpr int LDS_RING = 131072, LDS_MISC = LDS_RING + 320, LDS_BYTES = 147456;

DI float bf_lo(unsigned w) { return __uint_as_float(w << 16); }
DI float bf_hi(unsigned w) { return __uint_as_float(w & 0xffff0000u); }
DI float bf2f(bf16_t b) { return __uint_as_float((unsigned)b << 16); }
DI unsigned cvt_pk_bf16(float lo, float hi) { unsigned r; asm("v_cvt_pk_bf16_f32 %0, %1, %2" : "=v"(r) : "v"(lo), "v"(hi)); return r; }
DI float wave_sum(float v) {
#pragma unroll
    for (int o = 1; o < 64; o <<= 1) v += __shfl_xor(v, o);
    return v;
}
DI float wave_max(float v) {
#pragma unroll
    for (int o = 1; o < 64; o <<= 1) v = fmaxf(v, __shfl_xor(v, o));
    return v;
}
DI float sigm(float x) { return 1.f / (1.f + __expf(-x)); }
DI float silu(float x) { return x / (1.f + __expf(-x)); }
DI int tid_local() { int t = threadIdx.x; asm volatile("" : "+v"(t)); return t; }
#define LDS_WAIT() asm volatile("s_waitcnt lgkmcnt(0)" ::: "memory")
namespace pg8 {
constexpr int BM = 256, BK = 64, HALF = 128, HTB = HALF * BK * 2, STAGE_BYTES = 8 * HTB, NXCD = 8, WGM = 8;
__host__ __device__ __forceinline__ int lds_byte(int r, int c) { const int st = (r >> 4) * 2 + (c >> 5), rr = r & 15, cc = c & 31, ob = rr * 64 + cc * 2; return st * 1024 + (ob ^ (((ob >> 9) & 1) << 5)); }
__host__ __device__ __forceinline__ void stage_rc(int b, int& R, int& C) { const int st = b / 1024, sb = b % 1024, swz = sb ^ (((sb >> 9) & 1) << 5); R = (st >> 1) * 16 + swz / 64; C = (st & 1) * 32 + (swz % 64) / 2; }
__host__ __device__ __forceinline__ int perm32(int rho) { const int n = rho >> 4, i = rho & 15; return 8 * (i >> 2) + 4 * n + (i & 3); }

struct Unit { int pm, pn, pb, acol, aux; };
struct Gemm { const bf16_t* A; const bf16_t* Bt; int lda, ldb, K; const int* arow; };

struct StaticOrder {
    int nM, nN, nwg, G, c;
    DI void init(int M, int N, int G_, int c_) { nM = M / BM; nN = N / BM; nwg = nM * nN; G = G_; c = c_; }
    DI bool next(int i, Unit& u) const {
        const long L = (long)i * G + c; if (L >= nwg) return false;
        int wgid = (int)L; { const int q = nwg / NXCD, r = nwg % NXCD, xcd = wgid % NXCD, off = wgid / NXCD; wgid = (xcd < r ? xcd * (q + 1) : r * (q + 1) + (xcd - r) * q) + off; }
        const int nig = WGM * nN, gid = wgid / nig, fm = gid * WGM, gsz = (nM - fm) < WGM ? (nM - fm) : WGM;
        u.pm = fm + ((wgid % nig) % gsz); u.pn = (wgid % nig) / gsz; u.pb = u.pn; u.acol = 0; u.aux = 0; return true;
    }
};

template <class Epi, class Sched, bool ALIGN_EPI, bool GATHER = false>
DI void gemm_phase(LAS unsigned char* lds, const Gemm g, const Sched& S, const Epi& E) {
    const int tid = tid_local(), wid = __builtin_amdgcn_readfirstlane(tid >> 6), lane = tid & 63, wr = wid >> 2, wc = wid & 3, fr = lane & 15, fq = lane >> 4;
    const int nt = g.K / BK;
    int Ra[2], Ca[2], Rb[2];
#pragma unroll
    for (int i = 0; i < 2; ++i) { int R, C; stage_rc(tid * 16 + i * 8192, R, C); Ra[i] = R; Ca[i] = C; Rb[i] = (R & ~31) + perm32(R & 31); }
    const size_t kstep = (size_t)(BK * 2);
    const unsigned ldsw = (unsigned)wid * 1024u;
    const int aoff = lds_byte(wr * 64 + fr, fq * 8), boff = lds_byte(wc * 32 + fr, fq * 8);
#define PG8_SA(b, h) (((b) * 2 + (h)) * HTB)
#define PG8_SB(b, h) ((4 + (b) * 2 + (h)) * HTB)
#define PG8_STAGE(bufoff, gptr, offs) do { _Pragma("unroll") for (int _i = 0; _i < 2; ++_i) \
        __builtin_amdgcn_global_load_lds((const unsigned*)((gptr) + (offs)[_i]), (LAS unsigned*)(lds + (bufoff) + ldsw + _i * 8192), 16, 0, 0); } while (0)
#define PG8_LDA(dst, b, h) do { _Pragma("unroll") for (int m = 0; m < 4; ++m) _Pragma("unroll") for (int k = 0; k < 2; ++k) dst[m][k] = *(const LAS bf16x8*)(lds + PG8_SA(b, h) + aoff + m * 2048 + k * 1024); } while (0)
#define PG8_LDB(dst, b, h) do { _Pragma("unroll") for (int n = 0; n < 2; ++n) _Pragma("unroll") for (int k = 0; k < 2; ++k) dst[n][k] = *(const LAS bf16x8*)(lds + PG8_SB(b, h) + boff + n * 2048 + k * 1024); } while (0)
#define PG8_MMA(ai, bj, At, Bt) do { __builtin_amdgcn_s_setprio(1); _Pragma("unroll") for (int m = 0; m < 4; ++m) _Pragma("unroll") for (int n = 0; n < 2; ++n) _Pragma("unroll") for (int k = 0; k < 2; ++k) \
        acc[ai][bj][m][n] = __builtin_amdgcn_mfma_f32_16x16x32_bf16(Bt[n][k], At[m][k], acc[ai][bj][m][n], 0, 0, 0); __builtin_amdgcn_s_setprio(0); } while (0)
#define PG8_WAIT_V(n) asm volatile("s_waitcnt vmcnt(" #n ")" ::: "memory")
#define PG8_WAIT_L(n) asm volatile("s_waitcnt lgkmcnt(" #n ")" ::: "memory")
#define PG8_BAR __builtin_amdgcn_s_barrier()
#define PG8_SCHED __builtin_amdgcn_sched_barrier(0)
#define PG8_OFFS(u, oa) do { _Pragma("unroll") for (int h_ = 0; h_ < 2; ++h_) _Pragma("unroll") for (int i_ = 0; i_ < 2; ++i_) { \
        const int ar_ = g.arow[(u).pm * BM + h_ * HALF + Ra[i_]]; oa[h_][i_] = (unsigned)(ar_ * g.lda + (u).acol + Ca[i_]) * 2u; } } while (0)
    unsigned voffA[2], voffB[2];
#pragma unroll
    for (int i = 0; i < 2; ++i) { voffA[i] = (unsigned)(Ra[i] * g.lda + Ca[i]) * 2u; voffB[i] = (unsigned)(Rb[i] * g.ldb + Ca[i]) * 2u; }
    const size_t hstepA = (size_t)HALF * g.lda * 2, hstepB = (size_t)HALF * g.ldb * 2;
#define PG8_ABASE(u) ((const char*)g.A + (GATHER ? (size_t)0 : ((size_t)(u).pm * BM * g.lda + (u).acol) * 2))
#define PG8_BBASE(u) ((const char*)g.Bt + (size_t)(u).pb * BM * g.ldb * 2)
#define PG8_STAGE_A(bufoff, ab, oa, h) do { if constexpr (GATHER) { PG8_STAGE(bufoff, ab, (oa)[h]); } else { PG8_STAGE(bufoff, (ab) + (h) * hstepA, voffA); } } while (0)
#define PG8_STAGE_B(bufoff, bb, h) PG8_STAGE(bufoff, (bb) + (h) * hstepB, voffB)
    Unit cur, nxt; int ui = 0;
    if (!S.next(0, cur)) return;
    f32x4 acc[2][2][4][2];
#pragma unroll
    for (int a = 0; a < 2; ++a)
#pragma unroll
        for (int b = 0; b < 2; ++b)
#pragma unroll
            for (int m = 0; m < 4; ++m)
#pragma unroll
                for (int n = 0; n < 2; ++n) acc[a][b][m][n] = (f32x4){0.f, 0.f, 0.f, 0.f};
    bf16x8 At[4][2], B0[2][2], B1[2][2];
    unsigned oaC[2][2], oaN[2][2];
    if constexpr (GATHER) { PG8_OFFS(cur, oaC); }
    const char* cA = PG8_ABASE(cur); const char* cB = PG8_BBASE(cur);
    PG8_STAGE_B(PG8_SB(0, 0), cB, 0); PG8_STAGE_B(PG8_SB(0, 1), cB, 1); PG8_STAGE_A(PG8_SA(0, 0), cA, oaC, 0); PG8_STAGE_A(PG8_SA(0, 1), cA, oaC, 1);
    if (wr == 1) PG8_BAR;
    PG8_WAIT_V(2); PG8_BAR;
    PG8_STAGE_B(PG8_SB(1, 0), cB + kstep, 0); PG8_STAGE_A(PG8_SA(1, 0), cA + kstep, oaC, 0); PG8_STAGE_B(PG8_SB(1, 1), cB + kstep, 1);
    PG8_WAIT_V(6); PG8_BAR;
    for (;;) {
        const bool has_next = S.next(ui + 1, nxt);
        const char* nA = has_next ? PG8_ABASE(nxt) : cA; const char* nB = has_next ? PG8_BBASE(nxt) : cB;
        if constexpr (GATHER) {
            if (has_next) { PG8_OFFS(nxt, oaN); }
            else {
#pragma unroll
                for (int h_ = 0; h_ < 2; ++h_)
#pragma unroll
                    for (int i_ = 0; i_ < 2; ++i_) oaN[h_][i_] = oaC[h_][i_];
            }
        }
#pragma unroll 1
        for (int t = 0; t < nt; t += 2) {
            const bool last = (t == nt - 2);
            const char* a1 = cA + (size_t)(t + 1) * kstep;
            const char* a2 = last ? nA : cA + (size_t)(t + 2) * kstep; const char* b2 = last ? nB : cB + (size_t)(t + 2) * kstep;
            const char* a3 = a2 + kstep; const char* b3 = b2 + kstep;
            unsigned oa2[2][2];
            if constexpr (GATHER) {
#pragma unroll
                for (int h_ = 0; h_ < 2; ++h_)
#pragma unroll
                    for (int i_ = 0; i_ < 2; ++i_) oa2[h_][i_] = last ? oaN[h_][i_] : oaC[h_][i_];
            }
            PG8_LDB(B0, 0, 0); PG8_LDB(B1, 0, 1); PG8_SCHED; PG8_LDA(At, 0, 0); PG8_STAGE_A(PG8_SA(1, 1), a1, oaC, 1);
            PG8_WAIT_V(8); PG8_WAIT_L(0); PG8_BAR; PG8_MMA(0, 0, At, B0); PG8_MMA(0, 1, At, B1); PG8_BAR; PG8_SCHED;
            PG8_LDA(At, 0, 1); PG8_STAGE_B(PG8_SB(0, 0), b2, 0); PG8_STAGE_B(PG8_SB(0, 1), b2, 1); PG8_STAGE_A(PG8_SA(0, 0), a2, oa2, 0);
            PG8_WAIT_V(8); PG8_WAIT_L(0); PG8_BAR; PG8_MMA(1, 0, At, B0); PG8_MMA(1, 1, At, B1); PG8_BAR; PG8_SCHED;
            PG8_LDB(B0, 1, 0); PG8_LDB(B1, 1, 1); PG8_SCHED; PG8_LDA(At, 1, 0); PG8_STAGE_A(PG8_SA(0, 1), a2, oa2, 1);
            PG8_WAIT_V(8); PG8_WAIT_L(0); PG8_BAR; PG8_MMA(0, 0, At, B0); PG8_MMA(0, 1, At, B1); PG8_BAR; PG8_SCHED;
            PG8_LDA(At, 1, 1); PG8_STAGE_B(PG8_SB(1, 0), b3, 0); PG8_STAGE_B(PG8_SB(1, 1), b3, 1); PG8_STAGE_A(PG8_SA(1, 0), a3, oa2, 0);
            PG8_WAIT_V(8); PG8_WAIT_L(0); PG8_BAR; PG8_MMA(1, 0, At, B0); PG8_MMA(1, 1, At, B1); PG8_BAR; PG8_SCHED;
        }
        if constexpr (ALIGN_EPI) { if (wr == 0) PG8_BAR; }
        E(acc, cur, wr, wc, fr, fq);
        if (!has_next) break;
#pragma unroll
        for (int a = 0; a < 2; ++a)
#pragma unroll
            for (int b = 0; b < 2; ++b)
#pragma unroll
                for (int m = 0; m < 4; ++m)
#pragma unroll
                    for (int n = 0; n < 2; ++n) acc[a][b][m][n] = (f32x4){0.f, 0.f, 0.f, 0.f};
        cur = nxt; cA = nA; cB = nB; ++ui;
        if constexpr (GATHER) {
#pragma unroll
            for (int h_ = 0; h_ < 2; ++h_)
#pragma unroll
                for (int i_ = 0; i_ < 2; ++i_) oaC[h_][i_] = oaN[h_][i_];
        }
        if constexpr (ALIGN_EPI) { if (wr == 1) PG8_BAR; }
    }
    PG8_WAIT_V(0);
    if constexpr (!ALIGN_EPI) { if (wr == 0) PG8_BAR; }
    PG8_BAR;
#undef PG8_SA
#undef PG8_SB
#undef PG8_STAGE
#undef PG8_LDA
#undef PG8_LDB
#undef PG8_MMA
#undef PG8_WAIT_V
#undef PG8_WAIT_L
#undef PG8_BAR
#undef PG8_SCHED
#undef PG8_OFFS
#undef PG8_ABASE
#undef PG8_BBASE
#undef PG8_STAGE_A
#undef PG8_STAGE_B
}
}
using pg8::Unit; using pg8::BM; using pg8::HALF;

struct BranchOrder {
    int ntile, G, c;
    DI bool next(int i, Unit& u) const {
        const int L = (i / 3) * G + c; if (L >= ntile) return false;
        const int n = i % 3; u.pm = L >> 2; u.pn = L & 3; u.pb = n * 4 + u.pn; u.acol = n * 1024; u.aux = n; return true;
    }
};
struct ExpertGUOrder {
    const int* tile_e; int nunits, G, c;
    DI bool next(int i, Unit& u) const {
        const int L = i * G + c; if (L >= nunits) return false;
        const int t = L >> 1, hf = L & 1; const int e = tile_e[t];
        u.pm = t; u.pn = hf; u.pb = e * 2 + hf; u.acol = 0; u.aux = e; return true;
    }
};
struct ExpertDownOrder {
    const int* tile_e; int nunits, G, c, round;
    DI bool next(int i, Unit& u) const {
        const int L = i * G + c; if (L >= nunits) return false;
        const int e = tile_e[L];
        u.pm = L; u.pn = 0; u.pb = e * 4 + round; u.acol = 0; u.aux = e; return true;
    }
};

#define EPI_ARGS const f32x4 (&acc)[2][2][4][2], const Unit& u, int wr, int wc, int fr, int fq
DI u32x4 pack8(const f32x4 v0, const f32x4 v1) { u32x4 w; w.x = cvt_pk_bf16(v0[0], v0[1]); w.y = cvt_pk_bf16(v0[2], v0[3]); w.z = cvt_pk_bf16(v1[0], v1[1]); w.w = cvt_pk_bf16(v1[2], v1[3]); return w; }

struct EpiInProj {
    bf16_t* O; const float* bias;
    DI void operator()(EPI_ARGS) const {
        const int row0 = u.pm * BM + wr * 64 + fr, col0 = u.pn * BM + wc * 32 + 8 * fq;
        const float sc = (u.pn < 4) ? 0.125f * 1.4426950408889634f : ((u.pn >= 28 && u.pn < 32) ? 0.0625f * 1.4426950408889634f : 1.f);
        f32x4 bv[2][2];
#pragma unroll
        for (int bj = 0; bj < 2; ++bj)
#pragma unroll
            for (int n = 0; n < 2; ++n) bv[bj][n] = *(const f32x4*)(bias + col0 + bj * HALF + 4 * n);
#pragma unroll
        for (int ai = 0; ai < 2; ++ai)
#pragma unroll
            for (int m = 0; m < 4; ++m) { bf16_t* rowp = O + (size_t)(row0 + ai * HALF + m * 16) * NU + col0;
#pragma unroll
                for (int bj = 0; bj < 2; ++bj) *(u32x4*)(rowp + bj * HALF) = pack8((acc[ai][bj][m][0] + bv[bj][0]) * sc, (acc[ai][bj][m][1] + bv[bj][1]) * sc); }
    }
};
struct EpiPlain {
    bf16_t* O; int ldc;
    DI void operator()(EPI_ARGS) const {
        const int row0 = u.pm * BM + wr * 64 + fr, col0 = u.pn * BM + wc * 32 + 8 * fq;
#pragma unroll
        for (int ai = 0; ai < 2; ++ai)
#pragma unroll
            for (int m = 0; m < 4; ++m) { bf16_t* rowp = O + (size_t)(row0 + ai * HALF + m * 16) * ldc + col0;
#pragma unroll
                for (int bj = 0; bj < 2; ++bj) *(u32x4*)(rowp + bj * HALF) = pack8(acc[ai][bj][m][0], acc[ai][bj][m][1]); }
    }
};
struct EpiBranch {
    const bf16_t* U; float* F; bf16_t* M;
    DI void operator()(EPI_ARGS) const {
        const int row0 = u.pm * BM + wr * 64 + fr, col0 = u.pn * BM + wc * 32 + 8 * fq, n = u.aux;
#pragma unroll
        for (int ai = 0; ai < 2; ++ai)
#pragma unroll
            for (int m = 0; m < 4; ++m) { const size_t row = (size_t)(row0 + ai * HALF + m * 16);
#pragma unroll
                for (int bj = 0; bj < 2; ++bj) { const int col = col0 + bj * HALF;
                    const u32x4 gw = *(const u32x4*)(U + row * NU + UGT + n * 1024 + col);
                    f32x4 g0 = {sigm(bf_lo(gw.x)), sigm(bf_hi(gw.x)), sigm(bf_lo(gw.y)), sigm(bf_hi(gw.y))};
                    f32x4 g1 = {sigm(bf_lo(gw.z)), sigm(bf_hi(gw.z)), sigm(bf_lo(gw.w)), sigm(bf_hi(gw.w))};
                    f32x4 v0 = acc[ai][bj][m][0] * g0, v1 = acc[ai][bj][m][1] * g1;
                    float* fp = F + row * 1024 + col;
                    if (n > 0) { v0 += *(const f32x4*)fp; v1 += *(const f32x4*)(fp + 4); }
                    if (n < 2) { *(f32x4*)fp = v0; *(f32x4*)(fp + 4) = v1; }
                    else *(u32x4*)(M + row * 1024 + col) = pack8(v0, v1); }
                asm volatile("" ::: "memory"); }
    }
};
struct EpiOutProj {
    const float* X; float* Z;
    DI void operator()(EPI_ARGS) const {
        const int row0 = u.pm * BM + wr * 64 + fr, col0 = u.pn * BM + wc * 32 + 8 * fq;
#pragma unroll
        for (int ai = 0; ai < 2; ++ai)
#pragma unroll
            for (int m = 0; m < 4; ++m) { const size_t off = (size_t)(row0 + ai * HALF + m * 16) * 1024 + col0;
#pragma unroll
                for (int bj = 0; bj < 2; ++bj) { const float* xp = X + off + bj * HALF; float* zp = Z + off + bj * HALF;
                    *(f32x4*)zp = *(const f32x4*)xp * ALPHA + acc[ai][bj][m][0]; *(f32x4*)(zp + 4) = *(const f32x4*)(xp + 4) * ALPHA + acc[ai][bj][m][1]; }
                asm volatile("" ::: "memory"); }
    }
};
struct EpiF32 {
    float* O; int ldc;
    DI void operator()(EPI_ARGS) const {
        const int row0 = u.pm * BM + wr * 64 + fr, col0 = u.pn * BM + wc * 32 + 8 * fq;
#pragma unroll
        for (int ai = 0; ai < 2; ++ai)
#pragma unroll
            for (int m = 0; m < 4; ++m) { float* rowp = O + (size_t)(row0 + ai * HALF + m * 16) * ldc + col0;
#pragma unroll
                for (int bj = 0; bj < 2; ++bj) { *(f32x4*)(rowp + bj * HALF) = acc[ai][bj][m][0]; *(f32x4*)(rowp + bj * HALF + 4) = acc[ai][bj][m][1]; } }
    }
};
struct EpiGateUp {
    bf16_t* ACT;
    DI void operator()(EPI_ARGS) const {
        const int row0 = u.pm * BM + wr * 64 + fr, col0 = u.pn * HALF + wc * 32 + 8 * fq;
#pragma unroll
        for (int ai = 0; ai < 2; ++ai)
#pragma unroll
            for (int m = 0; m < 4; ++m) { f32x4 v[2];
#pragma unroll
                for (int n = 0; n < 2; ++n) { const f32x4 gt = acc[ai][0][m][n], up = acc[ai][1][m][n];
                    v[n] = (f32x4){silu(gt[0]) * up[0], silu(gt[1]) * up[1], silu(gt[2]) * up[2], silu(gt[3]) * up[3]}; }
                *(u32x4*)(ACT + (size_t)(row0 + ai * HALF + m * 16) * 256 + col0) = pack8(v[0], v[1]); }
    }
};
struct EpiDown {
    bf16_t* Y; const float* W;
    DI void operator()(EPI_ARGS) const {
        const int row0 = u.pm * BM + wr * 64 + fr, col0 = wc * 32 + 8 * fq;
#pragma unroll
        for (int ai = 0; ai < 2; ++ai)
#pragma unroll
            for (int m = 0; m < 4; ++m) { const int row = row0 + ai * HALF + m * 16; const float w = W[row];
#pragma unroll
                for (int bj = 0; bj < 2; ++bj) *(u32x4*)(Y + (size_t)row * 256 + col0 + bj * HALF) = pack8(acc[ai][bj][m][0] * w, acc[ai][bj][m][1] * w);
                asm volatile("" ::: "memory"); }
    }
};
#define RLX_AGENT __ATOMIC_RELAXED, __HIP_MEMORY_SCOPE_AGENT
#define XB_TMO      128
#define XB_XCNT(j)  (256  + 64 * (j))
#define XB_XSUB(j)  (1280 + 64 * (j))
#define XB_XGEN(j)  (2304 + 64 * (j))
#define XB_TOP      3328
#define XB_TOPGEN   3392
#define XCD_BAR_WORDS 3456
#define XB_SPIN_CAP (1u << 18)

__device__ __forceinline__ unsigned xb_ld(unsigned* p)              { return __hip_atomic_load(p, __ATOMIC_RELAXED, __HIP_MEMORY_SCOPE_AGENT); }
__device__ __forceinline__ unsigned xb_add(unsigned* p, unsigned v) { return __hip_atomic_fetch_add(p, v, __ATOMIC_RELAXED, __HIP_MEMORY_SCOPE_AGENT); }
__device__ __forceinline__ unsigned xb_xcc_id() { return (unsigned)__builtin_amdgcn_s_getreg((3 << 11) | 20) & 0xFu; }
#define XB_SPIN(cond, bar) do { unsigned _sp = 0; while (cond) { __builtin_amdgcn_s_sleep(1); \
    if ((++_sp & 255u) == 0u) { if (xb_ld(&(bar)[XB_TMO])) break; if (_sp > XB_SPIN_CAP) { atomicAdd(&(bar)[XB_TMO], 1u); break; } } } } while (0)

struct XcdBarrier {
    unsigned* bar; unsigned x;
    volatile LAS unsigned* st;
};

__device__ __forceinline__ XcdBarrier xcd_barrier_post(unsigned* bar, volatile LAS unsigned* st) {
    XcdBarrier b; b.bar = bar; b.x = xb_xcc_id(); b.st = st;
    if (threadIdx.x == 0) (void)xb_add(&bar[XB_XCNT(b.x)], 1u);
    return b;
}
__device__ __forceinline__ void xcd_barrier_complete(unsigned* bar, unsigned x, unsigned& nloc, unsigned& nx) {
    const unsigned G = gridDim.x * gridDim.y * gridDim.z;
    unsigned sum, cnt, mine, sp = 0u;
    for (;;) {
        sum = 0u; cnt = 0u; mine = 0u;
#pragma unroll
        for (unsigned j = 0; j < 16; ++j) { const unsigned c = xb_ld(&bar[XB_XCNT(j)]); sum += c; cnt += (c > 0u) ? 1u : 0u; mine = (j == x) ? c : mine; }
        if (sum == G) break;
        __builtin_amdgcn_s_sleep(1);
        if ((++sp & 255u) == 0u) { if (xb_ld(&bar[XB_TMO])) break; if (sp > XB_SPIN_CAP) { atomicAdd(&bar[XB_TMO], 1u); break; } }
    }
    nloc = mine > 0u ? mine : 1u; nx = cnt > 0u ? cnt : 1u;
}

__device__ __forceinline__ void xcd_barrier(const XcdBarrier& b) {
    asm volatile("s_waitcnt vmcnt(0)" ::: "memory");
    __syncthreads();
    if (threadIdx.x == 0) {
        unsigned* bar = b.bar;
        __builtin_amdgcn_s_waitcnt(0);
        unsigned nloc = b.st[0], nx = b.st[1];
        if (nloc == 0u) { xcd_barrier_complete(bar, b.x, nloc, nx); b.st[0] = nloc; b.st[1] = nx; }
        const unsigned old = xb_add(&bar[XB_XSUB(b.x)], 1u);
        const unsigned gen = old / nloc;
        if (old + 1u == (gen + 1u) * nloc) {
            __builtin_amdgcn_fence(__ATOMIC_RELEASE, "agent");
            asm volatile("s_waitcnt vmcnt(0)" ::: "memory");
            const unsigned og = xb_add(&bar[XB_TOP], 1u);
            const unsigned tg = og / nx;
            if (og + 1u == (tg + 1u) * nx) xb_add(&bar[XB_TOPGEN], 1u);
            else XB_SPIN(xb_ld(&bar[XB_TOPGEN]) == tg, bar);
            __builtin_amdgcn_fence(__ATOMIC_ACQUIRE, "agent");
            xb_add(&bar[XB_XGEN(b.x)], 1u);
            asm volatile("s_waitcnt vmcnt(0)" ::: "memory");
        } else {
            XB_SPIN(xb_ld(&bar[XB_XGEN(b.x)]) == gen, bar);
            __builtin_amdgcn_fence(__ATOMIC_ACQUIRE, "agent");
            asm volatile("s_waitcnt vmcnt(0)" ::: "memory");
        }
    }
    __syncthreads();
}

struct P {
    const float *x, *mem, *rel_bias, *w_in, *b_in, *conv_w, *diff_lambda, *subln_g, *mlstm_norm_g, *w_mem_kv, *w_branch, *w_out, *ln1_g, *ln1_b,
                *w_router, *router_bias, *w_e_gate, *w_e_up, *w_e_down, *w_s_gate, *w_s_up, *w_s_down, *ln2_g, *ln2_b;
    float* out; unsigned char* ws; int s_lo, s_hi;
};
typedef const P __attribute__((address_space(4)))* PP;
DI PP kargs() { PP k = (PP)__builtin_amdgcn_kernarg_segment_ptr(); asm volatile("" : "+s"(k)); return k; }
DI P load_args(PP k) { P r; const unsigned long long __attribute__((address_space(4)))* s = (const unsigned long long __attribute__((address_space(4)))*)k;
    void** d = (void**)&r;
#pragma unroll
    for (int i = 0; i < 26; ++i) d[i] = (void*)(GAS char*)s[i];
    ((unsigned long long*)&r)[26] = s[26];
    return r; }
static_assert(sizeof(P) == 27 * 8, "P = 26 pointers + 2 ints");
#define WSP(T, off) ((T*)(p.ws + (off)))

DI void transpose_item(const float* W, int ldw, int src_col0, bf16_t* WT, int ldt, int dst_row0, int k0, LAS float* scr, int lane) {
    float v[32];
    const float* src = W + (size_t)(k0 + (lane >> 5)) * ldw + src_col0 + (lane & 31);
#pragma unroll
    for (int i = 0; i < 32; ++i) v[i] = src[(size_t)(2 * i) * ldw];
#pragma unroll
    for (int i = 0; i < 32; ++i) scr[(2 * i + (lane >> 5)) * 33 + (lane & 31)] = v[i];
    LDS_WAIT();
    const int c = lane & 7;
#pragma unroll
    for (int j = 0; j < 4; ++j) { const int n = (lane >> 3) + 8 * j; const LAS float* s = scr + (8 * c) * 33 + n;
        u32x4 o; o.x = cvt_pk_bf16(s[0 * 33], s[1 * 33]); o.y = cvt_pk_bf16(s[2 * 33], s[3 * 33]); o.z = cvt_pk_bf16(s[4 * 33], s[5 * 33]); o.w = cvt_pk_bf16(s[6 * 33], s[7 * 33]);
        *(u32x4*)(WT + (size_t)(dst_row0 + n) * ldt + k0 + 8 * c) = o; }
    LDS_WAIT();
}
DI void transpose_mat(const float* W, int ldw, int src_col0, int K, int N, bf16_t* WT, int ldt, int dst_row0, int gw, int NGW, LAS float* scr, int lane) {
    const int nblk = N / 32, items = (K / 64) * nblk;
    for (int it = gw; it < items; it += NGW) { const int kb = it / nblk, nb = it % nblk; transpose_item(W, ldw, src_col0 + nb * 32, WT, ldt, dst_row0 + nb * 32, kb * 64, scr, lane); }
}
DI void row_to_bf16(const float* src, bf16_t* dst, int lane) {
    const f32x4* s = (const f32x4*)src + lane; u32x2* d = (u32x2*)dst + lane;
#pragma unroll
    for (int j = 0; j < 4; ++j) { const f32x4 v = s[64 * j]; u32x2 o; o.x = cvt_pk_bf16(v[0], v[1]); o.y = cvt_pk_bf16(v[2], v[3]); d[64 * j] = o; }
}

DI void ph_prologue(PP pk_, LAS unsigned char* lds) { const P p = load_args(pk_);
    const int tid = tid_local(), lane = tid & 63, wave = tid >> 6, gw = blockIdx.x * 8 + wave, NGW = gridDim.x * 8;
    LAS float* scr = (LAS float*)(lds + wave * 16384);
    bf16_t* WinT = WSP(bf16_t, WS_WIN);
    transpose_mat(p.w_in, CIN, 0, 1024, 7168, WinT, 1024, 0, gw, NGW, scr, lane);
    transpose_mat(p.w_in, CIN, 7176, 1024, 4096, WinT, 1024, 7168, gw, NGW, scr, lane);
    transpose_mat(p.w_mem_kv, 2048, 0, 1024, 2048, WSP(bf16_t, WS_WKV), 1024, 0, gw, NGW, scr, lane);
    for (int n = 0; n < 3; ++n) transpose_mat(p.w_branch + (size_t)n * 1024 * 1024, 1024, 0, 1024, 1024, WSP(bf16_t, WS_WBR), 1024, n * 1024, gw, NGW, scr, lane);
    transpose_mat(p.w_out, 1024, 0, 1024, 1024, WSP(bf16_t, WS_WOUT), 1024, 0, gw, NGW, scr, lane);
    transpose_mat(p.w_router, 256, 0, 1024, 256, WSP(bf16_t, WS_WR), 1024, 0, gw, NGW, scr, lane);
    bf16_t* memb = WSP(bf16_t, WS_MEMB);
    for (int r = gw; r < NBATCH * 256; r += NGW) row_to_bf16(p.mem + (size_t)r * 1024, memb + (size_t)r * 1024, lane);
    float* bias = WSP(float, WS_MISC + MS_BIAS);
    for (int j = blockIdx.x * 512 + tid; j < NU; j += gridDim.x * 512) bias[j] = p.b_in[j + (j >= 7168 ? 8 : 0)];
    if (gw == 0) {
        const float* lv = p.diff_lambda;
        const float s1 = wave_sum(lv[lane] * lv[64 + lane]), s2 = wave_sum(lv[128 + lane] * lv[192 + lane]);
        if (lane == 0) *WSP(float, WS_MISC + MS_LAM) = expf(s1) - expf(s2) + 0.2f;
    }
}

DI void ph_xconv(PP pk_, int g, LAS unsigned char* lds) { const P p = load_args(pk_);
    const int tid = tid_local(), lane = tid & 63, wave = tid >> 6, gw = blockIdx.x * 8 + wave, NGW = gridDim.x * 8;
    LAS float* wg = (LAS float*)lds;
    for (int i = tid; i < 2048; i += 512) { const int c = i >> 1, hf = i & 1; *(LAS f32x4*)(wg + c * 8 + hf * 4) = *(const f32x4*)(p.w_in + (size_t)c * CIN + 7168 + hf * 4); }
    __syncthreads();
    bf16_t* xb = WSP(bf16_t, WS_XB); float* gif = WSP(float, WS_GIF);
    for (int r = gw; r < TG; r += NGW) {
        const size_t t = (size_t)g * TG + r;
        const f32x4* xr = (const f32x4*)(p.x + t * 1024) + lane; u32x2* d = (u32x2*)(xb + (size_t)r * 1024) + lane;
        float gs[8];
#pragma unroll
        for (int q = 0; q < 8; ++q) gs[q] = 0.f;
#pragma unroll
        for (int j = 0; j < 4; ++j) { const f32x4 v = xr[64 * j]; u32x2 o; o.x = cvt_pk_bf16(v[0], v[1]); o.y = cvt_pk_bf16(v[2], v[3]); d[64 * j] = o;
#pragma unroll
            for (int e = 0; e < 4; ++e) { const int c = 4 * lane + 256 * j + e; const f32x4 wl = *(const LAS f32x4*)(wg + c * 8), wh = *(const LAS f32x4*)(wg + c * 8 + 4);
                gs[0] += v[e] * wl[0]; gs[1] += v[e] * wl[1]; gs[2] += v[e] * wl[2]; gs[3] += v[e] * wl[3]; gs[4] += v[e] * wh[0]; gs[5] += v[e] * wh[1]; gs[6] += v[e] * wh[2]; gs[7] += v[e] * wh[3]; } }
        float mine = 0.f;
#pragma unroll
        for (int q = 0; q < 8; ++q) { const float s = wave_sum(gs[q]); if (lane == q) mine = s; }
        if (lane < 8) gif[t * 8 + lane] = mine + p.b_in[7168 + lane];
    }
    __syncthreads();
}

DI int t5_bucket(int n) { return n < 16 ? n : min(31, 16 + (int)(__log2f((float)n * 0.0625f) * (16.f / 3.f))); }

DI void attn_naive_item(PP pk_, int item, LAS unsigned char* lds) { const P p = load_args(pk_);
    const int tid = tid_local(), qr = tid >> 3, map = (tid >> 2) & 1, dc = tid & 3;
    const int qb = item & 31, h = (item >> 5) & 7, b = item >> 8, q0 = qb * 64, qi = q0 + qr;
    const bf16_t* U = WSP(bf16_t, WS_U); const size_t rbase = (size_t)b * SEQ;
    LAS float* bt = (LAS float*)(lds + 16384);
    if (tid <= 128) bt[tid] = p.rel_bias[t5_bucket(tid) * 8 + h] * 1.4426950408889634f;
    float q[64];
    { const u32x4* qp = (const u32x4*)(U + (rbase + qi) * NU + UQ + h * 128 + map * 64);
#pragma unroll
      for (int i = 0; i < 8; ++i) { const u32x4 w = qp[i]; q[8 * i] = bf_lo(w.x); q[8 * i + 1] = bf_hi(w.x); q[8 * i + 2] = bf_lo(w.y); q[8 * i + 3] = bf_hi(w.y); q[8 * i + 4] = bf_lo(w.z); q[8 * i + 5] = bf_hi(w.z); q[8 * i + 6] = bf_lo(w.w); q[8 * i + 7] = bf_hi(w.w); } }
    float o[32];
#pragma unroll
    for (int c = 0; c < 32; ++c) o[c] = 0.f;
    float mrun = -INFINITY, lrun = 0.f;
    const int ntile = q0 / 32 + 2;
    for (int kt = 0; kt < ntile; ++kt) {
        const int k0 = kt * 32;
        __syncthreads();
        { const int key = tid >> 4, pc = tid & 15; const bf16_t* urow = U + (rbase + k0 + key) * NU;
          *(LAS u32x4*)(lds + (pc >> 3) * 4096 + key * 128 + (pc & 7) * 16) = *(const u32x4*)(urow + UK + h * 128 + pc * 8);
          *(LAS u32x4*)(lds + 8192 + key * 256 + pc * 16) = *(const u32x4*)(urow + UV + h * 128 + pc * 8); }
        __syncthreads();
#pragma unroll 1
        for (int j = 0; j < 32; ++j) {
            const int dist = qi - (k0 + j);
            const LAS u32x4* kp = (const LAS u32x4*)(lds + map * 4096 + j * 128); float a = 0.f;
#pragma unroll
            for (int i = 0; i < 8; ++i) { const u32x4 w = kp[i]; a += q[8 * i] * bf_lo(w.x) + q[8 * i + 1] * bf_hi(w.x) + q[8 * i + 2] * bf_lo(w.y) + q[8 * i + 3] * bf_hi(w.y) + q[8 * i + 4] * bf_lo(w.z) + q[8 * i + 5] * bf_hi(w.z) + q[8 * i + 6] * bf_lo(w.w) + q[8 * i + 7] * bf_hi(w.w); }
            if (dist >= 0) {
                a += bt[min(dist, 128)];
                if (a > mrun) { const float sc = __builtin_amdgcn_exp2f(mrun - a); mrun = a; lrun *= sc;
#pragma unroll
                    for (int c = 0; c < 32; ++c) o[c] *= sc; }
                const float pj = __builtin_amdgcn_exp2f(a - mrun); lrun += pj; const LAS u32x4* vp = (const LAS u32x4*)(lds + 8192 + j * 256 + dc * 64);
#pragma unroll
                for (int i = 0; i < 4; ++i) { const u32x4 w = vp[i]; o[8 * i] += pj * bf_lo(w.x); o[8 * i + 1] += pj * bf_hi(w.x); o[8 * i + 2] += pj * bf_lo(w.y); o[8 * i + 3] += pj * bf_hi(w.y); o[8 * i + 4] += pj * bf_lo(w.z); o[8 * i + 5] += pj * bf_hi(w.z); o[8 * i + 6] += pj * bf_lo(w.w); o[8 * i + 7] += pj * bf_hi(w.w); }
            }
        }
    }
    const float lam = *WSP(float, WS_MISC + MS_LAM), inv = 1.f / lrun;
    float ss = 0.f;
#pragma unroll
    for (int c = 0; c < 32; ++c) { const float mine = o[c] * inv, other = __shfl_xor(mine, 4); o[c] = mine - lam * other; ss += o[c] * o[c]; }
    ss += __shfl_xor(ss, 1); ss += __shfl_xor(ss, 2);
    const float rs = rsqrtf(ss * (1.f / 128.f) + LN_EPS) * 0.8f;
    if (map == 0) { bf16_t* yp = WSP(bf16_t, WS_Y) + (rbase + qi) * 3072 + h * 128 + dc * 32; const float* gp = p.subln_g + dc * 32;
#pragma unroll
        for (int i = 0; i < 4; ++i) { u32x4 w; w.x = cvt_pk_bf16(o[8 * i] * rs * gp[8 * i], o[8 * i + 1] * rs * gp[8 * i + 1]); w.y = cvt_pk_bf16(o[8 * i + 2] * rs * gp[8 * i + 2], o[8 * i + 3] * rs * gp[8 * i + 3]);
            w.z = cvt_pk_bf16(o[8 * i + 4] * rs * gp[8 * i + 4], o[8 * i + 5] * rs * gp[8 * i + 5]); w.w = cvt_pk_bf16(o[8 * i + 6] * rs * gp[8 * i + 6], o[8 * i + 7] * rs * gp[8 * i + 7]); *(u32x4*)(yp + 8 * i) = w; } }
    __syncthreads();
}

DI void xattn_naive_item(PP pk_, int g, int item, LAS unsigned char* lds) { const P p = load_args(pk_);
    const int tid = tid_local(), lane = tid & 63, wave = tid >> 6;
    const int qb = item & 63, h = (item >> 6) & 3, b = item >> 8;
    const bf16_t* U = WSP(bf16_t, WS_U); const bf16_t* KV = WSP(bf16_t, WS_KVM) + (size_t)(g * BG + b) * 256 * 2048;
    const size_t r0 = (size_t)b * SEQ + qb * 32;
    LAS float* qs = (LAS float*)lds; LAS float* ps = (LAS float*)(lds + 32768);
    __syncthreads();
    for (int i = tid; i < 32 * 32; i += 512) { const int r = i >> 5, c8 = i & 31; const u32x4 w = *(const u32x4*)(U + (r0 + r) * NU + UCQ + h * 256 + c8 * 8); LAS float* d = qs + r * 256 + c8 * 8;
        d[0] = bf_lo(w.x); d[1] = bf_hi(w.x); d[2] = bf_lo(w.y); d[3] = bf_hi(w.y); d[4] = bf_lo(w.z); d[5] = bf_hi(w.z); d[6] = bf_lo(w.w); d[7] = bf_hi(w.w); }
    __syncthreads();
    const int mcol = tid & 255, rh = tid >> 8;
    { float a[16];
#pragma unroll
      for (int r = 0; r < 16; ++r) a[r] = 0.f;
      const bf16_t* kp = KV + (size_t)mcol * 2048 + h * 256;
      for (int d0 = 0; d0 < 256; d0 += 8) { const u32x4 w = *(const u32x4*)(kp + d0); float kv[8] = {bf_lo(w.x), bf_hi(w.x), bf_lo(w.y), bf_hi(w.y), bf_lo(w.z), bf_hi(w.z), bf_lo(w.w), bf_hi(w.w)};
#pragma unroll
          for (int r = 0; r < 16; ++r) { const LAS f32x4* qp = (const LAS f32x4*)(qs + (rh * 16 + r) * 256 + d0); const f32x4 qa = qp[0], qc = qp[1];
              a[r] += qa[0] * kv[0] + qa[1] * kv[1] + qa[2] * kv[2] + qa[3] * kv[3] + qc[0] * kv[4] + qc[1] * kv[5] + qc[2] * kv[6] + qc[3] * kv[7]; } }
#pragma unroll
      for (int r = 0; r < 16; ++r) ps[(rh * 16 + r) * 256 + mcol] = a[r]; }
    __syncthreads();
#pragma unroll
    for (int rr = 0; rr < 4; ++rr) { const int r = wave * 4 + rr; LAS f32x4* pr = (LAS f32x4*)(ps + r * 256) + lane; f32x4 v = *pr;
        const float mx = wave_max(fmaxf(fmaxf(v[0], v[1]), fmaxf(v[2], v[3])));
        v = (f32x4){__builtin_amdgcn_exp2f(v[0] - mx), __builtin_amdgcn_exp2f(v[1] - mx), __builtin_amdgcn_exp2f(v[2] - mx), __builtin_amdgcn_exp2f(v[3] - mx)};
        const float inv = 1.f / wave_sum((v[0] + v[1]) + (v[2] + v[3])); *pr = v * inv; }
    __syncthreads();
    { float a[16];
#pragma unroll
      for (int r = 0; r < 16; ++r) a[r] = 0.f;
      const bf16_t* vp = KV + 1024 + h * 256 + mcol;
      for (int m = 0; m < 256; ++m) { const float vv = bf2f(vp[(size_t)m * 2048]);
#pragma unroll
          for (int r = 0; r < 16; ++r) a[r] += ps[(rh * 16 + r) * 256 + m] * vv; }
      bf16_t* yp = WSP(bf16_t, WS_Y) + (r0 + rh * 16) * 3072 + 2048 + h * 256 + mcol;
#pragma unroll
      for (int r = 0; r < 16; ++r) yp[(size_t)r * 3072] = (bf16_t)(cvt_pk_bf16(a[r], 0.f) & 0xffffu); }
    __syncthreads();
}

DI void mlstm_naive_item(PP pk_, int g, int item, LAS unsigned char* lds) { const P p = load_args(pk_);
    const int tid = tid_local(), v = tid >> 3, kc = tid & 7;
    const int sl = item & 3, h = (item >> 2) & 3, b = item >> 4;
    const bf16_t* U = WSP(bf16_t, WS_U); const float* gif = WSP(float, WS_GIF); float* HT = WSP(float, WS_F32);
    const size_t rbase = (size_t)b * SEQ; const size_t tbase = ((size_t)g * BG + b) * SEQ;
    LAS bf16_t* qs = (LAS bf16_t*)lds; LAS bf16_t* ks = (LAS bf16_t*)(lds + 32768); LAS float* vs = (LAS float*)(lds + 65536); LAS float* gi = (LAS float*)(lds + 81920); LAS float* gf = (LAS float*)(lds + 82176);
    float C[32], nn[32];
#pragma unroll
    for (int i = 0; i < 32; ++i) { C[i] = 0.f; nn[i] = 0.f; }
    float mst = 0.f;
    for (int ch = 0; ch < SEQ / 64; ++ch) {
        __syncthreads();
        for (int i = tid; i < 2 * 64 * 32; i += 512) { const int isk = i >> 11, s = (i >> 5) & 63, c8 = i & 31; const int ts = ch * 64 + s; const int col = (isk ? UMK : UMQ) + h * 256 + c8 * 8;
            float a[8];
#pragma unroll
            for (int e = 0; e < 8; ++e) a[e] = 0.f;
#pragma unroll
            for (int j = 0; j < 4; ++j) { const int tt = ts - 3 + j; if (tt >= 0) { const u32x4 w = *(const u32x4*)(U + (rbase + tt) * NU + col); const float* cw = p.conv_w + j * 2048 + isk * 1024 + h * 256 + c8 * 8;
                    a[0] += cw[0] * bf_lo(w.x); a[1] += cw[1] * bf_hi(w.x); a[2] += cw[2] * bf_lo(w.y); a[3] += cw[3] * bf_hi(w.y); a[4] += cw[4] * bf_lo(w.z); a[5] += cw[5] * bf_hi(w.z); a[6] += cw[6] * bf_lo(w.w); a[7] += cw[7] * bf_hi(w.w); } }
            const float sc = isk ? 0.0625f : 1.f; u32x4 o; o.x = cvt_pk_bf16(silu(a[0]) * sc, silu(a[1]) * sc); o.y = cvt_pk_bf16(silu(a[2]) * sc, silu(a[3]) * sc); o.z = cvt_pk_bf16(silu(a[4]) * sc, silu(a[5]) * sc); o.w = cvt_pk_bf16(silu(a[6]) * sc, silu(a[7]) * sc);
            *(LAS u32x4*)((isk ? ks : qs) + s * 256 + c8 * 8) = o; }
        for (int i = tid; i < 64 * 64; i += 512) { const int s = i >> 6, c = i & 63; vs[i] = bf2f(U[(rbase + ch * 64 + s) * NU + UMV + h * 256 + sl * 64 + c]); }
        if (tid < 64) { gi[tid] = gif[(tbase + ch * 64 + tid) * 8 + h]; gf[tid] = gif[(tbase + ch * 64 + tid) * 8 + 4 + h]; }
        __syncthreads();
        for (int s = 0; s < 64; ++s) {
            const float ip = gi[s], fp = gf[s];
            const float fl = fminf(fp, 0.f) - log1pf(expf(-fabsf(fp)));
            const float mm = fmaxf(fl + mst, ip), fg = expf(fl + mst - mm), ig = expf(ip - mm); mst = mm;
            const float vv = vs[s * 64 + v] * ig;
            const LAS u32x4* kp = (const LAS u32x4*)(ks + s * 256 + kc * 32); const LAS u32x4* qp = (const LAS u32x4*)(qs + s * 256 + kc * 32);
            float num = 0.f, den = 0.f;
#pragma unroll
            for (int c4 = 0; c4 < 4; ++c4) { const u32x4 kw = kp[c4], qw = qp[c4];
#pragma unroll
                for (int e = 0; e < 4; ++e) { const float k0 = bf_lo(kw[e]), k1 = bf_hi(kw[e]), q0 = bf_lo(qw[e]), q1 = bf_hi(qw[e]); const int kk = c4 * 8 + 2 * e;
                    C[kk] = fg * C[kk] + vv * k0; nn[kk] = fg * nn[kk] + ig * k0; num += C[kk] * q0; den += nn[kk] * q0;
                    C[kk + 1] = fg * C[kk + 1] + vv * k1; nn[kk + 1] = fg * nn[kk + 1] + ig * k1; num += C[kk + 1] * q1; den += nn[kk + 1] * q1; } }
            num += __shfl_xor(num, 1); num += __shfl_xor(num, 2); num += __shfl_xor(num, 4);
            den += __shfl_xor(den, 1); den += __shfl_xor(den, 2); den += __shfl_xor(den, 4);
            if (kc == 0) HT[(rbase + ch * 64 + s) * 1024 + h * 256 + sl * 64 + v] = num / fmaxf(fabsf(den), expf(-mst));
        }
    }
    __syncthreads();
}

typedef float f32x16 __attribute__((ext_vector_type(16)));
typedef __bf16 bf16x2_t __attribute__((ext_vector_type(2)));
typedef short s16x4 __attribute__((ext_vector_type(4)));
constexpr float LOG2E = 1.4426950408889634f;
DI unsigned pk_bf16(float a, float b) { const f32x2 v = {a, b}; return __builtin_bit_cast(unsigned, __builtin_convertvector(v, bf16x2_t)); }
DI int crow(int reg, int hh) { return (reg & 3) + 8 * (reg >> 2) + 4 * hh; }
#define MFMA32(a, b, c) __builtin_amdgcn_mfma_f32_32x32x16_bf16((a), (b), (c), 0, 0, 0)
DI bf16x8 tr_pair(const LAS unsigned char* a0, const LAS unsigned char* a1) {
    const s16x4 lo = __builtin_amdgcn_ds_read_tr16_b64_v4i16((LAS s16x4*)a0), hi = __builtin_amdgcn_ds_read_tr16_b64_v4i16((LAS s16x4*)a1);
    return __builtin_shufflevector(lo, hi, 0, 1, 2, 3, 4, 5, 6, 7);
}
DI bf16x8 pack_half(const f32x16& x, int s2) {
    u32x4 w;
#pragma unroll
    for (int k = 0; k < 4; ++k) w[k] = pk_bf16(x[8 * s2 + 2 * k], x[8 * s2 + 2 * k + 1]);
    return __builtin_bit_cast(bf16x8, w);
}
DI int next_item(unsigned* ctr, LAS unsigned char* lds) {
    volatile LAS int* slot = (volatile LAS int*)(lds + LDS_MISC + 64);
    __syncthreads();
    if (threadIdx.x == 0) *slot = (int)__hip_atomic_fetch_add(ctr, 1u, __ATOMIC_RELAXED, __HIP_MEMORY_SCOPE_AGENT);
    __syncthreads();
    return *slot;
}

constexpr int AT_KPITCH = 144, AT_VPITCH = 320, AT_KBYTES = 64 * AT_KPITCH, AT_VOFF = 2 * AT_KBYTES, AT_BUF = AT_VOFF + 64 * AT_VPITCH, AT_BT = 2 * AT_BUF;
DI void attn_mfma_item(PP pk_, int item, LAS unsigned char* lds) { const P p = load_args(pk_);
    const int tid = tid_local(), lane = tid & 63, wave = __builtin_amdgcn_readfirstlane(tid >> 6), mp = wave & 1, rq = wave >> 1, hh = lane >> 5, r = lane & 31;
    const int qb = item & 15, h = (item >> 4) & 7, b = item >> 7;
    const int q0 = qb * 128, qw = q0 + rq * 32, nt = 2 * qb + 2;
    const bf16_t* U = WSP(bf16_t, WS_U); const size_t rbase = (size_t)b * SEQ;
    LAS float* bt = (LAS float*)(lds + AT_BT);
    __syncthreads();
    if (tid <= 128) bt[tid] = p.rel_bias[t5_bucket(tid) * 8 + h] * LOG2E;
    bf16x8 qf[4];
    { const bf16_t* qp = U + (rbase + qw + r) * NU + UQ + h * 128 + mp * 64 + 8 * hh;
#pragma unroll
      for (int s = 0; s < 4; ++s) qf[s] = *(const bf16x8*)(qp + 16 * s); }
    f32x16 O[4];
#pragma unroll
    for (int dt = 0; dt < 4; ++dt)
#pragma unroll
        for (int i = 0; i < 16; ++i) O[dt][i] = 0.f;
    float mrun = -INFINITY, lrun = 0.f;
    const int row0 = tid >> 4, c16 = tid & 15;
    const bf16_t* gk = U + (rbase + row0) * NU + UK + h * 128 + c16 * 8;
    const bf16_t* gv = U + (rbase + row0) * NU + UV + h * 128 + c16 * 8;
    const unsigned lk = (c16 >> 3) * AT_KBYTES + row0 * AT_KPITCH + (c16 & 7) * 16, lv = AT_VOFF + row0 * AT_VPITCH + c16 * 16;
    u32x4 st[4];
#define AT_LOAD(t_) do { const size_t o_ = (size_t)(t_) * 64 * NU; st[0] = *(const u32x4*)(gk + o_); st[1] = *(const u32x4*)(gk + o_ + (size_t)32 * NU); st[2] = *(const u32x4*)(gv + o_); st[3] = *(const u32x4*)(gv + o_ + (size_t)32 * NU); } while (0)
#define AT_STORE(bufp) do { *(LAS u32x4*)((bufp) + lk) = st[0]; *(LAS u32x4*)((bufp) + lk + 32 * AT_KPITCH) = st[1]; *(LAS u32x4*)((bufp) + lv) = st[2]; *(LAS u32x4*)((bufp) + lv + 32 * AT_VPITCH) = st[3]; } while (0)
    AT_LOAD(0); AT_STORE(lds); __syncthreads();
    const float cfar = bt[128];
    const unsigned ka = mp * AT_KBYTES + r * AT_KPITCH + hh * 16;
    const int i16 = lane & 15;
    const unsigned va = AT_VOFF + (4 * hh + (i16 >> 2)) * AT_VPITCH + (16 * ((lane >> 4) & 1) + 4 * (i16 & 3)) * 2;
    for (int t = 0; t < nt; ++t) {
        const int k0 = t * 64; LAS unsigned char* buf = lds + (t & 1) * AT_BUF;
        if (t + 1 < nt) AT_LOAD(t + 1);
        if (k0 <= qw + 31) {
            const bool far = (qw - k0 - 63) >= 128;
            f32x16 S[2];
#pragma unroll
            for (int sub = 0; sub < 2; ++sub)
#pragma unroll
                for (int i = 0; i < 16; ++i) S[sub][i] = far ? cfar : 0.f;
#pragma unroll
            for (int sub = 0; sub < 2; ++sub)
#pragma unroll
                for (int s = 0; s < 4; ++s) S[sub] = MFMA32(*(const LAS bf16x8*)(buf + ka + sub * 32 * AT_KPITCH + s * 32), qf[s], S[sub]);
            if (!far) {
#pragma unroll
                for (int sub = 0; sub < 2; ++sub)
#pragma unroll
                    for (int i = 0; i < 16; ++i) { const int dist = (qw + r) - (k0 + sub * 32 + crow(i, hh)); S[sub][i] = dist < 0 ? -INFINITY : S[sub][i] + bt[min(dist, 128)]; }
            }
            float mx = fmaxf(S[0][0], S[1][0]);
#pragma unroll
            for (int i = 1; i < 16; ++i) mx = fmaxf(mx, fmaxf(S[0][i], S[1][i]));
            mx = fmaxf(mx, __shfl_xor(mx, 32));
            const float mnew = fmaxf(mrun, mx), alpha = __builtin_amdgcn_exp2f(mrun - mnew); mrun = mnew; lrun *= alpha;
#pragma unroll
            for (int dt = 0; dt < 4; ++dt) O[dt] *= alpha;
#pragma unroll
            for (int sub = 0; sub < 2; ++sub)
#pragma unroll
                for (int i = 0; i < 16; ++i) { S[sub][i] = __builtin_amdgcn_exp2f(S[sub][i] - mnew); lrun += S[sub][i]; }
#pragma unroll
            for (int sub = 0; sub < 2; ++sub)
#pragma unroll
                for (int s2 = 0; s2 < 2; ++s2) { const bf16x8 pb = pack_half(S[sub], s2); const LAS unsigned char* vb = buf + va + (sub * 32 + 16 * s2) * AT_VPITCH;
#pragma unroll
                    for (int dt = 0; dt < 4; ++dt) O[dt] = MFMA32(tr_pair(vb + dt * 64, vb + dt * 64 + 8 * AT_VPITCH), pb, O[dt]); }
        }
        if (t + 1 < nt) AT_STORE(lds + ((t + 1) & 1) * AT_BUF);
        __syncthreads();
    }
#undef AT_LOAD
#undef AT_STORE
    const float inv = 1.f / (lrun + __shfl_xor(lrun, 32));
    LAS float* X = (LAS float*)lds;
    if (mp == 1) {
#pragma unroll
        for (int dt = 0; dt < 4; ++dt)
#pragma unroll
            for (int i = 0; i < 16; ++i) X[(rq * 64 + dt * 16 + i) * 64 + lane] = O[dt][i] * inv;
    }
    __syncthreads();
    if (mp == 0) {
        const float lam = *WSP(float, WS_MISC + MS_LAM); float ss = 0.f;
#pragma unroll
        for (int dt = 0; dt < 4; ++dt)
#pragma unroll
            for (int i = 0; i < 16; ++i) { const float v = O[dt][i] * inv - lam * X[(rq * 64 + dt * 16 + i) * 64 + lane]; O[dt][i] = v; ss += v * v; }
        ss += __shfl_xor(ss, 32);
        const float rs = rsqrtf(ss * (1.f / 128.f) + LN_EPS) * 0.8f;
        bf16_t* yp = WSP(bf16_t, WS_Y) + (rbase + qw + r) * 3072 + h * 128;
#pragma unroll
        for (int dt = 0; dt < 4; ++dt)
#pragma unroll
            for (int g4 = 0; g4 < 4; ++g4) { const int dv = dt * 32 + 8 * g4 + 4 * hh; const f32x4 gn = *(const f32x4*)(p.subln_g + dv);
                u32x2 w; w.x = pk_bf16(O[dt][4 * g4] * rs * gn[0], O[dt][4 * g4 + 1] * rs * gn[1]); w.y = pk_bf16(O[dt][4 * g4 + 2] * rs * gn[2], O[dt][4 * g4 + 3] * rs * gn[3]);
                *(u32x2*)(yp + dv) = w; }
    }
}
DI void ph_conv(PP pk_, int g, LAS unsigned char* lds) { const P p = load_args(pk_);
    const int tid = tid_local();
    const bf16_t* U = WSP(bf16_t, WS_U); bf16_t* QKC = WSP(bf16_t, WS_QKC);
    for (int t = blockIdx.x * 512 + tid; t < (TG / 32) * 256; t += gridDim.x * 512) {
        const int c8 = t & 255, r0 = (t >> 8) * 32, isk = c8 >> 7; const float sc = isk ? 0.0625f : 1.f;
        f32x4 cw[4][2];
#pragma unroll
        for (int j = 0; j < 4; ++j) { cw[j][0] = *(const f32x4*)(p.conv_w + j * 2048 + c8 * 8); cw[j][1] = *(const f32x4*)(p.conv_w + j * 2048 + c8 * 8 + 4); }
        const bf16_t* src = U + (size_t)r0 * NU + UMQ + c8 * 8; bf16_t* dst = QKC + (size_t)r0 * 2048 + c8 * 8;
        const bool head = (r0 & (SEQ - 1)) == 0;
        u32x4 x0 = {0u, 0u, 0u, 0u}, x1 = x0, x2 = x0, x3;
        if (!head) { x0 = *(const u32x4*)(src - 3 * (size_t)NU); x1 = *(const u32x4*)(src - 2 * (size_t)NU); x2 = *(const u32x4*)(src - (size_t)NU); }
#define CONV_OUT(a_, b_, c_, d_, row_) do { float o_[8]; \
        o_[0] = cw[0][0][0] * bf_lo(a_.x) + cw[1][0][0] * bf_lo(b_.x) + cw[2][0][0] * bf_lo(c_.x) + cw[3][0][0] * bf_lo(d_.x); \
        o_[1] = cw[0][0][1] * bf_hi(a_.x) + cw[1][0][1] * bf_hi(b_.x) + cw[2][0][1] * bf_hi(c_.x) + cw[3][0][1] * bf_hi(d_.x); \
        o_[2] = cw[0][0][2] * bf_lo(a_.y) + cw[1][0][2] * bf_lo(b_.y) + cw[2][0][2] * bf_lo(c_.y) + cw[3][0][2] * bf_lo(d_.y); \
        o_[3] = cw[0][0][3] * bf_hi(a_.y) + cw[1][0][3] * bf_hi(b_.y) + cw[2][0][3] * bf_hi(c_.y) + cw[3][0][3] * bf_hi(d_.y); \
        o_[4] = cw[0][1][0] * bf_lo(a_.z) + cw[1][1][0] * bf_lo(b_.z) + cw[2][1][0] * bf_lo(c_.z) + cw[3][1][0] * bf_lo(d_.z); \
        o_[5] = cw[0][1][1] * bf_hi(a_.z) + cw[1][1][1] * bf_hi(b_.z) + cw[2][1][1] * bf_hi(c_.z) + cw[3][1][1] * bf_hi(d_.z); \
        o_[6] = cw[0][1][2] * bf_lo(a_.w) + cw[1][1][2] * bf_lo(b_.w) + cw[2][1][2] * bf_lo(c_.w) + cw[3][1][2] * bf_lo(d_.w); \
        o_[7] = cw[0][1][3] * bf_hi(a_.w) + cw[1][1][3] * bf_hi(b_.w) + cw[2][1][3] * bf_hi(c_.w) + cw[3][1][3] * bf_hi(d_.w); \
        u32x4 w_; w_.x = pk_bf16(silu(o_[0]) * sc, silu(o_[1]) * sc); w_.y = pk_bf16(silu(o_[2]) * sc, silu(o_[3]) * sc); w_.z = pk_bf16(silu(o_[4]) * sc, silu(o_[5]) * sc); w_.w = pk_bf16(silu(o_[6]) * sc, silu(o_[7]) * sc); \
        *(u32x4*)(dst + (size_t)(row_) * 2048) = w_; } while (0)
#pragma unroll 1
        for (int i = 0; i < 32; i += 4) {
            const u32x4 y0 = *(const u32x4*)(src + (size_t)(i) * NU), y1 = *(const u32x4*)(src + (size_t)(i + 1) * NU), y2 = *(const u32x4*)(src + (size_t)(i + 2) * NU), y3 = *(const u32x4*)(src + (size_t)(i + 3) * NU);
            x3 = y0; CONV_OUT(x0, x1, x2, x3, i);
            CONV_OUT(x1, x2, y0, y1, i + 1);
            CONV_OUT(x2, y0, y1, y2, i + 2);
            CONV_OUT(y0, y1, y2, y3, i + 3);
            x0 = y1; x1 = y2; x2 = y3;
        }
#undef CONV_OUT
    }
}
constexpr int ML_QP = 528, ML_KP = 576, ML_VP = 576, ML_WP = 144;
constexpr int ML_Q = 0, ML_K = ML_Q + 64 * ML_QP, ML_V = ML_K + 64 * ML_KP, ML_W = ML_V + 64 * ML_VP, ML_TAB = ML_W + 64 * ML_WP;
constexpr int T_BCUM = 0, T_A = 256, T_MROW = 512, T_IW = 768, T_WS = 1024, T_RS = 1280, T_ND = 2304, T_GI = 2560, T_GF = 2816, T_N = 3072, T_SC = 4096, T_INVD = 4352;
static_assert(ML_TAB + 4608 <= LDS_RING, "mLSTM LDS map");
DI void mlstm_mfma_item(PP pk_, int g, int item, LAS unsigned char* lds) { const P p = load_args(pk_);
    const int tid0 = tid_local(), w = __builtin_amdgcn_readfirstlane(tid0 >> 6);
    const int h = item & 3, b = item >> 2;
    const bf16_t* U = WSP(bf16_t, WS_U); const float* gif = WSP(float, WS_GIF); bf16_t* Y = WSP(bf16_t, WS_Y);
    const size_t rbase = (size_t)b * SEQ, tbase = ((size_t)g * BG + b) * SEQ;
    LAS unsigned char* TB = lds + ML_TAB;
#define TABF(off) ((LAS float*)(TB + (off)))
    f32x16 C[8];
#pragma unroll
    for (int kt = 0; kt < 8; ++kt)
#pragma unroll
        for (int i = 0; i < 16; ++i) C[kt][i] = 0.f;
    float mst = 0.f;
    __syncthreads();
    if (tid0 < 256) TABF(T_N)[tid0] = 0.f;
    const bf16_t* QKC = WSP(bf16_t, WS_QKC);
    u32x4 pf[4];
#define ML_PREFETCH(ch_, tv_) do { _Pragma("unroll") for (int i_ = 0; i_ < 4; ++i_) { const int pc_ = (tv_) + 512 * i_, s_ = pc_ >> 5, cc_ = pc_ & 31; const size_t row_ = rbase + (ch_) * 64 + s_; \
        pf[i_] = *(const u32x4*)(QKC + row_ * 2048 + h * 256 + cc_ * 8); } \
        } while (0)
    ML_PREFETCH(0, tid0);
    for (int ch = 0; ch < SEQ / 64; ++ch) {
        int tid = tid0; asm volatile("" : "+v"(tid));
        const int lane = tid & 63, hh = lane >> 5, r = lane & 31, i16 = lane & 15, l4 = lane >> 4;
        __syncthreads();
        {
#pragma unroll
            for (int i = 0; i < 4; ++i) { const int pc = tid + 512 * i, s = pc >> 5, cc = pc & 31;
                *(LAS u32x4*)(lds + ML_Q + s * ML_QP + cc * 16) = pf[i];
                *(LAS u32x4*)(lds + ML_K + s * ML_KP + cc * 16) = *(const u32x4*)(QKC + (rbase + ch * 64 + s) * 2048 + 1024 + h * 256 + cc * 8); }
            if (tid < 64) { TABF(T_GI)[tid] = gif[(tbase + ch * 64 + tid) * 8 + h]; TABF(T_GF)[tid] = gif[(tbase + ch * 64 + tid) * 8 + 4 + h]; }
        }
        u32x4 vf[4];
#pragma unroll
        for (int i = 0; i < 4; ++i) { const int pc = tid + 512 * i, s = pc >> 5, cc = pc & 31; vf[i] = *(const u32x4*)(U + (rbase + ch * 64 + s) * NU + UMV + h * 256 + cc * 8); }
        __syncthreads();
        if (w == 0) {
            const float ip = TABF(T_GI)[lane], fp = TABF(T_GF)[lane];
            float bc = fminf(fp, 0.f) - log1pf(expf(-fabsf(fp)));
#pragma unroll
            for (int o = 1; o < 64; o <<= 1) { const float t = __shfl_up(bc, o); if (lane >= o) bc += t; }
            const float aa = ip - bc; float pm = aa;
#pragma unroll
            for (int o = 1; o < 64; o <<= 1) { const float t = __shfl_up(pm, o); if (lane >= o) pm = fmaxf(pm, t); }
            const float mrow = bc + fmaxf(mst, pm), iw = expf(bc + mst - mrow);
            const float total = __shfl(bc, 63), amax = __shfl(pm, 63), mnew = total + fmaxf(mst, amax), decay = expf(total + mst - mnew), ws = expf(total + aa - mnew);
            TABF(T_BCUM)[lane] = bc; TABF(T_A)[lane] = aa; TABF(T_MROW)[lane] = mrow; TABF(T_IW)[lane] = iw; TABF(T_WS)[lane] = ws;
            if (lane == 0) TABF(T_SC)[1] = decay;
            mst = mnew;
        }
        f32x4 S2[2];
#pragma unroll
        for (int tt = 0; tt < 2; ++tt) { const int tile = 2 * w + tt, jt = tile >> 2, st = tile & 3; f32x4 s = {0.f, 0.f, 0.f, 0.f};
            const LAS unsigned char* qa = lds + ML_Q + (jt * 16 + i16) * ML_QP + l4 * 16; const LAS unsigned char* ka = lds + ML_K + (st * 16 + i16) * ML_KP + l4 * 16;
#pragma unroll
            for (int c = 0; c < 8; ++c) s = __builtin_amdgcn_mfma_f32_16x16x32_bf16(*(const LAS bf16x8*)(qa + c * 64), *(const LAS bf16x8*)(ka + c * 64), s, 0, 0, 0);
            S2[tt] = s; }
        { const f32x4 nv = *(const LAS f32x4*)(TABF(T_N) + 4 * lane);
#pragma unroll
          for (int jj = 0; jj < 8; ++jj) { const int j = 8 * w + jj; const u32x2 qw = *(const LAS u32x2*)(lds + ML_Q + j * ML_QP + lane * 8);
              const float d = wave_sum(bf_lo(qw.x) * nv[0] + bf_hi(qw.x) * nv[1] + bf_lo(qw.y) * nv[2] + bf_hi(qw.y) * nv[3]); if (lane == 0) TABF(T_ND)[j] = d; } }
#pragma unroll
        for (int i = 0; i < 4; ++i) { const int pc = tid + 512 * i, s = pc >> 5, cc = pc & 31; *(LAS u32x4*)(lds + ML_V + s * ML_VP + cc * 16) = vf[i]; }
        __syncthreads();
#pragma unroll
        for (int tt = 0; tt < 2; ++tt) { const int tile = 2 * w + tt, jt = tile >> 2, st = tile & 3, s = st * 16 + i16; const float as = TABF(T_A)[s];
#pragma unroll
            for (int rg = 0; rg < 4; ++rg) { const int j = jt * 16 + l4 * 4 + rg;
                float val = s <= j ? __expf(TABF(T_BCUM)[j] + as - TABF(T_MROW)[j]) * S2[tt][rg] : 0.f;
                *(LAS bf16_t*)(lds + ML_W + j * ML_WP + s * 2) = (bf16_t)(pk_bf16(val, 0.f) & 0xffffu);
                val += __shfl_xor(val, 1); val += __shfl_xor(val, 2); val += __shfl_xor(val, 4); val += __shfl_xor(val, 8);
                if (i16 == 0) TABF(T_RS)[j * 4 + st] = val; } }
        __syncthreads();
        if (tid < 64) { const int j = tid; const f32x4 rs = *(const LAS f32x4*)(TABF(T_RS) + 4 * j);
            const float den = TABF(T_IW)[j] * TABF(T_ND)[j] + ((rs[0] + rs[1]) + (rs[2] + rs[3]));
            TABF(T_INVD)[j] = 1.f / fmaxf(fabsf(den), expf(-TABF(T_MROW)[j])); }
        f32x16 acc[2];
#pragma unroll
        for (int jt2 = 0; jt2 < 2; ++jt2)
#pragma unroll
            for (int i = 0; i < 16; ++i) acc[jt2][i] = 0.f;
#pragma unroll
        for (int kt = 0; kt < 8; ++kt) { __builtin_amdgcn_sched_barrier(0);
#pragma unroll
            for (int s = 0; s < 2; ++s) { const bf16x8 bfr = pack_half(C[kt], s);
#pragma unroll
                for (int jt2 = 0; jt2 < 2; ++jt2) { const LAS unsigned char* qa = lds + ML_Q + (jt2 * 32 + r) * ML_QP + (kt * 32 + 16 * s + 4 * hh) * 2;
                    const s16x4 lo = *(const LAS s16x4*)qa, hi = *(const LAS s16x4*)(qa + 16);
                    acc[jt2] = MFMA32(__builtin_shufflevector(lo, hi, 0, 1, 2, 3, 4, 5, 6, 7), bfr, acc[jt2]); } } }
        __builtin_amdgcn_sched_barrier(0);
#pragma unroll
        for (int jt2 = 0; jt2 < 2; ++jt2)
#pragma unroll
            for (int i = 0; i < 16; ++i) acc[jt2][i] *= TABF(T_IW)[jt2 * 32 + crow(i, hh)];
        const unsigned vtr = ML_V + (8 * hh + (i16 >> 2)) * ML_VP + (32 * w + 16 * (l4 & 1) + 4 * (i16 & 3)) * 2;
#pragma unroll
        for (int ks = 0; ks < 4; ++ks) { const bf16x8 bv = tr_pair(lds + vtr + 16 * ks * ML_VP, lds + vtr + (16 * ks + 4) * ML_VP);
#pragma unroll
            for (int jt2 = 0; jt2 < 2; ++jt2) acc[jt2] = MFMA32(*(const LAS bf16x8*)(lds + ML_W + (jt2 * 32 + r) * ML_WP + (16 * ks + 8 * hh) * 2), bv, acc[jt2]); }
        __syncthreads();
#pragma unroll
        for (int jt2 = 0; jt2 < 2; ++jt2)
#pragma unroll
            for (int i = 0; i < 16; ++i) { const int j = jt2 * 32 + crow(i, hh); *(LAS bf16_t*)(lds + ML_Q + j * 512 + (32 * w + r) * 2) = (bf16_t)(pk_bf16(acc[jt2][i] * TABF(T_INVD)[j], 0.f) & 0xffffu); }
        const float decay = TABF(T_SC)[1];
        if (tid < 256) { float nn = TABF(T_N)[tid] * decay;
#pragma unroll 8
            for (int s = 0; s < 64; ++s) nn += TABF(T_WS)[s] * bf2f(*(const LAS bf16_t*)(lds + ML_K + s * ML_KP + tid * 2));
            TABF(T_N)[tid] = nn; }
#pragma unroll
        for (int kt = 0; kt < 8; ++kt) C[kt] *= decay;
        const unsigned ktr = ML_K + (8 * hh + (i16 >> 2)) * ML_KP + (16 * (l4 & 1) + 4 * (i16 & 3)) * 2;
#pragma unroll
        for (int ks = 0; ks < 4; ++ks) { __builtin_amdgcn_sched_barrier(0); const bf16x8 bv = tr_pair(lds + vtr + 16 * ks * ML_VP, lds + vtr + (16 * ks + 4) * ML_VP);
            const u32x4 bw = __builtin_bit_cast(u32x4, bv); const f32x4 w0 = *(const LAS f32x4*)(TABF(T_WS) + 16 * ks + 8 * hh), w1 = *(const LAS f32x4*)(TABF(T_WS) + 16 * ks + 8 * hh + 4);
            u32x4 sw; sw.x = pk_bf16(bf_lo(bw.x) * w0[0], bf_hi(bw.x) * w0[1]); sw.y = pk_bf16(bf_lo(bw.y) * w0[2], bf_hi(bw.y) * w0[3]); sw.z = pk_bf16(bf_lo(bw.z) * w1[0], bf_hi(bw.z) * w1[1]); sw.w = pk_bf16(bf_lo(bw.w) * w1[2], bf_hi(bw.w) * w1[3]);
            const bf16x8 bs = __builtin_bit_cast(bf16x8, sw);
#pragma unroll
            for (int kt = 0; kt < 8; ++kt) C[kt] = MFMA32(tr_pair(lds + ktr + 16 * ks * ML_KP + kt * 64, lds + ktr + (16 * ks + 4) * ML_KP + kt * 64), bs, C[kt]); }
        __syncthreads();
        if (ch + 1 < SEQ / 64) ML_PREFETCH(ch + 1, tid);
#pragma unroll 1
        for (int jj = 0; jj < 8; ++jj) { const int j = 8 * w + jj; const u32x2 hw = *(const LAS u32x2*)(lds + ML_Q + j * 512 + lane * 8);
            const f32x4 v = {bf_lo(hw.x), bf_hi(hw.x), bf_lo(hw.y), bf_hi(hw.y)};
            const float mu = wave_sum((v[0] + v[1]) + (v[2] + v[3])) * (1.f / 256.f); const f32x4 d = v - mu;
            const float rstd = rsqrtf(wave_sum((d[0] * d[0] + d[1] * d[1]) + (d[2] * d[2] + d[3] * d[3])) * (1.f / 256.f) + LN_EPS);
            const size_t row = rbase + ch * 64 + j;
            const f32x4 gn = *((const f32x4*)(p.mlstm_norm_g + h * 256) + lane);
            const u32x2 ow = *((const u32x2*)(U + row * NU + UMO + h * 256) + lane);
            u32x2 o; o.x = pk_bf16(d[0] * rstd * gn[0] * sigm(bf_lo(ow.x)), d[1] * rstd * gn[1] * sigm(bf_hi(ow.x))); o.y = pk_bf16(d[2] * rstd * gn[2] * sigm(bf_lo(ow.y)), d[3] * rstd * gn[3] * sigm(bf_hi(ow.y)));
            *((u32x2*)(Y + row * 3072 + 1024 + h * 256) + lane) = o; }
    }
#undef TABF
#undef ML_PREFETCH
}
constexpr int XA_KP = 528, XA_VP = 576, XA_VOFF = 32 * XA_KP, XA_BUF = XA_VOFF + 32 * XA_VP;
static_assert(2 * XA_BUF <= LDS_RING, "xattn LDS map");
DI void xattn_mfma_item(PP pk_, int g, int item, LAS unsigned char* lds) { const P p = load_args(pk_);
    const int tid = tid_local(), lane = tid & 63, wave = __builtin_amdgcn_readfirstlane(tid >> 6), dvh = wave & 1, rq = wave >> 1, hh = lane >> 5, r = lane & 31;
    const int qb = item & 15, h = (item >> 4) & 3, b = item >> 6;
    const bf16_t* U = WSP(bf16_t, WS_U); const bf16_t* KV = WSP(bf16_t, WS_KVM) + (size_t)(g * BG + b) * 256 * 2048 + h * 256;
    const size_t qrow = (size_t)b * SEQ + qb * 128 + rq * 32 + r;
    bf16x8 qf[16];
    { const bf16_t* qp = U + qrow * NU + UCQ + h * 256 + 8 * hh;
#pragma unroll
      for (int s = 0; s < 16; ++s) qf[s] = *(const bf16x8*)(qp + 16 * s); }
    f32x16 O[4];
#pragma unroll
    for (int dt = 0; dt < 4; ++dt)
#pragma unroll
        for (int i = 0; i < 16; ++i) O[dt][i] = 0.f;
    float mrun = -INFINITY, lrun = 0.f;
    const int row0 = tid >> 5, c32 = tid & 31;
    const bf16_t* gk = KV + (size_t)row0 * 2048 + c32 * 8;
    const unsigned lk = row0 * XA_KP + c32 * 16, lv = XA_VOFF + row0 * XA_VP + c32 * 16;
    u32x4 st[4];
#define XA_LOAD(t_) do { const bf16_t* s_ = gk + (size_t)(t_) * 32 * 2048; st[0] = *(const u32x4*)s_; st[1] = *(const u32x4*)(s_ + 16 * 2048); st[2] = *(const u32x4*)(s_ + 1024); st[3] = *(const u32x4*)(s_ + 16 * 2048 + 1024); } while (0)
#define XA_STORE(bufp) do { *(LAS u32x4*)((bufp) + lk) = st[0]; *(LAS u32x4*)((bufp) + lk + 16 * XA_KP) = st[1]; *(LAS u32x4*)((bufp) + lv) = st[2]; *(LAS u32x4*)((bufp) + lv + 16 * XA_VP) = st[3]; } while (0)
    __syncthreads();
    XA_LOAD(0); XA_STORE(lds); __syncthreads();
    const unsigned ka = r * XA_KP + hh * 16;
    const int i16 = lane & 15;
    const unsigned va = XA_VOFF + (4 * hh + (i16 >> 2)) * XA_VP + (dvh * 128 + 16 * ((lane >> 4) & 1) + 4 * (i16 & 3)) * 2;
#pragma unroll 1
    for (int t = 0; t < 8; ++t) {
        LAS unsigned char* buf = lds + (t & 1) * XA_BUF;
        if (t + 1 < 8) XA_LOAD(t + 1);
        f32x16 S;
#pragma unroll
        for (int i = 0; i < 16; ++i) S[i] = 0.f;
#pragma unroll
        for (int s = 0; s < 16; ++s) S = MFMA32(*(const LAS bf16x8*)(buf + ka + s * 32), qf[s], S);
        float mx = S[0];
#pragma unroll
        for (int i = 1; i < 16; ++i) mx = fmaxf(mx, S[i]);
        mx = fmaxf(mx, __shfl_xor(mx, 32));
        const float mnew = fmaxf(mrun, mx), alpha = __builtin_amdgcn_exp2f(mrun - mnew); mrun = mnew; lrun *= alpha;
#pragma unroll
        for (int dt = 0; dt < 4; ++dt) O[dt] *= alpha;
#pragma unroll
        for (int i = 0; i < 16; ++i) { S[i] = __builtin_amdgcn_exp2f(S[i] - mnew); lrun += S[i]; }
#pragma unroll
        for (int s2 = 0; s2 < 2; ++s2) { const bf16x8 pb = pack_half(S, s2); const LAS unsigned char* vb = buf + va + 16 * s2 * XA_VP;
#pragma unroll
            for (int dt = 0; dt < 4; ++dt) O[dt] = MFMA32(tr_pair(vb + dt * 64, vb + dt * 64 + 8 * XA_VP), pb, O[dt]); }
        if (t + 1 < 8) XA_STORE(lds + ((t + 1) & 1) * XA_BUF);
        __syncthreads();
    }
#undef XA_LOAD
#undef XA_STORE
    const float inv = 1.f / (lrun + __shfl_xor(lrun, 32));
    bf16_t* yp = WSP(bf16_t, WS_Y) + qrow * 3072 + 2048 + h * 256 + dvh * 128;
#pragma unroll
    for (int dt = 0; dt < 4; ++dt)
#pragma unroll
        for (int g4 = 0; g4 < 4; ++g4) { const int dv = dt * 32 + 8 * g4 + 4 * hh;
            u32x2 w; w.x = pk_bf16(O[dt][4 * g4] * inv, O[dt][4 * g4 + 1] * inv); w.y = pk_bf16(O[dt][4 * g4 + 2] * inv, O[dt][4 * g4 + 3] * inv);
            *(u32x2*)(yp + dv) = w; }
}
#ifndef ATTN_NAIVE
#define ATTN_NAIVE 0
#endif
#ifndef XATTN_NAIVE
#define XATTN_NAIVE 0
#endif
#ifndef MLSTM_NAIVE
#define MLSTM_NAIVE 0
#endif
DI void ph_mix(PP pk_, int g, int rep, LAS unsigned char* lds) { const P p = load_args(pk_);
    constexpr int N_ML = MLSTM_NAIVE ? BG * 4 * 4 : BG * 4, N_AT = ATTN_NAIVE ? BG * 8 * 32 : BG * 8 * 16, N_XA = XATTN_NAIVE ? BG * 4 * 64 : BG * 4 * 16;
    unsigned* ctr = WSP(unsigned, WS_CTL) + CW_Q + 64 * (g + NGRP * rep);
    for (;;) {
        const int it = next_item(ctr, lds);
        if (it >= N_ML + N_AT + N_XA) break;
        if (it < N_ML) { if (MLSTM_NAIVE) mlstm_naive_item(pk_, g, it, lds); else mlstm_mfma_item(pk_, g, it, lds); }
        else if (it < N_ML + N_AT) { const int ix = it - N_ML;
            if (ATTN_NAIVE) attn_naive_item(pk_, N_AT - 1 - ix, lds);
            else attn_mfma_item(pk_, ((ix & 63) << 4) | (15 - (ix >> 6)), lds); }
        else { if (XATTN_NAIVE) xattn_naive_item(pk_, g, it - N_ML - N_AT, lds); else xattn_mfma_item(pk_, g, it - N_ML - N_AT, lds); }
    }
}

DI void ph_mlstm_out(PP pk_, int g, LAS unsigned char* lds) { const P p = load_args(pk_);
    const int tid = tid_local(), lane = tid & 63, wave = tid >> 6, gw = blockIdx.x * 8 + wave, NGW = gridDim.x * 8;
    const float* HT = WSP(float, WS_F32); const bf16_t* U = WSP(bf16_t, WS_U); bf16_t* Y = WSP(bf16_t, WS_Y);
    for (int it = gw; it < TG * 4; it += NGW) { const int r = it >> 2, h = it & 3;
        const f32x4 v = *((const f32x4*)(HT + (size_t)r * 1024 + h * 256) + lane);
        const float mu = wave_sum((v[0] + v[1]) + (v[2] + v[3])) * (1.f / 256.f); const f32x4 d = v - mu;
        const float rstd = rsqrtf(wave_sum((d[0] * d[0] + d[1] * d[1]) + (d[2] * d[2] + d[3] * d[3])) * (1.f / 256.f) + LN_EPS);
        const f32x4 gn = *((const f32x4*)(p.mlstm_norm_g + h * 256) + lane);
        const u32x2 ow = *((const u32x2*)(U + (size_t)r * NU + UMO + h * 256) + lane);
        u32x2 o; o.x = cvt_pk_bf16(d[0] * rstd * gn[0] * sigm(bf_lo(ow.x)), d[1] * rstd * gn[1] * sigm(bf_hi(ow.x))); o.y = cvt_pk_bf16(d[2] * rstd * gn[2] * sigm(bf_lo(ow.y)), d[3] * rstd * gn[3] * sigm(bf_hi(ow.y)));
        *((u32x2*)(Y + (size_t)r * 3072 + 1024 + h * 256) + lane) = o; }
}

DI void ph_ln1(PP pk_, int g, LAS unsigned char* lds) { const P p = load_args(pk_);
    const int tid = tid_local(), lane = tid & 63, wave = tid >> 6, gw = blockIdx.x * 8 + wave, NGW = gridDim.x * 8;
    const float* Z = WSP(float, WS_Z); bf16_t* X1 = WSP(bf16_t, WS_X1B) + (size_t)g * TG * 1024;
    for (int r = gw; r < TG; r += NGW) {
        const f32x4* zr = (const f32x4*)(Z + (size_t)r * 1024) + lane; f32x4 v[4]; float s = 0.f;
#pragma unroll
        for (int j = 0; j < 4; ++j) { v[j] = zr[64 * j]; s += (v[j][0] + v[j][1]) + (v[j][2] + v[j][3]); }
        const float mu = wave_sum(s) * (1.f / 1024.f); float s2 = 0.f;
#pragma unroll
        for (int j = 0; j < 4; ++j) { v[j] = v[j] - mu; s2 += (v[j][0] * v[j][0] + v[j][1] * v[j][1]) + (v[j][2] * v[j][2] + v[j][3] * v[j][3]); }
        const float rstd = rsqrtf(wave_sum(s2) * (1.f / 1024.f) + LN_EPS);
        u32x2* d = (u32x2*)(X1 + (size_t)r * 1024) + lane;
#pragma unroll
        for (int j = 0; j < 4; ++j) { const f32x4 gn = *((const f32x4*)p.ln1_g + lane + 64 * j), bb = *((const f32x4*)p.ln1_b + lane + 64 * j); const f32x4 o = v[j] * rstd * gn + bb;
            u32x2 w; w.x = cvt_pk_bf16(o[0], o[1]); w.y = cvt_pk_bf16(o[2], o[3]); d[64 * j] = w; }
    }
}
DI void ph_expert_weights(PP pk_, LAS unsigned char* lds) { const P p = load_args(pk_);
    const int tid = tid_local(), lane = tid & 63, wave = tid >> 6, gw = blockIdx.x * 8 + wave, NGW = gridDim.x * 8;
    LAS float* scr = (LAS float*)(lds + wave * 16384);
    bf16_t* WGU = WSP(bf16_t, WS_WGU); bf16_t* WD = WSP(bf16_t, WS_WD);
    for (int it = gw; it < 257 * 256; it += NGW) { const int e = it >> 8, r = it & 255, isup = r >> 7, kb = (r >> 3) & 15, nb = r & 7;
        const float* W = (e < 256) ? ((isup ? p.w_e_up : p.w_e_gate) + (size_t)e * 1024 * 256) : (isup ? p.w_s_up : p.w_s_gate);
        const int n0 = nb * 32, drow = (n0 >> 7) * 256 + (n0 & 127) + isup * 128;
        transpose_item(W, 256, n0, WGU + (size_t)e * 512 * 1024, 1024, drow, kb * 64, scr, lane); }
    for (int it = gw; it < 257 * 128; it += NGW) { const int e = it >> 7, r = it & 127, kb = r >> 5, nb = r & 31;
        const float* W = (e < 256) ? (p.w_e_down + (size_t)e * 256 * 1024) : p.w_s_down;
        transpose_item(W, 1024, nb * 32, WD + (size_t)e * 1024 * 256, 256, nb * 32, kb * 64, scr, lane); }
}

DI void ph_topk(PP pk_, LAS unsigned char* lds) { const P p = load_args(pk_);
    const int tid = tid_local(), lane = tid & 63, wave = tid >> 6, gw = blockIdx.x * 8 + wave, NGW = gridDim.x * 8;
    const float* LG = WSP(float, WS_LOGIT); int* TKI = WSP(int, WS_TKI); float* TKW = WSP(float, WS_TKW); unsigned* cnt = WSP(unsigned, WS_CTL) + CW_CNT;
    int* tokof = WSP(int, WS_TOKOF); float* wof = WSP(float, WS_WOF);
    for (int i = blockIdx.x * 512 + tid; i < MAXRT * 256; i += gridDim.x * 512) { tokof[i] = 0; wof[i] = 0.f; }
    const f32x4 rb = *((const f32x4*)p.router_bias + lane);
    for (int t = gw; t < T_ALL; t += NGW) {
        const f32x4 lg = *((const f32x4*)(LG + (size_t)t * 256) + lane);
        float sc[4], ch[4];
#pragma unroll
        for (int j = 0; j < 4; ++j) { sc[j] = 1.f / (1.f + expf(-lg[j])); ch[j] = sc[j] + rb[j]; }
        const float m01 = fmaxf(ch[0], ch[1]), n01 = fminf(ch[0], ch[1]), m23 = fmaxf(ch[2], ch[3]), n23 = fminf(ch[2], ch[3]);
        float a1 = fmaxf(m01, m23), a2 = fmaxf(fminf(m01, m23), fmaxf(n01, n23));
#pragma unroll
        for (int o = 1; o < 8; o <<= 1) { const float b1 = __shfl_xor(a1, o), b2 = __shfl_xor(a2, o); const float n1 = fmaxf(a1, b1), n2 = fmaxf(fminf(a1, b1), fmaxf(a2, b2)); a1 = n1; a2 = n2; }
        const float gs = a1 + a2; const int myg = lane >> 3; int rank = 0;
#pragma unroll
        for (int g2 = 0; g2 < 8; ++g2) { const float og = __shfl(gs, 8 * g2); rank += (og > gs || (og == gs && g2 < myg)) ? 1 : 0; }
        if (rank >= 4) { ch[0] = -INFINITY; ch[1] = -INFINITY; ch[2] = -INFINITY; ch[3] = -INFINITY; }
        int myidx = 0; float mys = 0.f, ssum = 0.f;
#pragma unroll
        for (int r = 0; r < 8; ++r) {
            float bv = ch[0]; int bi = 4 * lane;
#pragma unroll
            for (int j = 1; j < 4; ++j) if (ch[j] > bv) { bv = ch[j]; bi = 4 * lane + j; }
#pragma unroll
            for (int o = 32; o >= 1; o >>= 1) { const float ov = __shfl_xor(bv, o); const int oi = __shfl_xor(bi, o); if (ov > bv || (ov == bv && oi < bi)) { bv = ov; bi = oi; } }
            const int jl = bi & 3; const float scsel = jl == 0 ? sc[0] : (jl == 1 ? sc[1] : (jl == 2 ? sc[2] : sc[3]));
            const float sv = __shfl(scsel, bi >> 2);
            if ((bi >> 2) == lane) { if (jl == 0) ch[0] = -INFINITY; else if (jl == 1) ch[1] = -INFINITY; else if (jl == 2) ch[2] = -INFINITY; else ch[3] = -INFINITY; }
            ssum += sv; if (lane == r) { myidx = bi; mys = sv; }
        }
        if (lane < 8) { TKI[(size_t)t * 8 + lane] = myidx; TKW[(size_t)t * 8 + lane] = mys / (ssum + 1e-20f) * 2.5f; atomicAdd(cnt + myidx, 1u); }
    }
}

DI void ph_scan(PP pk_, LAS unsigned char* lds) { const P p = load_args(pk_);
    if (blockIdx.x != 0) return;
    const int tid = tid_local();
    const unsigned* cnt = WSP(unsigned, WS_CTL) + CW_CNT; int* tbase = WSP(int, WS_MISC + MS_TBASE); int* nt = WSP(int, WS_MISC + MS_NT); int* tile_e = WSP(int, WS_MISC + MS_TILEE);
    LAS int* sb = (LAS int*)lds;
    if (tid < 256) sb[tid] = (int)((cnt[tid] + 255u) >> 8);
    __syncthreads();
    if (tid == 0) { int a = 0; for (int e = 0; e < 256; ++e) { const int n = sb[e]; sb[e] = a; a += n; } sb[256] = a; }
    __syncthreads();
    const int nrt = sb[256];
    if (tid < 256) { const int b0 = sb[tid], b1 = sb[tid + 1]; tbase[tid] = b0; for (int t = b0; t < b1; ++t) tile_e[t] = tid; tile_e[nrt + tid] = 256; }
    if (tid == 0) { tbase[256] = nrt; nt[0] = nrt; nt[1] = nrt + 256; }
    __syncthreads();
}

DI void ph_slots(PP pk_, LAS unsigned char* lds) { const P p = load_args(pk_);
    const int tid = tid_local();
    const int* TKI = WSP(int, WS_TKI); const float* TKW = WSP(float, WS_TKW); unsigned* cur = WSP(unsigned, WS_CTL) + CW_CUR; const int* tbase = WSP(int, WS_MISC + MS_TBASE);
    int* tokof = WSP(int, WS_TOKOF); float* wof = WSP(float, WS_WOF); int* slotof = WSP(int, WS_SLOTOF);
    const int s0 = tbase[256] * 256;
    for (int i = blockIdx.x * 512 + tid; i < T_ALL * 8; i += gridDim.x * 512) { const int e = TKI[i]; const int slot = tbase[e] * 256 + (int)atomicAdd(cur + e, 1u); tokof[slot] = i >> 3; wof[slot] = TKW[i]; slotof[i] = slot; }
    for (int t = blockIdx.x * 512 + tid; t < T_ALL; t += gridDim.x * 512) { tokof[s0 + t] = t; wof[s0 + t] = 1.f; }
}

DI void ph_combine(PP pk_, int round, LAS unsigned char* lds) { const P p = load_args(pk_);
    const int tid = tid_local();
    const bf16_t* Y = WSP(bf16_t, WS_YCH); const bf16_t* X1 = WSP(bf16_t, WS_X1B); const int* slotof = WSP(int, WS_SLOTOF); const int s0 = WSP(int, WS_MISC + MS_TBASE)[256] * 256;
    for (int i = blockIdx.x * 512 + tid; i < T_ALL * 32; i += gridDim.x * 512) { const int t = i >> 5, c8 = (i & 31) * 8;
        const u32x4 xw = *(const u32x4*)(X1 + (size_t)t * 1024 + round * 256 + c8);
        float a[8] = {bf_lo(xw.x) * ALPHA, bf_hi(xw.x) * ALPHA, bf_lo(xw.y) * ALPHA, bf_hi(xw.y) * ALPHA, bf_lo(xw.z) * ALPHA, bf_hi(xw.z) * ALPHA, bf_lo(xw.w) * ALPHA, bf_hi(xw.w) * ALPHA};
#pragma unroll
        for (int k = 0; k < 9; ++k) { const int slot = k < 8 ? slotof[(size_t)t * 8 + k] : s0 + t; const u32x4 w = *(const u32x4*)(Y + (size_t)slot * 256 + c8);
            a[0] += bf_lo(w.x); a[1] += bf_hi(w.x); a[2] += bf_lo(w.y); a[3] += bf_hi(w.y); a[4] += bf_lo(w.z); a[5] += bf_hi(w.z); a[6] += bf_lo(w.w); a[7] += bf_hi(w.w); }
        float* op = p.out + (size_t)t * 1024 + round * 256 + c8; *(f32x4*)op = (f32x4){a[0], a[1], a[2], a[3]}; *(f32x4*)(op + 4) = (f32x4){a[4], a[5], a[6], a[7]}; }
}

DI void ph_ln2(PP pk_, LAS unsigned char* lds) { const P p = load_args(pk_);
    const int tid = tid_local(), lane = tid & 63, wave = tid >> 6, gw = blockIdx.x * 8 + wave, NGW = gridDim.x * 8;
    for (int r = gw; r < T_ALL; r += NGW) {
        f32x4* zr = (f32x4*)(p.out + (size_t)r * 1024) + lane; f32x4 v[4]; float s = 0.f;
#pragma unroll
        for (int j = 0; j < 4; ++j) { v[j] = zr[64 * j]; s += (v[j][0] + v[j][1]) + (v[j][2] + v[j][3]); }
        const float mu = wave_sum(s) * (1.f / 1024.f); float s2 = 0.f;
#pragma unroll
        for (int j = 0; j < 4; ++j) { v[j] = v[j] - mu; s2 += (v[j][0] * v[j][0] + v[j][1] * v[j][1]) + (v[j][2] * v[j][2] + v[j][3] * v[j][3]); }
        const float rstd = rsqrtf(wave_sum(s2) * (1.f / 1024.f) + LN_EPS);
#pragma unroll
        for (int j = 0; j < 4; ++j) { const f32x4 gn = *((const f32x4*)p.ln2_g + lane + 64 * j), bb = *((const f32x4*)p.ln2_b + lane + 64 * j); zr[64 * j] = v[j] * rstd * gn + bb; }
    }
}

__global__ void __launch_bounds__(512, 2) fwd(P p_unused) {
    extern __shared__ __attribute__((aligned(16))) unsigned char lds_raw[];
    LAS unsigned char* lds = (LAS unsigned char*)lds_raw;
    const int tid = threadIdx.x, G = gridDim.x, bid = blockIdx.x;
    volatile LAS unsigned* MISC = (volatile LAS unsigned*)(lds + LDS_MISC);
    if (tid < 32) MISC[tid] = 0u;
    __syncthreads();
    const int lo = kargs()->s_lo, hi = kargs()->s_hi;
    XcdBarrier bar; { unsigned* bw = (unsigned*)(kargs()->ws + WS_CTL) + CW_BAR; bar.bar = bw; bar.x = 0; bar.st = nullptr; if (hi - lo > 1) bar = xcd_barrier_post(bw, MISC + 8); }
    int s = 0;
#ifndef PROBE_TYPE
#define PROBE_TYPE -1
#define PROBE_REPS 1
#endif
#define STEP_BEGIN(type) if (s >= lo && s < hi) { const int reps_ = ((type) == PROBE_TYPE) ? PROBE_REPS : 1; for (int rep_ = 0; rep_ < reps_; ++rep_) { PP pk_ = kargs(); const P p = load_args(pk_);
#define STEP_END if (s + 1 < hi || rep_ + 1 < reps_) xcd_barrier(bar); } } ++s;

    STEP_BEGIN(0) ph_prologue(pk_, lds); STEP_END
    for (int g = 0; g < NGRP; ++g) {
        STEP_BEGIN(1) ph_xconv(pk_, g, lds); STEP_END
        STEP_BEGIN(2) {
            pg8::Gemm gm{WSP(bf16_t, WS_XB), WSP(bf16_t, WS_WIN), 1024, 1024, 1024, nullptr}; pg8::StaticOrder S; S.init(TG, NU, G, bid);
            EpiInProj E{WSP(bf16_t, WS_U), WSP(float, WS_MISC + MS_BIAS)};
            pg8::gemm_phase<EpiInProj, pg8::StaticOrder, true>(lds, gm, S, E);
            if (g == 0) {
                pg8::Gemm gk{WSP(bf16_t, WS_MEMB), WSP(bf16_t, WS_WKV), 1024, 1024, 1024, nullptr}; pg8::StaticOrder S2; S2.init(NBATCH * 256, 2048, G, bid);
                EpiPlain E2{WSP(bf16_t, WS_KVM), 2048};
                pg8::gemm_phase<EpiPlain, pg8::StaticOrder, true>(lds, gk, S2, E2);
            }
        } STEP_END
        STEP_BEGIN(4) ph_conv(pk_, g, lds); STEP_END
        STEP_BEGIN(3) ph_mix(pk_, g, rep_, lds); STEP_END
        STEP_BEGIN(5) {
            pg8::Gemm gm{WSP(bf16_t, WS_Y), WSP(bf16_t, WS_WBR), 3072, 1024, 1024, nullptr}; BranchOrder S{(TG / 256) * 4, G, bid};
            EpiBranch E{WSP(bf16_t, WS_U), WSP(float, WS_F32), WSP(bf16_t, WS_MRG)};
            pg8::gemm_phase<EpiBranch, BranchOrder, true>(lds, gm, S, E);
        } STEP_END
        STEP_BEGIN(6) {
            pg8::Gemm gm{WSP(bf16_t, WS_MRG), WSP(bf16_t, WS_WOUT), 1024, 1024, 1024, nullptr}; pg8::StaticOrder S; S.init(TG, 1024, G, bid);
            EpiOutProj E{p.x + (size_t)g * TG * 1024, WSP(float, WS_Z)};
            pg8::gemm_phase<EpiOutProj, pg8::StaticOrder, true>(lds, gm, S, E);
        } STEP_END
        STEP_BEGIN(7) ph_ln1(pk_, g, lds); STEP_END
    }
    STEP_BEGIN(8) {
        pg8::Gemm gm{WSP(bf16_t, WS_X1B), WSP(bf16_t, WS_WR), 1024, 1024, 1024, nullptr}; pg8::StaticOrder S; S.init(T_ALL, 256, G, bid);
        EpiF32 E{WSP(float, WS_LOGIT), 256};
        pg8::gemm_phase<EpiF32, pg8::StaticOrder, true>(lds, gm, S, E);
        ph_expert_weights(pk_, lds);
    } STEP_END
    STEP_BEGIN(9) ph_topk(pk_, lds); STEP_END
    STEP_BEGIN(10) ph_scan(pk_, lds); STEP_END
    STEP_BEGIN(11) ph_slots(pk_, lds); STEP_END
    STEP_BEGIN(12) {
        const int* ntp = WSP(int, WS_MISC + MS_NT);
        pg8::Gemm gm{WSP(bf16_t, WS_X1B), WSP(bf16_t, WS_WGU), 1024, 1024, 1024, WSP(int, WS_TOKOF)}; ExpertGUOrder S{WSP(int, WS_MISC + MS_TILEE), ntp[1] * 2, G, bid};
        EpiGateUp E{WSP(bf16_t, WS_ACT)};
        pg8::gemm_phase<EpiGateUp, ExpertGUOrder, true, true>(lds, gm, S, E);
    } STEP_END
    for (int r = 0; r < 4; ++r) {
        STEP_BEGIN(13) {
            const int* ntp = WSP(int, WS_MISC + MS_NT);
            pg8::Gemm gm{WSP(bf16_t, WS_ACT), WSP(bf16_t, WS_WD), 256, 256, 256, nullptr}; ExpertDownOrder S{WSP(int, WS_MISC + MS_TILEE), ntp[1], G, bid, r};
            EpiDown E{WSP(bf16_t, WS_YCH), WSP(float, WS_WOF)};
            pg8::gemm_phase<EpiDown, ExpertDownOrder, true>(lds, gm, S, E);
        } STEP_END
        STEP_BEGIN(14) ph_combine(pk_, r, lds); STEP_END
    }
    STEP_BEGIN(15) ph_ln2(pk_, lds); STEP_END
}
constexpr int NSTEPS = 1 + NGRP * 7 + 5 + 8 + 1;

extern "C" void kernel_launch(void* const* d_in, const int* in_sizes, int n_in, void* d_out, int out_size, void* d_ws, size_t ws_size, hipStream_t stream) {
    static int grid = 0;
    if (grid == 0) {
        int dev = 0, cus = 0;
        if (hipGetDevice(&dev) != hipSuccess || hipDeviceGetAttribute(&cus, hipDeviceAttributeMultiprocessorCount, dev) != hipSuccess) { fprintf(stderr, "kernel_launch: device query failed\n"); grid = -1; return; }
        if (hipFuncSetAttribute((const void*)fwd, hipFuncAttributeMaxDynamicSharedMemorySize, LDS_BYTES) != hipSuccess) { fprintf(stderr, "kernel_launch: hipFuncSetAttribute failed\n"); grid = -1; return; }
        if (n_in != 24 || ws_size < WS_END) fprintf(stderr, "kernel_launch: n_in %d ws %zu (need %zu)\n", n_in, ws_size, (size_t)WS_END);
        grid = cus;
    }
    if (grid < 0) return;
    (void)hipMemsetAsync((char*)d_ws + WS_CTL, 0, CTL_BYTES, stream);
    P p{};
    const float** pp = (const float**)&p;
    for (int i = 0; i < 24; ++i) pp[i] = (const float*)d_in[i];
    p.out = (float*)d_out; p.ws = (unsigned char*)d_ws;
#ifndef ONE_LAUNCH
    for (int s = 0; s < NSTEPS; ++s) { p.s_lo = s; p.s_hi = s + 1; hipLaunchKernelGGL(fwd, dim3(grid), dim3(512), LDS_BYTES, stream, p); }
#else
    p.s_lo = 0; p.s_hi = NSTEPS; hipLaunchKernelGGL(fwd, dim3(grid), dim3(512), LDS_BYTES, stream, p);
#endif
}
```

```cpp
#define ONE_LAUNCH 1
#include <hip/hip_runtime.h>
#include <cstdio>
#include <cstdint>
#define DI __device__ __forceinline__
#define LAS __attribute__((address_space(3)))
#define GAS __attribute__((address_space(1)))
typedef unsigned short bf16_t;
typedef short bf16x8 __attribute__((ext_vector_type(8)));
typedef float f32x4 __attribute__((ext_vector_type(4)));
typedef float f32x2 __attribute__((ext_vector_type(2)));
typedef unsigned u32x4 __attribute__((ext_vector_type(4)));
typedef unsigned u32x2 __attribute__((ext_vector_type(2)));

constexpr int T_ALL = 65536, DM = 1024, SEQ = 2048, NBATCH = 32, NGRP = 4, TG = T_ALL / NGRP, BG = NBATCH / NGRP;
constexpr int NU = 11264, CIN = 11272;
constexpr int UQ = 0, UK = 1024, UV = 2048, UMQ = 3072, UMK = 4096, UMV = 5120, UMO = 6144, UCQ = 7168, UGT = 8192;
constexpr int NEXP = 256, MAXRT = 2304, MAXTILES = MAXRT + 256, MAXSLOTS = MAXTILES * 256;
constexpr float ALPHA = 1.189207115002721f;
constexpr float LN_EPS = 1e-5f;

constexpr size_t MiB = 1ull << 20;
constexpr size_t WS_CTL = 0, CTL_BYTES = 1 * MiB;
constexpr size_t WS_MISC = 1 * MiB;
constexpr size_t WS_WIN = 2 * MiB, WS_WKV = 24 * MiB, WS_WBR = 28 * MiB, WS_WOUT = 34 * MiB, WS_WR = 36 * MiB;
constexpr size_t WS_GIF = 38 * MiB, WS_MEMB = 40 * MiB, WS_KVM = 56 * MiB, WS_X1B = 88 * MiB, WS_R = 216 * MiB;
constexpr size_t WS_XB = WS_R, WS_U = WS_R + 32 * MiB, WS_Y = WS_R + 384 * MiB, WS_F32 = WS_R + 480 * MiB, WS_MRG = WS_R + 544 * MiB, WS_Z = WS_R + 576 * MiB, WS_QKC = WS_R + 640 * MiB;
constexpr size_t WS_TKI = WS_R, WS_TKW = WS_R + 2 * MiB, WS_SLOTOF = WS_R + 4 * MiB, WS_TOKOF = WS_R + 6 * MiB, WS_WOF = WS_R + 9 * MiB;
constexpr size_t WS_LOGIT = WS_R + 16 * MiB, WS_WGU = WS_R + 80 * MiB, WS_WD = WS_R + 337 * MiB, WS_ACT = WS_R + 580 * MiB, WS_YCH = WS_R + 16 * MiB;
constexpr size_t WS_END = WS_R + 900 * MiB;
constexpr size_t MS_BIAS = 0, MS_LAM = 48 * 1024, MS_TBASE = 52 * 1024, MS_NT = 56 * 1024, MS_TILEE = 64 * 1024;
constexpr int CW_CNT = 1024, CW_CUR = 2048, CW_BAR = 8192, CW_Q = 16384;

constexpr int LDS_RING = 131072, LDS_MISC = LDS_RING + 320, LDS_BYTES = 147456;

DI float bf_lo(unsigned w) { return __uint_as_float(w << 16); }
DI float bf_hi(unsigned w) { return __uint_as_float(w & 0xffff0000u); }
DI float bf2f(bf16_t b) { return __uint_as_float((unsigned)b << 16); }
DI unsigned cvt_pk_bf16(float lo, float hi) { unsigned r; asm("v_cvt_pk_bf16_f32 %0, %1, %2" : "=v"(r) : "v"(lo), "v"(hi)); return r; }
DI float wave_sum(float v) {
#pragma unroll
    for (int o = 1; o < 64; o <<= 1) v += __shfl_xor(v, o);
    return v;
}
DI float wave_max(float v) {
#pragma unroll
    for (int o = 1; o < 64; o <<= 1) v = fmaxf(v, __shfl_xor(v, o));
    return v;
}
template <int CTRL> DI float dppf(float v) { return __builtin_bit_cast(float, __builtin_amdgcn_update_dpp(0, __builtin_bit_cast(int, v), CTRL, 0xf, 0xf, true)); }
DI float row16_sum(float v) { v += dppf<0xB1>(v); v += dppf<0x4E>(v); v += dppf<0x124>(v); v += dppf<0x128>(v); return v; }
DI float rdlane(float v, int l) { return __builtin_bit_cast(float, __builtin_amdgcn_readlane(__builtin_bit_cast(int, v), l)); }
DI float wave_sum_fast(float v) { v = row16_sum(v); return (rdlane(v, 0) + rdlane(v, 16)) + (rdlane(v, 32) + rdlane(v, 48)); }
DI float sigm(float x) { return 1.f / (1.f + __expf(-x)); }
DI float silu(float x) { return x / (1.f + __expf(-x)); }
DI int tid_local() { int t = threadIdx.x; asm volatile("" : "+v"(t)); return t; }
DI void lds_barrier() { asm volatile("s_waitcnt lgkmcnt(0)" ::: "memory"); __builtin_amdgcn_s_barrier(); asm volatile("" ::: "memory"); }
#define LDS_WAIT() asm volatile("s_waitcnt lgkmcnt(0)" ::: "memory")
namespace pg8 {
constexpr int BM = 256, BK = 64, HALF = 128, HTB = HALF * BK * 2, STAGE_BYTES = 8 * HTB, NXCD = 8, WGM = 8;
__host__ __device__ __forceinline__ int lds_byte(int r, int c) { const int st = (r >> 4) * 2 + (c >> 5), rr = r & 15, cc = c & 31, ob = rr * 64 + cc * 2; return st * 1024 + (ob ^ (((ob >> 9) & 1) << 5)); }
__host__ __device__ __forceinline__ void stage_rc(int b, int& R, int& C) { const int st = b / 1024, sb = b % 1024, swz = sb ^ (((sb >> 9) & 1) << 5); R = (st >> 1) * 16 + swz / 64; C = (st & 1) * 32 + (swz % 64) / 2; }
__host__ __device__ __forceinline__ int perm32(int rho) { const int n = rho >> 4, i = rho & 15; return 8 * (i >> 2) + 4 * n + (i & 3); }

struct Unit { int pm, pn, pb, acol, aux; };
struct Gemm { const bf16_t* A; const bf16_t* Bt; int lda, ldb, K; const int* arow; };

struct StaticOrder {
    int nM, nN, nwg, G, c;
    DI void init(int M, int N, int G_, int c_) { nM = M / BM; nN = N / BM; nwg = nM * nN; G = G_; c = c_; }
    DI bool next(int i, Unit& u) const {
        const long L = (long)i * G + c; if (L >= nwg) return false;
        int wgid = (int)L; { const int q = nwg / NXCD, r = nwg % NXCD, xcd = wgid % NXCD, off = wgid / NXCD; wgid = (xcd < r ? xcd * (q + 1) : r * (q + 1) + (xcd - r) * q) + off; }
        const int nig = WGM * nN, gid = wgid / nig, fm = gid * WGM, gsz = (nM - fm) < WGM ? (nM - fm) : WGM;
        u.pm = fm + ((wgid % nig) % gsz); u.pn = (wgid % nig) / gsz; u.pb = u.pn; u.acol = 0; u.aux = 0; return true;
    }
};

template <class Epi, class Sched, bool ALIGN_EPI, bool GATHER = false>
DI void gemm_phase(LAS unsigned char* lds, const Gemm g, const Sched& S, const Epi& E) {
    const int tid = tid_local(), wid = __builtin_amdgcn_readfirstlane(tid >> 6), lane = tid & 63, wr = wid >> 2, wc = wid & 3, fr = lane & 15, fq = lane >> 4;
    const int nt = g.K / BK;
    int Ra[2], Ca[2], Rb[2];
#pragma unroll
    for (int i = 0; i < 2; ++i) { int R, C; stage_rc(tid * 16 + i * 8192, R, C); Ra[i] = R; Ca[i] = C; Rb[i] = (R & ~31) + perm32(R & 31); }
    const size_t kstep = (size_t)(BK * 2);
    const unsigned ldsw = (unsigned)wid * 1024u;
    const int aoff = lds_byte(wr * 64 + fr, fq * 8), boff = lds_byte(wc * 32 + fr, fq * 8);
#define PG8_SA(b, h) (((b) * 2 + (h)) * HTB)
#define PG8_SB(b, h) ((4 + (b) * 2 + (h)) * HTB)
#define PG8_STAGE(bufoff, gptr, offs) do { _Pragma("unroll") for (int _i = 0; _i < 2; ++_i) \
        __builtin_amdgcn_global_load_lds((const unsigned*)((gptr) + (offs)[_i]), (LAS unsigned*)(lds + (bufoff) + ldsw + _i * 8192), 16, 0, 0); } while (0)
#define PG8_LDA(dst, b, h) do { _Pragma("unroll") for (int m = 0; m < 4; ++m) _Pragma("unroll") for (int k = 0; k < 2; ++k) dst[m][k] = *(const LAS bf16x8*)(lds + PG8_SA(b, h) + aoff + m * 2048 + k * 1024); } while (0)
#define PG8_LDB(dst, b, h) do { _Pragma("unroll") for (int n = 0; n < 2; ++n) _Pragma("unroll") for (int k = 0; k < 2; ++k) dst[n][k] = *(const LAS bf16x8*)(lds + PG8_SB(b, h) + boff + n * 2048 + k * 1024); } while (0)
#define PG8_MMA(ai, bj, At, Bt) do { __builtin_amdgcn_s_setprio(1); _Pragma("unroll") for (int m = 0; m < 4; ++m) _Pragma("unroll") for (int n = 0; n < 2; ++n) _Pragma("unroll") for (int k = 0; k < 2; ++k) \
        acc[ai][bj][m][n] = __builtin_amdgcn_mfma_f32_16x16x32_bf16(Bt[n][k], At[m][k], acc[ai][bj][m][n], 0, 0, 0); __builtin_amdgcn_s_setprio(0); } while (0)
#define PG8_WAIT_V(n) asm volatile("s_waitcnt vmcnt(" #n ")" ::: "memory")
#define PG8_WAIT_L(n) asm volatile("s_waitcnt lgkmcnt(" #n ")" ::: "memory")
#define PG8_BAR __builtin_amdgcn_s_barrier()
#define PG8_SCHED __builtin_amdgcn_sched_barrier(0)
#define PG8_OFFS(u, oa) do { _Pragma("unroll") for (int h_ = 0; h_ < 2; ++h_) _Pragma("unroll") for (int i_ = 0; i_ < 2; ++i_) { \
        const int ar_ = g.arow[(u).pm * BM + h_ * HALF + Ra[i_]]; oa[h_][i_] = (unsigned)(ar_ * g.lda + (u).acol + Ca[i_]) * 2u; } } while (0)
    unsigned voffA[2], voffB[2];
#pragma unroll
    for (int i = 0; i < 2; ++i) { voffA[i] = (unsigned)(Ra[i] * g.lda + Ca[i]) * 2u; voffB[i] = (unsigned)(Rb[i] * g.ldb + Ca[i]) * 2u; }
    const size_t hstepA = (size_t)HALF * g.lda * 2, hstepB = (size_t)HALF * g.ldb * 2;
#define PG8_ABASE(u) ((const char*)g.A + (GATHER ? (size_t)0 : ((size_t)(u).pm * BM * g.lda + (u).acol) * 2))
#define PG8_BBASE(u) ((const char*)g.Bt + (size_t)(u).pb * BM * g.ldb * 2)
#define PG8_STAGE_A(bufoff, ab, oa, h) do { if constexpr (GATHER) { PG8_STAGE(bufoff, ab, (oa)[h]); } else { PG8_STAGE(bufoff, (ab) + (h) * hstepA, voffA); } } while (0)
#define PG8_STAGE_B(bufoff, bb, h) PG8_STAGE(bufoff, (bb) + (h) * hstepB, voffB)
    Unit cur, nxt; int ui = 0;
    if (!S.next(0, cur)) return;
    f32x4 acc[2][2][4][2];
#pragma unroll
    for (int a = 0; a < 2; ++a)
#pragma unroll
        for (int b = 0; b < 2; ++b)
#pragma unroll
            for (int m = 0; m < 4; ++m)
#pragma unroll
                for (int n = 0; n < 2; ++n) acc[a][b][m][n] = (f32x4){0.f, 0.f, 0.f, 0.f};
    bf16x8 At[4][2], B0[2][2], B1[2][2];
    unsigned oaC[2][2], oaN[2][2];
    if constexpr (GATHER) { PG8_OFFS(cur, oaC); }
    const char* cA = PG8_ABASE(cur); const char* cB = PG8_BBASE(cur);
    PG8_STAGE_B(PG8_SB(0, 0), cB, 0); PG8_STAGE_B(PG8_SB(0, 1), cB, 1); PG8_STAGE_A(PG8_SA(0, 0), cA, oaC, 0); PG8_STAGE_A(PG8_SA(0, 1), cA, oaC, 1);
    if (wr == 1) PG8_BAR;
    PG8_WAIT_V(2); PG8_BAR;
    PG8_STAGE_B(PG8_SB(1, 0), cB + kstep, 0); PG8_STAGE_A(PG8_SA(1, 0), cA + kstep, oaC, 0); PG8_STAGE_B(PG8_SB(1, 1), cB + kstep, 1);
    PG8_WAIT_V(6); PG8_BAR;
    for (;;) {
        const bool has_next = S.next(ui + 1, nxt);
        const char* nA = has_next ? PG8_ABASE(nxt) : cA; const char* nB = has_next ? PG8_BBASE(nxt) : cB;
        if constexpr (GATHER) {
            if (has_next) { PG8_OFFS(nxt, oaN); }
            else {
#pragma unroll
                for (int h_ = 0; h_ < 2; ++h_)
#pragma unroll
                    for (int i_ = 0; i_ < 2; ++i_) oaN[h_][i_] = oaC[h_][i_];
            }
        }
#pragma unroll 1
        for (int t = 0; t < nt; t += 2) {
            const bool last = (t == nt - 2);
            const char* a1 = cA + (size_t)(t + 1) * kstep;
            const char* a2 = last ? nA : cA + (size_t)(t + 2) * kstep; const char* b2 = last ? nB : cB + (size_t)(t + 2) * kstep;
            const char* a3 = a2 + kstep; const char* b3 = b2 + kstep;
            unsigned oa2[2][2];
            if constexpr (GATHER) {
#pragma unroll
                for (int h_ = 0; h_ < 2; ++h_)
#pragma unroll
                    for (int i_ = 0; i_ < 2; ++i_) oa2[h_][i_] = last ? oaN[h_][i_] : oaC[h_][i_];
            }
            PG8_LDB(B0, 0, 0); PG8_LDB(B1, 0, 1); PG8_SCHED; PG8_LDA(At, 0, 0); PG8_STAGE_A(PG8_SA(1, 1), a1, oaC, 1);
            PG8_WAIT_V(8); PG8_WAIT_L(0); PG8_BAR; PG8_MMA(0, 0, At, B0); PG8_MMA(0, 1, At, B1); PG8_BAR; PG8_SCHED;
            PG8_LDA(At, 0, 1); PG8_STAGE_B(PG8_SB(0, 0), b2, 0); PG8_STAGE_B(PG8_SB(0, 1), b2, 1); PG8_STAGE_A(PG8_SA(0, 0), a2, oa2, 0);
            PG8_WAIT_V(8); PG8_WAIT_L(0); PG8_BAR; PG8_MMA(1, 0, At, B0); PG8_MMA(1, 1, At, B1); PG8_BAR; PG8_SCHED;
            PG8_LDB(B0, 1, 0); PG8_LDB(B1, 1, 1); PG8_SCHED; PG8_LDA(At, 1, 0); PG8_STAGE_A(PG8_SA(0, 1), a2, oa2, 1);
            PG8_WAIT_V(8); PG8_WAIT_L(0); PG8_BAR; PG8_MMA(0, 0, At, B0); PG8_MMA(0, 1, At, B1); PG8_BAR; PG8_SCHED;
            PG8_LDA(At, 1, 1); PG8_STAGE_B(PG8_SB(1, 0), b3, 0); PG8_STAGE_B(PG8_SB(1, 1), b3, 1); PG8_STAGE_A(PG8_SA(1, 0), a3, oa2, 0);
            PG8_WAIT_V(8); PG8_WAIT_L(0); PG8_BAR; PG8_MMA(1, 0, At, B0); PG8_MMA(1, 1, At, B1); PG8_BAR; PG8_SCHED;
        }
        if constexpr (ALIGN_EPI) { if (wr == 0) PG8_BAR; }
        E(acc, cur, wr, wc, fr, fq);
        if (!has_next) break;
#pragma unroll
        for (int a = 0; a < 2; ++a)
#pragma unroll
            for (int b = 0; b < 2; ++b)
#pragma unroll
                for (int m = 0; m < 4; ++m)
#pragma unroll
                    for (int n = 0; n < 2; ++n) acc[a][b][m][n] = (f32x4){0.f, 0.f, 0.f, 0.f};
        cur = nxt; cA = nA; cB = nB; ++ui;
        if constexpr (GATHER) {
#pragma unroll
            for (int h_ = 0; h_ < 2; ++h_)
#pragma unroll
                for (int i_ = 0; i_ < 2; ++i_) oaC[h_][i_] = oaN[h_][i_];
        }
        if constexpr (ALIGN_EPI) { if (wr == 1) PG8_BAR; }
    }
    PG8_WAIT_V(0);
    if constexpr (!ALIGN_EPI) { if (wr == 0) PG8_BAR; }
    PG8_BAR;
#undef PG8_SA
#undef PG8_SB
#undef PG8_STAGE
#undef PG8_LDA
#undef PG8_LDB
#undef PG8_MMA
#undef PG8_WAIT_V
#undef PG8_WAIT_L
#undef PG8_BAR
#undef PG8_SCHED
#undef PG8_OFFS
#undef PG8_ABASE
#undef PG8_BBASE
#undef PG8_STAGE_A
#undef PG8_STAGE_B
}
}
using pg8::Unit; using pg8::BM; using pg8::HALF;

struct BranchOrder {
    int ntile, G, c;
    DI bool next(int i, Unit& u) const {
        const int L = (i / 3) * G + c; if (L >= ntile) return false;
        const int n = i % 3; u.pm = L >> 2; u.pn = L & 3; u.pb = n * 4 + u.pn; u.acol = n * 1024; u.aux = n; return true;
    }
};
struct ExpertGUOrder {
    const int* tile_e; int nunits, G, c;
    DI bool next(int i, Unit& u) const {
        const int L = i * G + c; if (L >= nunits) return false;
        const int t = L >> 1, hf = L & 1; const int e = tile_e[t];
        u.pm = t; u.pn = hf; u.pb = e * 2 + hf; u.acol = 0; u.aux = e; return true;
    }
};
struct ExpertDownOrder {
    const int* tile_e; int nunits, G, c, round;
    DI bool next(int i, Unit& u) const {
        const int L = i * G + c; if (L >= nunits) return false;
        const int e = tile_e[L];
        u.pm = L; u.pn = 0; u.pb = e * 4 + round; u.acol = 0; u.aux = e; return true;
    }
};

#define EPI_ARGS const f32x4 (&acc)[2][2][4][2], const Unit& u, int wr, int wc, int fr, int fq
DI u32x4 pack8(const f32x4 v0, const f32x4 v1) { u32x4 w; w.x = cvt_pk_bf16(v0[0], v0[1]); w.y = cvt_pk_bf16(v0[2], v0[3]); w.z = cvt_pk_bf16(v1[0], v1[1]); w.w = cvt_pk_bf16(v1[2], v1[3]); return w; }

struct EpiInProj {
    bf16_t* O; const float* bias;
    DI void operator()(EPI_ARGS) const {
        const int row0 = u.pm * BM + wr * 64 + fr, col0 = u.pn * BM + wc * 32 + 8 * fq;
        const float sc = (u.pn < 4) ? 0.125f * 1.4426950408889634f : ((u.pn >= 28 && u.pn < 32) ? 0.0625f * 1.4426950408889634f : 1.f);
        f32x4 bv[2][2];
#pragma unroll
        for (int bj = 0; bj < 2; ++bj)
#pragma unroll
            for (int n = 0; n < 2; ++n) bv[bj][n] = *(const f32x4*)(bias + col0 + bj * HALF + 4 * n);
#pragma unroll
        for (int ai = 0; ai < 2; ++ai)
#pragma unroll
            for (int m = 0; m < 4; ++m) { bf16_t* rowp = O + (size_t)(row0 + ai * HALF + m * 16) * NU + col0;
#pragma unroll
                for (int bj = 0; bj < 2; ++bj) *(u32x4*)(rowp + bj * HALF) = pack8((acc[ai][bj][m][0] + bv[bj][0]) * sc, (acc[ai][bj][m][1] + bv[bj][1]) * sc); }
    }
};
struct EpiPlain {
    bf16_t* O; int ldc;
    DI void operator()(EPI_ARGS) const {
        const int row0 = u.pm * BM + wr * 64 + fr, col0 = u.pn * BM + wc * 32 + 8 * fq;
#pragma unroll
        for (int ai = 0; ai < 2; ++ai)
#pragma unroll
            for (int m = 0; m < 4; ++m) { bf16_t* rowp = O + (size_t)(row0 + ai * HALF + m * 16) * ldc + col0;
#pragma unroll
                for (int bj = 0; bj < 2; ++bj) *(u32x4*)(rowp + bj * HALF) = pack8(acc[ai][bj][m][0], acc[ai][bj][m][1]); }
    }
};
struct EpiBranch {
    const bf16_t* U; float* F; bf16_t* M;
    DI void operator()(EPI_ARGS) const {
        const int row0 = u.pm * BM + wr * 64 + fr, col0 = u.pn * BM + wc * 32 + 8 * fq, n = u.aux;
#pragma unroll
        for (int ai = 0; ai < 2; ++ai)
#pragma unroll
            for (int m = 0; m < 4; ++m) { const size_t row = (size_t)(row0 + ai * HALF + m * 16);
#pragma unroll
                for (int bj = 0; bj < 2; ++bj) { const int col = col0 + bj * HALF;
                    const u32x4 gw = *(const u32x4*)(U + row * NU + UGT + n * 1024 + col);
                    f32x4 g0 = {sigm(bf_lo(gw.x)), sigm(bf_hi(gw.x)), sigm(bf_lo(gw.y)), sigm(bf_hi(gw.y))};
                    f32x4 g1 = {sigm(bf_lo(gw.z)), sigm(bf_hi(gw.z)), sigm(bf_lo(gw.w)), sigm(bf_hi(gw.w))};
                    f32x4 v0 = acc[ai][bj][m][0] * g0, v1 = acc[ai][bj][m][1] * g1;
                    float* fp = F + row * 1024 + col;
                    if (n > 0) { v0 += *(const f32x4*)fp; v1 += *(const f32x4*)(fp + 4); }
                    if (n < 2) { *(f32x4*)fp = v0; *(f32x4*)(fp + 4) = v1; }
                    else *(u32x4*)(M + row * 1024 + col) = pack8(v0, v1); }
                asm volatile("" ::: "memory"); }
    }
};
struct EpiOutProj {
    const float* X; float* Z;
    DI void operator()(EPI_ARGS) const {
        const int row0 = u.pm * BM + wr * 64 + fr, col0 = u.pn * BM + wc * 32 + 8 * fq;
#pragma unroll
        for (int ai = 0; ai < 2; ++ai)
#pragma unroll
            for (int m = 0; m < 4; ++m) { const size_t off = (size_t)(row0 + ai * HALF + m * 16) * 1024 + col0;
#pragma unroll
                for (int bj = 0; bj < 2; ++bj) { const float* xp = X + off + bj * HALF; float* zp = Z + off + bj * HALF;
                    *(f32x4*)zp = *(const f32x4*)xp * ALPHA + acc[ai][bj][m][0]; *(f32x4*)(zp + 4) = *(const f32x4*)(xp + 4) * ALPHA + acc[ai][bj][m][1]; }
                asm volatile("" ::: "memory"); }
    }
};
struct EpiF32 {
    float* O; int ldc;
    DI void operator()(EPI_ARGS) const {
        const int row0 = u.pm * BM + wr * 64 + fr, col0 = u.pn * BM + wc * 32 + 8 * fq;
#pragma unroll
        for (int ai = 0; ai < 2; ++ai)
#pragma unroll
            for (int m = 0; m < 4; ++m) { float* rowp = O + (size_t)(row0 + ai * HALF + m * 16) * ldc + col0;
#pragma unroll
                for (int bj = 0; bj < 2; ++bj) { *(f32x4*)(rowp + bj * HALF) = acc[ai][bj][m][0]; *(f32x4*)(rowp + bj * HALF + 4) = acc[ai][bj][m][1]; } }
    }
};
struct EpiGateUp {
    bf16_t* ACT;
    DI void operator()(EPI_ARGS) const {
        const int row0 = u.pm * BM + wr * 64 + fr, col0 = u.pn * HALF + wc * 32 + 8 * fq;
#pragma unroll
        for (int ai = 0; ai < 2; ++ai)
#pragma unroll
            for (int m = 0; m < 4; ++m) { f32x4 v[2];
#pragma unroll
                for (int n = 0; n < 2; ++n) { const f32x4 gt = acc[ai][0][m][n], up = acc[ai][1][m][n];
                    v[n] = (f32x4){silu(gt[0]) * up[0], silu(gt[1]) * up[1], silu(gt[2]) * up[2], silu(gt[3]) * up[3]}; }
                *(u32x4*)(ACT + (size_t)(row0 + ai * HALF + m * 16) * 256 + col0) = pack8(v[0], v[1]); }
    }
};
struct EpiDown {
    bf16_t* Y; const float* W;
    DI void operator()(EPI_ARGS) const {
        const int row0 = u.pm * BM + wr * 64 + fr, col0 = wc * 32 + 8 * fq;
#pragma unroll
        for (int ai = 0; ai < 2; ++ai)
#pragma unroll
            for (int m = 0; m < 4; ++m) { const int row = row0 + ai * HALF + m * 16; const float w = W[row];
#pragma unroll
                for (int bj = 0; bj < 2; ++bj) *(u32x4*)(Y + (size_t)row * 256 + col0 + bj * HALF) = pack8(acc[ai][bj][m][0] * w, acc[ai][bj][m][1] * w);
                asm volatile("" ::: "memory"); }
    }
};
#define RLX_AGENT __ATOMIC_RELAXED, __HIP_MEMORY_SCOPE_AGENT
#define XB_TMO      128
#define XB_XCNT(j)  (256  + 64 * (j))
#define XB_XSUB(j)  (1280 + 64 * (j))
#define XB_XGEN(j)  (2304 + 64 * (j))
#define XB_TOP      3328
#define XB_TOPGEN   3392
#define XCD_BAR_WORDS 3456
#define XB_SPIN_CAP (1u << 18)

__device__ __forceinline__ unsigned xb_ld(unsigned* p)              { return __hip_atomic_load(p, __ATOMIC_RELAXED, __HIP_MEMORY_SCOPE_AGENT); }
__device__ __forceinline__ unsigned xb_add(unsigned* p, unsigned v) { return __hip_atomic_fetch_add(p, v, __ATOMIC_RELAXED, __HIP_MEMORY_SCOPE_AGENT); }
__device__ __forceinline__ unsigned xb_xcc_id() { return (unsigned)__builtin_amdgcn_s_getreg((3 << 11) | 20) & 0xFu; }
#define XB_SPIN(cond, bar) do { unsigned _sp = 0; while (cond) { __builtin_amdgcn_s_sleep(1); \
    if ((++_sp & 255u) == 0u) { if (xb_ld(&(bar)[XB_TMO])) break; if (_sp > XB_SPIN_CAP) { atomicAdd(&(bar)[XB_TMO], 1u); break; } } } } while (0)

struct XcdBarrier {
    unsigned* bar; unsigned x;
    volatile LAS unsigned* st;
};

__device__ __forceinline__ XcdBarrier xcd_barrier_post(unsigned* bar, volatile LAS unsigned* st) {
    XcdBarrier b; b.bar = bar; b.x = xb_xcc_id(); b.st = st;
    if (threadIdx.x == 0) (void)xb_add(&bar[XB_XCNT(b.x)], 1u);
    return b;
}
__device__ __forceinline__ void xcd_barrier_complete(unsigned* bar, unsigned x, unsigned& nloc, unsigned& nx) {
    const unsigned G = gridDim.x * gridDim.y * gridDim.z;
    unsigned sum, cnt, mine, sp = 0u;
    for (;;) {
        sum = 0u; cnt = 0u; mine = 0u;
#pragma unroll
        for (unsigned j = 0; j < 16; ++j) { const unsigned c = xb_ld(&bar[XB_XCNT(j)]); sum += c; cnt += (c > 0u) ? 1u : 0u; mine = (j == x) ? c : mine; }
        if (sum == G) break;
        __builtin_amdgcn_s_sleep(1);
        if ((++sp & 255u) == 0u) { if (xb_ld(&bar[XB_TMO])) break; if (sp > XB_SPIN_CAP) { atomicAdd(&bar[XB_TMO], 1u); break; } }
    }
    nloc = mine > 0u ? mine : 1u; nx = cnt > 0u ? cnt : 1u;
}

__device__ __forceinline__ void xcd_barrier(const XcdBarrier& b) {
    asm volatile("s_waitcnt vmcnt(0)" ::: "memory");
    __syncthreads();
    if (threadIdx.x == 0) {
        unsigned* bar = b.bar;
        __builtin_amdgcn_s_waitcnt(0);
        unsigned nloc = b.st[0], nx = b.st[1];
        if (nloc == 0u) { xcd_barrier_complete(bar, b.x, nloc, nx); b.st[0] = nloc; b.st[1] = nx; }
        const unsigned old = xb_add(&bar[XB_XSUB(b.x)], 1u);
        const unsigned gen = old / nloc;
        if (old + 1u == (gen + 1u) * nloc) {
            __builtin_amdgcn_fence(__ATOMIC_RELEASE, "agent");
            asm volatile("s_waitcnt vmcnt(0)" ::: "memory");
            const unsigned og = xb_add(&bar[XB_TOP], 1u);
            const unsigned tg = og / nx;
            if (og + 1u == (tg + 1u) * nx) xb_add(&bar[XB_TOPGEN], 1u);
            else XB_SPIN(xb_ld(&bar[XB_TOPGEN]) == tg, bar);
            __builtin_amdgcn_fence(__ATOMIC_ACQUIRE, "agent");
            xb_add(&bar[XB_XGEN(b.x)], 1u);
            asm volatile("s_waitcnt vmcnt(0)" ::: "memory");
        } else {
            XB_SPIN(xb_ld(&bar[XB_XGEN(b.x)]) == gen, bar);
            __builtin_amdgcn_fence(__ATOMIC_ACQUIRE, "agent");
            asm volatile("s_waitcnt vmcnt(0)" ::: "memory");
        }
    }
    __syncthreads();
}

struct P {
    const float *x, *mem, *rel_bias, *w_in, *b_in, *conv_w, *diff_lambda, *subln_g, *mlstm_norm_g, *w_mem_kv, *w_branch, *w_out, *ln1_g, *ln1_b,
                *w_router, *router_bias, *w_e_gate, *w_e_up, *w_e_down, *w_s_gate, *w_s_up, *w_s_down, *ln2_g, *ln2_b;
    float* out; unsigned char* ws; int s_lo, s_hi;
};
typedef const P __attribute__((address_space(4)))* PP;
DI PP kargs() { PP k = (PP)__builtin_amdgcn_kernarg_segment_ptr(); asm volatile("" : "+s"(k)); return k; }
DI P load_args(PP k) { P r; const unsigned long long __attribute__((address_space(4)))* s = (const unsigned long long __attribute__((address_space(4)))*)k;
    void** d = (void**)&r;
#pragma unroll
    for (int i = 0; i < 26; ++i) d[i] = (void*)(GAS char*)s[i];
    ((unsigned long long*)&r)[26] = s[26];
    return r; }
static_assert(sizeof(P) == 27 * 8, "P = 26 pointers + 2 ints");
#define WSP(T, off) ((T*)(p.ws + (off)))

DI void transpose_item(const float* W, int ldw, int src_col0, bf16_t* WT, int ldt, int dst_row0, int k0, LAS float* scr, int lane) {
    float v[32];
    const float* src = W + (size_t)(k0 + (lane >> 5)) * ldw + src_col0 + (lane & 31);
#pragma unroll
    for (int i = 0; i < 32; ++i) v[i] = src[(size_t)(2 * i) * ldw];
#pragma unroll
    for (int i = 0; i < 32; ++i) scr[(2 * i + (lane >> 5)) * 33 + (lane & 31)] = v[i];
    LDS_WAIT();
    const int c = lane & 7;
#pragma unroll
    for (int j = 0; j < 4; ++j) { const int n = (lane >> 3) + 8 * j; const LAS float* s = scr + (8 * c) * 33 + n;
        u32x4 o; o.x = cvt_pk_bf16(s[0 * 33], s[1 * 33]); o.y = cvt_pk_bf16(s[2 * 33], s[3 * 33]); o.z = cvt_pk_bf16(s[4 * 33], s[5 * 33]); o.w = cvt_pk_bf16(s[6 * 33], s[7 * 33]);
        *(u32x4*)(WT + (size_t)(dst_row0 + n) * ldt + k0 + 8 * c) = o; }
    LDS_WAIT();
}
DI void transpose_mat(const float* W, int ldw, int src_col0, int K, int N, bf16_t* WT, int ldt, int dst_row0, int gw, int NGW, LAS float* scr, int lane) {
    const int nblk = N / 32, items = (K / 64) * nblk;
    for (int it = gw; it < items; it += NGW) { const int kb = it / nblk, nb = it % nblk; transpose_item(W, ldw, src_col0 + nb * 32, WT, ldt, dst_row0 + nb * 32, kb * 64, scr, lane); }
}
DI void row_to_bf16(const float* src, bf16_t* dst, int lane) {
    const f32x4* s = (const f32x4*)src + lane; u32x2* d = (u32x2*)dst + lane;
#pragma unroll
    for (int j = 0; j < 4; ++j) { const f32x4 v = s[64 * j]; u32x2 o; o.x = cvt_pk_bf16(v[0], v[1]); o.y = cvt_pk_bf16(v[2], v[3]); d[64 * j] = o; }
}

DI void ph_prologue(PP pk_, LAS unsigned char* lds) { const P p = load_args(pk_);
    const int tid = tid_local(), lane = tid & 63, wave = tid >> 6, gw = blockIdx.x * 8 + wave, NGW = gridDim.x * 8;
    LAS float* scr = (LAS float*)(lds + wave * 16384);
    bf16_t* WinT = WSP(bf16_t, WS_WIN);
    transpose_mat(p.w_in, CIN, 0, 1024, 7168, WinT, 1024, 0, gw, NGW, scr, lane);
    transpose_mat(p.w_in, CIN, 7176, 1024, 4096, WinT, 1024, 7168, gw, NGW, scr, lane);
    transpose_mat(p.w_mem_kv, 2048, 0, 1024, 2048, WSP(bf16_t, WS_WKV), 1024, 0, gw, NGW, scr, lane);
    for (int n = 0; n < 3; ++n) transpose_mat(p.w_branch + (size_t)n * 1024 * 1024, 1024, 0, 1024, 1024, WSP(bf16_t, WS_WBR), 1024, n * 1024, gw, NGW, scr, lane);
    transpose_mat(p.w_out, 1024, 0, 1024, 1024, WSP(bf16_t, WS_WOUT), 1024, 0, gw, NGW, scr, lane);
    transpose_mat(p.w_router, 256, 0, 1024, 256, WSP(bf16_t, WS_WR), 1024, 0, gw, NGW, scr, lane);
    bf16_t* memb = WSP(bf16_t, WS_MEMB);
    for (int r = gw; r < NBATCH * 256; r += NGW) row_to_bf16(p.mem + (size_t)r * 1024, memb + (size_t)r * 1024, lane);
    float* bias = WSP(float, WS_MISC + MS_BIAS);
    for (int j = blockIdx.x * 512 + tid; j < NU; j += gridDim.x * 512) bias[j] = p.b_in[j + (j >= 7168 ? 8 : 0)];
    if (gw == 0) {
        const float* lv = p.diff_lambda;
        const float s1 = wave_sum(lv[lane] * lv[64 + lane]), s2 = wave_sum(lv[128 + lane] * lv[192 + lane]);
        if (lane == 0) *WSP(float, WS_MISC + MS_LAM) = expf(s1) - expf(s2) + 0.2f;
    }
}

DI void ph_xconv(PP pk_, int g, LAS unsigned char* lds) { const P p = load_args(pk_);
    const int tid = tid_local(), lane = tid & 63, wave = tid >> 6, gw = blockIdx.x * 8 + wave, NGW = gridDim.x * 8;
    LAS float* wg = (LAS float*)lds;
    for (int i = tid; i < 2048; i += 512) { const int c = i >> 1, hf = i & 1; *(LAS f32x4*)(wg + c * 8 + hf * 4) = *(const f32x4*)(p.w_in + (size_t)c * CIN + 7168 + hf * 4); }
    __syncthreads();
    bf16_t* xb = WSP(bf16_t, WS_XB); float* gif = WSP(float, WS_GIF);
    for (int r = gw; r < TG; r += NGW) {
        const size_t t = (size_t)g * TG + r;
        const f32x4* xr = (const f32x4*)(p.x + t * 1024) + lane; u32x2* d = (u32x2*)(xb + (size_t)r * 1024) + lane;
        float gs[8];
#pragma unroll
        for (int q = 0; q < 8; ++q) gs[q] = 0.f;
#pragma unroll
        for (int j = 0; j < 4; ++j) { const f32x4 v = xr[64 * j]; u32x2 o; o.x = cvt_pk_bf16(v[0], v[1]); o.y = cvt_pk_bf16(v[2], v[3]); d[64 * j] = o;
#pragma unroll
            for (int e = 0; e < 4; ++e) { const int c = 4 * lane + 256 * j + e; const f32x4 wl = *(const LAS f32x4*)(wg + c * 8), wh = *(const LAS f32x4*)(wg + c * 8 + 4);
                gs[0] += v[e] * wl[0]; gs[1] += v[e] * wl[1]; gs[2] += v[e] * wl[2]; gs[3] += v[e] * wl[3]; gs[4] += v[e] * wh[0]; gs[5] += v[e] * wh[1]; gs[6] += v[e] * wh[2]; gs[7] += v[e] * wh[3]; } }
        float mine = 0.f;
#pragma unroll
        for (int q = 0; q < 8; ++q) { const float s = wave_sum(gs[q]); if (lane == q) mine = s; }
        if (lane < 8) gif[t * 8 + lane] = mine + p.b_in[7168 + lane];
    }
    __syncthreads();
}

DI int t5_bucket(int n) { return n < 16 ? n : min(31, 16 + (int)(__log2f((float)n * 0.0625f) * (16.f / 3.f))); }

DI void attn_naive_item(PP pk_, int item, LAS unsigned char* lds) { const P p = load_args(pk_);
    const int tid = tid_local(), qr = tid >> 3, map = (tid >> 2) & 1, dc = tid & 3;
    const int qb = item & 31, h = (item >> 5) & 7, b = item >> 8, q0 = qb * 64, qi = q0 + qr;
    const bf16_t* U = WSP(bf16_t, WS_U); const size_t rbase = (size_t)b * SEQ;
    LAS float* bt = (LAS float*)(lds + 16384);
    if (tid <= 128) bt[tid] = p.rel_bias[t5_bucket(tid) * 8 + h] * 1.4426950408889634f;
    float q[64];
    { const u32x4* qp = (const u32x4*)(U + (rbase + qi) * NU + UQ + h * 128 + map * 64);
#pragma unroll
      for (int i = 0; i < 8; ++i) { const u32x4 w = qp[i]; q[8 * i] = bf_lo(w.x); q[8 * i + 1] = bf_hi(w.x); q[8 * i + 2] = bf_lo(w.y); q[8 * i + 3] = bf_hi(w.y); q[8 * i + 4] = bf_lo(w.z); q[8 * i + 5] = bf_hi(w.z); q[8 * i + 6] = bf_lo(w.w); q[8 * i + 7] = bf_hi(w.w); } }
    float o[32];
#pragma unroll
    for (int c = 0; c < 32; ++c) o[c] = 0.f;
    float mrun = -INFINITY, lrun = 0.f;
    const int ntile = q0 / 32 + 2;
    for (int kt = 0; kt < ntile; ++kt) {
        const int k0 = kt * 32;
        __syncthreads();
        { const int key = tid >> 4, pc = tid & 15; const bf16_t* urow = U + (rbase + k0 + key) * NU;
          *(LAS u32x4*)(lds + (pc >> 3) * 4096 + key * 128 + (pc & 7) * 16) = *(const u32x4*)(urow + UK + h * 128 + pc * 8);
          *(LAS u32x4*)(lds + 8192 + key * 256 + pc * 16) = *(const u32x4*)(urow + UV + h * 128 + pc * 8); }
        __syncthreads();
#pragma unroll 1
        for (int j = 0; j < 32; ++j) {
            const int dist = qi - (k0 + j);
            const LAS u32x4* kp = (const LAS u32x4*)(lds + map * 4096 + j * 128); float a = 0.f;
#pragma unroll
            for (int i = 0; i < 8; ++i) { const u32x4 w = kp[i]; a += q[8 * i] * bf_lo(w.x) + q[8 * i + 1] * bf_hi(w.x) + q[8 * i + 2] * bf_lo(w.y) + q[8 * i + 3] * bf_hi(w.y) + q[8 * i + 4] * bf_lo(w.z) + q[8 * i + 5] * bf_hi(w.z) + q[8 * i + 6] * bf_lo(w.w) + q[8 * i + 7] * bf_hi(w.w); }
            if (dist >= 0) {
                a += bt[min(dist, 128)];
                if (a > mrun) { const float sc = __builtin_amdgcn_exp2f(mrun - a); mrun = a; lrun *= sc;
#pragma unroll
                    for (int c = 0; c < 32; ++c) o[c] *= sc; }
                const float pj = __builtin_amdgcn_exp2f(a - mrun); lrun += pj; const LAS u32x4* vp = (const LAS u32x4*)(lds + 8192 + j * 256 + dc * 64);
#pragma unroll
                for (int i = 0; i < 4; ++i) { const u32x4 w = vp[i]; o[8 * i] += pj * bf_lo(w.x); o[8 * i + 1] += pj * bf_hi(w.x); o[8 * i + 2] += pj * bf_lo(w.y); o[8 * i + 3] += pj * bf_hi(w.y); o[8 * i + 4] += pj * bf_lo(w.z); o[8 * i + 5] += pj * bf_hi(w.z); o[8 * i + 6] += pj * bf_lo(w.w); o[8 * i + 7] += pj * bf_hi(w.w); }
            }
        }
    }
    const float lam = *WSP(float, WS_MISC + MS_LAM), inv = 1.f / lrun;
    float ss = 0.f;
#pragma unroll
    for (int c = 0; c < 32; ++c) { const float mine = o[c] * inv, other = __shfl_xor(mine, 4); o[c] = mine - lam * other; ss += o[c] * o[c]; }
    ss += __shfl_xor(ss, 1); ss += __shfl_xor(ss, 2);
    const float rs = rsqrtf(ss * (1.f / 128.f) + LN_EPS) * 0.8f;
    if (map == 0) { bf16_t* yp = WSP(bf16_t, WS_Y) + (rbase + qi) * 3072 + h * 128 + dc * 32; const float* gp = p.subln_g + dc * 32;
#pragma unroll
        for (int i = 0; i < 4; ++i) { u32x4 w; w.x = cvt_pk_bf16(o[8 * i] * rs * gp[8 * i], o[8 * i + 1] * rs * gp[8 * i + 1]); w.y = cvt_pk_bf16(o[8 * i + 2] * rs * gp[8 * i + 2], o[8 * i + 3] * rs * gp[8 * i + 3]);
            w.z = cvt_pk_bf16(o[8 * i + 4] * rs * gp[8 * i + 4], o[8 * i + 5] * rs * gp[8 * i + 5]); w.w = cvt_pk_bf16(o[8 * i + 6] * rs * gp[8 * i + 6], o[8 * i + 7] * rs * gp[8 * i + 7]); *(u32x4*)(yp + 8 * i) = w; } }
    __syncthreads();
}

DI void xattn_naive_item(PP pk_, int g, int item, LAS unsigned char* lds) { const P p = load_args(pk_);
    const int tid = tid_local(), lane = tid & 63, wave = tid >> 6;
    const int qb = item & 63, h = (item >> 6) & 3, b = item >> 8;
    const bf16_t* U = WSP(bf16_t, WS_U); const bf16_t* KV = WSP(bf16_t, WS_KVM) + (size_t)(g * BG + b) * 256 * 2048;
    const size_t r0 = (size_t)b * SEQ + qb * 32;
    LAS float* qs = (LAS float*)lds; LAS float* ps = (LAS float*)(lds + 32768);
    __syncthreads();
    for (int i = tid; i < 32 * 32; i += 512) { const int r = i >> 5, c8 = i & 31; const u32x4 w = *(const u32x4*)(U + (r0 + r) * NU + UCQ + h * 256 + c8 * 8); LAS float* d = qs + r * 256 + c8 * 8;
        d[0] = bf_lo(w.x); d[1] = bf_hi(w.x); d[2] = bf_lo(w.y); d[3] = bf_hi(w.y); d[4] = bf_lo(w.z); d[5] = bf_hi(w.z); d[6] = bf_lo(w.w); d[7] = bf_hi(w.w); }
    __syncthreads();
    const int mcol = tid & 255, rh = tid >> 8;
    { float a[16];
#pragma unroll
      for (int r = 0; r < 16; ++r) a[r] = 0.f;
      const bf16_t* kp = KV + (size_t)mcol * 2048 + h * 256;
      for (int d0 = 0; d0 < 256; d0 += 8) { const u32x4 w = *(const u32x4*)(kp + d0); float kv[8] = {bf_lo(w.x), bf_hi(w.x), bf_lo(w.y), bf_hi(w.y), bf_lo(w.z), bf_hi(w.z), bf_lo(w.w), bf_hi(w.w)};
#pragma unroll
          for (int r = 0; r < 16; ++r) { const LAS f32x4* qp = (const LAS f32x4*)(qs + (rh * 16 + r) * 256 + d0); const f32x4 qa = qp[0], qc = qp[1];
              a[r] += qa[0] * kv[0] + qa[1] * kv[1] + qa[2] * kv[2] + qa[3] * kv[3] + qc[0] * kv[4] + qc[1] * kv[5] + qc[2] * kv[6] + qc[3] * kv[7]; } }
#pragma unroll
      for (int r = 0; r < 16; ++r) ps[(rh * 16 + r) * 256 + mcol] = a[r]; }
    __syncthreads();
#pragma unroll
    for (int rr = 0; rr < 4; ++rr) { const int r = wave * 4 + rr; LAS f32x4* pr = (LAS f32x4*)(ps + r * 256) + lane; f32x4 v = *pr;
        const float mx = wave_max(fmaxf(fmaxf(v[0], v[1]), fmaxf(v[2], v[3])));
        v = (f32x4){__builtin_amdgcn_exp2f(v[0] - mx), __builtin_amdgcn_exp2f(v[1] - mx), __builtin_amdgcn_exp2f(v[2] - mx), __builtin_amdgcn_exp2f(v[3] - mx)};
        const float inv = 1.f / wave_sum((v[0] + v[1]) + (v[2] + v[3])); *pr = v * inv; }
    __syncthreads();
    { float a[16];
#pragma unroll
      for (int r = 0; r < 16; ++r) a[r] = 0.f;
      const bf16_t* vp = KV + 1024 + h * 256 + mcol;
      for (int m = 0; m < 256; ++m) { const float vv = bf2f(vp[(size_t)m * 2048]);
#pragma unroll
          for (int r = 0; r < 16; ++r) a[r] += ps[(rh * 16 + r) * 256 + m] * vv; }
      bf16_t* yp = WSP(bf16_t, WS_Y) + (r0 + rh * 16) * 3072 + 2048 + h * 256 + mcol;
#pragma unroll
      for (int r = 0; r < 16; ++r) yp[(size_t)r * 3072] = (bf16_t)(cvt_pk_bf16(a[r], 0.f) & 0xffffu); }
    __syncthreads();
}

DI void mlstm_naive_item(PP pk_, int g, int item, LAS unsigned char* lds) { const P p = load_args(pk_);
    const int tid = tid_local(), v = tid >> 3, kc = tid & 7;
    const int sl = item & 3, h = (item >> 2) & 3, b = item >> 4;
    const bf16_t* U = WSP(bf16_t, WS_U); const float* gif = WSP(float, WS_GIF); float* HT = WSP(float, WS_F32);
    const size_t rbase = (size_t)b * SEQ; const size_t tbase = ((size_t)g * BG + b) * SEQ;
    LAS bf16_t* qs = (LAS bf16_t*)lds; LAS bf16_t* ks = (LAS bf16_t*)(lds + 32768); LAS float* vs = (LAS float*)(lds + 65536); LAS float* gi = (LAS float*)(lds + 81920); LAS float* gf = (LAS float*)(lds + 82176);
    float C[32], nn[32];
#pragma unroll
    for (int i = 0; i < 32; ++i) { C[i] = 0.f; nn[i] = 0.f; }
    float mst = 0.f;
    for (int ch = 0; ch < SEQ / 64; ++ch) {
        __syncthreads();
        for (int i = tid; i < 2 * 64 * 32; i += 512) { const int isk = i >> 11, s = (i >> 5) & 63, c8 = i & 31; const int ts = ch * 64 + s; const int col = (isk ? UMK : UMQ) + h * 256 + c8 * 8;
            float a[8];
#pragma unroll
            for (int e = 0; e < 8; ++e) a[e] = 0.f;
#pragma unroll
            for (int j = 0; j < 4; ++j) { const int tt = ts - 3 + j; if (tt >= 0) { const u32x4 w = *(const u32x4*)(U + (rbase + tt) * NU + col); const float* cw = p.conv_w + j * 2048 + isk * 1024 + h * 256 + c8 * 8;
                    a[0] += cw[0] * bf_lo(w.x); a[1] += cw[1] * bf_hi(w.x); a[2] += cw[2] * bf_lo(w.y); a[3] += cw[3] * bf_hi(w.y); a[4] += cw[4] * bf_lo(w.z); a[5] += cw[5] * bf_hi(w.z); a[6] += cw[6] * bf_lo(w.w); a[7] += cw[7] * bf_hi(w.w); } }
            const float sc = isk ? 0.0625f : 1.f; u32x4 o; o.x = cvt_pk_bf16(silu(a[0]) * sc, silu(a[1]) * sc); o.y = cvt_pk_bf16(silu(a[2]) * sc, silu(a[3]) * sc); o.z = cvt_pk_bf16(silu(a[4]) * sc, silu(a[5]) * sc); o.w = cvt_pk_bf16(silu(a[6]) * sc, silu(a[7]) * sc);
            *(LAS u32x4*)((isk ? ks : qs) + s * 256 + c8 * 8) = o; }
        for (int i = tid; i < 64 * 64; i += 512) { const int s = i >> 6, c = i & 63; vs[i] = bf2f(U[(rbase + ch * 64 + s) * NU + UMV + h * 256 + sl * 64 + c]); }
        if (tid < 64) { gi[tid] = gif[(tbase + ch * 64 + tid) * 8 + h]; gf[tid] = gif[(tbase + ch * 64 + tid) * 8 + 4 + h]; }
        __syncthreads();
        for (int s = 0; s < 64; ++s) {
            const float ip = gi[s], fp = gf[s];
            const float fl = fminf(fp, 0.f) - log1pf(expf(-fabsf(fp)));
            const float mm = fmaxf(fl + mst, ip), fg = expf(fl + mst - mm), ig = expf(ip - mm); mst = mm;
            const float vv = vs[s * 64 + v] * ig;
            const LAS u32x4* kp = (const LAS u32x4*)(ks + s * 256 + kc * 32); const LAS u32x4* qp = (const LAS u32x4*)(qs + s * 256 + kc * 32);
            float num = 0.f, den = 0.f;
#pragma unroll
            for (int c4 = 0; c4 < 4; ++c4) { const u32x4 kw = kp[c4], qw = qp[c4];
#pragma unroll
                for (int e = 0; e < 4; ++e) { const float k0 = bf_lo(kw[e]), k1 = bf_hi(kw[e]), q0 = bf_lo(qw[e]), q1 = bf_hi(qw[e]); const int kk = c4 * 8 + 2 * e;
                    C[kk] = fg * C[kk] + vv * k0; nn[kk] = fg * nn[kk] + ig * k0; num += C[kk] * q0; den += nn[kk] * q0;
                    C[kk + 1] = fg * C[kk + 1] + vv * k1; nn[kk + 1] = fg * nn[kk + 1] + ig * k1; num += C[kk + 1] * q1; den += nn[kk + 1] * q1; } }
            num += __shfl_xor(num, 1); num += __shfl_xor(num, 2); num += __shfl_xor(num, 4);
            den += __shfl_xor(den, 1); den += __shfl_xor(den, 2); den += __shfl_xor(den, 4);
            if (kc == 0) HT[(rbase + ch * 64 + s) * 1024 + h * 256 + sl * 64 + v] = num / fmaxf(fabsf(den), expf(-mst));
        }
    }
    __syncthreads();
}

typedef float f32x16 __attribute__((ext_vector_type(16)));
typedef __bf16 bf16x2_t __attribute__((ext_vector_type(2)));
typedef short s16x4 __attribute__((ext_vector_type(4)));
constexpr float LOG2E = 1.4426950408889634f;
DI unsigned pk_bf16(float a, float b) { const f32x2 v = {a, b}; return __builtin_bit_cast(unsigned, __builtin_convertvector(v, bf16x2_t)); }
DI int crow(int reg, int hh) { return (reg & 3) + 8 * (reg >> 2) + 4 * hh; }
#define MFMA32(a, b, c) __builtin_amdgcn_mfma_f32_32x32x16_bf16((a), (b), (c), 0, 0, 0)
DI bf16x8 tr_pair(const LAS unsigned char* a0, const LAS unsigned char* a1) {
    const s16x4 lo = __builtin_amdgcn_ds_read_tr16_b64_v4i16((LAS s16x4*)a0), hi = __builtin_amdgcn_ds_read_tr16_b64_v4i16((LAS s16x4*)a1);
    return __builtin_shufflevector(lo, hi, 0, 1, 2, 3, 4, 5, 6, 7);
}
DI bf16x8 pack_half(const f32x16& x, int s2) {
    u32x4 w;
#pragma unroll
    for (int k = 0; k < 4; ++k) w[k] = pk_bf16(x[8 * s2 + 2 * k], x[8 * s2 + 2 * k + 1]);
    return __builtin_bit_cast(bf16x8, w);
}
DI float xhalf_max(float x) { const auto r = __builtin_amdgcn_permlane32_swap(__builtin_bit_cast(int, x), __builtin_bit_cast(int, x), false, false); return fmaxf(__builtin_bit_cast(float, (int)r[0]), __builtin_bit_cast(float, (int)r[1])); }
DI float xhalf_sum(float x) { const auto r = __builtin_amdgcn_permlane32_swap(__builtin_bit_cast(int, x), __builtin_bit_cast(int, x), false, false); return __builtin_bit_cast(float, (int)r[0]) + __builtin_bit_cast(float, (int)r[1]); }
DI int next_item(unsigned* ctr, LAS unsigned char* lds) {
    volatile LAS int* slot = (volatile LAS int*)(lds + LDS_MISC + 64);
    __syncthreads();
    if (threadIdx.x == 0) *slot = (int)__hip_atomic_fetch_add(ctr, 1u, __ATOMIC_RELAXED, __HIP_MEMORY_SCOPE_AGENT);
    __syncthreads();
    return *slot;
}

constexpr int AT_KPITCH = 144, AT_VPITCH = 320, AT_KBYTES = 64 * AT_KPITCH, AT_VOFF = 2 * AT_KBYTES, AT_BUF = AT_VOFF + 64 * AT_VPITCH, AT_BT = 2 * AT_BUF;
DI void attn_tile(const LAS unsigned char* buf, int k0, int qw, int r, int hh, unsigned ka, unsigned va, const LAS float* bt, float cfar, const bf16x8 (&qf)[4], f32x16 (&O)[4], float& mrun, float& lrun) {
    if (k0 <= qw + 31) {
            const bool far = (qw - k0 - 63) >= 128;
            f32x16 S[2];
#pragma unroll
            for (int sub = 0; sub < 2; ++sub)
#pragma unroll
                for (int i = 0; i < 16; ++i) S[sub][i] = far ? cfar : 0.f;
#pragma unroll
            for (int sub = 0; sub < 2; ++sub)
#pragma unroll
                for (int s = 0; s < 4; ++s) S[sub] = MFMA32(*(const LAS bf16x8*)(buf + ka + sub * 32 * AT_KPITCH + s * 32), qf[s], S[sub]);
            if (!far) {
#pragma unroll
                for (int sub = 0; sub < 2; ++sub)
#pragma unroll
                    for (int i = 0; i < 16; ++i) { const int dist = (qw + r) - (k0 + sub * 32 + crow(i, hh)); S[sub][i] = dist < 0 ? -INFINITY : S[sub][i] + bt[min(dist, 128)]; }
            }
            float mx = fmaxf(S[0][0], S[1][0]);
#pragma unroll
            for (int i = 1; i < 16; ++i) mx = fmaxf(mx, fmaxf(S[0][i], S[1][i]));
            mx = xhalf_max(mx);
            const float mnew = fmaxf(mrun, mx);
            if (__builtin_amdgcn_ballot_w64(mnew > mrun) != 0ull) { const float alpha = __builtin_amdgcn_exp2f(mrun - mnew); lrun *= alpha;
#pragma unroll
                for (int dt = 0; dt < 4; ++dt) O[dt] *= alpha; }
            mrun = mnew;
#pragma unroll
            for (int sub = 0; sub < 2; ++sub)
#pragma unroll
                for (int i = 0; i < 16; ++i) { S[sub][i] = __builtin_amdgcn_exp2f(S[sub][i] - mnew); lrun += S[sub][i]; }
#pragma unroll
            for (int sub = 0; sub < 2; ++sub)
#pragma unroll
                for (int s2 = 0; s2 < 2; ++s2) { const bf16x8 pb = pack_half(S[sub], s2); const LAS unsigned char* vb = buf + va + (sub * 32 + 16 * s2) * AT_VPITCH;
#pragma unroll
                    for (int dt = 0; dt < 4; ++dt) O[dt] = MFMA32(tr_pair(vb + dt * 64, vb + dt * 64 + 8 * AT_VPITCH), pb, O[dt]); }
        }
}
DI void attn_mfma_item(PP pk_, int item, LAS unsigned char* lds) { const P p = load_args(pk_);
    const int tid = tid_local(), lane = tid & 63, wave = __builtin_amdgcn_readfirstlane(tid >> 6), mp = wave & 1, rq = wave >> 1, hh = lane >> 5, r = lane & 31;
    const int qb = item & 15, h = (item >> 4) & 7, b = item >> 7;
    const int q0 = qb * 128, qw = q0 + rq * 32, nt = 2 * qb + 2;
    const bf16_t* U = WSP(bf16_t, WS_U); const size_t rbase = (size_t)b * SEQ;
    LAS float* bt = (LAS float*)(lds + AT_BT);
    __syncthreads();
    if (tid <= 128) bt[tid] = p.rel_bias[t5_bucket(tid) * 8 + h] * LOG2E;
    bf16x8 qf[4];
    { const bf16_t* qp = U + (rbase + qw + r) * NU + UQ + h * 128 + mp * 64 + 8 * hh;
#pragma unroll
      for (int s = 0; s < 4; ++s) qf[s] = *(const bf16x8*)(qp + 16 * s); }
    f32x16 O[4];
#pragma unroll
    for (int dt = 0; dt < 4; ++dt)
#pragma unroll
        for (int i = 0; i < 16; ++i) O[dt][i] = 0.f;
    float mrun = -INFINITY, lrun = 0.f;
    const int row0 = tid >> 4, c16 = tid & 15;
    const bf16_t* gk = U + (rbase + row0) * NU + UK + h * 128 + c16 * 8;
    const bf16_t* gv = U + (rbase + row0) * NU + UV + h * 128 + c16 * 8;
    const unsigned lk = (c16 >> 3) * AT_KBYTES + row0 * AT_KPITCH + (c16 & 7) * 16, lv = AT_VOFF + row0 * AT_VPITCH + c16 * 16;
    u32x4 st[4];
#define AT_LOAD(t_) do { const size_t o_ = (size_t)(t_) * 64 * NU; st[0] = *(const u32x4*)(gk + o_); st[1] = *(const u32x4*)(gk + o_ + (size_t)32 * NU); st[2] = *(const u32x4*)(gv + o_); st[3] = *(const u32x4*)(gv + o_ + (size_t)32 * NU); } while (0)
#define AT_STORE(bufp) do { *(LAS u32x4*)((bufp) + lk) = st[0]; *(LAS u32x4*)((bufp) + lk + 32 * AT_KPITCH) = st[1]; *(LAS u32x4*)((bufp) + lv) = st[2]; *(LAS u32x4*)((bufp) + lv + 32 * AT_VPITCH) = st[3]; } while (0)
    AT_LOAD(0); AT_STORE(lds); __syncthreads();
    const float cfar = bt[128];
    const unsigned ka = mp * AT_KBYTES + r * AT_KPITCH + hh * 16;
    const int i16 = lane & 15;
    const unsigned va = AT_VOFF + (4 * hh + (i16 >> 2)) * AT_VPITCH + (16 * ((lane >> 4) & 1) + 4 * (i16 & 3)) * 2;
    u32x4 st2[4];
#define AT_LOAD2(t_) do { const size_t o_ = (size_t)(t_) * 64 * NU; st2[0] = *(const u32x4*)(gk + o_); st2[1] = *(const u32x4*)(gk + o_ + (size_t)32 * NU); st2[2] = *(const u32x4*)(gv + o_); st2[3] = *(const u32x4*)(gv + o_ + (size_t)32 * NU); } while (0)
#define AT_STORE2(bufp) do { *(LAS u32x4*)((bufp) + lk) = st2[0]; *(LAS u32x4*)((bufp) + lk + 32 * AT_KPITCH) = st2[1]; *(LAS u32x4*)((bufp) + lv) = st2[2]; *(LAS u32x4*)((bufp) + lv + 32 * AT_VPITCH) = st2[3]; } while (0)
    AT_LOAD2(1);
    for (int t = 0; t < nt; t += 2) {
        if (t + 2 < nt) AT_LOAD(t + 2);
        attn_tile(lds, t * 64, qw, r, hh, ka, va, bt, cfar, qf, O, mrun, lrun);
        AT_STORE2(lds + AT_BUF);
        lds_barrier();
        if (t + 3 < nt) AT_LOAD2(t + 3);
        attn_tile(lds + AT_BUF, t * 64 + 64, qw, r, hh, ka, va, bt, cfar, qf, O, mrun, lrun);
        if (t + 2 < nt) AT_STORE(lds);
        lds_barrier();
    }
#undef AT_LOAD2
#undef AT_STORE2
#undef AT_LOAD
#undef AT_STORE
    const float inv = 1.f / xhalf_sum(lrun);
    LAS float* X = (LAS float*)lds;
    if (mp == 1) {
#pragma unroll
        for (int dt = 0; dt < 4; ++dt)
#pragma unroll
            for (int i = 0; i < 16; ++i) X[(rq * 64 + dt * 16 + i) * 64 + lane] = O[dt][i] * inv;
    }
    __syncthreads();
    if (mp == 0) {
        const float lam = *WSP(float, WS_MISC + MS_LAM); float ss = 0.f;
#pragma unroll
        for (int dt = 0; dt < 4; ++dt)
#pragma unroll
            for (int i = 0; i < 16; ++i) { const float v = O[dt][i] * inv - lam * X[(rq * 64 + dt * 16 + i) * 64 + lane]; O[dt][i] = v; ss += v * v; }
        ss = xhalf_sum(ss);
        const float rs = rsqrtf(ss * (1.f / 128.f) + LN_EPS) * 0.8f;
        bf16_t* yp = WSP(bf16_t, WS_Y) + (rbase + qw + r) * 3072 + h * 128;
#pragma unroll
        for (int dt = 0; dt < 4; ++dt)
#pragma unroll
            for (int g4 = 0; g4 < 4; ++g4) { const int dv = dt * 32 + 8 * g4 + 4 * hh; const f32x4 gn = *(const f32x4*)(p.subln_g + dv);
                u32x2 w; w.x = pk_bf16(O[dt][4 * g4] * rs * gn[0], O[dt][4 * g4 + 1] * rs * gn[1]); w.y = pk_bf16(O[dt][4 * g4 + 2] * rs * gn[2], O[dt][4 * g4 + 3] * rs * gn[3]);
                *(u32x2*)(yp + dv) = w; }
    }
}
DI void ph_conv(PP pk_, int g, LAS unsigned char* lds) { const P p = load_args(pk_);
    const int tid = tid_local();
    const bf16_t* U = WSP(bf16_t, WS_U); bf16_t* QKC = WSP(bf16_t, WS_QKC);
    for (int t = blockIdx.x * 512 + tid; t < (TG / 32) * 256; t += gridDim.x * 512) {
        const int c8 = t & 255, r0 = (t >> 8) * 32, isk = c8 >> 7; const float sc = isk ? 0.0625f : 1.f;
        f32x4 cw[4][2];
#pragma unroll
        for (int j = 0; j < 4; ++j) { cw[j][0] = *(const f32x4*)(p.conv_w + j * 2048 + c8 * 8); cw[j][1] = *(const f32x4*)(p.conv_w + j * 2048 + c8 * 8 + 4); }
        const bf16_t* src = U + (size_t)r0 * NU + UMQ + c8 * 8; bf16_t* dst = QKC + (size_t)r0 * 2048 + c8 * 8;
        const bool head = (r0 & (SEQ - 1)) == 0;
        u32x4 x0 = {0u, 0u, 0u, 0u}, x1 = x0, x2 = x0, x3;
        if (!head) { x0 = *(const u32x4*)(src - 3 * (size_t)NU); x1 = *(const u32x4*)(src - 2 * (size_t)NU); x2 = *(const u32x4*)(src - (size_t)NU); }
#define CONV_OUT(a_, b_, c_, d_, row_) do { float o_[8]; \
        o_[0] = cw[0][0][0] * bf_lo(a_.x) + cw[1][0][0] * bf_lo(b_.x) + cw[2][0][0] * bf_lo(c_.x) + cw[3][0][0] * bf_lo(d_.x); \
        o_[1] = cw[0][0][1] * bf_hi(a_.x) + cw[1][0][1] * bf_hi(b_.x) + cw[2][0][1] * bf_hi(c_.x) + cw[3][0][1] * bf_hi(d_.x); \
        o_[2] = cw[0][0][2] * bf_lo(a_.y) + cw[1][0][2] * bf_lo(b_.y) + cw[2][0][2] * bf_lo(c_.y) + cw[3][0][2] * bf_lo(d_.y); \
        o_[3] = cw[0][0][3] * bf_hi(a_.y) + cw[1][0][3] * bf_hi(b_.y) + cw[2][0][3] * bf_hi(c_.y) + cw[3][0][3] * bf_hi(d_.y); \
        o_[4] = cw[0][1][0] * bf_lo(a_.z) + cw[1][1][0] * bf_lo(b_.z) + cw[2][1][0] * bf_lo(c_.z) + cw[3][1][0] * bf_lo(d_.z); \
        o_[5] = cw[0][1][1] * bf_hi(a_.z) + cw[1][1][1] * bf_hi(b_.z) + cw[2][1][1] * bf_hi(c_.z) + cw[3][1][1] * bf_hi(d_.z); \
        o_[6] = cw[0][1][2] * bf_lo(a_.w) + cw[1][1][2] * bf_lo(b_.w) + cw[2][1][2] * bf_lo(c_.w) + cw[3][1][2] * bf_lo(d_.w); \
        o_[7] = cw[0][1][3] * bf_hi(a_.w) + cw[1][1][3] * bf_hi(b_.w) + cw[2][1][3] * bf_hi(c_.w) + cw[3][1][3] * bf_hi(d_.w); \
        u32x4 w_; w_.x = pk_bf16(silu(o_[0]) * sc, silu(o_[1]) * sc); w_.y = pk_bf16(silu(o_[2]) * sc, silu(o_[3]) * sc); w_.z = pk_bf16(silu(o_[4]) * sc, silu(o_[5]) * sc); w_.w = pk_bf16(silu(o_[6]) * sc, silu(o_[7]) * sc); \
        *(u32x4*)(dst + (size_t)(row_) * 2048) = w_; } while (0)
#pragma unroll 1
        for (int i = 0; i < 32; i += 4) {
            const u32x4 y0 = *(const u32x4*)(src + (size_t)(i) * NU), y1 = *(const u32x4*)(src + (size_t)(i + 1) * NU), y2 = *(const u32x4*)(src + (size_t)(i + 2) * NU), y3 = *(const u32x4*)(src + (size_t)(i + 3) * NU);
            x3 = y0; CONV_OUT(x0, x1, x2, x3, i);
            CONV_OUT(x1, x2, y0, y1, i + 1);
            CONV_OUT(x2, y0, y1, y2, i + 2);
            CONV_OUT(y0, y1, y2, y3, i + 3);
            x0 = y1; x1 = y2; x2 = y3;
        }
#undef CONV_OUT
    }
}
constexpr int ML_QP = 528, ML_KP = 576, ML_VP = 576, ML_WP = 144;
constexpr int ML_Q = 0, ML_K = ML_Q + 64 * ML_QP, ML_V = ML_K + 64 * ML_KP, ML_W = ML_V + 64 * ML_VP, ML_TAB = ML_W + 64 * ML_WP;
constexpr int T_BCUM = 0, T_A = 256, T_MROW = 512, T_IW = 768, T_WS = 1024, T_RS = 1280, T_ND = 2304, T_GI = 2560, T_GF = 2816, T_N = 3072, T_SC = 4096, T_INVD = 4352, T_NP = 4608;
static_assert(ML_TAB + 4608 + 2048 <= LDS_RING, "mLSTM LDS map");
#ifndef PROBE_ML_SKIP
#define PROBE_ML_SKIP 0
#endif
DI void mlstm_mfma_item(PP pk_, int g, int item, int rep, LAS unsigned char* lds) { const P p = load_args(pk_);
    const int skip = rep > 0 ? PROBE_ML_SKIP : 0;
    const int tid0 = tid_local(), w = __builtin_amdgcn_readfirstlane(tid0 >> 6);
    const int h = item & 3, b = item >> 2;
    const bf16_t* U = WSP(bf16_t, WS_U); const float* gif = WSP(float, WS_GIF); bf16_t* HB = rep > 0 && PROBE_ML_SKIP ? WSP(bf16_t, WS_Z) : WSP(bf16_t, WS_MRG);
    const size_t rbase = (size_t)b * SEQ, tbase = ((size_t)g * BG + b) * SEQ;
    LAS unsigned char* TB = lds + ML_TAB;
#define TABF(off) ((LAS float*)(TB + (off)))
    f32x16 C[8];
#pragma unroll
    for (int kt = 0; kt < 8; ++kt)
#pragma unroll
        for (int i = 0; i < 16; ++i) C[kt][i] = 0.f;
    float mst = 0.f;
    __syncthreads();
    if (tid0 < 256) TABF(T_N)[tid0] = 0.f;
    const bf16_t* QKC = WSP(bf16_t, WS_QKC);
    u32x4 pf[4];
#define ML_PREFETCH(ch_, tv_) do { _Pragma("unroll") for (int i_ = 0; i_ < 4; ++i_) { const int pc_ = (tv_) + 512 * i_, s_ = pc_ >> 5, cc_ = pc_ & 31; const size_t row_ = rbase + (ch_) * 64 + s_; \
        pf[i_] = *(const u32x4*)(QKC + row_ * 2048 + h * 256 + cc_ * 8); } \
        } while (0)
    ML_PREFETCH(0, tid0);
    for (int ch = 0; ch < SEQ / 64; ++ch) {
        int tid = tid0; asm volatile("" : "+v"(tid));
        const int lane = tid & 63, hh = lane >> 5, r = lane & 31, i16 = lane & 15, l4 = lane >> 4;
        lds_barrier();
        {
#pragma unroll
            for (int i = 0; i < 4; ++i) { const int pc = tid + 512 * i, s = pc >> 5, cc = pc & 31;
                *(LAS u32x4*)(lds + ML_Q + s * ML_QP + cc * 16) = pf[i];
                *(LAS u32x4*)(lds + ML_K + s * ML_KP + cc * 16) = *(const u32x4*)(QKC + (rbase + ch * 64 + s) * 2048 + 1024 + h * 256 + cc * 8); }
            if (tid < 64) { TABF(T_GI)[tid] = gif[(tbase + ch * 64 + tid) * 8 + h]; TABF(T_GF)[tid] = gif[(tbase + ch * 64 + tid) * 8 + 4 + h]; }
        }
        u32x4 vf[4];
#pragma unroll
        for (int i = 0; i < 4; ++i) { const int pc = tid + 512 * i, s = pc >> 5, cc = pc & 31; vf[i] = *(const u32x4*)(U + (rbase + ch * 64 + s) * NU + UMV + h * 256 + cc * 8); }
        lds_barrier();
        if (w == 0 && !(skip & 16)) {
            const float ip = TABF(T_GI)[lane], fp = TABF(T_GF)[lane];
            float bc = fminf(fp, 0.f) - log1pf(expf(-fabsf(fp)));
#pragma unroll
            for (int o = 1; o < 64; o <<= 1) { const float t = __shfl_up(bc, o); if (lane >= o) bc += t; }
            const float aa = ip - bc; float pm = aa;
#pragma unroll
            for (int o = 1; o < 64; o <<= 1) { const float t = __shfl_up(pm, o); if (lane >= o) pm = fmaxf(pm, t); }
            const float mrow = bc + fmaxf(mst, pm), iw = expf(bc + mst - mrow);
            const float total = __shfl(bc, 63), amax = __shfl(pm, 63), mnew = total + fmaxf(mst, amax), decay = expf(total + mst - mnew), ws = expf(total + aa - mnew);
            TABF(T_BCUM)[lane] = bc; TABF(T_A)[lane] = aa; TABF(T_MROW)[lane] = mrow; TABF(T_IW)[lane] = iw; TABF(T_WS)[lane] = ws;
            if (lane == 0) TABF(T_SC)[1] = decay;
            mst = mnew;
        }
        f32x4 S2[2];
#pragma unroll
        for (int tt = 0; tt < 2; ++tt) { const int tile = 2 * w + tt, jt = tile >> 2, st = tile & 3; f32x4 s = {0.f, 0.f, 0.f, 0.f};
            const LAS unsigned char* qa = lds + ML_Q + (jt * 16 + i16) * ML_QP + l4 * 16; const LAS unsigned char* ka = lds + ML_K + (st * 16 + i16) * ML_KP + l4 * 16;
#pragma unroll
            for (int c = 0; c < 8; ++c) s = __builtin_amdgcn_mfma_f32_16x16x32_bf16(*(const LAS bf16x8*)(qa + c * 64), *(const LAS bf16x8*)(ka + c * 64), s, 0, 0, 0);
            S2[tt] = s; }
        { const f32x4 nv = *(const LAS f32x4*)(TABF(T_N) + 4 * lane);
#pragma unroll
          for (int jj = 0; jj < 8; ++jj) { const int j = 8 * w + jj; const u32x2 qw = *(const LAS u32x2*)(lds + ML_Q + j * ML_QP + lane * 8);
              const float d = wave_sum_fast(bf_lo(qw.x) * nv[0] + bf_hi(qw.x) * nv[1] + bf_lo(qw.y) * nv[2] + bf_hi(qw.y) * nv[3]); if (lane == 0) TABF(T_ND)[j] = d; } }
#pragma unroll
        for (int i = 0; i < 4; ++i) { const int pc = tid + 512 * i, s = pc >> 5, cc = pc & 31; *(LAS u32x4*)(lds + ML_V + s * ML_VP + cc * 16) = vf[i]; }
        lds_barrier();
#pragma unroll
        for (int tt = 0; tt < 2; ++tt) { const int tile = 2 * w + tt, jt = tile >> 2, st = tile & 3, s = st * 16 + i16; const float as = TABF(T_A)[s];
#pragma unroll
            for (int rg = 0; rg < 4; ++rg) { const int j = jt * 16 + l4 * 4 + rg;
                float val = s <= j ? __expf(TABF(T_BCUM)[j] + as - TABF(T_MROW)[j]) * S2[tt][rg] : 0.f;
                *(LAS bf16_t*)(lds + ML_W + j * ML_WP + s * 2) = (bf16_t)(pk_bf16(val, 0.f) & 0xffffu);
                val = row16_sum(val);
                if (i16 == 0) TABF(T_RS)[j * 4 + st] = val; } }
        lds_barrier();
        if (tid < 64) { const int j = tid; const f32x4 rs = *(const LAS f32x4*)(TABF(T_RS) + 4 * j);
            const float den = TABF(T_IW)[j] * TABF(T_ND)[j] + ((rs[0] + rs[1]) + (rs[2] + rs[3]));
            TABF(T_INVD)[j] = 1.f / fmaxf(fabsf(den), expf(-TABF(T_MROW)[j])); }
        f32x16 acc[2];
#pragma unroll
        for (int jt2 = 0; jt2 < 2; ++jt2)
#pragma unroll
            for (int i = 0; i < 16; ++i) acc[jt2][i] = 0.f;
        const unsigned vtr = ML_V + (8 * hh + (i16 >> 2)) * ML_VP + (32 * w + 16 * (l4 & 1) + 4 * (i16 & 3)) * 2;
        if (!(skip & 4)) {
#pragma unroll
        for (int kt = 0; kt < 8; ++kt) { __builtin_amdgcn_sched_barrier(0);
#pragma unroll
            for (int s = 0; s < 2; ++s) { const bf16x8 bfr = pack_half(C[kt], s);
#pragma unroll
                for (int jt2 = 0; jt2 < 2; ++jt2) { const LAS unsigned char* qa = lds + ML_Q + (jt2 * 32 + r) * ML_QP + (kt * 32 + 16 * s + 4 * hh) * 2;
                    const s16x4 lo = *(const LAS s16x4*)qa, hi = *(const LAS s16x4*)(qa + 16);
                    acc[jt2] = MFMA32(__builtin_shufflevector(lo, hi, 0, 1, 2, 3, 4, 5, 6, 7), bfr, acc[jt2]); } } }
        __builtin_amdgcn_sched_barrier(0);
#pragma unroll
        for (int jt2 = 0; jt2 < 2; ++jt2)
#pragma unroll
            for (int i = 0; i < 16; ++i) acc[jt2][i] *= TABF(T_IW)[jt2 * 32 + crow(i, hh)];
#pragma unroll
        for (int ks = 0; ks < 4; ++ks) { const bf16x8 bv = tr_pair(lds + vtr + 16 * ks * ML_VP, lds + vtr + (16 * ks + 4) * ML_VP);
#pragma unroll
            for (int jt2 = 0; jt2 < 2; ++jt2) acc[jt2] = MFMA32(*(const LAS bf16x8*)(lds + ML_W + (jt2 * 32 + r) * ML_WP + (16 * ks + 8 * hh) * 2), bv, acc[jt2]); }
        }
        lds_barrier();
#pragma unroll
        for (int jt2 = 0; jt2 < 2; ++jt2)
#pragma unroll
            for (int i = 0; i < 16; ++i) { const int j = jt2 * 32 + crow(i, hh); *(LAS bf16_t*)(lds + ML_Q + j * 512 + (32 * w + r) * 2) = (bf16_t)(pk_bf16(acc[jt2][i] * TABF(T_INVD)[j], 0.f) & 0xffffu); }
        const float decay = TABF(T_SC)[1];
        if (!(skip & 2)) {
        { const int dk = tid & 255, sh = tid >> 8; float nn = 0.f;
#pragma unroll 8
          for (int s = 32 * sh; s < 32 * sh + 32; ++s) nn += TABF(T_WS)[s] * bf2f(*(const LAS bf16_t*)(lds + ML_K + s * ML_KP + dk * 2));
          TABF(T_NP)[tid] = nn; }
#pragma unroll
        for (int kt = 0; kt < 8; ++kt) C[kt] *= decay;
        const unsigned ktr = ML_K + (8 * hh + (i16 >> 2)) * ML_KP + (16 * (l4 & 1) + 4 * (i16 & 3)) * 2;
#pragma unroll
        for (int ks = 0; ks < 4; ++ks) { __builtin_amdgcn_sched_barrier(0); const bf16x8 bv = tr_pair(lds + vtr + 16 * ks * ML_VP, lds + vtr + (16 * ks + 4) * ML_VP);
            const u32x4 bw = __builtin_bit_cast(u32x4, bv); const f32x4 w0 = *(const LAS f32x4*)(TABF(T_WS) + 16 * ks + 8 * hh), w1 = *(const LAS f32x4*)(TABF(T_WS) + 16 * ks + 8 * hh + 4);
            u32x4 sw; sw.x = pk_bf16(bf_lo(bw.x) * w0[0], bf_hi(bw.x) * w0[1]); sw.y = pk_bf16(bf_lo(bw.y) * w0[2], bf_hi(bw.y) * w0[3]); sw.z = pk_bf16(bf_lo(bw.z) * w1[0], bf_hi(bw.z) * w1[1]); sw.w = pk_bf16(bf_lo(bw.w) * w1[2], bf_hi(bw.w) * w1[3]);
            const bf16x8 bs = __builtin_bit_cast(bf16x8, sw);
#pragma unroll
            for (int kt = 0; kt < 8; ++kt) C[kt] = MFMA32(tr_pair(lds + ktr + 16 * ks * ML_KP + kt * 64, lds + ktr + (16 * ks + 4) * ML_KP + kt * 64), bs, C[kt]); }
        }
        lds_barrier();
        if (tid < 256 && !(skip & 2)) TABF(T_N)[tid] = TABF(T_N)[tid] * TABF(T_SC)[1] + (TABF(T_NP)[tid] + TABF(T_NP)[tid + 256]);
#pragma unroll
        for (int i = 0; i < 4; ++i) { const int pc = tid + 512 * i, s = pc >> 5, cc = pc & 31; *(u32x4*)(HB + (rbase + ch * 64 + s) * 1024 + h * 256 + cc * 8) = *(const LAS u32x4*)(lds + ML_Q + s * 512 + cc * 16); }
        if (ch + 1 < SEQ / 64) ML_PREFETCH(ch + 1, tid);
    }
#undef TABF
#undef ML_PREFETCH
}
constexpr int XA_KP = 528, XA_VP = 576, XA_VOFF = 32 * XA_KP, XA_BUF = XA_VOFF + 32 * XA_VP;
static_assert(2 * XA_BUF <= LDS_RING, "xattn LDS map");
DI void xattn_tile(const LAS unsigned char* buf, unsigned ka, unsigned va, const bf16x8 (&qf)[16], f32x16 (&O)[4], float& mrun, float& lrun) {
        f32x16 S;
#pragma unroll
        for (int i = 0; i < 16; ++i) S[i] = 0.f;
#pragma unroll
        for (int s = 0; s < 16; ++s) S = MFMA32(*(const LAS bf16x8*)(buf + ka + s * 32), qf[s], S);
        float mx = S[0];
#pragma unroll
        for (int i = 1; i < 16; ++i) mx = fmaxf(mx, S[i]);
        mx = xhalf_max(mx);
        const float mnew = fmaxf(mrun, mx);
        if (__builtin_amdgcn_ballot_w64(mnew > mrun) != 0ull) { const float alpha = __builtin_amdgcn_exp2f(mrun - mnew); lrun *= alpha;
#pragma unroll
            for (int dt = 0; dt < 4; ++dt) O[dt] *= alpha; }
        mrun = mnew;
#pragma unroll
        for (int i = 0; i < 16; ++i) { S[i] = __builtin_amdgcn_exp2f(S[i] - mnew); lrun += S[i]; }
#pragma unroll
        for (int s2 = 0; s2 < 2; ++s2) { const bf16x8 pb = pack_half(S, s2); const LAS unsigned char* vb = buf + va + 16 * s2 * XA_VP;
#pragma unroll
            for (int dt = 0; dt < 4; ++dt) O[dt] = MFMA32(tr_pair(vb + dt * 64, vb + dt * 64 + 8 * XA_VP), pb, O[dt]); }
}
DI void xattn_mfma_item(PP pk_, int g, int item, LAS unsigned char* lds) { const P p = load_args(pk_);
    const int tid = tid_local(), lane = tid & 63, wave = __builtin_amdgcn_readfirstlane(tid >> 6), dvh = wave & 1, rq = wave >> 1, hh = lane >> 5, r = lane & 31;
    const int qb = item & 15, h = (item >> 4) & 3, b = item >> 6;
    const bf16_t* U = WSP(bf16_t, WS_U); const bf16_t* KV = WSP(bf16_t, WS_KVM) + (size_t)(g * BG + b) * 256 * 2048 + h * 256;
    const size_t qrow = (size_t)b * SEQ + qb * 128 + rq * 32 + r;
    bf16x8 qf[16];
    { const bf16_t* qp = U + qrow * NU + UCQ + h * 256 + 8 * hh;
#pragma unroll
      for (int s = 0; s < 16; ++s) qf[s] = *(const bf16x8*)(qp + 16 * s); }
    f32x16 O[4];
#pragma unroll
    for (int dt = 0; dt < 4; ++dt)
#pragma unroll
        for (int i = 0; i < 16; ++i) O[dt][i] = 0.f;
    float mrun = -INFINITY, lrun = 0.f;
    const int row0 = tid >> 5, c32 = tid & 31;
    const bf16_t* gk = KV + (size_t)row0 * 2048 + c32 * 8;
    const unsigned lk = row0 * XA_KP + c32 * 16, lv = XA_VOFF + row0 * XA_VP + c32 * 16;
    u32x4 st[4];
#define XA_LOAD(t_) do { const bf16_t* s_ = gk + (size_t)(t_) * 32 * 2048; st[0] = *(const u32x4*)s_; st[1] = *(const u32x4*)(s_ + 16 * 2048); st[2] = *(const u32x4*)(s_ + 1024); st[3] = *(const u32x4*)(s_ + 16 * 2048 + 1024); } while (0)
#define XA_STORE(bufp) do { *(LAS u32x4*)((bufp) + lk) = st[0]; *(LAS u32x4*)((bufp) + lk + 16 * XA_KP) = st[1]; *(LAS u32x4*)((bufp) + lv) = st[2]; *(LAS u32x4*)((bufp) + lv + 16 * XA_VP) = st[3]; } while (0)
    __syncthreads();
    XA_LOAD(0); XA_STORE(lds); __syncthreads();
    const unsigned ka = r * XA_KP + hh * 16;
    const int i16 = lane & 15;
    const unsigned va = XA_VOFF + (4 * hh + (i16 >> 2)) * XA_VP + (dvh * 128 + 16 * ((lane >> 4) & 1) + 4 * (i16 & 3)) * 2;
    u32x4 st2[4];
#define XA_LOAD2(t_) do { const bf16_t* s_ = gk + (size_t)(t_) * 32 * 2048; st2[0] = *(const u32x4*)s_; st2[1] = *(const u32x4*)(s_ + 16 * 2048); st2[2] = *(const u32x4*)(s_ + 1024); st2[3] = *(const u32x4*)(s_ + 16 * 2048 + 1024); } while (0)
#define XA_STORE2(bufp) do { *(LAS u32x4*)((bufp) + lk) = st2[0]; *(LAS u32x4*)((bufp) + lk + 16 * XA_KP) = st2[1]; *(LAS u32x4*)((bufp) + lv) = st2[2]; *(LAS u32x4*)((bufp) + lv + 16 * XA_VP) = st2[3]; } while (0)
    XA_LOAD2(1);
#pragma unroll 1
    for (int t = 0; t < 8; t += 2) {
        if (t + 2 < 8) XA_LOAD(t + 2);
        xattn_tile(lds, ka, va, qf, O, mrun, lrun);
        XA_STORE2(lds + XA_BUF);
        lds_barrier();
        if (t + 3 < 8) XA_LOAD2(t + 3);
        xattn_tile(lds + XA_BUF, ka, va, qf, O, mrun, lrun);
        if (t + 2 < 8) XA_STORE(lds);
        lds_barrier();
    }
#undef XA_LOAD2
#undef XA_STORE2
#undef XA_LOAD
#undef XA_STORE
    const float inv = 1.f / xhalf_sum(lrun);
    bf16_t* yp = WSP(bf16_t, WS_Y) + qrow * 3072 + 2048 + h * 256 + dvh * 128;
#pragma unroll
    for (int dt = 0; dt < 4; ++dt)
#pragma unroll
        for (int g4 = 0; g4 < 4; ++g4) { const int dv = dt * 32 + 8 * g4 + 4 * hh;
            u32x2 w; w.x = pk_bf16(O[dt][4 * g4] * inv, O[dt][4 * g4 + 1] * inv); w.y = pk_bf16(O[dt][4 * g4 + 2] * inv, O[dt][4 * g4 + 3] * inv);
            *(u32x2*)(yp + dv) = w; }
}
#ifndef ATTN_NAIVE
#define ATTN_NAIVE 0
#endif
#ifndef XATTN_NAIVE
#define XATTN_NAIVE 0
#endif
#ifndef MLSTM_NAIVE
#define MLSTM_NAIVE 0
#endif
DI void ph_mix(PP pk_, int g, int rep, LAS unsigned char* lds) { const P p = load_args(pk_);
    constexpr int N_ML = BG * 4, N_AT = ATTN_NAIVE ? BG * 8 * 32 : BG * 8 * 16, N_XA = XATTN_NAIVE ? BG * 4 * 64 : BG * 4 * 16;
    unsigned* ctr = WSP(unsigned, WS_CTL) + CW_Q + 64 * (g + NGRP * rep);
#ifndef PROBE_MIX_ONLY
#define PROBE_MIX_ONLY -1
#endif
    for (;;) {
        const int it = next_item(ctr, lds);
        if (it >= N_ML + N_AT + N_XA) break;
        if (rep > 0 && PROBE_MIX_ONLY >= 0) { const int ty = it < N_ML ? 0 : (it < N_ML + N_AT ? 1 : 2); if (ty != PROBE_MIX_ONLY) continue; }
        if (it < N_ML) mlstm_mfma_item(pk_, g, it, rep, lds);
        else if (it < N_ML + N_AT) { const int ix = it - N_ML;
            if (ATTN_NAIVE) attn_naive_item(pk_, N_AT - 1 - ix, lds);
            else attn_mfma_item(pk_, ((ix & 63) << 4) | (15 - (ix >> 6)), lds); }
        else { if (XATTN_NAIVE) xattn_naive_item(pk_, g, it - N_ML - N_AT, lds); else xattn_mfma_item(pk_, g, it - N_ML - N_AT, lds); }
    }
}

DI void ph_mlstm_out(PP pk_, int g, LAS unsigned char* lds) { const P p = load_args(pk_);
    const int tid = tid_local(), lane = tid & 63, wave = tid >> 6, gw = blockIdx.x * 8 + wave, NGW = gridDim.x * 8;
    const bf16_t* HB = WSP(bf16_t, WS_MRG); const bf16_t* U = WSP(bf16_t, WS_U); bf16_t* Y = WSP(bf16_t, WS_Y);
    for (int it = gw; it < TG * 4; it += NGW) { const int r = it >> 2, h = it & 3;
        const u32x2 hw = *((const u32x2*)(HB + (size_t)r * 1024 + h * 256) + lane);
        const f32x4 v = {bf_lo(hw.x), bf_hi(hw.x), bf_lo(hw.y), bf_hi(hw.y)};
        const float mu = wave_sum_fast((v[0] + v[1]) + (v[2] + v[3])) * (1.f / 256.f); const f32x4 d = v - mu;
        const float rstd = rsqrtf(wave_sum_fast((d[0] * d[0] + d[1] * d[1]) + (d[2] * d[2] + d[3] * d[3])) * (1.f / 256.f) + LN_EPS);
        const f32x4 gn = *((const f32x4*)(p.mlstm_norm_g + h * 256) + lane);
        const u32x2 ow = *((const u32x2*)(U + (size_t)r * NU + UMO + h * 256) + lane);
        u32x2 o; o.x = cvt_pk_bf16(d[0] * rstd * gn[0] * sigm(bf_lo(ow.x)), d[1] * rstd * gn[1] * sigm(bf_hi(ow.x))); o.y = cvt_pk_bf16(d[2] * rstd * gn[2] * sigm(bf_lo(ow.y)), d[3] * rstd * gn[3] * sigm(bf_hi(ow.y)));
        *((u32x2*)(Y + (size_t)r * 3072 + 1024 + h * 256) + lane) = o; }
}

DI void ph_ln1(PP pk_, int g, LAS unsigned char* lds) { const P p = load_args(pk_);
    const int tid = tid_local(), lane = tid & 63, wave = tid >> 6, gw = blockIdx.x * 8 + wave, NGW = gridDim.x * 8;
    const float* Z = WSP(float, WS_Z); bf16_t* X1 = WSP(bf16_t, WS_X1B) + (size_t)g * TG * 1024;
    for (int r = gw; r < TG; r += NGW) {
        const f32x4* zr = (const f32x4*)(Z + (size_t)r * 1024) + lane; f32x4 v[4]; float s = 0.f;
#pragma unroll
        for (int j = 0; j < 4; ++j) { v[j] = zr[64 * j]; s += (v[j][0] + v[j][1]) + (v[j][2] + v[j][3]); }
        const float mu = wave_sum(s) * (1.f / 1024.f); float s2 = 0.f;
#pragma unroll
        for (int j = 0; j < 4; ++j) { v[j] = v[j] - mu; s2 += (v[j][0] * v[j][0] + v[j][1] * v[j][1]) + (v[j][2] * v[j][2] + v[j][3] * v[j][3]); }
        const float rstd = rsqrtf(wave_sum(s2) * (1.f / 1024.f) + LN_EPS);
        u32x2* d = (u32x2*)(X1 + (size_t)r * 1024) + lane;
#pragma unroll
        for (int j = 0; j < 4; ++j) { const f32x4 gn = *((const f32x4*)p.ln1_g + lane + 64 * j), bb = *((const f32x4*)p.ln1_b + lane + 64 * j); const f32x4 o = v[j] * rstd * gn + bb;
            u32x2 w; w.x = cvt_pk_bf16(o[0], o[1]); w.y = cvt_pk_bf16(o[2], o[3]); d[64 * j] = w; }
    }
}
DI void ph_expert_weights(PP pk_, LAS unsigned char* lds) { const P p = load_args(pk_);
    const int tid = tid_local(), lane = tid & 63, wave = tid >> 6, gw = blockIdx.x * 8 + wave, NGW = gridDim.x * 8;
    LAS float* scr = (LAS float*)(lds + wave * 16384);
    bf16_t* WGU = WSP(bf16_t, WS_WGU); bf16_t* WD = WSP(bf16_t, WS_WD);
    for (int it = gw; it < 257 * 256; it += NGW) { const int e = it >> 8, r = it & 255, isup = r >> 7, kb = (r >> 3) & 15, nb = r & 7;
        const float* W = (e < 256) ? ((isup ? p.w_e_up : p.w_e_gate) + (size_t)e * 1024 * 256) : (isup ? p.w_s_up : p.w_s_gate);
        const int n0 = nb * 32, drow = (n0 >> 7) * 256 + (n0 & 127) + isup * 128;
        transpose_item(W, 256, n0, WGU + (size_t)e * 512 * 1024, 1024, drow, kb * 64, scr, lane); }
    for (int it = gw; it < 257 * 128; it += NGW) { const int e = it >> 7, r = it & 127, kb = r >> 5, nb = r & 31;
        const float* W = (e < 256) ? (p.w_e_down + (size_t)e * 256 * 1024) : p.w_s_down;
        transpose_item(W, 1024, nb * 32, WD + (size_t)e * 1024 * 256, 256, nb * 32, kb * 64, scr, lane); }
}

DI void ph_topk(PP pk_, LAS unsigned char* lds) { const P p = load_args(pk_);
    const int tid = tid_local(), lane = tid & 63, wave = tid >> 6, gw = blockIdx.x * 8 + wave, NGW = gridDim.x * 8;
    const float* LG = WSP(float, WS_LOGIT); int* TKI = WSP(int, WS_TKI); float* TKW = WSP(float, WS_TKW); unsigned* cnt = WSP(unsigned, WS_CTL) + CW_CNT;
    int* tokof = WSP(int, WS_TOKOF); float* wof = WSP(float, WS_WOF);
    for (int i = blockIdx.x * 512 + tid; i < MAXRT * 256; i += gridDim.x * 512) { tokof[i] = 0; wof[i] = 0.f; }
    const f32x4 rb = *((const f32x4*)p.router_bias + lane);
    for (int t = gw; t < T_ALL; t += NGW) {
        const f32x4 lg = *((const f32x4*)(LG + (size_t)t * 256) + lane);
        float sc[4], ch[4];
#pragma unroll
        for (int j = 0; j < 4; ++j) { sc[j] = 1.f / (1.f + expf(-lg[j])); ch[j] = sc[j] + rb[j]; }
        const float m01 = fmaxf(ch[0], ch[1]), n01 = fminf(ch[0], ch[1]), m23 = fmaxf(ch[2], ch[3]), n23 = fminf(ch[2], ch[3]);
        float a1 = fmaxf(m01, m23), a2 = fmaxf(fminf(m01, m23), fmaxf(n01, n23));
#pragma unroll
        for (int o = 1; o < 8; o <<= 1) { const float b1 = __shfl_xor(a1, o), b2 = __shfl_xor(a2, o); const float n1 = fmaxf(a1, b1), n2 = fmaxf(fminf(a1, b1), fmaxf(a2, b2)); a1 = n1; a2 = n2; }
        const float gs = a1 + a2; const int myg = lane >> 3; int rank = 0;
#pragma unroll
        for (int g2 = 0; g2 < 8; ++g2) { const float og = __shfl(gs, 8 * g2); rank += (og > gs || (og == gs && g2 < myg)) ? 1 : 0; }
        if (rank >= 4) { ch[0] = -INFINITY; ch[1] = -INFINITY; ch[2] = -INFINITY; ch[3] = -INFINITY; }
        int myidx = 0; float mys = 0.f, ssum = 0.f;
#pragma unroll
        for (int r = 0; r < 8; ++r) {
            float bv = ch[0]; int bi = 4 * lane;
#pragma unroll
            for (int j = 1; j < 4; ++j) if (ch[j] > bv) { bv = ch[j]; bi = 4 * lane + j; }
#pragma unroll
            for (int o = 32; o >= 1; o >>= 1) { const float ov = __shfl_xor(bv, o); const int oi = __shfl_xor(bi, o); if (ov > bv || (ov == bv && oi < bi)) { bv = ov; bi = oi; } }
            const int jl = bi & 3; const float scsel = jl == 0 ? sc[0] : (jl == 1 ? sc[1] : (jl == 2 ? sc[2] : sc[3]));
            const float sv = __shfl(scsel, bi >> 2);
            if ((bi >> 2) == lane) { if (jl == 0) ch[0] = -INFINITY; else if (jl == 1) ch[1] = -INFINITY; else if (jl == 2) ch[2] = -INFINITY; else ch[3] = -INFINITY; }
            ssum += sv; if (lane == r) { myidx = bi; mys = sv; }
        }
        if (lane < 8) { TKI[(size_t)t * 8 + lane] = myidx; TKW[(size_t)t * 8 + lane] = mys / (ssum + 1e-20f) * 2.5f; atomicAdd(cnt + myidx, 1u); }
    }
}

DI void ph_scan(PP pk_, LAS unsigned char* lds) { const P p = load_args(pk_);
    if (blockIdx.x != 0) return;
    const int tid = tid_local();
    const unsigned* cnt = WSP(unsigned, WS_CTL) + CW_CNT; int* tbase = WSP(int, WS_MISC + MS_TBASE); int* nt = WSP(int, WS_MISC + MS_NT); int* tile_e = WSP(int, WS_MISC + MS_TILEE);
    LAS int* sb = (LAS int*)lds;
    if (tid < 256) sb[tid] = (int)((cnt[tid] + 255u) >> 8);
    __syncthreads();
    if (tid == 0) { int a = 0; for (int e = 0; e < 256; ++e) { const int n = sb[e]; sb[e] = a; a += n; } sb[256] = a; }
    __syncthreads();
    const int nrt = sb[256];
    if (tid < 256) { const int b0 = sb[tid], b1 = sb[tid + 1]; tbase[tid] = b0; for (int t = b0; t < b1; ++t) tile_e[t] = tid; tile_e[nrt + tid] = 256; }
    if (tid == 0) { tbase[256] = nrt; nt[0] = nrt; nt[1] = nrt + 256; }
    __syncthreads();
}

DI void ph_slots(PP pk_, LAS unsigned char* lds) { const P p = load_args(pk_);
    const int tid = tid_local();
    const int* TKI = WSP(int, WS_TKI); const float* TKW = WSP(float, WS_TKW); unsigned* cur = WSP(unsigned, WS_CTL) + CW_CUR; const int* tbase = WSP(int, WS_MISC + MS_TBASE);
    int* tokof = WSP(int, WS_TOKOF); float* wof = WSP(float, WS_WOF); int* slotof = WSP(int, WS_SLOTOF);
    const int s0 = tbase[256] * 256;
    for (int i = blockIdx.x * 512 + tid; i < T_ALL * 8; i += gridDim.x * 512) { const int e = TKI[i]; const int slot = tbase[e] * 256 + (int)atomicAdd(cur + e, 1u); tokof[slot] = i >> 3; wof[slot] = TKW[i]; slotof[i] = slot; }
    for (int t = blockIdx.x * 512 + tid; t < T_ALL; t += gridDim.x * 512) { tokof[s0 + t] = t; wof[s0 + t] = 1.f; }
}

DI void ph_combine(PP pk_, int round, LAS unsigned char* lds) { const P p = load_args(pk_);
    const int tid = tid_local();
    const bf16_t* Y = WSP(bf16_t, WS_YCH); const bf16_t* X1 = WSP(bf16_t, WS_X1B); const int* slotof = WSP(int, WS_SLOTOF); const int s0 = WSP(int, WS_MISC + MS_TBASE)[256] * 256;
    for (int i = blockIdx.x * 512 + tid; i < T_ALL * 32; i += gridDim.x * 512) { const int t = i >> 5, c8 = (i & 31) * 8;
        const u32x4 xw = *(const u32x4*)(X1 + (size_t)t * 1024 + round * 256 + c8);
        float a[8] = {bf_lo(xw.x) * ALPHA, bf_hi(xw.x) * ALPHA, bf_lo(xw.y) * ALPHA, bf_hi(xw.y) * ALPHA, bf_lo(xw.z) * ALPHA, bf_hi(xw.z) * ALPHA, bf_lo(xw.w) * ALPHA, bf_hi(xw.w) * ALPHA};
#pragma unroll
        for (int k = 0; k < 9; ++k) { const int slot = k < 8 ? slotof[(size_t)t * 8 + k] : s0 + t; const u32x4 w = *(const u32x4*)(Y + (size_t)slot * 256 + c8);
            a[0] += bf_lo(w.x); a[1] += bf_hi(w.x); a[2] += bf_lo(w.y); a[3] += bf_hi(w.y); a[4] += bf_lo(w.z); a[5] += bf_hi(w.z); a[6] += bf_lo(w.w); a[7] += bf_hi(w.w); }
        float* op = p.out + (size_t)t * 1024 + round * 256 + c8; *(f32x4*)op = (f32x4){a[0], a[1], a[2], a[3]}; *(f32x4*)(op + 4) = (f32x4){a[4], a[5], a[6], a[7]}; }
}

DI void ph_ln2(PP pk_, LAS unsigned char* lds) { const P p = load_args(pk_);
    const int tid = tid_local(), lane = tid & 63, wave = tid >> 6, gw = blockIdx.x * 8 + wave, NGW = gridDim.x * 8;
    for (int r = gw; r < T_ALL; r += NGW) {
        f32x4* zr = (f32x4*)(p.out + (size_t)r * 1024) + lane; f32x4 v[4]; float s = 0.f;
#pragma unroll
        for (int j = 0; j < 4; ++j) { v[j] = zr[64 * j]; s += (v[j][0] + v[j][1]) + (v[j][2] + v[j][3]); }
        const float mu = wave_sum(s) * (1.f / 1024.f); float s2 = 0.f;
#pragma unroll
        for (int j = 0; j < 4; ++j) { v[j] = v[j] - mu; s2 += (v[j][0] * v[j][0] + v[j][1] * v[j][1]) + (v[j][2] * v[j][2] + v[j][3] * v[j][3]); }
        const float rstd = rsqrtf(wave_sum(s2) * (1.f / 1024.f) + LN_EPS);
#pragma unroll
        for (int j = 0; j < 4; ++j) { const f32x4 gn = *((const f32x4*)p.ln2_g + lane + 64 * j), bb = *((const f32x4*)p.ln2_b + lane + 64 * j); zr[64 * j] = v[j] * rstd * gn + bb; }
    }
}

__global__ void __launch_bounds__(512, 2) fwd(P p_unused) {
    extern __shared__ __attribute__((aligned(16))) unsigned char lds_raw[];
    LAS unsigned char* lds = (LAS unsigned char*)lds_raw;
    const int tid = threadIdx.x, G = gridDim.x, bid = blockIdx.x;
    volatile LAS unsigned* MISC = (volatile LAS unsigned*)(lds + LDS_MISC);
    if (tid < 32) MISC[tid] = 0u;
    __syncthreads();
    const int lo = kargs()->s_lo, hi = kargs()->s_hi;
    XcdBarrier bar; { unsigned* bw = (unsigned*)(kargs()->ws + WS_CTL) + CW_BAR; bar.bar = bw; bar.x = 0; bar.st = nullptr; if (hi - lo > 1) bar = xcd_barrier_post(bw, MISC + 8); }
    int s = 0;
#ifndef PROBE_TYPE
#define PROBE_TYPE -1
#define PROBE_REPS 1
#endif
#define STEP_BEGIN(type) if (s >= lo && s < hi) { const int reps_ = ((type) == PROBE_TYPE) ? PROBE_REPS : 1; for (int rep_ = 0; rep_ < reps_; ++rep_) { PP pk_ = kargs(); const P p = load_args(pk_);
#define STEP_END if (s + 1 < hi || rep_ + 1 < reps_) xcd_barrier(bar); } } ++s;

    STEP_BEGIN(0) ph_prologue(pk_, lds); STEP_END
    for (int g = 0; g < NGRP; ++g) {
        STEP_BEGIN(1) ph_xconv(pk_, g, lds); STEP_END
        STEP_BEGIN(2) {
            pg8::Gemm gm{WSP(bf16_t, WS_XB), WSP(bf16_t, WS_WIN), 1024, 1024, 1024, nullptr}; pg8::StaticOrder S; S.init(TG, NU, G, bid);
            EpiInProj E{WSP(bf16_t, WS_U), WSP(float, WS_MISC + MS_BIAS)};
            pg8::gemm_phase<EpiInProj, pg8::StaticOrder, true>(lds, gm, S, E);
            if (g == 0) {
                pg8::Gemm gk{WSP(bf16_t, WS_MEMB), WSP(bf16_t, WS_WKV), 1024, 1024, 1024, nullptr}; pg8::StaticOrder S2; S2.init(NBATCH * 256, 2048, G, bid);
                EpiPlain E2{WSP(bf16_t, WS_KVM), 2048};
                pg8::gemm_phase<EpiPlain, pg8::StaticOrder, true>(lds, gk, S2, E2);
            }
        } STEP_END
        STEP_BEGIN(4) ph_conv(pk_, g, lds); STEP_END
        STEP_BEGIN(3) ph_mix(pk_, g, rep_, lds); STEP_END
        STEP_BEGIN(16) ph_mlstm_out(pk_, g, lds); STEP_END
        STEP_BEGIN(5) {
            pg8::Gemm gm{WSP(bf16_t, WS_Y), WSP(bf16_t, WS_WBR), 3072, 1024, 1024, nullptr}; BranchOrder S{(TG / 256) * 4, G, bid};
            EpiBranch E{WSP(bf16_t, WS_U), WSP(float, WS_F32), WSP(bf16_t, WS_MRG)};
            pg8::gemm_phase<EpiBranch, BranchOrder, true>(lds, gm, S, E);
        } STEP_END
        STEP_BEGIN(6) {
            pg8::Gemm gm{WSP(bf16_t, WS_MRG), WSP(bf16_t, WS_WOUT), 1024, 1024, 1024, nullptr}; pg8::StaticOrder S; S.init(TG, 1024, G, bid);
            EpiOutProj E{p.x + (size_t)g * TG * 1024, WSP(float, WS_Z)};
            pg8::gemm_phase<EpiOutProj, pg8::StaticOrder, true>(lds, gm, S, E);
        } STEP_END
        STEP_BEGIN(7) ph_ln1(pk_, g, lds); STEP_END
    }
    STEP_BEGIN(8) {
        pg8::Gemm gm{WSP(bf16_t, WS_X1B), WSP(bf16_t, WS_WR), 1024, 1024, 1024, nullptr}; pg8::StaticOrder S; S.init(T_ALL, 256, G, bid);
        EpiF32 E{WSP(float, WS_LOGIT), 256};
        pg8::gemm_phase<EpiF32, pg8::StaticOrder, true>(lds, gm, S, E);
        ph_expert_weights(pk_, lds);
    } STEP_END
    STEP_BEGIN(9) ph_topk(pk_, lds); STEP_END
    STEP_BEGIN(10) ph_scan(pk_, lds); STEP_END
    STEP_BEGIN(11) ph_slots(pk_, lds); STEP_END
    STEP_BEGIN(12) {
        const int* ntp = WSP(int, WS_MISC + MS_NT);
        pg8::Gemm gm{WSP(bf16_t, WS_X1B), WSP(bf16_t, WS_WGU), 1024, 1024, 1024, WSP(int, WS_TOKOF)}; ExpertGUOrder S{WSP(int, WS_MISC + MS_TILEE), ntp[1] * 2, G, bid};
        EpiGateUp E{WSP(bf16_t, WS_ACT)};
        pg8::gemm_phase<EpiGateUp, ExpertGUOrder, true, true>(lds, gm, S, E);
    } STEP_END
    for (int r = 0; r < 4; ++r) {
        STEP_BEGIN(13) {
            const int* ntp = WSP(int, WS_MISC + MS_NT);
            pg8::Gemm gm{WSP(bf16_t, WS_ACT), WSP(bf16_t, WS_WD), 256, 256, 256, nullptr}; ExpertDownOrder S{WSP(int, WS_MISC + MS_TILEE), ntp[1], G, bid, r};
            EpiDown E{WSP(bf16_t, WS_YCH), WSP(float, WS_WOF)};
            pg8::gemm_phase<EpiDown, ExpertDownOrder, true>(lds, gm, S, E);
        } STEP_END
        STEP_BEGIN(14) ph_combine(pk_, r, lds); STEP_END
    }
    STEP_BEGIN(15) ph_ln2(pk_, lds); STEP_END
}
constexpr int NSTEPS = 1 + NGRP * 8 + 5 + 8 + 1;

extern "C" void kernel_launch(void* const* d_in, const int* in_sizes, int n_in, void* d_out, int out_size, void* d_ws, size_t ws_size, hipStream_t stream) {
    static int grid = 0;
    if (grid == 0) {
        int dev = 0, cus = 0;
        if (hipGetDevice(&dev) != hipSuccess || hipDeviceGetAttribute(&cus, hipDeviceAttributeMultiprocessorCount, dev) != hipSuccess) { fprintf(stderr, "kernel_launch: device query failed\n"); grid = -1; return; }
        if (hipFuncSetAttribute((const void*)fwd, hipFuncAttributeMaxDynamicSharedMemorySize, LDS_BYTES) != hipSuccess) { fprintf(stderr, "kernel_launch: hipFuncSetAttribute failed\n"); grid = -1; return; }
        if (n_in != 24 || ws_size < WS_END) fprintf(stderr, "kernel_launch: n_in %d ws %zu (need %zu)\n", n_in, ws_size, (size_t)WS_END);
        grid = cus;
    }
    if (grid < 0) return;
    (void)hipMemsetAsync((char*)d_ws + WS_CTL, 0, CTL_BYTES, stream);
    P p{};
    const float** pp = (const float**)&p;
    for (int i = 0; i < 24; ++i) pp[i] = (const float*)d_in[i];
    p.out = (float*)d_out; p.ws = (unsigned char*)d_ws;
#ifndef ONE_LAUNCH
    for (int s = 0; s < NSTEPS; ++s) { p.s_lo = s; p.s_hi = s + 1; hipLaunchKernelGGL(fwd, dim3(grid), dim3(512), LDS_BYTES, stream, p); }
#else
    p.s_lo = 0; p.s_hi = NSTEPS; hipLaunchKernelGGL(fwd, dim3(grid), dim3(512), LDS_BYTES, stream, p);
#endif
}
```

```cpp
#define ONE_LAUNCH 1
#include <hip/hip_runtime.h>
#include <cstdio>
#include <cstdint>
#define DI __device__ __forceinline__
#define LAS __attribute__((address_space(3)))
#define GAS __attribute__((address_space(1)))
typedef unsigned short bf16_t;
typedef short bf16x8 __attribute__((ext_vector_type(8)));
typedef float f32x4 __attribute__((ext_vector_type(4)));
typedef float f32x2 __attribute__((ext_vector_type(2)));
typedef unsigned u32x4 __attribute__((ext_vector_type(4)));
typedef unsigned u32x2 __attribute__((ext_vector_type(2)));

constexpr int T_ALL = 65536, DM = 1024, SEQ = 2048, NBATCH = 32, NGRP = 4, TG = T_ALL / NGRP, BG = NBATCH / NGRP;
constexpr int NU = 11264, CIN = 11272;
constexpr int UQ = 0, UK = 1024, UV = 2048, UMQ = 3072, UMK = 4096, UMV = 5120, UMO = 6144, UCQ = 7168, UGT = 8192;
constexpr int NEXP = 256, MAXRT = 2304, MAXTILES = MAXRT + 256, MAXSLOTS = MAXTILES * 256;
constexpr float ALPHA = 1.189207115002721f;
constexpr float LN_EPS = 1e-5f;

constexpr size_t MiB = 1ull << 20;
constexpr size_t WS_CTL = 0, CTL_BYTES = 1 * MiB;
constexpr size_t WS_MISC = 1 * MiB;
constexpr size_t WS_WIN = 2 * MiB, WS_WKV = 24 * MiB, WS_WBR = 28 * MiB, WS_WOUT = 34 * MiB, WS_WR = 36 * MiB;
constexpr size_t WS_GIF = 38 * MiB, WS_MEMB = 40 * MiB, WS_KVM = 56 * MiB, WS_X1B = 88 * MiB, WS_R = 216 * MiB;
constexpr size_t WS_XB = WS_R, WS_U = WS_R + 32 * MiB, WS_Y = WS_R + 384 * MiB, WS_F32 = WS_R + 480 * MiB, WS_MRG = WS_R + 544 * MiB, WS_Z = WS_R + 576 * MiB, WS_QKC = WS_R + 640 * MiB;
constexpr size_t WS_TKI = WS_R, WS_TKW = WS_R + 2 * MiB, WS_SLOTOF = WS_R + 4 * MiB, WS_TOKOF = WS_R + 6 * MiB, WS_WOF = WS_R + 9 * MiB;
constexpr size_t WS_LOGIT = WS_R + 16 * MiB, WS_WGU = WS_R + 80 * MiB, WS_WD = WS_R + 337 * MiB, WS_ACT = WS_R + 580 * MiB, WS_YCH = WS_R + 16 * MiB;
constexpr size_t WS_END = WS_R + 900 * MiB;
constexpr size_t MS_BIAS = 0, MS_LAM = 48 * 1024, MS_TBASE = 52 * 1024, MS_NT = 56 * 1024, MS_TILEE = 64 * 1024;
constexpr int CW_CNT = 1024, CW_CUR = 2048, CW_BAR = 8192, CW_Q = 16384;

constexpr int LDS_RING = 131072, LDS_MISC = LDS_RING + 320, LDS_BYTES = 147456;

DI float bf_lo(unsigned w) { return __uint_as_float(w << 16); }
DI float bf_hi(unsigned w) { return __uint_as_float(w & 0xffff0000u); }
DI float bf2f(bf16_t b) { return __uint_as_float((unsigned)b << 16); }
DI unsigned cvt_pk_bf16(float lo, float hi) { unsigned r; asm("v_cvt_pk_bf16_f32 %0, %1, %2" : "=v"(r) : "v"(lo), "v"(hi)); return r; }
DI float wave_sum(float v) {
#pragma unroll
    for (int o = 1; o < 64; o <<= 1) v += __shfl_xor(v, o);
    return v;
}
DI float wave_max(float v) {
#pragma unroll
    for (int o = 1; o < 64; o <<= 1) v = fmaxf(v, __shfl_xor(v, o));
    return v;
}
template <int CTRL> DI float dppf(float v) { return __builtin_bit_cast(float, __builtin_amdgcn_update_dpp(0, __builtin_bit_cast(int, v), CTRL, 0xf, 0xf, true)); }
DI float row16_sum(float v) { v += dppf<0xB1>(v); v += dppf<0x4E>(v); v += dppf<0x124>(v); v += dppf<0x128>(v); return v; }
DI float rdlane(float v, int l) { return __builtin_bit_cast(float, __builtin_amdgcn_readlane(__builtin_bit_cast(int, v), l)); }
DI float wave_sum_fast(float v) { v = row16_sum(v); return (rdlane(v, 0) + rdlane(v, 16)) + (rdlane(v, 32) + rdlane(v, 48)); }
DI float sigm(float x) { return 1.f / (1.f + __expf(-x)); }
DI float silu(float x) { return x / (1.f + __expf(-x)); }
DI int tid_local() { int t = threadIdx.x; asm volatile("" : "+v"(t)); return t; }
DI void lds_barrier() { asm volatile("s_waitcnt lgkmcnt(0)" ::: "memory"); __builtin_amdgcn_s_barrier(); asm volatile("" ::: "memory"); }
#define LDS_WAIT() asm volatile("s_waitcnt lgkmcnt(0)" ::: "memory")
namespace pg8 {
constexpr int BM = 256, BK = 64, HALF = 128, HTB = HALF * BK * 2, STAGE_BYTES = 8 * HTB, NXCD = 8, WGM = 8;
__host__ __device__ __forceinline__ int lds_byte(int r, int c) { const int st = (r >> 4) * 2 + (c >> 5), rr = r & 15, cc = c & 31, ob = rr * 64 + cc * 2; return st * 1024 + (ob ^ (((ob >> 9) & 1) << 5)); }
__host__ __device__ __forceinline__ void stage_rc(int b, int& R, int& C) { const int st = b / 1024, sb = b % 1024, swz = sb ^ (((sb >> 9) & 1) << 5); R = (st >> 1) * 16 + swz / 64; C = (st & 1) * 32 + (swz % 64) / 2; }
__host__ __device__ __forceinline__ int perm32(int rho) { const int n = rho >> 4, i = rho & 15; return 8 * (i >> 2) + 4 * n + (i & 3); }

struct Unit { int pm, pn, pb, acol, aux; };
struct Gemm { const bf16_t* A; const bf16_t* Bt; int lda, ldb, K; const int* arow; };

struct StaticOrder {
    int nM, nN, nwg, G, c;
    DI void init(int M, int N, int G_, int c_) { nM = M / BM; nN = N / BM; nwg = nM * nN; G = G_; c = c_; }
    DI bool next(int i, Unit& u) const {
        const long L = (long)i * G + c; if (L >= nwg) return false;
        int wgid = (int)L; { const int q = nwg / NXCD, r = nwg % NXCD, xcd = wgid % NXCD, off = wgid / NXCD; wgid = (xcd < r ? xcd * (q + 1) : r * (q + 1) + (xcd - r) * q) + off; }
        const int nig = WGM * nN, gid = wgid / nig, fm = gid * WGM, gsz = (nM - fm) < WGM ? (nM - fm) : WGM;
        u.pm = fm + ((wgid % nig) % gsz); u.pn = (wgid % nig) / gsz; u.pb = u.pn; u.acol = 0; u.aux = 0; return true;
    }
};

struct NoMid { static constexpr int EVERY = 0; DI void operator()(f32x4 (&)[2][2][4][2], const Unit&, int, int, int, int, int) const {} };
template <class Epi, class Sched, bool ALIGN_EPI, bool GATHER = false, class Mid = NoMid>
DI void gemm_phase(LAS unsigned char* lds, const Gemm g, const Sched& S, const Epi& E, const Mid& mid = Mid()) {
    const int tid = tid_local(), wid = __builtin_amdgcn_readfirstlane(tid >> 6), lane = tid & 63, wr = wid >> 2, wc = wid & 3, fr = lane & 15, fq = lane >> 4;
    const int nt = g.K / BK;
    int Ra[2], Ca[2], Rb[2];
#pragma unroll
    for (int i = 0; i < 2; ++i) { int R, C; stage_rc(tid * 16 + i * 8192, R, C); Ra[i] = R; Ca[i] = C; Rb[i] = (R & ~31) + perm32(R & 31); }
    const size_t kstep = (size_t)(BK * 2);
    const unsigned ldsw = (unsigned)wid * 1024u;
    const int aoff = lds_byte(wr * 64 + fr, fq * 8), boff = lds_byte(wc * 32 + fr, fq * 8);
#define PG8_SA(b, h) (((b) * 2 + (h)) * HTB)
#define PG8_SB(b, h) ((4 + (b) * 2 + (h)) * HTB)
#define PG8_STAGE(bufoff, gptr, offs) do { _Pragma("unroll") for (int _i = 0; _i < 2; ++_i) \
        __builtin_amdgcn_global_load_lds((const unsigned*)((gptr) + (offs)[_i]), (LAS unsigned*)(lds + (bufoff) + ldsw + _i * 8192), 16, 0, 0); } while (0)
#define PG8_LDA(dst, b, h) do { _Pragma("unroll") for (int m = 0; m < 4; ++m) _Pragma("unroll") for (int k = 0; k < 2; ++k) dst[m][k] = *(const LAS bf16x8*)(lds + PG8_SA(b, h) + aoff + m * 2048 + k * 1024); } while (0)
#define PG8_LDB(dst, b, h) do { _Pragma("unroll") for (int n = 0; n < 2; ++n) _Pragma("unroll") for (int k = 0; k < 2; ++k) dst[n][k] = *(const LAS bf16x8*)(lds + PG8_SB(b, h) + boff + n * 2048 + k * 1024); } while (0)
#define PG8_MMA(ai, bj, At, Bt) do { __builtin_amdgcn_s_setprio(1); _Pragma("unroll") for (int m = 0; m < 4; ++m) _Pragma("unroll") for (int n = 0; n < 2; ++n) _Pragma("unroll") for (int k = 0; k < 2; ++k) \
        acc[ai][bj][m][n] = __builtin_amdgcn_mfma_f32_16x16x32_bf16(Bt[n][k], At[m][k], acc[ai][bj][m][n], 0, 0, 0); __builtin_amdgcn_s_setprio(0); } while (0)
#define PG8_WAIT_V(n) asm volatile("s_waitcnt vmcnt(" #n ")" ::: "memory")
#define PG8_WAIT_L(n) asm volatile("s_waitcnt lgkmcnt(" #n ")" ::: "memory")
#define PG8_BAR __builtin_amdgcn_s_barrier()
#define PG8_SCHED __builtin_amdgcn_sched_barrier(0)
#define PG8_OFFS(u, oa) do { _Pragma("unroll") for (int h_ = 0; h_ < 2; ++h_) _Pragma("unroll") for (int i_ = 0; i_ < 2; ++i_) { \
        const int ar_ = g.arow[(u).pm * BM + h_ * HALF + Ra[i_]]; oa[h_][i_] = (unsigned)(ar_ * g.lda + (u).acol + Ca[i_]) * 2u; } } while (0)
    unsigned voffA[2], voffB[2];
#pragma unroll
    for (int i = 0; i < 2; ++i) { voffA[i] = (unsigned)(Ra[i] * g.lda + Ca[i]) * 2u; voffB[i] = (unsigned)(Rb[i] * g.ldb + Ca[i]) * 2u; }
    const size_t hstepA = (size_t)HALF * g.lda * 2, hstepB = (size_t)HALF * g.ldb * 2;
#define PG8_ABASE(u) ((const char*)g.A + (GATHER ? (size_t)0 : ((size_t)(u).pm * BM * g.lda + (u).acol) * 2))
#define PG8_BBASE(u) ((const char*)g.Bt + (size_t)(u).pb * BM * g.ldb * 2)
#define PG8_STAGE_A(bufoff, ab, oa, h) do { if constexpr (GATHER) { PG8_STAGE(bufoff, ab, (oa)[h]); } else { PG8_STAGE(bufoff, (ab) + (h) * hstepA, voffA); } } while (0)
#define PG8_STAGE_B(bufoff, bb, h) PG8_STAGE(bufoff, (bb) + (h) * hstepB, voffB)
    Unit cur, nxt; int ui = 0;
    if (!S.next(0, cur)) return;
    f32x4 acc[2][2][4][2];
#pragma unroll
    for (int a = 0; a < 2; ++a)
#pragma unroll
        for (int b = 0; b < 2; ++b)
#pragma unroll
            for (int m = 0; m < 4; ++m)
#pragma unroll
                for (int n = 0; n < 2; ++n) acc[a][b][m][n] = (f32x4){0.f, 0.f, 0.f, 0.f};
    bf16x8 At[4][2], B0[2][2], B1[2][2];
    unsigned oaC[2][2], oaN[2][2];
    if constexpr (GATHER) { PG8_OFFS(cur, oaC); }
    const char* cA = PG8_ABASE(cur); const char* cB = PG8_BBASE(cur);
    PG8_STAGE_B(PG8_SB(0, 0), cB, 0); PG8_STAGE_B(PG8_SB(0, 1), cB, 1); PG8_STAGE_A(PG8_SA(0, 0), cA, oaC, 0); PG8_STAGE_A(PG8_SA(0, 1), cA, oaC, 1);
    if (wr == 1) PG8_BAR;
    PG8_WAIT_V(2); PG8_BAR;
    PG8_STAGE_B(PG8_SB(1, 0), cB + kstep, 0); PG8_STAGE_A(PG8_SA(1, 0), cA + kstep, oaC, 0); PG8_STAGE_B(PG8_SB(1, 1), cB + kstep, 1);
    PG8_WAIT_V(6); PG8_BAR;
    for (;;) {
        const bool has_next = S.next(ui + 1, nxt);
        const char* nA = has_next ? PG8_ABASE(nxt) : cA; const char* nB = has_next ? PG8_BBASE(nxt) : cB;
        if constexpr (GATHER) {
            if (has_next) { PG8_OFFS(nxt, oaN); }
            else {
#pragma unroll
                for (int h_ = 0; h_ < 2; ++h_)
#pragma unroll
                    for (int i_ = 0; i_ < 2; ++i_) oaN[h_][i_] = oaC[h_][i_];
            }
        }
#pragma unroll 1
        for (int t = 0; t < nt; t += 2) {
            const bool last = (t == nt - 2);
            const char* a1 = cA + (size_t)(t + 1) * kstep;
            const char* a2 = last ? nA : cA + (size_t)(t + 2) * kstep; const char* b2 = last ? nB : cB + (size_t)(t + 2) * kstep;
            const char* a3 = a2 + kstep; const char* b3 = b2 + kstep;
            unsigned oa2[2][2];
            if constexpr (GATHER) {
#pragma unroll
                for (int h_ = 0; h_ < 2; ++h_)
#pragma unroll
                    for (int i_ = 0; i_ < 2; ++i_) oa2[h_][i_] = last ? oaN[h_][i_] : oaC[h_][i_];
            }
            PG8_LDB(B0, 0, 0); PG8_LDB(B1, 0, 1); PG8_SCHED; PG8_LDA(At, 0, 0); PG8_STAGE_A(PG8_SA(1, 1), a1, oaC, 1);
            PG8_WAIT_V(8); PG8_WAIT_L(0); PG8_BAR; PG8_MMA(0, 0, At, B0); PG8_MMA(0, 1, At, B1); PG8_BAR; PG8_SCHED;
            PG8_LDA(At, 0, 1); PG8_STAGE_B(PG8_SB(0, 0), b2, 0); PG8_STAGE_B(PG8_SB(0, 1), b2, 1); PG8_STAGE_A(PG8_SA(0, 0), a2, oa2, 0);
            PG8_WAIT_V(8); PG8_WAIT_L(0); PG8_BAR; PG8_MMA(1, 0, At, B0); PG8_MMA(1, 1, At, B1); PG8_BAR; PG8_SCHED;
            PG8_LDB(B0, 1, 0); PG8_LDB(B1, 1, 1); PG8_SCHED; PG8_LDA(At, 1, 0); PG8_STAGE_A(PG8_SA(0, 1), a2, oa2, 1);
            PG8_WAIT_V(8); PG8_WAIT_L(0); PG8_BAR; PG8_MMA(0, 0, At, B0); PG8_MMA(0, 1, At, B1); PG8_BAR; PG8_SCHED;
            PG8_LDA(At, 1, 1); PG8_STAGE_B(PG8_SB(1, 0), b3, 0); PG8_STAGE_B(PG8_SB(1, 1), b3, 1); PG8_STAGE_A(PG8_SA(1, 0), a3, oa2, 0);
            PG8_WAIT_V(8); PG8_WAIT_L(0); PG8_BAR; PG8_MMA(1, 0, At, B0); PG8_MMA(1, 1, At, B1); PG8_BAR; PG8_SCHED;
            if constexpr (Mid::EVERY > 0) { if (((t + 2) % Mid::EVERY) == 0 && (t + 2) < nt) mid(acc, cur, (t + 2) / Mid::EVERY - 1, wr, wc, fr, fq); }
        }
        if constexpr (ALIGN_EPI) { if (wr == 0) PG8_BAR; }
        E(acc, cur, wr, wc, fr, fq);
        if (!has_next) break;
#pragma unroll
        for (int a = 0; a < 2; ++a)
#pragma unroll
            for (int b = 0; b < 2; ++b)
#pragma unroll
                for (int m = 0; m < 4; ++m)
#pragma unroll
                    for (int n = 0; n < 2; ++n) acc[a][b][m][n] = (f32x4){0.f, 0.f, 0.f, 0.f};
        cur = nxt; cA = nA; cB = nB; ++ui;
        if constexpr (GATHER) {
#pragma unroll
            for (int h_ = 0; h_ < 2; ++h_)
#pragma unroll
                for (int i_ = 0; i_ < 2; ++i_) oaC[h_][i_] = oaN[h_][i_];
        }
        if constexpr (ALIGN_EPI) { if (wr == 1) PG8_BAR; }
    }
    PG8_WAIT_V(0);
    if constexpr (!ALIGN_EPI) { if (wr == 0) PG8_BAR; }
    PG8_BAR;
#undef PG8_SA
#undef PG8_SB
#undef PG8_STAGE
#undef PG8_LDA
#undef PG8_LDB
#undef PG8_MMA
#undef PG8_WAIT_V
#undef PG8_WAIT_L
#undef PG8_BAR
#undef PG8_SCHED
#undef PG8_OFFS
#undef PG8_ABASE
#undef PG8_BBASE
#undef PG8_STAGE_A
#undef PG8_STAGE_B
}
}
using pg8::Unit; using pg8::BM; using pg8::HALF;

struct BranchOrder {
    int ntile, G, c;
    DI bool next(int i, Unit& u) const {
        const int L = (i / 3) * G + c; if (L >= ntile) return false;
        const int n = i % 3; u.pm = L >> 2; u.pn = L & 3; u.pb = n * 4 + u.pn; u.acol = n * 1024; u.aux = n; return true;
    }
};
struct ExpertGUOrder {
    const int* tile_e; int nunits, G, c;
    DI bool next(int i, Unit& u) const {
        const int L = i * G + c; if (L >= nunits) return false;
        const int t = L >> 1, hf = L & 1; const int e = tile_e[t];
        u.pm = t; u.pn = hf; u.pb = e * 2 + hf; u.acol = 0; u.aux = e; return true;
    }
};
struct ExpertDownOrder {
    const int* tile_e; int nunits, G, c, round;
    DI bool next(int i, Unit& u) const {
        const int L = i * G + c; if (L >= nunits) return false;
        const int t = L >> 1, cn = L & 1; const int e = tile_e[t];
        u.pm = t; u.pn = cn; u.pb = e * 4 + round * 2 + cn; u.acol = 0; u.aux = e; return true;
    }
};

#define EPI_ARGS const f32x4 (&acc)[2][2][4][2], const Unit& u, int wr, int wc, int fr, int fq
DI u32x4 pack8(const f32x4 v0, const f32x4 v1) { u32x4 w; w.x = cvt_pk_bf16(v0[0], v0[1]); w.y = cvt_pk_bf16(v0[2], v0[3]); w.z = cvt_pk_bf16(v1[0], v1[1]); w.w = cvt_pk_bf16(v1[2], v1[3]); return w; }

struct EpiInProj {
    bf16_t* O; const float* bias;
    DI void operator()(EPI_ARGS) const {
        const int row0 = u.pm * BM + wr * 64 + fr, col0 = u.pn * BM + wc * 32 + 8 * fq;
        const float sc = (u.pn < 4) ? 0.125f * 1.4426950408889634f : ((u.pn >= 28 && u.pn < 32) ? 0.0625f * 1.4426950408889634f : 1.f);
        f32x4 bv[2][2];
#pragma unroll
        for (int bj = 0; bj < 2; ++bj)
#pragma unroll
            for (int n = 0; n < 2; ++n) bv[bj][n] = *(const f32x4*)(bias + col0 + bj * HALF + 4 * n);
#pragma unroll
        for (int ai = 0; ai < 2; ++ai)
#pragma unroll
            for (int m = 0; m < 4; ++m) { bf16_t* rowp = O + (size_t)(row0 + ai * HALF + m * 16) * NU + col0;
#pragma unroll
                for (int bj = 0; bj < 2; ++bj) *(u32x4*)(rowp + bj * HALF) = pack8((acc[ai][bj][m][0] + bv[bj][0]) * sc, (acc[ai][bj][m][1] + bv[bj][1]) * sc); }
    }
};
struct EpiPlain {
    bf16_t* O; int ldc;
    DI void operator()(EPI_ARGS) const {
        const int row0 = u.pm * BM + wr * 64 + fr, col0 = u.pn * BM + wc * 32 + 8 * fq;
#pragma unroll
        for (int ai = 0; ai < 2; ++ai)
#pragma unroll
            for (int m = 0; m < 4; ++m) { bf16_t* rowp = O + (size_t)(row0 + ai * HALF + m * 16) * ldc + col0;
#pragma unroll
                for (int bj = 0; bj < 2; ++bj) *(u32x4*)(rowp + bj * HALF) = pack8(acc[ai][bj][m][0], acc[ai][bj][m][1]); }
    }
};
struct EpiBranch {
    const bf16_t* U; float* F; bf16_t* M;
    DI void operator()(EPI_ARGS) const {
        const int row0 = u.pm * BM + wr * 64 + fr, col0 = u.pn * BM + wc * 32 + 8 * fq, n = u.aux;
#pragma unroll
        for (int ai = 0; ai < 2; ++ai)
#pragma unroll
            for (int m = 0; m < 4; ++m) { const size_t row = (size_t)(row0 + ai * HALF + m * 16);
#pragma unroll
                for (int bj = 0; bj < 2; ++bj) { const int col = col0 + bj * HALF;
                    const u32x4 gw = *(const u32x4*)(U + row * NU + UGT + n * 1024 + col);
                    f32x4 g0 = {sigm(bf_lo(gw.x)), sigm(bf_hi(gw.x)), sigm(bf_lo(gw.y)), sigm(bf_hi(gw.y))};
                    f32x4 g1 = {sigm(bf_lo(gw.z)), sigm(bf_hi(gw.z)), sigm(bf_lo(gw.w)), sigm(bf_hi(gw.w))};
                    f32x4 v0 = acc[ai][bj][m][0] * g0, v1 = acc[ai][bj][m][1] * g1;
                    float* fp = F + row * 1024 + col;
                    if (n > 0) { v0 += *(const f32x4*)fp; v1 += *(const f32x4*)(fp + 4); }
                    if (n < 2) { *(f32x4*)fp = v0; *(f32x4*)(fp + 4) = v1; }
                    else *(u32x4*)(M + row * 1024 + col) = pack8(v0, v1); }
                asm volatile("" ::: "memory"); }
    }
};
DI f32x4 sig_ratio4(float a0, float a1, float a2, float a3, float b0, float b1, float b2, float b3) {
    return (f32x4){(1.f + __expf(-b0)) / (1.f + __expf(-a0)), (1.f + __expf(-b1)) / (1.f + __expf(-a1)), (1.f + __expf(-b2)) / (1.f + __expf(-a2)), (1.f + __expf(-b3)) / (1.f + __expf(-a3))};
}
struct MidBranch { static constexpr int EVERY = 16; const bf16_t* U;
    DI void operator()(f32x4 (&acc)[2][2][4][2], const Unit& u, int n, int wr, int wc, int fr_, int fq_) const {
        int fr = fr_, fq = fq_; asm volatile("" : "+v"(fr), "+v"(fq));
        const int row0 = u.pm * BM + wr * 64 + fr, col0 = u.pn * BM + wc * 32 + 8 * fq;
#pragma unroll
        for (int ai = 0; ai < 2; ++ai)
#pragma unroll
            for (int m = 0; m < 4; ++m) { const bf16_t* gp = U + (size_t)(row0 + ai * HALF + m * 16) * NU + UGT + n * 1024 + col0;
#pragma unroll
                for (int bj = 0; bj < 2; ++bj) { const u32x4 ga = *(const u32x4*)(gp + bj * HALF), gb = *(const u32x4*)(gp + bj * HALF + 1024);
                    acc[ai][bj][m][0] *= sig_ratio4(bf_lo(ga.x), bf_hi(ga.x), bf_lo(ga.y), bf_hi(ga.y), bf_lo(gb.x), bf_hi(gb.x), bf_lo(gb.y), bf_hi(gb.y));
                    acc[ai][bj][m][1] *= sig_ratio4(bf_lo(ga.z), bf_hi(ga.z), bf_lo(ga.w), bf_hi(ga.w), bf_lo(gb.z), bf_hi(gb.z), bf_lo(gb.w), bf_hi(gb.w));
                    asm volatile("" ::: "memory"); } }
    }
};
struct EpiBranch2 {
    const bf16_t* U; bf16_t* M;
    DI void operator()(EPI_ARGS) const {
        const int row0 = u.pm * BM + wr * 64 + fr, col0 = u.pn * BM + wc * 32 + 8 * fq;
#pragma unroll
        for (int ai = 0; ai < 2; ++ai)
#pragma unroll
            for (int m = 0; m < 4; ++m) { const size_t row = (size_t)(row0 + ai * HALF + m * 16);
#pragma unroll
                for (int bj = 0; bj < 2; ++bj) { const int col = col0 + bj * HALF; const u32x4 gw = *(const u32x4*)(U + row * NU + UGT + 2048 + col);
                    const f32x4 g0 = {sigm(bf_lo(gw.x)), sigm(bf_hi(gw.x)), sigm(bf_lo(gw.y)), sigm(bf_hi(gw.y))}, g1 = {sigm(bf_lo(gw.z)), sigm(bf_hi(gw.z)), sigm(bf_lo(gw.w)), sigm(bf_hi(gw.w))};
                    *(u32x4*)(M + row * 1024 + col) = pack8(acc[ai][bj][m][0] * g0, acc[ai][bj][m][1] * g1); }
                asm volatile("" ::: "memory"); }
    }
};
struct EpiOutProj {
    const float* X; float* Z;
    DI void operator()(EPI_ARGS) const {
        const int row0 = u.pm * BM + wr * 64 + fr, col0 = u.pn * BM + wc * 32 + 8 * fq;
#pragma unroll
        for (int ai = 0; ai < 2; ++ai)
#pragma unroll
            for (int m = 0; m < 4; ++m) { const size_t off = (size_t)(row0 + ai * HALF + m * 16) * 1024 + col0;
#pragma unroll
                for (int bj = 0; bj < 2; ++bj) { const float* xp = X + off + bj * HALF; float* zp = Z + off + bj * HALF;
                    *(f32x4*)zp = *(const f32x4*)xp * ALPHA + acc[ai][bj][m][0]; *(f32x4*)(zp + 4) = *(const f32x4*)(xp + 4) * ALPHA + acc[ai][bj][m][1]; }
                asm volatile("" ::: "memory"); }
    }
};
struct EpiF32 {
    float* O; int ldc;
    DI void operator()(EPI_ARGS) const {
        const int row0 = u.pm * BM + wr * 64 + fr, col0 = u.pn * BM + wc * 32 + 8 * fq;
#pragma unroll
        for (int ai = 0; ai < 2; ++ai)
#pragma unroll
            for (int m = 0; m < 4; ++m) { float* rowp = O + (size_t)(row0 + ai * HALF + m * 16) * ldc + col0;
#pragma unroll
                for (int bj = 0; bj < 2; ++bj) { *(f32x4*)(rowp + bj * HALF) = acc[ai][bj][m][0]; *(f32x4*)(rowp + bj * HALF + 4) = acc[ai][bj][m][1]; } }
    }
};
struct EpiGateUp {
    bf16_t* ACT;
    DI void operator()(EPI_ARGS) const {
        const int row0 = u.pm * BM + wr * 64 + fr, col0 = u.pn * HALF + wc * 32 + 8 * fq;
#pragma unroll
        for (int ai = 0; ai < 2; ++ai)
#pragma unroll
            for (int m = 0; m < 4; ++m) { f32x4 v[2];
#pragma unroll
                for (int n = 0; n < 2; ++n) { const f32x4 gt = acc[ai][0][m][n], up = acc[ai][1][m][n];
                    v[n] = (f32x4){silu(gt[0]) * up[0], silu(gt[1]) * up[1], silu(gt[2]) * up[2], silu(gt[3]) * up[3]}; }
                *(u32x4*)(ACT + (size_t)(row0 + ai * HALF + m * 16) * 256 + col0) = pack8(v[0], v[1]); }
    }
};
DI unsigned pk4_fp8(float a, float b, float c, float d) { int p = __builtin_amdgcn_cvt_pk_fp8_f32(a, b, 0, false); return (unsigned)__builtin_amdgcn_cvt_pk_fp8_f32(c, d, p, true); }
constexpr float Y8_SCALE = 32.f, Y8_MAX = 400.f;
struct EpiDown {
    unsigned char* Y; const float* W;
    DI void operator()(EPI_ARGS) const {
        const int row0 = u.pm * BM + wr * 64 + fr, col0 = u.pn * BM + wc * 32 + 8 * fq;
#pragma unroll
        for (int ai = 0; ai < 2; ++ai)
#pragma unroll
            for (int m = 0; m < 4; ++m) { const int row = row0 + ai * HALF + m * 16; const float w = W[row] * Y8_SCALE;
#pragma unroll
                for (int bj = 0; bj < 2; ++bj) { f32x4 v0 = acc[ai][bj][m][0] * w, v1 = acc[ai][bj][m][1] * w;
#pragma unroll
                    for (int e = 0; e < 4; ++e) { v0[e] = __builtin_amdgcn_fmed3f(v0[e], -Y8_MAX, Y8_MAX); v1[e] = __builtin_amdgcn_fmed3f(v1[e], -Y8_MAX, Y8_MAX); }
                    u32x2 o; o.x = pk4_fp8(v0[0], v0[1], v0[2], v0[3]); o.y = pk4_fp8(v1[0], v1[1], v1[2], v1[3]);
                    *(u32x2*)(Y + (size_t)row * 512 + col0 + bj * HALF) = o; }
                asm volatile("" ::: "memory"); }
    }
};
#define RLX_AGENT __ATOMIC_RELAXED, __HIP_MEMORY_SCOPE_AGENT
#define XB_TMO      128
#define XB_XCNT(j)  (256  + 64 * (j))
#define XB_XSUB(j)  (1280 + 64 * (j))
#define XB_XGEN(j)  (2304 + 64 * (j))
#define XB_TOP      3328
#define XB_TOPGEN   3392
#define XCD_BAR_WORDS 3456
#define XB_SPIN_CAP (1u << 18)

__device__ __forceinline__ unsigned xb_ld(unsigned* p)              { return __hip_atomic_load(p, __ATOMIC_RELAXED, __HIP_MEMORY_SCOPE_AGENT); }
__device__ __forceinline__ unsigned xb_add(unsigned* p, unsigned v) { return __hip_atomic_fetch_add(p, v, __ATOMIC_RELAXED, __HIP_MEMORY_SCOPE_AGENT); }
__device__ __forceinline__ unsigned xb_xcc_id() { return (unsigned)__builtin_amdgcn_s_getreg((3 << 11) | 20) & 0xFu; }
#define XB_SPIN(cond, bar) do { unsigned _sp = 0; while (cond) { __builtin_amdgcn_s_sleep(1); \
    if ((++_sp & 255u) == 0u) { if (xb_ld(&(bar)[XB_TMO])) break; if (_sp > XB_SPIN_CAP) { atomicAdd(&(bar)[XB_TMO], 1u); break; } } } } while (0)

struct XcdBarrier {
    unsigned* bar; unsigned x;
    volatile LAS unsigned* st;
};

__device__ __forceinline__ XcdBarrier xcd_barrier_post(unsigned* bar, volatile LAS unsigned* st) {
    XcdBarrier b; b.bar = bar; b.x = xb_xcc_id(); b.st = st;
    if (threadIdx.x == 0) (void)xb_add(&bar[XB_XCNT(b.x)], 1u);
    return b;
}
__device__ __forceinline__ void xcd_barrier_complete(unsigned* bar, unsigned x, unsigned& nloc, unsigned& nx) {
    const unsigned G = gridDim.x * gridDim.y * gridDim.z;
    unsigned sum, cnt, mine, sp = 0u;
    for (;;) {
        sum = 0u; cnt = 0u; mine = 0u;
#pragma unroll
        for (unsigned j = 0; j < 16; ++j) { const unsigned c = xb_ld(&bar[XB_XCNT(j)]); sum += c; cnt += (c > 0u) ? 1u : 0u; mine = (j == x) ? c : mine; }
        if (sum == G) break;
        __builtin_amdgcn_s_sleep(1);
        if ((++sp & 255u) == 0u) { if (xb_ld(&bar[XB_TMO])) break; if (sp > XB_SPIN_CAP) { atomicAdd(&bar[XB_TMO], 1u); break; } }
    }
    nloc = mine > 0u ? mine : 1u; nx = cnt > 0u ? cnt : 1u;
}

__device__ __forceinline__ void xcd_barrier(const XcdBarrier& b) {
    asm volatile("s_waitcnt vmcnt(0)" ::: "memory");
    __syncthreads();
    if (threadIdx.x == 0) {
        unsigned* bar = b.bar; asm volatile("" : "+s"(bar));
        __builtin_amdgcn_s_waitcnt(0);
        volatile LAS unsigned* stp = b.st; asm volatile("" : "+s"(stp));
        unsigned nloc = stp[0], nx = stp[1];
        if (nloc == 0u) { xcd_barrier_complete(bar, b.x, nloc, nx); stp[0] = nloc; stp[1] = nx; }
        const unsigned old = xb_add(&bar[XB_XSUB(b.x)], 1u);
        const unsigned gen = old / nloc;
        if (old + 1u == (gen + 1u) * nloc) {
            __builtin_amdgcn_fence(__ATOMIC_RELEASE, "agent");
            asm volatile("s_waitcnt vmcnt(0)" ::: "memory");
            const unsigned og = xb_add(&bar[XB_TOP], 1u);
            const unsigned tg = og / nx;
            if (og + 1u == (tg + 1u) * nx) xb_add(&bar[XB_TOPGEN], 1u);
            else XB_SPIN(xb_ld(&bar[XB_TOPGEN]) == tg, bar);
            __builtin_amdgcn_fence(__ATOMIC_ACQUIRE, "agent");
            xb_add(&bar[XB_XGEN(b.x)], 1u);
            asm volatile("s_waitcnt vmcnt(0)" ::: "memory");
        } else {
            XB_SPIN(xb_ld(&bar[XB_XGEN(b.x)]) == gen, bar);
            __builtin_amdgcn_fence(__ATOMIC_ACQUIRE, "agent");
            asm volatile("s_waitcnt vmcnt(0)" ::: "memory");
        }
    }
    __syncthreads();
}

struct P {
    const float *x, *mem, *rel_bias, *w_in, *b_in, *conv_w, *diff_lambda, *subln_g, *mlstm_norm_g, *w_mem_kv, *w_branch, *w_out, *ln1_g, *ln1_b,
                *w_router, *router_bias, *w_e_gate, *w_e_up, *w_e_down, *w_s_gate, *w_s_up, *w_s_down, *ln2_g, *ln2_b;
    float* out; unsigned char* ws; int s_lo, s_hi;
};
typedef const P __attribute__((address_space(4)))* PP;
DI PP kargs() { PP k = (PP)__builtin_amdgcn_kernarg_segment_ptr(); asm volatile("" : "+s"(k)); return k; }
DI P load_args(PP k) { P r; const unsigned long long __attribute__((address_space(4)))* s = (const unsigned long long __attribute__((address_space(4)))*)k;
    void** d = (void**)&r;
#pragma unroll
    for (int i = 0; i < 26; ++i) d[i] = (void*)(GAS char*)s[i];
    ((unsigned long long*)&r)[26] = s[26];
    return r; }
static_assert(sizeof(P) == 27 * 8, "P = 26 pointers + 2 ints");
#define WSP(T, off) ((T*)(p.ws + (off)))

DI void transpose_item(const float* W, int ldw, int src_col0, bf16_t* WT, int ldt, int dst_row0, int k0, LAS float* scr, int lane) {
    float v[32];
    const float* src = W + (size_t)(k0 + (lane >> 5)) * ldw + src_col0 + (lane & 31);
#pragma unroll
    for (int i = 0; i < 32; ++i) v[i] = src[(size_t)(2 * i) * ldw];
#pragma unroll
    for (int i = 0; i < 32; ++i) scr[(2 * i + (lane >> 5)) * 33 + (lane & 31)] = v[i];
    LDS_WAIT();
    const int c = lane & 7;
#pragma unroll
    for (int j = 0; j < 4; ++j) { const int n = (lane >> 3) + 8 * j; const LAS float* s = scr + (8 * c) * 33 + n;
        u32x4 o; o.x = cvt_pk_bf16(s[0 * 33], s[1 * 33]); o.y = cvt_pk_bf16(s[2 * 33], s[3 * 33]); o.z = cvt_pk_bf16(s[4 * 33], s[5 * 33]); o.w = cvt_pk_bf16(s[6 * 33], s[7 * 33]);
        *(u32x4*)(WT + (size_t)(dst_row0 + n) * ldt + k0 + 8 * c) = o; }
    LDS_WAIT();
}
DI void transpose_mat(const float* W, int ldw, int src_col0, int K, int N, bf16_t* WT, int ldt, int dst_row0, int gw, int NGW, LAS float* scr, int lane) {
    const int nblk = N / 32, items = (K / 64) * nblk;
    for (int it = gw; it < items; it += NGW) { const int kb = it / nblk, nb = it % nblk; transpose_item(W, ldw, src_col0 + nb * 32, WT, ldt, dst_row0 + nb * 32, kb * 64, scr, lane); }
}
DI void row_to_bf16(const float* src, bf16_t* dst, int lane) {
    const f32x4* s = (const f32x4*)src + lane; u32x2* d = (u32x2*)dst + lane;
#pragma unroll
    for (int j = 0; j < 4; ++j) { const f32x4 v = s[64 * j]; u32x2 o; o.x = cvt_pk_bf16(v[0], v[1]); o.y = cvt_pk_bf16(v[2], v[3]); d[64 * j] = o; }
}

DI void ph_prologue(PP pk_, LAS unsigned char* lds) { const P p = load_args(pk_);
    const int tid = tid_local(), lane = tid & 63, wave = tid >> 6, gw = blockIdx.x * 8 + wave, NGW = gridDim.x * 8;
    LAS float* scr = (LAS float*)(lds + wave * 16384);
    bf16_t* WinT = WSP(bf16_t, WS_WIN);
    transpose_mat(p.w_in, CIN, 0, 1024, 7168, WinT, 1024, 0, gw, NGW, scr, lane);
    transpose_mat(p.w_in, CIN, 7176, 1024, 4096, WinT, 1024, 7168, gw, NGW, scr, lane);
    transpose_mat(p.w_mem_kv, 2048, 0, 1024, 2048, WSP(bf16_t, WS_WKV), 1024, 0, gw, NGW, scr, lane);
    for (int n = 0; n < 3; ++n) transpose_mat(p.w_branch + (size_t)n * 1024 * 1024, 1024, 0, 1024, 1024, WSP(bf16_t, WS_WBR) + n * 1024, 3072, 0, gw, NGW, scr, lane);
    transpose_mat(p.w_out, 1024, 0, 1024, 1024, WSP(bf16_t, WS_WOUT), 1024, 0, gw, NGW, scr, lane);
    transpose_mat(p.w_router, 256, 0, 1024, 256, WSP(bf16_t, WS_WR), 1024, 0, gw, NGW, scr, lane);
    bf16_t* memb = WSP(bf16_t, WS_MEMB);
    for (int r = gw; r < NBATCH * 256; r += NGW) row_to_bf16(p.mem + (size_t)r * 1024, memb + (size_t)r * 1024, lane);
    float* bias = WSP(float, WS_MISC + MS_BIAS);
    for (int j = blockIdx.x * 512 + tid; j < NU; j += gridDim.x * 512) bias[j] = p.b_in[j + (j >= 7168 ? 8 : 0)];
    if (gw == 0) {
        const float* lv = p.diff_lambda;
        const float s1 = wave_sum(lv[lane] * lv[64 + lane]), s2 = wave_sum(lv[128 + lane] * lv[192 + lane]);
        if (lane == 0) *WSP(float, WS_MISC + MS_LAM) = expf(s1) - expf(s2) + 0.2f;
    }
}

DI void xconv_item(PP pk_, int g, int item, LAS unsigned char* lds) { const P p = load_args(pk_);
    const int tid = tid_local(), lane = tid & 63, wave = tid >> 6;
    LAS float* wg = (LAS float*)lds;
    __syncthreads();
    for (int i = tid; i < 2048; i += 512) { const int c = i >> 1, hf = i & 1; *(LAS f32x4*)(wg + c * 8 + hf * 4) = *(const f32x4*)(p.w_in + (size_t)c * CIN + 7168 + hf * 4); }
    __syncthreads();
    bf16_t* xb = WSP(bf16_t, WS_XB); float* gif = WSP(float, WS_GIF);
#pragma unroll 1
    for (int rr = 0; rr < 32; ++rr) { const int r = item * 256 + wave * 32 + rr;
        const size_t t = (size_t)g * TG + r;
        const f32x4* xr = (const f32x4*)(p.x + t * 1024) + lane; u32x2* d = (u32x2*)(xb + (size_t)r * 1024) + lane;
        float gs[8];
#pragma unroll
        for (int q = 0; q < 8; ++q) gs[q] = 0.f;
#pragma unroll
        for (int j = 0; j < 4; ++j) { const f32x4 v = xr[64 * j]; u32x2 o; o.x = cvt_pk_bf16(v[0], v[1]); o.y = cvt_pk_bf16(v[2], v[3]); d[64 * j] = o;
#pragma unroll
            for (int e = 0; e < 4; ++e) { const int c = 4 * lane + 256 * j + e; const f32x4 wl = *(const LAS f32x4*)(wg + c * 8), wh = *(const LAS f32x4*)(wg + c * 8 + 4);
                gs[0] += v[e] * wl[0]; gs[1] += v[e] * wl[1]; gs[2] += v[e] * wl[2]; gs[3] += v[e] * wl[3]; gs[4] += v[e] * wh[0]; gs[5] += v[e] * wh[1]; gs[6] += v[e] * wh[2]; gs[7] += v[e] * wh[3]; } }
        float mine = 0.f;
#pragma unroll
        for (int q = 0; q < 8; ++q) { const float s = wave_sum_fast(gs[q]); if (lane == q) mine = s; }
        if (lane < 8) gif[t * 8 + lane] = mine + p.b_in[7168 + lane];
    }
}
DI void ph_xconv(PP pk_, int g, LAS unsigned char* lds) { for (int it = blockIdx.x; it < TG / 256; it += gridDim.x) xconv_item(pk_, g, it, lds); __syncthreads(); }

DI int t5_bucket(int n) { return n < 16 ? n : min(31, 16 + (int)(__log2f((float)n * 0.0625f) * (16.f / 3.f))); }

DI void attn_naive_item(PP pk_, int item, LAS unsigned char* lds) { const P p = load_args(pk_);
    const int tid = tid_local(), qr = tid >> 3, map = (tid >> 2) & 1, dc = tid & 3;
    const int qb = item & 31, h = (item >> 5) & 7, b = item >> 8, q0 = qb * 64, qi = q0 + qr;
    const bf16_t* U = WSP(bf16_t, WS_U); const size_t rbase = (size_t)b * SEQ;
    LAS float* bt = (LAS float*)(lds + 16384);
    if (tid <= 128) bt[tid] = p.rel_bias[t5_bucket(tid) * 8 + h] * 1.4426950408889634f;
    float q[64];
    { const u32x4* qp = (const u32x4*)(U + (rbase + qi) * NU + UQ + h * 128 + map * 64);
#pragma unroll
      for (int i = 0; i < 8; ++i) { const u32x4 w = qp[i]; q[8 * i] = bf_lo(w.x); q[8 * i + 1] = bf_hi(w.x); q[8 * i + 2] = bf_lo(w.y); q[8 * i + 3] = bf_hi(w.y); q[8 * i + 4] = bf_lo(w.z); q[8 * i + 5] = bf_hi(w.z); q[8 * i + 6] = bf_lo(w.w); q[8 * i + 7] = bf_hi(w.w); } }
    float o[32];
#pragma unroll
    for (int c = 0; c < 32; ++c) o[c] = 0.f;
    float mrun = -INFINITY, lrun = 0.f;
    const int ntile = q0 / 32 + 2;
    for (int kt = 0; kt < ntile; ++kt) {
        const int k0 = kt * 32;
        __syncthreads();
        { const int key = tid >> 4, pc = tid & 15; const bf16_t* urow = U + (rbase + k0 + key) * NU;
          *(LAS u32x4*)(lds + (pc >> 3) * 4096 + key * 128 + (pc & 7) * 16) = *(const u32x4*)(urow + UK + h * 128 + pc * 8);
          *(LAS u32x4*)(lds + 8192 + key * 256 + pc * 16) = *(const u32x4*)(urow + UV + h * 128 + pc * 8); }
        __syncthreads();
#pragma unroll 1
        for (int j = 0; j < 32; ++j) {
            const int dist = qi - (k0 + j);
            const LAS u32x4* kp = (const LAS u32x4*)(lds + map * 4096 + j * 128); float a = 0.f;
#pragma unroll
            for (int i = 0; i < 8; ++i) { const u32x4 w = kp[i]; a += q[8 * i] * bf_lo(w.x) + q[8 * i + 1] * bf_hi(w.x) + q[8 * i + 2] * bf_lo(w.y) + q[8 * i + 3] * bf_hi(w.y) + q[8 * i + 4] * bf_lo(w.z) + q[8 * i + 5] * bf_hi(w.z) + q[8 * i + 6] * bf_lo(w.w) + q[8 * i + 7] * bf_hi(w.w); }
            if (dist >= 0) {
                a += bt[min(dist, 128)];
                if (a > mrun) { const float sc = __builtin_amdgcn_exp2f(mrun - a); mrun = a; lrun *= sc;
#pragma unroll
                    for (int c = 0; c < 32; ++c) o[c] *= sc; }
                const float pj = __builtin_amdgcn_exp2f(a - mrun); lrun += pj; const LAS u32x4* vp = (const LAS u32x4*)(lds + 8192 + j * 256 + dc * 64);
#pragma unroll
                for (int i = 0; i < 4; ++i) { const u32x4 w = vp[i]; o[8 * i] += pj * bf_lo(w.x); o[8 * i + 1] += pj * bf_hi(w.x); o[8 * i + 2] += pj * bf_lo(w.y); o[8 * i + 3] += pj * bf_hi(w.y); o[8 * i + 4] += pj * bf_lo(w.z); o[8 * i + 5] += pj * bf_hi(w.z); o[8 * i + 6] += pj * bf_lo(w.w); o[8 * i + 7] += pj * bf_hi(w.w); }
            }
        }
    }
    const float lam = *WSP(float, WS_MISC + MS_LAM), inv = 1.f / lrun;
    float ss = 0.f;
#pragma unroll
    for (int c = 0; c < 32; ++c) { const float mine = o[c] * inv, other = __shfl_xor(mine, 4); o[c] = mine - lam * other; ss += o[c] * o[c]; }
    ss += __shfl_xor(ss, 1); ss += __shfl_xor(ss, 2);
    const float rs = rsqrtf(ss * (1.f / 128.f) + LN_EPS) * 0.8f;
    if (map == 0) { bf16_t* yp = WSP(bf16_t, WS_Y) + (rbase + qi) * 3072 + h * 128 + dc * 32; const float* gp = p.subln_g + dc * 32;
#pragma unroll
        for (int i = 0; i < 4; ++i) { u32x4 w; w.x = cvt_pk_bf16(o[8 * i] * rs * gp[8 * i], o[8 * i + 1] * rs * gp[8 * i + 1]); w.y = cvt_pk_bf16(o[8 * i + 2] * rs * gp[8 * i + 2], o[8 * i + 3] * rs * gp[8 * i + 3]);
            w.z = cvt_pk_bf16(o[8 * i + 4] * rs * gp[8 * i + 4], o[8 * i + 5] * rs * gp[8 * i + 5]); w.w = cvt_pk_bf16(o[8 * i + 6] * rs * gp[8 * i + 6], o[8 * i + 7] * rs * gp[8 * i + 7]); *(u32x4*)(yp + 8 * i) = w; } }
    __syncthreads();
}

DI void xattn_naive_item(PP pk_, int g, int item, LAS unsigned char* lds) { const P p = load_args(pk_);
    const int tid = tid_local(), lane = tid & 63, wave = tid >> 6;
    const int qb = item & 63, h = (item >> 6) & 3, b = item >> 8;
    const bf16_t* U = WSP(bf16_t, WS_U); const bf16_t* KV = WSP(bf16_t, WS_KVM) + (size_t)(g * BG + b) * 256 * 2048;
    const size_t r0 = (size_t)b * SEQ + qb * 32;
    LAS float* qs = (LAS float*)lds; LAS float* ps = (LAS float*)(lds + 32768);
    __syncthreads();
    for (int i = tid; i < 32 * 32; i += 512) { const int r = i >> 5, c8 = i & 31; const u32x4 w = *(const u32x4*)(U + (r0 + r) * NU + UCQ + h * 256 + c8 * 8); LAS float* d = qs + r * 256 + c8 * 8;
        d[0] = bf_lo(w.x); d[1] = bf_hi(w.x); d[2] = bf_lo(w.y); d[3] = bf_hi(w.y); d[4] = bf_lo(w.z); d[5] = bf_hi(w.z); d[6] = bf_lo(w.w); d[7] = bf_hi(w.w); }
    __syncthreads();
    const int mcol = tid & 255, rh = tid >> 8;
    { float a[16];
#pragma unroll
      for (int r = 0; r < 16; ++r) a[r] = 0.f;
      const bf16_t* kp = KV + (size_t)mcol * 2048 + h * 256;
      for (int d0 = 0; d0 < 256; d0 += 8) { const u32x4 w = *(const u32x4*)(kp + d0); float kv[8] = {bf_lo(w.x), bf_hi(w.x), bf_lo(w.y), bf_hi(w.y), bf_lo(w.z), bf_hi(w.z), bf_lo(w.w), bf_hi(w.w)};
#pragma unroll
          for (int r = 0; r < 16; ++r) { const LAS f32x4* qp = (const LAS f32x4*)(qs + (rh * 16 + r) * 256 + d0); const f32x4 qa = qp[0], qc = qp[1];
              a[r] += qa[0] * kv[0] + qa[1] * kv[1] + qa[2] * kv[2] + qa[3] * kv[3] + qc[0] * kv[4] + qc[1] * kv[5] + qc[2] * kv[6] + qc[3] * kv[7]; } }
#pragma unroll
      for (int r = 0; r < 16; ++r) ps[(rh * 16 + r) * 256 + mcol] = a[r]; }
    __syncthreads();
#pragma unroll
    for (int rr = 0; rr < 4; ++rr) { const int r = wave * 4 + rr; LAS f32x4* pr = (LAS f32x4*)(ps + r * 256) + lane; f32x4 v = *pr;
        const float mx = wave_max(fmaxf(fmaxf(v[0], v[1]), fmaxf(v[2], v[3])));
        v = (f32x4){__builtin_amdgcn_exp2f(v[0] - mx), __builtin_amdgcn_exp2f(v[1] - mx), __builtin_amdgcn_exp2f(v[2] - mx), __builtin_amdgcn_exp2f(v[3] - mx)};
        const float inv = 1.f / wave_sum((v[0] + v[1]) + (v[2] + v[3])); *pr = v * inv; }
    __syncthreads();
    { float a[16];
#pragma unroll
      for (int r = 0; r < 16; ++r) a[r] = 0.f;
      const bf16_t* vp = KV + 1024 + h * 256 + mcol;
      for (int m = 0; m < 256; ++m) { const float vv = bf2f(vp[(size_t)m * 2048]);
#pragma unroll
          for (int r = 0; r < 16; ++r) a[r] += ps[(rh * 16 + r) * 256 + m] * vv; }
      bf16_t* yp = WSP(bf16_t, WS_Y) + (r0 + rh * 16) * 3072 + 2048 + h * 256 + mcol;
#pragma unroll
      for (int r = 0; r < 16; ++r) yp[(size_t)r * 3072] = (bf16_t)(cvt_pk_bf16(a[r], 0.f) & 0xffffu); }
    __syncthreads();
}

DI void mlstm_naive_item(PP pk_, int g, int item, LAS unsigned char* lds) { const P p = load_args(pk_);
    const int tid = tid_local(), v = tid >> 3, kc = tid & 7;
    const int sl = item & 3, h = (item >> 2) & 3, b = item >> 4;
    const bf16_t* U = WSP(bf16_t, WS_U); const float* gif = WSP(float, WS_GIF); float* HT = WSP(float, WS_F32);
    const size_t rbase = (size_t)b * SEQ; const size_t tbase = ((size_t)g * BG + b) * SEQ;
    LAS bf16_t* qs = (LAS bf16_t*)lds; LAS bf16_t* ks = (LAS bf16_t*)(lds + 32768); LAS float* vs = (LAS float*)(lds + 65536); LAS float* gi = (LAS float*)(lds + 81920); LAS float* gf = (LAS float*)(lds + 82176);
    float C[32], nn[32];
#pragma unroll
    for (int i = 0; i < 32; ++i) { C[i] = 0.f; nn[i] = 0.f; }
    float mst = 0.f;
    for (int ch = 0; ch < SEQ / 64; ++ch) {
        __syncthreads();
        for (int i = tid; i < 2 * 64 * 32; i += 512) { const int isk = i >> 11, s = (i >> 5) & 63, c8 = i & 31; const int ts = ch * 64 + s; const int col = (isk ? UMK : UMQ) + h * 256 + c8 * 8;
            float a[8];
#pragma unroll
            for (int e = 0; e < 8; ++e) a[e] = 0.f;
#pragma unroll
            for (int j = 0; j < 4; ++j) { const int tt = ts - 3 + j; if (tt >= 0) { const u32x4 w = *(const u32x4*)(U + (rbase + tt) * NU + col); const float* cw = p.conv_w + j * 2048 + isk * 1024 + h * 256 + c8 * 8;
                    a[0] += cw[0] * bf_lo(w.x); a[1] += cw[1] * bf_hi(w.x); a[2] += cw[2] * bf_lo(w.y); a[3] += cw[3] * bf_hi(w.y); a[4] += cw[4] * bf_lo(w.z); a[5] += cw[5] * bf_hi(w.z); a[6] += cw[6] * bf_lo(w.w); a[7] += cw[7] * bf_hi(w.w); } }
            const float sc = isk ? 0.0625f : 1.f; u32x4 o; o.x = cvt_pk_bf16(silu(a[0]) * sc, silu(a[1]) * sc); o.y = cvt_pk_bf16(silu(a[2]) * sc, silu(a[3]) * sc); o.z = cvt_pk_bf16(silu(a[4]) * sc, silu(a[5]) * sc); o.w = cvt_pk_bf16(silu(a[6]) * sc, silu(a[7]) * sc);
            *(LAS u32x4*)((isk ? ks : qs) + s * 256 + c8 * 8) = o; }
        for (int i = tid; i < 64 * 64; i += 512) { const int s = i >> 6, c = i & 63; vs[i] = bf2f(U[(rbase + ch * 64 + s) * NU + UMV + h * 256 + sl * 64 + c]); }
        if (tid < 64) { gi[tid] = gif[(tbase + ch * 64 + tid) * 8 + h]; gf[tid] = gif[(tbase + ch * 64 + tid) * 8 + 4 + h]; }
        __syncthreads();
        for (int s = 0; s < 64; ++s) {
            const float ip = gi[s], fp = gf[s];
            const float fl = fminf(fp, 0.f) - log1pf(expf(-fabsf(fp)));
            const float mm = fmaxf(fl + mst, ip), fg = expf(fl + mst - mm), ig = expf(ip - mm); mst = mm;
            const float vv = vs[s * 64 + v] * ig;
            const LAS u32x4* kp = (const LAS u32x4*)(ks + s * 256 + kc * 32); const LAS u32x4* qp = (const LAS u32x4*)(qs + s * 256 + kc * 32);
            float num = 0.f, den = 0.f;
#pragma unroll
            for (int c4 = 0; c4 < 4; ++c4) { const u32x4 kw = kp[c4], qw = qp[c4];
#pragma unroll
                for (int e = 0; e < 4; ++e) { const float k0 = bf_lo(kw[e]), k1 = bf_hi(kw[e]), q0 = bf_lo(qw[e]), q1 = bf_hi(qw[e]); const int kk = c4 * 8 + 2 * e;
                    C[kk] = fg * C[kk] + vv * k0; nn[kk] = fg * nn[kk] + ig * k0; num += C[kk] * q0; den += nn[kk] * q0;
                    C[kk + 1] = fg * C[kk + 1] + vv * k1; nn[kk + 1] = fg * nn[kk + 1] + ig * k1; num += C[kk + 1] * q1; den += nn[kk + 1] * q1; } }
            num += __shfl_xor(num, 1); num += __shfl_xor(num, 2); num += __shfl_xor(num, 4);
            den += __shfl_xor(den, 1); den += __shfl_xor(den, 2); den += __shfl_xor(den, 4);
            if (kc == 0) HT[(rbase + ch * 64 + s) * 1024 + h * 256 + sl * 64 + v] = num / fmaxf(fabsf(den), expf(-mst));
        }
    }
    __syncthreads();
}

typedef float f32x16 __attribute__((ext_vector_type(16)));
typedef __bf16 bf16x2_t __attribute__((ext_vector_type(2)));
typedef short s16x4 __attribute__((ext_vector_type(4)));
constexpr float LOG2E = 1.4426950408889634f;
DI unsigned pk_bf16(float a, float b) { const f32x2 v = {a, b}; return __builtin_bit_cast(unsigned, __builtin_convertvector(v, bf16x2_t)); }
DI int crow(int reg, int hh) { return (reg & 3) + 8 * (reg >> 2) + 4 * hh; }
#define MFMA32(a, b, c) __builtin_amdgcn_mfma_f32_32x32x16_bf16((a), (b), (c), 0, 0, 0)
DI bf16x8 tr_pair(const LAS unsigned char* a0, const LAS unsigned char* a1) {
    const s16x4 lo = __builtin_amdgcn_ds_read_tr16_b64_v4i16((LAS s16x4*)a0), hi = __builtin_amdgcn_ds_read_tr16_b64_v4i16((LAS s16x4*)a1);
    return __builtin_shufflevector(lo, hi, 0, 1, 2, 3, 4, 5, 6, 7);
}
DI bf16x8 pack_half(const f32x16& x, int s2) {
    u32x4 w;
#pragma unroll
    for (int k = 0; k < 4; ++k) w[k] = pk_bf16(x[8 * s2 + 2 * k], x[8 * s2 + 2 * k + 1]);
    return __builtin_bit_cast(bf16x8, w);
}
DI float xhalf_max(float x) { const auto r = __builtin_amdgcn_permlane32_swap(__builtin_bit_cast(int, x), __builtin_bit_cast(int, x), false, false); return fmaxf(__builtin_bit_cast(float, (int)r[0]), __builtin_bit_cast(float, (int)r[1])); }
DI float xhalf_sum(float x) { const auto r = __builtin_amdgcn_permlane32_swap(__builtin_bit_cast(int, x), __builtin_bit_cast(int, x), false, false); return __builtin_bit_cast(float, (int)r[0]) + __builtin_bit_cast(float, (int)r[1]); }
DI int next_item(unsigned* ctr, LAS unsigned char* lds) {
    volatile LAS int* slot = (volatile LAS int*)(lds + LDS_MISC + 64);
    __syncthreads();
    if (threadIdx.x == 0) *slot = (int)__hip_atomic_fetch_add(ctr, 1u, __ATOMIC_RELAXED, __HIP_MEMORY_SCOPE_AGENT);
    __syncthreads();
    return *slot;
}

constexpr int AT_KPITCH = 144, AT_VPITCH = 320, AT_KBYTES = 64 * AT_KPITCH, AT_VOFF = 2 * AT_KBYTES, AT_BUF = AT_VOFF + 64 * AT_VPITCH, AT_BT = 2 * AT_BUF;
DI void attn_tile(const LAS unsigned char* buf, int k0, int qw, int r, int hh, unsigned ka, unsigned va, const LAS float* bt, float cfar, const bf16x8 (&qf)[4], f32x16 (&O)[4], float& mrun, float& lrun) {
    if (k0 <= qw + 31) {
            const bool far = (qw - k0 - 63) >= 128;
            f32x16 S[2];
#pragma unroll
            for (int sub = 0; sub < 2; ++sub)
#pragma unroll
                for (int i = 0; i < 16; ++i) S[sub][i] = far ? cfar : 0.f;
#pragma unroll
            for (int sub = 0; sub < 2; ++sub)
#pragma unroll
                for (int s = 0; s < 4; ++s) S[sub] = MFMA32(*(const LAS bf16x8*)(buf + ka + sub * 32 * AT_KPITCH + s * 32), qf[s], S[sub]);
            if (!far) {
#pragma unroll
                for (int sub = 0; sub < 2; ++sub)
#pragma unroll
                    for (int i = 0; i < 16; ++i) { const int dist = (qw + r) - (k0 + sub * 32 + crow(i, hh)); S[sub][i] = dist < 0 ? -INFINITY : S[sub][i] + bt[min(dist, 128)]; }
            }
            float mx = fmaxf(S[0][0], S[1][0]);
#pragma unroll
            for (int i = 1; i < 16; ++i) mx = fmaxf(mx, fmaxf(S[0][i], S[1][i]));
            mx = xhalf_max(mx);
            const float mnew = fmaxf(mrun, mx);
            if (__builtin_amdgcn_ballot_w64(mnew > mrun) != 0ull) { const float alpha = __builtin_amdgcn_exp2f(mrun - mnew); lrun *= alpha;
#pragma unroll
                for (int dt = 0; dt < 4; ++dt) O[dt] *= alpha; }
            mrun = mnew;
#pragma unroll
            for (int sub = 0; sub < 2; ++sub)
#pragma unroll
                for (int i = 0; i < 16; ++i) { S[sub][i] = __builtin_amdgcn_exp2f(S[sub][i] - mnew); lrun += S[sub][i]; }
#pragma unroll
            for (int sub = 0; sub < 2; ++sub)
#pragma unroll
                for (int s2 = 0; s2 < 2; ++s2) { const bf16x8 pb = pack_half(S[sub], s2); const LAS unsigned char* vb = buf + va + (sub * 32 + 16 * s2) * AT_VPITCH;
#pragma unroll
                    for (int dt = 0; dt < 4; ++dt) O[dt] = MFMA32(tr_pair(vb + dt * 64, vb + dt * 64 + 8 * AT_VPITCH), pb, O[dt]); }
        }
}
DI void attn_mfma_item(PP pk_, int item, LAS unsigned char* lds) { const P p = load_args(pk_);
    const int tid = tid_local(), lane = tid & 63, wave = __builtin_amdgcn_readfirstlane(tid >> 6), mp = wave & 1, rq = wave >> 1, hh = lane >> 5, r = lane & 31;
    const int qb = item & 15, h = (item >> 4) & 7, b = item >> 7;
    const int q0 = qb * 128, qw = q0 + rq * 32, nt = 2 * qb + 2;
    const bf16_t* U = WSP(bf16_t, WS_U); const size_t rbase = (size_t)b * SEQ;
    LAS float* bt = (LAS float*)(lds + AT_BT);
    __syncthreads();
    if (tid <= 128) bt[tid] = p.rel_bias[t5_bucket(tid) * 8 + h] * LOG2E;
    bf16x8 qf[4];
    { const bf16_t* qp = U + (rbase + qw + r) * NU + UQ + h * 128 + mp * 64 + 8 * hh;
#pragma unroll
      for (int s = 0; s < 4; ++s) qf[s] = *(const bf16x8*)(qp + 16 * s); }
    f32x16 O[4];
#pragma unroll
    for (int dt = 0; dt < 4; ++dt)
#pragma unroll
        for (int i = 0; i < 16; ++i) O[dt][i] = 0.f;
    float mrun = -INFINITY, lrun = 0.f;
    const int row0 = tid >> 4, c16 = tid & 15;
    const bf16_t* gk = U + (rbase + row0) * NU + UK + h * 128 + c16 * 8;
    const bf16_t* gv = U + (rbase + row0) * NU + UV + h * 128 + c16 * 8;
    const unsigned lk = (c16 >> 3) * AT_KBYTES + row0 * AT_KPITCH + (c16 & 7) * 16, lv = AT_VOFF + row0 * AT_VPITCH + c16 * 16;
    u32x4 st[4];
#define AT_LOAD(t_) do { const size_t o_ = (size_t)(t_) * 64 * NU; st[0] = *(const u32x4*)(gk + o_); st[1] = *(const u32x4*)(gk + o_ + (size_t)32 * NU); st[2] = *(const u32x4*)(gv + o_); st[3] = *(const u32x4*)(gv + o_ + (size_t)32 * NU); } while (0)
#define AT_STORE(bufp) do { *(LAS u32x4*)((bufp) + lk) = st[0]; *(LAS u32x4*)((bufp) + lk + 32 * AT_KPITCH) = st[1]; *(LAS u32x4*)((bufp) + lv) = st[2]; *(LAS u32x4*)((bufp) + lv + 32 * AT_VPITCH) = st[3]; } while (0)
    AT_LOAD(0); AT_STORE(lds); __syncthreads();
    const float cfar = bt[128];
    const unsigned ka = mp * AT_KBYTES + r * AT_KPITCH + hh * 16;
    const int i16 = lane & 15;
    const unsigned va = AT_VOFF + (4 * hh + (i16 >> 2)) * AT_VPITCH + (16 * ((lane >> 4) & 1) + 4 * (i16 & 3)) * 2;
    u32x4 st2[4];
#define AT_LOAD2(t_) do { const size_t o_ = (size_t)(t_) * 64 * NU; st2[0] = *(const u32x4*)(gk + o_); st2[1] = *(const u32x4*)(gk + o_ + (size_t)32 * NU); st2[2] = *(const u32x4*)(gv + o_); st2[3] = *(const u32x4*)(gv + o_ + (size_t)32 * NU); } while (0)
#define AT_STORE2(bufp) do { *(LAS u32x4*)((bufp) + lk) = st2[0]; *(LAS u32x4*)((bufp) + lk + 32 * AT_KPITCH) = st2[1]; *(LAS u32x4*)((bufp) + lv) = st2[2]; *(LAS u32x4*)((bufp) + lv + 32 * AT_VPITCH) = st2[3]; } while (0)
    AT_LOAD2(1);
    for (int t = 0; t < nt; t += 2) {
        if (t + 2 < nt) AT_LOAD(t + 2);
        attn_tile(lds, t * 64, qw, r, hh, ka, va, bt, cfar, qf, O, mrun, lrun);
        AT_STORE2(lds + AT_BUF);
        lds_barrier();
        if (t + 3 < nt) AT_LOAD2(t + 3);
        attn_tile(lds + AT_BUF, t * 64 + 64, qw, r, hh, ka, va, bt, cfar, qf, O, mrun, lrun);
        if (t + 2 < nt) AT_STORE(lds);
        lds_barrier();
    }
#undef AT_LOAD2
#undef AT_STORE2
#undef AT_LOAD
#undef AT_STORE
    const float inv = 1.f / xhalf_sum(lrun);
    LAS float* X = (LAS float*)lds;
    if (mp == 1) {
#pragma unroll
        for (int dt = 0; dt < 4; ++dt)
#pragma unroll
            for (int i = 0; i < 16; ++i) X[(rq * 64 + dt * 16 + i) * 64 + lane] = O[dt][i] * inv;
    }
    __syncthreads();
    if (mp == 0) {
        const float lam = *WSP(float, WS_MISC + MS_LAM); float ss = 0.f;
#pragma unroll
        for (int dt = 0; dt < 4; ++dt)
#pragma unroll
            for (int i = 0; i < 16; ++i) { const float v = O[dt][i] * inv - lam * X[(rq * 64 + dt * 16 + i) * 64 + lane]; O[dt][i] = v; ss += v * v; }
        ss = xhalf_sum(ss);
        const float rs = rsqrtf(ss * (1.f / 128.f) + LN_EPS) * 0.8f;
        bf16_t* yp = WSP(bf16_t, WS_Y) + (rbase + qw + r) * 3072 + h * 128;
#pragma unroll
        for (int dt = 0; dt < 4; ++dt)
#pragma unroll
            for (int g4 = 0; g4 < 4; ++g4) { const int dv = dt * 32 + 8 * g4 + 4 * hh; const f32x4 gn = *(const f32x4*)(p.subln_g + dv);
                u32x2 w; w.x = pk_bf16(O[dt][4 * g4] * rs * gn[0], O[dt][4 * g4 + 1] * rs * gn[1]); w.y = pk_bf16(O[dt][4 * g4 + 2] * rs * gn[2], O[dt][4 * g4 + 3] * rs * gn[3]);
                *(u32x2*)(yp + dv) = w; }
    }
}
DI void ph_conv(PP pk_, int g, LAS unsigned char* lds) { const P p = load_args(pk_);
    const int tid = tid_local();
    const bf16_t* U = WSP(bf16_t, WS_U); bf16_t* QKC = WSP(bf16_t, WS_QKC);
    for (int t = blockIdx.x * 512 + tid; t < (TG / 32) * 256; t += gridDim.x * 512) {
        const int c8 = t & 255, r0 = (t >> 8) * 32, isk = c8 >> 7; const float sc = isk ? 0.0625f : 1.f;
        f32x4 cw[4][2];
#pragma unroll
        for (int j = 0; j < 4; ++j) { cw[j][0] = *(const f32x4*)(p.conv_w + j * 2048 + c8 * 8); cw[j][1] = *(const f32x4*)(p.conv_w + j * 2048 + c8 * 8 + 4); }
        const bf16_t* src = U + (size_t)r0 * NU + UMQ + c8 * 8; bf16_t* dst = QKC + (size_t)r0 * 2048 + c8 * 8;
        const bool head = (r0 & (SEQ - 1)) == 0;
        u32x4 x0 = {0u, 0u, 0u, 0u}, x1 = x0, x2 = x0, x3;
        if (!head) { x0 = *(const u32x4*)(src - 3 * (size_t)NU); x1 = *(const u32x4*)(src - 2 * (size_t)NU); x2 = *(const u32x4*)(src - (size_t)NU); }
#define CONV_OUT(a_, b_, c_, d_, row_) do { float o_[8]; \
        o_[0] = cw[0][0][0] * bf_lo(a_.x) + cw[1][0][0] * bf_lo(b_.x) + cw[2][0][0] * bf_lo(c_.x) + cw[3][0][0] * bf_lo(d_.x); \
        o_[1] = cw[0][0][1] * bf_hi(a_.x) + cw[1][0][1] * bf_hi(b_.x) + cw[2][0][1] * bf_hi(c_.x) + cw[3][0][1] * bf_hi(d_.x); \
        o_[2] = cw[0][0][2] * bf_lo(a_.y) + cw[1][0][2] * bf_lo(b_.y) + cw[2][0][2] * bf_lo(c_.y) + cw[3][0][2] * bf_lo(d_.y); \
        o_[3] = cw[0][0][3] * bf_hi(a_.y) + cw[1][0][3] * bf_hi(b_.y) + cw[2][0][3] * bf_hi(c_.y) + cw[3][0][3] * bf_hi(d_.y); \
        o_[4] = cw[0][1][0] * bf_lo(a_.z) + cw[1][1][0] * bf_lo(b_.z) + cw[2][1][0] * bf_lo(c_.z) + cw[3][1][0] * bf_lo(d_.z); \
        o_[5] = cw[0][1][1] * bf_hi(a_.z) + cw[1][1][1] * bf_hi(b_.z) + cw[2][1][1] * bf_hi(c_.z) + cw[3][1][1] * bf_hi(d_.z); \
        o_[6] = cw[0][1][2] * bf_lo(a_.w) + cw[1][1][2] * bf_lo(b_.w) + cw[2][1][2] * bf_lo(c_.w) + cw[3][1][2] * bf_lo(d_.w); \
        o_[7] = cw[0][1][3] * bf_hi(a_.w) + cw[1][1][3] * bf_hi(b_.w) + cw[2][1][3] * bf_hi(c_.w) + cw[3][1][3] * bf_hi(d_.w); \
        u32x4 w_; w_.x = pk_bf16(silu(o_[0]) * sc, silu(o_[1]) * sc); w_.y = pk_bf16(silu(o_[2]) * sc, silu(o_[3]) * sc); w_.z = pk_bf16(silu(o_[4]) * sc, silu(o_[5]) * sc); w_.w = pk_bf16(silu(o_[6]) * sc, silu(o_[7]) * sc); \
        *(u32x4*)(dst + (size_t)(row_) * 2048) = w_; } while (0)
#pragma unroll 1
        for (int i = 0; i < 32; i += 4) {
            const u32x4 y0 = *(const u32x4*)(src + (size_t)(i) * NU), y1 = *(const u32x4*)(src + (size_t)(i + 1) * NU), y2 = *(const u32x4*)(src + (size_t)(i + 2) * NU), y3 = *(const u32x4*)(src + (size_t)(i + 3) * NU);
            x3 = y0; CONV_OUT(x0, x1, x2, x3, i);
            CONV_OUT(x1, x2, y0, y1, i + 1);
            CONV_OUT(x2, y0, y1, y2, i + 2);
            CONV_OUT(y0, y1, y2, y3, i + 3);
            x0 = y1; x1 = y2; x2 = y3;
        }
#undef CONV_OUT
    }
}
constexpr int ML_QP = 528, ML_KP = 576, ML_VP = 576, ML_WP = 144;
constexpr int ML_Q = 0, ML_K = ML_Q + 64 * ML_QP, ML_V = ML_K + 64 * ML_KP, ML_W = ML_V + 64 * ML_VP, ML_TAB = ML_W + 64 * ML_WP;
constexpr int T_BCUM = 0, T_A = 256, T_MROW = 512, T_IW = 768, T_WS = 1024, T_RS = 1280, T_ND = 2304, T_GI = 2560, T_GF = 2816, T_N = 3072, T_SC = 4096, T_INVD = 4352, T_NP = 4608;
static_assert(ML_TAB + 4608 + 2048 <= LDS_RING, "mLSTM LDS map");
#ifndef PROBE_ML_SKIP
#define PROBE_ML_SKIP 0
#endif
DI void mlstm_mfma_item(PP pk_, int g, int item, int rep, LAS unsigned char* lds) { const P p = load_args(pk_);
    const int skip = rep > 0 ? PROBE_ML_SKIP : 0;
    const int tid0 = tid_local(), w = __builtin_amdgcn_readfirstlane(tid0 >> 6);
    const int h = item & 3, b = item >> 2;
    const bf16_t* U = WSP(bf16_t, WS_U); const float* gif = WSP(float, WS_GIF); bf16_t* HB = rep > 0 && PROBE_ML_SKIP ? WSP(bf16_t, WS_Z) : WSP(bf16_t, WS_MRG);
    const size_t rbase = (size_t)b * SEQ, tbase = ((size_t)g * BG + b) * SEQ;
    LAS unsigned char* TB = lds + ML_TAB;
#define TABF(off) ((LAS float*)(TB + (off)))
    f32x16 C[8];
#pragma unroll
    for (int kt = 0; kt < 8; ++kt)
#pragma unroll
        for (int i = 0; i < 16; ++i) C[kt][i] = 0.f;
    float mst = 0.f;
    __syncthreads();
    if (tid0 < 256) TABF(T_N)[tid0] = 0.f;
    const bf16_t* QKC = WSP(bf16_t, WS_QKC);
    u32x4 pf[2];
#define ML_PREFETCH(ch_, tv_) do { _Pragma("unroll") for (int i_ = 0; i_ < 2; ++i_) { const int pc_ = (tv_) + 512 * i_, s_ = pc_ >> 5, cc_ = pc_ & 31; const size_t row_ = rbase + (ch_) * 64 + s_; \
        pf[i_] = *(const u32x4*)(QKC + row_ * 2048 + h * 256 + cc_ * 8); } \
        } while (0)
    ML_PREFETCH(0, tid0);
    for (int ch = 0; ch < SEQ / 64; ++ch) {
        int tid = tid0; asm volatile("" : "+v"(tid));
        const int lane = tid & 63, hh = lane >> 5, r = lane & 31, i16 = lane & 15, l4 = lane >> 4;
        lds_barrier();
        {
#pragma unroll
            for (int i = 0; i < 4; ++i) { const int pc = tid + 512 * i, s = pc >> 5, cc = pc & 31;
                *(LAS u32x4*)(lds + ML_Q + s * ML_QP + cc * 16) = i < 2 ? pf[i & 1] : *(const u32x4*)(QKC + (rbase + ch * 64 + s) * 2048 + h * 256 + cc * 8);
                *(LAS u32x4*)(lds + ML_K + s * ML_KP + cc * 16) = *(const u32x4*)(QKC + (rbase + ch * 64 + s) * 2048 + 1024 + h * 256 + cc * 8); }
            if (tid < 64) { TABF(T_GI)[tid] = gif[(tbase + ch * 64 + tid) * 8 + h]; TABF(T_GF)[tid] = gif[(tbase + ch * 64 + tid) * 8 + 4 + h]; }
        }
        lds_barrier();
        if (w == 0 && !(skip & 16)) {
            const float ip = TABF(T_GI)[lane], fp = TABF(T_GF)[lane];
            float bc = fminf(fp, 0.f) - log1pf(expf(-fabsf(fp)));
#pragma unroll
            for (int o = 1; o < 64; o <<= 1) { const float t = __shfl_up(bc, o); if (lane >= o) bc += t; }
            const float aa = ip - bc; float pm = aa;
#pragma unroll
            for (int o = 1; o < 64; o <<= 1) { const float t = __shfl_up(pm, o); if (lane >= o) pm = fmaxf(pm, t); }
            const float mrow = bc + fmaxf(mst, pm), iw = expf(bc + mst - mrow);
            const float total = __shfl(bc, 63), amax = __shfl(pm, 63), mnew = total + fmaxf(mst, amax), decay = expf(total + mst - mnew), ws = expf(total + aa - mnew);
            TABF(T_BCUM)[lane] = bc; TABF(T_A)[lane] = aa; TABF(T_MROW)[lane] = mrow; TABF(T_IW)[lane] = iw; TABF(T_WS)[lane] = ws;
            if (lane == 0) TABF(T_SC)[1] = decay;
            mst = mnew;
        }
        f32x4 S2[2];
#pragma unroll
        for (int tt = 0; tt < 2; ++tt) { const int tile = 2 * w + tt, jt = tile >> 2, st = tile & 3; f32x4 s = {0.f, 0.f, 0.f, 0.f};
            const LAS unsigned char* qa = lds + ML_Q + (jt * 16 + i16) * ML_QP + l4 * 16; const LAS unsigned char* ka = lds + ML_K + (st * 16 + i16) * ML_KP + l4 * 16;
#pragma unroll
            for (int c = 0; c < 8; ++c) s = __builtin_amdgcn_mfma_f32_16x16x32_bf16(*(const LAS bf16x8*)(qa + c * 64), *(const LAS bf16x8*)(ka + c * 64), s, 0, 0, 0);
            S2[tt] = s; }
        u32x4 vf[4];
#pragma unroll
        for (int i = 0; i < 4; ++i) { const int pc = tid + 512 * i, s = pc >> 5, cc = pc & 31; vf[i] = *(const u32x4*)(U + (rbase + ch * 64 + s) * NU + UMV + h * 256 + cc * 8); }
        { const f32x4 nv = *(const LAS f32x4*)(TABF(T_N) + 4 * lane);
#pragma unroll
          for (int jj = 0; jj < 8; ++jj) { const int j = 8 * w + jj; const u32x2 qw = *(const LAS u32x2*)(lds + ML_Q + j * ML_QP + lane * 8);
              const float d = wave_sum_fast(bf_lo(qw.x) * nv[0] + bf_hi(qw.x) * nv[1] + bf_lo(qw.y) * nv[2] + bf_hi(qw.y) * nv[3]); if (lane == 0) TABF(T_ND)[j] = d; } }
#pragma unroll
        for (int i = 0; i < 4; ++i) { const int pc = tid + 512 * i, s = pc >> 5, cc = pc & 31; *(LAS u32x4*)(lds + ML_V + s * ML_VP + cc * 16) = vf[i]; }
        lds_barrier();
#pragma unroll
        for (int tt = 0; tt < 2; ++tt) { const int tile = 2 * w + tt, jt = tile >> 2, st = tile & 3, s = st * 16 + i16; const float as = TABF(T_A)[s];
#pragma unroll
            for (int rg = 0; rg < 4; ++rg) { const int j = jt * 16 + l4 * 4 + rg;
                float val = s <= j ? __expf(TABF(T_BCUM)[j] + as - TABF(T_MROW)[j]) * S2[tt][rg] : 0.f;
                *(LAS bf16_t*)(lds + ML_W + j * ML_WP + s * 2) = (bf16_t)(pk_bf16(val, 0.f) & 0xffffu);
                val = row16_sum(val);
                if (i16 == 0) TABF(T_RS)[j * 4 + st] = val; } }
        lds_barrier();
        if (tid < 64) { const int j = tid; const f32x4 rs = *(const LAS f32x4*)(TABF(T_RS) + 4 * j);
            const float den = TABF(T_IW)[j] * TABF(T_ND)[j] + ((rs[0] + rs[1]) + (rs[2] + rs[3]));
            TABF(T_INVD)[j] = 1.f / fmaxf(fabsf(den), expf(-TABF(T_MROW)[j])); }
        f32x16 acc[2];
#pragma unroll
        for (int jt2 = 0; jt2 < 2; ++jt2)
#pragma unroll
            for (int i = 0; i < 16; ++i) acc[jt2][i] = 0.f;
        const unsigned vtr = ML_V + (8 * hh + (i16 >> 2)) * ML_VP + (32 * w + 16 * (l4 & 1) + 4 * (i16 & 3)) * 2;
        if (!(skip & 4)) {
#pragma unroll
        for (int kt = 0; kt < 8; ++kt) { __builtin_amdgcn_sched_barrier(0);
#pragma unroll
            for (int s = 0; s < 2; ++s) { const bf16x8 bfr = pack_half(C[kt], s);
#pragma unroll
                for (int jt2 = 0; jt2 < 2; ++jt2) { const LAS unsigned char* qa = lds + ML_Q + (jt2 * 32 + r) * ML_QP + (kt * 32 + 16 * s + 4 * hh) * 2;
                    const s16x4 lo = *(const LAS s16x4*)qa, hi = *(const LAS s16x4*)(qa + 16);
                    acc[jt2] = MFMA32(__builtin_shufflevector(lo, hi, 0, 1, 2, 3, 4, 5, 6, 7), bfr, acc[jt2]); } } }
        __builtin_amdgcn_sched_barrier(0);
#pragma unroll
        for (int jt2 = 0; jt2 < 2; ++jt2)
#pragma unroll
            for (int i = 0; i < 16; ++i) acc[jt2][i] *= TABF(T_IW)[jt2 * 32 + crow(i, hh)];
#pragma unroll
        for (int ks = 0; ks < 4; ++ks) { const bf16x8 bv = tr_pair(lds + vtr + 16 * ks * ML_VP, lds + vtr + (16 * ks + 4) * ML_VP);
#pragma unroll
            for (int jt2 = 0; jt2 < 2; ++jt2) acc[jt2] = MFMA32(*(const LAS bf16x8*)(lds + ML_W + (jt2 * 32 + r) * ML_WP + (16 * ks + 8 * hh) * 2), bv, acc[jt2]); }
        }
        lds_barrier();
#pragma unroll
        for (int jt2 = 0; jt2 < 2; ++jt2)
#pragma unroll
            for (int i = 0; i < 16; ++i) { const int j = jt2 * 32 + crow(i, hh); *(LAS bf16_t*)(lds + ML_Q + j * 512 + (32 * w + r) * 2) = (bf16_t)(pk_bf16(acc[jt2][i] * TABF(T_INVD)[j], 0.f) & 0xffffu); }
        const float decay = TABF(T_SC)[1];
        if (!(skip & 2)) {
        { const int dk = tid & 255, sh = tid >> 8; float nn = 0.f;
#pragma unroll 8
          for (int s = 32 * sh; s < 32 * sh + 32; ++s) nn += TABF(T_WS)[s] * bf2f(*(const LAS bf16_t*)(lds + ML_K + s * ML_KP + dk * 2));
          TABF(T_NP)[tid] = nn; }
#pragma unroll
        for (int kt = 0; kt < 8; ++kt) C[kt] *= decay;
        const unsigned ktr = ML_K + (8 * hh + (i16 >> 2)) * ML_KP + (16 * (l4 & 1) + 4 * (i16 & 3)) * 2;
#pragma unroll
        for (int ks = 0; ks < 4; ++ks) { __builtin_amdgcn_sched_barrier(0); const bf16x8 bv = tr_pair(lds + vtr + 16 * ks * ML_VP, lds + vtr + (16 * ks + 4) * ML_VP);
            const u32x4 bw = __builtin_bit_cast(u32x4, bv); const f32x4 w0 = *(const LAS f32x4*)(TABF(T_WS) + 16 * ks + 8 * hh), w1 = *(const LAS f32x4*)(TABF(T_WS) + 16 * ks + 8 * hh + 4);
            u32x4 sw; sw.x = pk_bf16(bf_lo(bw.x) * w0[0], bf_hi(bw.x) * w0[1]); sw.y = pk_bf16(bf_lo(bw.y) * w0[2], bf_hi(bw.y) * w0[3]); sw.z = pk_bf16(bf_lo(bw.z) * w1[0], bf_hi(bw.z) * w1[1]); sw.w = pk_bf16(bf_lo(bw.w) * w1[2], bf_hi(bw.w) * w1[3]);
            const bf16x8 bs = __builtin_bit_cast(bf16x8, sw);
#pragma unroll
            for (int kt = 0; kt < 8; ++kt) C[kt] = MFMA32(tr_pair(lds + ktr + 16 * ks * ML_KP + kt * 64, lds + ktr + (16 * ks + 4) * ML_KP + kt * 64), bs, C[kt]); }
        }
        lds_barrier();
        if (tid < 256 && !(skip & 2)) TABF(T_N)[tid] = TABF(T_N)[tid] * TABF(T_SC)[1] + (TABF(T_NP)[tid] + TABF(T_NP)[tid + 256]);
#pragma unroll
        for (int i = 0; i < 4; ++i) { const int pc = tid + 512 * i, s = pc >> 5, cc = pc & 31; *(u32x4*)(HB + (rbase + ch * 64 + s) * 1024 + h * 256 + cc * 8) = *(const LAS u32x4*)(lds + ML_Q + s * 512 + cc * 16); }
        if (ch + 1 < SEQ / 64) ML_PREFETCH(ch + 1, tid);
    }
#undef TABF
#undef ML_PREFETCH
}
constexpr int XA_KP = 528, XA_VP = 576, XA_VOFF = 32 * XA_KP, XA_BUF = XA_VOFF + 32 * XA_VP;
static_assert(2 * XA_BUF <= LDS_RING, "xattn LDS map");
DI void xattn_tile(const LAS unsigned char* buf, unsigned ka, unsigned va, const bf16x8 (&qf)[16], f32x16 (&O)[4], float& mrun, float& lrun) {
        f32x16 S;
#pragma unroll
        for (int i = 0; i < 16; ++i) S[i] = 0.f;
#pragma unroll
        for (int s = 0; s < 16; ++s) S = MFMA32(*(const LAS bf16x8*)(buf + ka + s * 32), qf[s], S);
        float mx = S[0];
#pragma unroll
        for (int i = 1; i < 16; ++i) mx = fmaxf(mx, S[i]);
        mx = xhalf_max(mx);
        const float mnew = fmaxf(mrun, mx);
        if (__builtin_amdgcn_ballot_w64(mnew > mrun) != 0ull) { const float alpha = __builtin_amdgcn_exp2f(mrun - mnew); lrun *= alpha;
#pragma unroll
            for (int dt = 0; dt < 4; ++dt) O[dt] *= alpha; }
        mrun = mnew;
#pragma unroll
        for (int i = 0; i < 16; ++i) { S[i] = __builtin_amdgcn_exp2f(S[i] - mnew); lrun += S[i]; }
#pragma unroll
        for (int s2 = 0; s2 < 2; ++s2) { const bf16x8 pb = pack_half(S, s2); const LAS unsigned char* vb = buf + va + 16 * s2 * XA_VP;
#pragma unroll
            for (int dt = 0; dt < 4; ++dt) O[dt] = MFMA32(tr_pair(vb + dt * 64, vb + dt * 64 + 8 * XA_VP), pb, O[dt]); }
}
DI void xattn_mfma_item(PP pk_, int g, int item, LAS unsigned char* lds) { const P p = load_args(pk_);
    const int tid = tid_local(), lane = tid & 63, wave = __builtin_amdgcn_readfirstlane(tid >> 6), dvh = wave & 1, rq = wave >> 1, hh = lane >> 5, r = lane & 31;
    const int qb = item & 15, h = (item >> 4) & 3, b = item >> 6;
    const bf16_t* U = WSP(bf16_t, WS_U); const bf16_t* KV = WSP(bf16_t, WS_KVM) + (size_t)(g * BG + b) * 256 * 2048 + h * 256;
    const size_t qrow = (size_t)b * SEQ + qb * 128 + rq * 32 + r;
    bf16x8 qf[16];
    { const bf16_t* qp = U + qrow * NU + UCQ + h * 256 + 8 * hh;
#pragma unroll
      for (int s = 0; s < 16; ++s) qf[s] = *(const bf16x8*)(qp + 16 * s); }
    f32x16 O[4];
#pragma unroll
    for (int dt = 0; dt < 4; ++dt)
#pragma unroll
        for (int i = 0; i < 16; ++i) O[dt][i] = 0.f;
    float mrun = -INFINITY, lrun = 0.f;
    const int row0 = tid >> 5, c32 = tid & 31;
    const bf16_t* gk = KV + (size_t)row0 * 2048 + c32 * 8;
    const unsigned lk = row0 * XA_KP + c32 * 16, lv = XA_VOFF + row0 * XA_VP + c32 * 16;
    u32x4 st[4];
#define XA_LOAD(t_) do { const bf16_t* s_ = gk + (size_t)(t_) * 32 * 2048; st[0] = *(const u32x4*)s_; st[1] = *(const u32x4*)(s_ + 16 * 2048); st[2] = *(const u32x4*)(s_ + 1024); st[3] = *(const u32x4*)(s_ + 16 * 2048 + 1024); } while (0)
#define XA_STORE(bufp) do { *(LAS u32x4*)((bufp) + lk) = st[0]; *(LAS u32x4*)((bufp) + lk + 16 * XA_KP) = st[1]; *(LAS u32x4*)((bufp) + lv) = st[2]; *(LAS u32x4*)((bufp) + lv + 16 * XA_VP) = st[3]; } while (0)
    __syncthreads();
    XA_LOAD(0); XA_STORE(lds); __syncthreads();
    const unsigned ka = r * XA_KP + hh * 16;
    const int i16 = lane & 15;
    const unsigned va = XA_VOFF + (4 * hh + (i16 >> 2)) * XA_VP + (dvh * 128 + 16 * ((lane >> 4) & 1) + 4 * (i16 & 3)) * 2;
    u32x4 st2[4];
#define XA_LOAD2(t_) do { const bf16_t* s_ = gk + (size_t)(t_) * 32 * 2048; st2[0] = *(const u32x4*)s_; st2[1] = *(const u32x4*)(s_ + 16 * 2048); st2[2] = *(const u32x4*)(s_ + 1024); st2[3] = *(const u32x4*)(s_ + 16 * 2048 + 1024); } while (0)
#define XA_STORE2(bufp) do { *(LAS u32x4*)((bufp) + lk) = st2[0]; *(LAS u32x4*)((bufp) + lk + 16 * XA_KP) = st2[1]; *(LAS u32x4*)((bufp) + lv) = st2[2]; *(LAS u32x4*)((bufp) + lv + 16 * XA_VP) = st2[3]; } while (0)
    XA_LOAD2(1);
#pragma unroll 1
    for (int t = 0; t < 8; t += 2) {
        if (t + 2 < 8) XA_LOAD(t + 2);
        xattn_tile(lds, ka, va, qf, O, mrun, lrun);
        XA_STORE2(lds + XA_BUF);
        lds_barrier();
        if (t + 3 < 8) XA_LOAD2(t + 3);
        xattn_tile(lds + XA_BUF, ka, va, qf, O, mrun, lrun);
        if (t + 2 < 8) XA_STORE(lds);
        lds_barrier();
    }
#undef XA_LOAD2
#undef XA_STORE2
#undef XA_LOAD
#undef XA_STORE
    const float inv = 1.f / xhalf_sum(lrun);
    bf16_t* yp = WSP(bf16_t, WS_Y) + qrow * 3072 + 2048 + h * 256 + dvh * 128;
#pragma unroll
    for (int dt = 0; dt < 4; ++dt)
#pragma unroll
        for (int g4 = 0; g4 < 4; ++g4) { const int dv = dt * 32 + 8 * g4 + 4 * hh;
            u32x2 w; w.x = pk_bf16(O[dt][4 * g4] * inv, O[dt][4 * g4 + 1] * inv); w.y = pk_bf16(O[dt][4 * g4 + 2] * inv, O[dt][4 * g4 + 3] * inv);
            *(u32x2*)(yp + dv) = w; }
}
#ifndef ATTN_NAIVE
#define ATTN_NAIVE 0
#endif
#ifndef XATTN_NAIVE
#define XATTN_NAIVE 0
#endif
#ifndef MLSTM_NAIVE
#define MLSTM_NAIVE 0
#endif
DI void ph_mix(PP pk_, int g, int rep, LAS unsigned char* lds) { const P p = load_args(pk_);
    const int N_XC = (g + 1 < NGRP) ? TG / 256 : 0;
    constexpr int N_ML = BG * 4, N_AT = ATTN_NAIVE ? BG * 8 * 32 : BG * 8 * 16, N_XA = XATTN_NAIVE ? BG * 4 * 64 : BG * 4 * 16;
    unsigned* ctr = WSP(unsigned, WS_CTL) + CW_Q + 64 * (g + NGRP * rep);
#ifndef PROBE_MIX_ONLY
#define PROBE_MIX_ONLY -1
#endif
    for (;;) {
        const int it = next_item(ctr, lds);
        if (it >= N_ML + N_AT + N_XA + N_XC) break;
        if (it >= N_ML + N_AT + N_XA) { if (rep == 0) xconv_item(pk_, g + 1, it - (N_ML + N_AT + N_XA), lds); continue; }
        if (rep > 0 && PROBE_MIX_ONLY >= 0) { const int ty = it < N_ML ? 0 : (it < N_ML + N_AT ? 1 : 2); if (ty != PROBE_MIX_ONLY) continue; }
        if (it < N_ML) mlstm_mfma_item(pk_, g, it, rep, lds);
        else if (it < N_ML + N_AT) { const int ix = it - N_ML;
            if (ATTN_NAIVE) attn_naive_item(pk_, N_AT - 1 - ix, lds);
            else attn_mfma_item(pk_, ((ix & 63) << 4) | (15 - (ix >> 6)), lds); }
        else { if (XATTN_NAIVE) xattn_naive_item(pk_, g, it - N_ML - N_AT, lds); else xattn_mfma_item(pk_, g, it - N_ML - N_AT, lds); }
    }
}

DI void ph_mlstm_out(PP pk_, int g, LAS unsigned char* lds) { const P p = load_args(pk_);
    const int tid = tid_local(), lane = tid & 63, wave = tid >> 6, gw = blockIdx.x * 8 + wave, NGW = gridDim.x * 8;
    const bf16_t* HB = WSP(bf16_t, WS_MRG); const bf16_t* U = WSP(bf16_t, WS_U); bf16_t* Y = WSP(bf16_t, WS_Y);
    for (int it = gw; it < TG * 4; it += NGW) { const int r = it >> 2, h = it & 3;
        const u32x2 hw = *((const u32x2*)(HB + (size_t)r * 1024 + h * 256) + lane);
        const f32x4 v = {bf_lo(hw.x), bf_hi(hw.x), bf_lo(hw.y), bf_hi(hw.y)};
        const float mu = wave_sum_fast((v[0] + v[1]) + (v[2] + v[3])) * (1.f / 256.f); const f32x4 d = v - mu;
        const float rstd = rsqrtf(wave_sum_fast((d[0] * d[0] + d[1] * d[1]) + (d[2] * d[2] + d[3] * d[3])) * (1.f / 256.f) + LN_EPS);
        const f32x4 gn = *((const f32x4*)(p.mlstm_norm_g + h * 256) + lane);
        const u32x2 ow = *((const u32x2*)(U + (size_t)r * NU + UMO + h * 256) + lane);
        u32x2 o; o.x = cvt_pk_bf16(d[0] * rstd * gn[0] * sigm(bf_lo(ow.x)), d[1] * rstd * gn[1] * sigm(bf_hi(ow.x))); o.y = cvt_pk_bf16(d[2] * rstd * gn[2] * sigm(bf_lo(ow.y)), d[3] * rstd * gn[3] * sigm(bf_hi(ow.y)));
        *((u32x2*)(Y + (size_t)r * 3072 + 1024 + h * 256) + lane) = o; }
}

DI void ph_ln1(PP pk_, int g, LAS unsigned char* lds) { const P p = load_args(pk_);
    const int tid = tid_local(), lane = tid & 63, wave = tid >> 6, gw = blockIdx.x * 8 + wave, NGW = gridDim.x * 8;
    const float* Z = WSP(float, WS_Z); bf16_t* X1 = WSP(bf16_t, WS_X1B) + (size_t)g * TG * 1024;
    for (int r = gw; r < TG; r += NGW) {
        const f32x4* zr = (const f32x4*)(Z + (size_t)r * 1024) + lane; f32x4 v[4]; float s = 0.f;
#pragma unroll
        for (int j = 0; j < 4; ++j) { v[j] = zr[64 * j]; s += (v[j][0] + v[j][1]) + (v[j][2] + v[j][3]); }
        const float mu = wave_sum(s) * (1.f / 1024.f); float s2 = 0.f;
#pragma unroll
        for (int j = 0; j < 4; ++j) { v[j] = v[j] - mu; s2 += (v[j][0] * v[j][0] + v[j][1] * v[j][1]) + (v[j][2] * v[j][2] + v[j][3] * v[j][3]); }
        const float rstd = rsqrtf(wave_sum(s2) * (1.f / 1024.f) + LN_EPS);
        u32x2* d = (u32x2*)(X1 + (size_t)r * 1024) + lane;
#pragma unroll
        for (int j = 0; j < 4; ++j) { const f32x4 gn = *((const f32x4*)p.ln1_g + lane + 64 * j), bb = *((const f32x4*)p.ln1_b + lane + 64 * j); const f32x4 o = v[j] * rstd * gn + bb;
            u32x2 w; w.x = cvt_pk_bf16(o[0], o[1]); w.y = cvt_pk_bf16(o[2], o[3]); d[64 * j] = w; }
    }
}
DI void ph_expert_weights(PP pk_, LAS unsigned char* lds) { const P p = load_args(pk_);
    const int tid = tid_local(), lane = tid & 63, wave = tid >> 6, gw = blockIdx.x * 8 + wave, NGW = gridDim.x * 8;
    LAS float* scr = (LAS float*)(lds + wave * 16384);
    bf16_t* WGU = WSP(bf16_t, WS_WGU); bf16_t* WD = WSP(bf16_t, WS_WD);
    for (int it = gw; it < 257 * 256; it += NGW) { const int e = it >> 8, r = it & 255, isup = r >> 7, kb = (r >> 3) & 15, nb = r & 7;
        const float* W = (e < 256) ? ((isup ? p.w_e_up : p.w_e_gate) + (size_t)e * 1024 * 256) : (isup ? p.w_s_up : p.w_s_gate);
        const int n0 = nb * 32, drow = (n0 >> 7) * 256 + (n0 & 127) + isup * 128;
        transpose_item(W, 256, n0, WGU + (size_t)e * 512 * 1024, 1024, drow, kb * 64, scr, lane); }
    for (int it = gw; it < 257 * 128; it += NGW) { const int e = it >> 7, r = it & 127, kb = r >> 5, nb = r & 31;
        const float* W = (e < 256) ? (p.w_e_down + (size_t)e * 256 * 1024) : p.w_s_down;
        transpose_item(W, 1024, nb * 32, WD + (size_t)e * 1024 * 256, 256, nb * 32, kb * 64, scr, lane); }
}

DI void ph_topk(PP pk_, LAS unsigned char* lds) { const P p = load_args(pk_);
    const int tid = tid_local(), lane = tid & 63, wave = tid >> 6, gw = blockIdx.x * 8 + wave, NGW = gridDim.x * 8;
    const float* LG = WSP(float, WS_LOGIT); int* TKI = WSP(int, WS_TKI); float* TKW = WSP(float, WS_TKW); unsigned* cnt = WSP(unsigned, WS_CTL) + CW_CNT;
    int* tokof = WSP(int, WS_TOKOF); float* wof = WSP(float, WS_WOF);
    for (int i = blockIdx.x * 512 + tid; i < MAXRT * 256; i += gridDim.x * 512) { tokof[i] = 0; wof[i] = 0.f; }
    const f32x4 rb = *((const f32x4*)p.router_bias + lane);
    for (int t = gw; t < T_ALL; t += NGW) {
        const f32x4 lg = *((const f32x4*)(LG + (size_t)t * 256) + lane);
        float sc[4], ch[4];
#pragma unroll
        for (int j = 0; j < 4; ++j) { sc[j] = 1.f / (1.f + expf(-lg[j])); ch[j] = sc[j] + rb[j]; }
        const float m01 = fmaxf(ch[0], ch[1]), n01 = fminf(ch[0], ch[1]), m23 = fmaxf(ch[2], ch[3]), n23 = fminf(ch[2], ch[3]);
        float a1 = fmaxf(m01, m23), a2 = fmaxf(fminf(m01, m23), fmaxf(n01, n23));
#pragma unroll
        for (int o = 1; o < 8; o <<= 1) { const float b1 = __shfl_xor(a1, o), b2 = __shfl_xor(a2, o); const float n1 = fmaxf(a1, b1), n2 = fmaxf(fminf(a1, b1), fmaxf(a2, b2)); a1 = n1; a2 = n2; }
        const float gs = a1 + a2; const int myg = lane >> 3; int rank = 0;
#pragma unroll
        for (int g2 = 0; g2 < 8; ++g2) { const float og = __shfl(gs, 8 * g2); rank += (og > gs || (og == gs && g2 < myg)) ? 1 : 0; }
        if (rank >= 4) { ch[0] = -INFINITY; ch[1] = -INFINITY; ch[2] = -INFINITY; ch[3] = -INFINITY; }
        int myidx = 0; float mys = 0.f, ssum = 0.f;
#pragma unroll
        for (int r = 0; r < 8; ++r) {
            float bv = ch[0]; int bi = 4 * lane;
#pragma unroll
            for (int j = 1; j < 4; ++j) if (ch[j] > bv) { bv = ch[j]; bi = 4 * lane + j; }
#pragma unroll
            for (int o = 32; o >= 1; o >>= 1) { const float ov = __shfl_xor(bv, o); const int oi = __shfl_xor(bi, o); if (ov > bv || (ov == bv && oi < bi)) { bv = ov; bi = oi; } }
            const int jl = bi & 3; const float scsel = jl == 0 ? sc[0] : (jl == 1 ? sc[1] : (jl == 2 ? sc[2] : sc[3]));
            const float sv = __shfl(scsel, bi >> 2);
            if ((bi >> 2) == lane) { if (jl == 0) ch[0] = -INFINITY; else if (jl == 1) ch[1] = -INFINITY; else if (jl == 2) ch[2] = -INFINITY; else ch[3] = -INFINITY; }
            ssum += sv; if (lane == r) { myidx = bi; mys = sv; }
        }
        if (lane < 8) { TKI[(size_t)t * 8 + lane] = myidx; TKW[(size_t)t * 8 + lane] = mys / (ssum + 1e-20f) * 2.5f; atomicAdd(cnt + myidx, 1u); }
    }
}

DI void ph_slots(PP pk_, LAS unsigned char* lds) { const P p = load_args(pk_);
    const int tid = tid_local();
    const unsigned* cnt = WSP(unsigned, WS_CTL) + CW_CNT; int* tbase = WSP(int, WS_MISC + MS_TBASE); int* nt = WSP(int, WS_MISC + MS_NT); int* tile_e = WSP(int, WS_MISC + MS_TILEE);
    LAS int* sb = (LAS int*)lds;
    __syncthreads();
    if (tid < 256) sb[tid] = (int)((cnt[tid] + 255u) >> 8);
    __syncthreads();
    if (tid == 0) { int a = 0; for (int e = 0; e < 256; ++e) { const int n = sb[e]; sb[e] = a; a += n; } sb[256] = a; }
    __syncthreads();
    const int nrt = sb[256];
    if (blockIdx.x == 0) {
        if (tid < 256) { const int b0 = sb[tid], b1 = sb[tid + 1]; tbase[tid] = b0; for (int t = b0; t < b1; ++t) tile_e[t] = tid; tile_e[nrt + tid] = 256; }
        if (tid == 0) { tbase[256] = nrt; nt[0] = nrt; nt[1] = nrt + 256; }
    }
    const int* TKI = WSP(int, WS_TKI); const float* TKW = WSP(float, WS_TKW); unsigned* cur = WSP(unsigned, WS_CTL) + CW_CUR;
    int* tokof = WSP(int, WS_TOKOF); float* wof = WSP(float, WS_WOF); int* slotof = WSP(int, WS_SLOTOF);
    const int s0 = nrt * 256;
    for (int i = blockIdx.x * 512 + tid; i < T_ALL * 8; i += gridDim.x * 512) { const int e = TKI[i]; const int slot = sb[e] * 256 + (int)atomicAdd(cur + e, 1u); tokof[slot] = i >> 3; wof[slot] = TKW[i]; slotof[i] = slot; }
    for (int t = blockIdx.x * 512 + tid; t < T_ALL; t += gridDim.x * 512) { tokof[s0 + t] = t; wof[s0 + t] = 1.f; }
    __syncthreads();
}

DI void ph_combine(PP pk_, int round, LAS unsigned char* lds) { const P p = load_args(pk_);
    const int tid = tid_local();
    const unsigned char* Y = WSP(unsigned char, WS_YCH); const bf16_t* X1 = WSP(bf16_t, WS_X1B); const int* slotof = WSP(int, WS_SLOTOF); const int s0 = WSP(int, WS_MISC + MS_TBASE)[256] * 256;
    for (int i = blockIdx.x * 512 + tid; i < T_ALL * 64; i += gridDim.x * 512) { const int t = i >> 6, c8 = (i & 63) * 8;
        const u32x4 xw = *(const u32x4*)(X1 + (size_t)t * 1024 + round * 512 + c8);
        float a[8];
#pragma unroll
        for (int e = 0; e < 8; ++e) a[e] = 0.f;
#pragma unroll
        for (int k = 0; k < 9; ++k) { const int slot = k < 8 ? slotof[(size_t)t * 8 + k] : s0 + t; const u32x2 w = *(const u32x2*)(Y + (size_t)slot * 512 + c8);
            const f32x2 v0 = __builtin_amdgcn_cvt_pk_f32_fp8((int)w.x, false), v1 = __builtin_amdgcn_cvt_pk_f32_fp8((int)w.x, true), v2 = __builtin_amdgcn_cvt_pk_f32_fp8((int)w.y, false), v3 = __builtin_amdgcn_cvt_pk_f32_fp8((int)w.y, true);
            a[0] += v0[0]; a[1] += v0[1]; a[2] += v1[0]; a[3] += v1[1]; a[4] += v2[0]; a[5] += v2[1]; a[6] += v3[0]; a[7] += v3[1]; }
        constexpr float is = 1.f / Y8_SCALE;
        float* op = p.out + (size_t)t * 1024 + round * 512 + c8;
        *(f32x4*)op = (f32x4){bf_lo(xw.x) * ALPHA + a[0] * is, bf_hi(xw.x) * ALPHA + a[1] * is, bf_lo(xw.y) * ALPHA + a[2] * is, bf_hi(xw.y) * ALPHA + a[3] * is};
        *(f32x4*)(op + 4) = (f32x4){bf_lo(xw.z) * ALPHA + a[4] * is, bf_hi(xw.z) * ALPHA + a[5] * is, bf_lo(xw.w) * ALPHA + a[6] * is, bf_hi(xw.w) * ALPHA + a[7] * is}; }
}

DI void ph_ln2(PP pk_, LAS unsigned char* lds) { const P p = load_args(pk_);
    const int tid = tid_local(), lane = tid & 63, wave = tid >> 6, gw = blockIdx.x * 8 + wave, NGW = gridDim.x * 8;
    for (int r = gw; r < T_ALL; r += NGW) {
        f32x4* zr = (f32x4*)(p.out + (size_t)r * 1024) + lane; f32x4 v[4]; float s = 0.f;
#pragma unroll
        for (int j = 0; j < 4; ++j) { v[j] = zr[64 * j]; s += (v[j][0] + v[j][1]) + (v[j][2] + v[j][3]); }
        const float mu = wave_sum(s) * (1.f / 1024.f); float s2 = 0.f;
#pragma unroll
        for (int j = 0; j < 4; ++j) { v[j] = v[j] - mu; s2 += (v[j][0] * v[j][0] + v[j][1] * v[j][1]) + (v[j][2] * v[j][2] + v[j][3] * v[j][3]); }
        const float rstd = rsqrtf(wave_sum(s2) * (1.f / 1024.f) + LN_EPS);
#pragma unroll
        for (int j = 0; j < 4; ++j) { const f32x4 gn = *((const f32x4*)p.ln2_g + lane + 64 * j), bb = *((const f32x4*)p.ln2_b + lane + 64 * j); zr[64 * j] = v[j] * rstd * gn + bb; }
    }
}

__global__ void __launch_bounds__(512, 2) fwd(P p_unused) {
    extern __shared__ __attribute__((aligned(16))) unsigned char lds_raw[];
    LAS unsigned char* lds = (LAS unsigned char*)lds_raw;
    const int tid = threadIdx.x, G = gridDim.x, bid = blockIdx.x;
    volatile LAS unsigned* MISC = (volatile LAS unsigned*)(lds + LDS_MISC);
    if (tid < 32) MISC[tid] = 0u;
    __syncthreads();
    XcdBarrier bar; { unsigned* bw = (unsigned*)(kargs()->ws + WS_CTL) + CW_BAR; bar.bar = bw; bar.x = 0; bar.st = nullptr; bar = xcd_barrier_post(bw, MISC + 8); }
#ifndef PROBE_TYPE
#define PROBE_TYPE -1
#define PROBE_REPS 1
#endif
#define STEP_BEGIN(type) { const int reps_ = ((type) == PROBE_TYPE) ? PROBE_REPS : 1; for (int rep_ = 0; rep_ < reps_; ++rep_) { PP pk_ = kargs(); const P p = load_args(pk_);
#define STEP_END xcd_barrier(bar); } }
#define STEP_END_LAST if (rep_ + 1 < reps_) xcd_barrier(bar); } }

    STEP_BEGIN(0) ph_prologue(pk_, lds); __syncthreads(); ph_xconv(pk_, 0, lds); STEP_END
    for (int g = 0; g < NGRP; ++g) {
        STEP_BEGIN(2) {
            if (g > 0) { ph_ln1(pk_, g - 1, lds); __syncthreads(); }
            pg8::Gemm gm{WSP(bf16_t, WS_XB), WSP(bf16_t, WS_WIN), 1024, 1024, 1024, nullptr}; pg8::StaticOrder S; S.init(TG, NU, G, bid);
            EpiInProj E{WSP(bf16_t, WS_U), WSP(float, WS_MISC + MS_BIAS)};
            pg8::gemm_phase<EpiInProj, pg8::StaticOrder, true>(lds, gm, S, E);
            if (g == 0) {
                pg8::Gemm gk{WSP(bf16_t, WS_MEMB), WSP(bf16_t, WS_WKV), 1024, 1024, 1024, nullptr}; pg8::StaticOrder S2; S2.init(NBATCH * 256, 2048, G, bid);
                EpiPlain E2{WSP(bf16_t, WS_KVM), 2048};
                pg8::gemm_phase<EpiPlain, pg8::StaticOrder, true>(lds, gk, S2, E2);
            }
        } STEP_END
        STEP_BEGIN(4) ph_conv(pk_, g, lds); STEP_END
        STEP_BEGIN(3) ph_mix(pk_, g, rep_, lds); STEP_END
        STEP_BEGIN(16) ph_mlstm_out(pk_, g, lds); STEP_END
        STEP_BEGIN(5) {
            pg8::Gemm gm{WSP(bf16_t, WS_Y), WSP(bf16_t, WS_WBR), 3072, 3072, 3072, nullptr}; pg8::StaticOrder S; S.init(TG, 1024, G, bid);
            EpiBranch2 E{WSP(bf16_t, WS_U), WSP(bf16_t, WS_MRG)}; MidBranch MB{WSP(bf16_t, WS_U)};
            pg8::gemm_phase<EpiBranch2, pg8::StaticOrder, true, false, MidBranch>(lds, gm, S, E, MB);
        } STEP_END
        STEP_BEGIN(6) {
            pg8::Gemm gm{WSP(bf16_t, WS_MRG), WSP(bf16_t, WS_WOUT), 1024, 1024, 1024, nullptr}; pg8::StaticOrder S; S.init(TG, 1024, G, bid);
            EpiOutProj E{p.x + (size_t)g * TG * 1024, WSP(float, WS_Z)};
            pg8::gemm_phase<EpiOutProj, pg8::StaticOrder, true>(lds, gm, S, E);
        } STEP_END
        if (g == NGRP - 1) { STEP_BEGIN(7) ph_ln1(pk_, g, lds); STEP_END }
    }
    STEP_BEGIN(8) {
        pg8::Gemm gm{WSP(bf16_t, WS_X1B), WSP(bf16_t, WS_WR), 1024, 1024, 1024, nullptr}; pg8::StaticOrder S; S.init(T_ALL, 256, G, bid);
        EpiF32 E{WSP(float, WS_LOGIT), 256};
        pg8::gemm_phase<EpiF32, pg8::StaticOrder, true>(lds, gm, S, E);
        ph_expert_weights(pk_, lds);
    } STEP_END
    STEP_BEGIN(9) ph_topk(pk_, lds); STEP_END
    STEP_BEGIN(11) ph_slots(pk_, lds); STEP_END
    STEP_BEGIN(12) {
        const int* ntp = WSP(int, WS_MISC + MS_NT);
        pg8::Gemm gm{WSP(bf16_t, WS_X1B), WSP(bf16_t, WS_WGU), 1024, 1024, 1024, WSP(int, WS_TOKOF)}; ExpertGUOrder S{WSP(int, WS_MISC + MS_TILEE), ntp[1] * 2, G, (G % 8 == 0) ? (bid % 8) * (G / 8) + bid / 8 : bid};
        EpiGateUp E{WSP(bf16_t, WS_ACT)};
        pg8::gemm_phase<EpiGateUp, ExpertGUOrder, true, true>(lds, gm, S, E);
    } STEP_END
    for (int r = 0; r < 2; ++r) {
        STEP_BEGIN(13) {
            const int* ntp = WSP(int, WS_MISC + MS_NT);
            pg8::Gemm gm{WSP(bf16_t, WS_ACT), WSP(bf16_t, WS_WD), 256, 256, 256, nullptr}; ExpertDownOrder S{WSP(int, WS_MISC + MS_TILEE), ntp[1] * 2, G, (G % 8 == 0) ? (bid % 8) * (G / 8) + bid / 8 : bid, r};
            EpiDown E{WSP(unsigned char, WS_YCH), WSP(float, WS_WOF)};
            pg8::gemm_phase<EpiDown, ExpertDownOrder, true>(lds, gm, S, E);
        } STEP_END
        STEP_BEGIN(14) ph_combine(pk_, r, lds); STEP_END
    }
    STEP_BEGIN(15) ph_ln2(pk_, lds); STEP_END_LAST
}
constexpr int NSTEPS = 1 + NGRP * 6 + 1 + 4 + 4 + 1;

extern "C" void kernel_launch(void* const* d_in, const int* in_sizes, int n_in, void* d_out, int out_size, void* d_ws, size_t ws_size, hipStream_t stream) {
    static int grid = 0;
    if (grid == 0) {
        int dev = 0, cus = 0;
        if (hipGetDevice(&dev) != hipSuccess || hipDeviceGetAttribute(&cus, hipDeviceAttributeMultiprocessorCount, dev) != hipSuccess) { fprintf(stderr, "kernel_launch: device query failed\n"); grid = -1; return; }
        if (hipFuncSetAttribute((const void*)fwd, hipFuncAttributeMaxDynamicSharedMemorySize, LDS_BYTES) != hipSuccess) { fprintf(stderr, "kernel_launch: hipFuncSetAttribute failed\n"); grid = -1; return; }
        if (n_in != 24 || ws_size < WS_END) fprintf(stderr, "kernel_launch: n_in %d ws %zu (need %zu)\n", n_in, ws_size, (size_t)WS_END);
        grid = cus;
    }
    if (grid < 0) return;
    (void)hipMemsetAsync((char*)d_ws + WS_CTL, 0, CTL_BYTES, stream);
    P p{};
    const float** pp = (const float**)&p;
    for (int i = 0; i < 24; ++i) pp[i] = (const float*)d_in[i];
    p.out = (float*)d_out; p.ws = (unsigned char*)d_ws;
    p.s_lo = 0; p.s_hi = NSTEPS; hipLaunchKernelGGL(fwd, dim3(grid), dim3(512), LDS_BYTES, stream, p);
}
```

```cpp
#define ONE_LAUNCH 1
#include <hip/hip_runtime.h>
#include <cstdio>
#include <cstdint>
#define DI __device__ __forceinline__
#define LAS __attribute__((address_space(3)))
#define GAS __attribute__((address_space(1)))
typedef unsigned short bf16_t;
typedef short bf16x8 __attribute__((ext_vector_type(8)));
typedef float f32x4 __attribute__((ext_vector_type(4)));
typedef float f32x2 __attribute__((ext_vector_type(2)));
typedef unsigned u32x4 __attribute__((ext_vector_type(4)));
typedef unsigned u32x2 __attribute__((ext_vector_type(2)));

constexpr int T_ALL = 65536, DM = 1024, SEQ = 2048, NBATCH = 32, NGRP = 4, TG = T_ALL / NGRP, BG = NBATCH / NGRP;
constexpr int NU = 11264, CIN = 11272;
constexpr int UQ = 0, UK = 1024, UV = 2048, UMQ = 3072, UMK = 4096, UMV = 5120, UMO = 6144, UCQ = 7168, UGT = 8192;
constexpr int NEXP = 256, MAXRT = 2304, MAXTILES = MAXRT + 256, MAXSLOTS = MAXTILES * 256;
constexpr float ALPHA = 1.189207115002721f;
constexpr float LN_EPS = 1e-5f;

constexpr size_t MiB = 1ull << 20;
constexpr size_t WS_CTL = 0, CTL_BYTES = 1 * MiB;
constexpr size_t WS_MISC = 1 * MiB;
constexpr size_t WS_WIN = 2 * MiB, WS_WKV = 24 * MiB, WS_WBR = 28 * MiB, WS_WOUT = 34 * MiB, WS_WR = 36 * MiB;
constexpr size_t WS_GIF = 38 * MiB, WS_MEMB = 40 * MiB, WS_KVM = 56 * MiB, WS_X1B = 88 * MiB, WS_R = 216 * MiB;
constexpr size_t WS_XB = WS_R, WS_U = WS_R + 32 * MiB, WS_Y = WS_R + 384 * MiB, WS_F32 = WS_R + 480 * MiB, WS_MRG = WS_R + 544 * MiB, WS_Z = WS_R + 576 * MiB, WS_QKC = WS_R + 640 * MiB;
constexpr size_t WS_TKI = WS_R, WS_TKW = WS_R + 2 * MiB, WS_SLOTOF = WS_R + 4 * MiB, WS_TOKOF = WS_R + 6 * MiB, WS_WOF = WS_R + 9 * MiB;
constexpr size_t WS_LOGIT = WS_R + 16 * MiB, WS_WGU = WS_R + 80 * MiB, WS_WD = WS_R + 704 * MiB  , WS_ACT = WS_R + 337 * MiB, WS_YCH = WS_R + 16 * MiB;
constexpr size_t WS_END = WS_R + 900 * MiB;
constexpr size_t MS_BIAS = 0, MS_LAM = 48 * 1024, MS_TBASE = 52 * 1024, MS_NT = 56 * 1024, MS_TILEE = 64 * 1024;
constexpr int CW_CNT = 1024, CW_CUR = 2048, CW_BAR = 8192, CW_Q = 16384;

constexpr int LDS_RING = 131072, LDS_MISC = LDS_RING + 320, LDS_BYTES = 147456;

DI float bf_lo(unsigned w) { return __uint_as_float(w << 16); }
DI float bf_hi(unsigned w) { return __uint_as_float(w & 0xffff0000u); }
DI float bf2f(bf16_t b) { return __uint_as_float((unsigned)b << 16); }
DI unsigned cvt_pk_bf16(float lo, float hi) { unsigned r; asm("v_cvt_pk_bf16_f32 %0, %1, %2" : "=v"(r) : "v"(lo), "v"(hi)); return r; }
template <int CTRL> DI float dppf(float v) { return __builtin_bit_cast(float, __builtin_amdgcn_update_dpp(0, __builtin_bit_cast(int, v), CTRL, 0xf, 0xf, true)); }
DI float row16_sum(float v) { v += dppf<0xB1>(v); v += dppf<0x4E>(v); v += dppf<0x124>(v); v += dppf<0x128>(v); return v; }
DI float rdlane(float v, int l) { return __builtin_bit_cast(float, __builtin_amdgcn_readlane(__builtin_bit_cast(int, v), l)); }
DI float wave_sum_fast(float v) { v = row16_sum(v); return (rdlane(v, 0) + rdlane(v, 16)) + (rdlane(v, 32) + rdlane(v, 48)); }
DI float wave_sum(float v) { return wave_sum_fast(v); }
DI float row16_max(float v) { v = fmaxf(v, dppf<0xB1>(v)); v = fmaxf(v, dppf<0x4E>(v)); v = fmaxf(v, dppf<0x124>(v)); v = fmaxf(v, dppf<0x128>(v)); return v; }
DI float wave_max(float v) { v = row16_max(v); return fmaxf(fmaxf(rdlane(v, 0), rdlane(v, 16)), fmaxf(rdlane(v, 32), rdlane(v, 48))); }
DI float bperm(float v, int src) { return __builtin_bit_cast(float, __builtin_amdgcn_ds_bpermute(src << 2, __builtin_bit_cast(int, v))); }
DI int bperm_i(int v, int src) { return __builtin_amdgcn_ds_bpermute(src << 2, v); }
DI float sigm(float x) { return 1.f / (1.f + __expf(-x)); }
DI float silu(float x) { return x / (1.f + __expf(-x)); }
DI float zero_local() { float z = 0.f; asm volatile("" : "+v"(z)); return z; }
DI int bid_local() { int b = blockIdx.x; asm volatile("" : "+s"(b)); return b; }
DI int tid_local() { int t = threadIdx.x; asm volatile("" : "+v"(t)); return t; }
DI void lds_barrier() { asm volatile("s_waitcnt lgkmcnt(0)" ::: "memory"); __builtin_amdgcn_s_barrier(); asm volatile("" ::: "memory"); }
#define LDS_WAIT() asm volatile("s_waitcnt lgkmcnt(0)" ::: "memory")
namespace pg8 {
constexpr int BM = 256, BK = 64, HALF = 128, HTB = HALF * BK * 2, STAGE_BYTES = 8 * HTB, NXCD = 8, WGM = 8;
__host__ __device__ __forceinline__ int lds_byte(int r, int c) { const int st = (r >> 4) * 2 + (c >> 5), rr = r & 15, cc = c & 31, ob = rr * 64 + cc * 2; return st * 1024 + (ob ^ (((ob >> 9) & 1) << 5)); }
__host__ __device__ __forceinline__ void stage_rc(int b, int& R, int& C) { const int st = b / 1024, sb = b % 1024, swz = sb ^ (((sb >> 9) & 1) << 5); R = (st >> 1) * 16 + swz / 64; C = (st & 1) * 32 + (swz % 64) / 2; }
__host__ __device__ __forceinline__ int perm32(int rho) { const int n = rho >> 4, i = rho & 15; return 8 * (i >> 2) + 4 * n + (i & 3); }

struct Unit { int pm, pn, pb, acol, aux; };
struct Gemm { const bf16_t* A; const bf16_t* Bt; int lda, ldb, K; const int* arow; };

struct StaticOrder {
    int nM, nN, nwg, G, c;
    DI void init(int M, int N, int G_, int c_) { nM = M / BM; nN = N / BM; nwg = nM * nN; G = G_; c = c_; }
    DI bool next(int i, Unit& u) const {
        const long L = (long)i * G + c; if (L >= nwg) return false;
        int wgid = (int)L; { const int q = nwg / NXCD, r = nwg % NXCD, xcd = wgid % NXCD, off = wgid / NXCD; wgid = (xcd < r ? xcd * (q + 1) : r * (q + 1) + (xcd - r) * q) + off; }
        const int nig = WGM * nN, gid = wgid / nig, fm = gid * WGM, gsz = (nM - fm) < WGM ? (nM - fm) : WGM;
        u.pm = fm + ((wgid % nig) % gsz); u.pn = (wgid % nig) / gsz; u.pb = u.pn; u.acol = 0; u.aux = 0; return true;
    }
};

struct NoMid { static constexpr int EVERY = 0; DI void operator()(f32x4 (&)[2][2][4][2], const Unit&, int, int, int, int, int) const {} };
template <class Epi, class Sched, bool ALIGN_EPI, bool GATHER = false, class Mid = NoMid>
DI void gemm_phase(LAS unsigned char* lds, const Gemm g, const Sched& S, const Epi& E, const Mid& mid = Mid()) {
    const int tid = tid_local(), wid = __builtin_amdgcn_readfirstlane(tid >> 6), lane = tid & 63, wr = wid >> 2, wc = wid & 3, fr = lane & 15, fq = lane >> 4;
    const int nt = g.K / BK;
    int Ra[2], Ca[2], Rb[2];
#pragma unroll
    for (int i = 0; i < 2; ++i) { int R, C; stage_rc(tid * 16 + i * 8192, R, C); Ra[i] = R; Ca[i] = C; Rb[i] = (R & ~31) + perm32(R & 31); }
    const size_t kstep = (size_t)(BK * 2);
    const unsigned ldsw = (unsigned)wid * 1024u;
    const int aoff = lds_byte(wr * 64 + fr, fq * 8), boff = lds_byte(wc * 32 + fr, fq * 8);
#define PG8_SA(b, h) (((b) * 2 + (h)) * HTB)
#define PG8_SB(b, h) ((4 + (b) * 2 + (h)) * HTB)
#define PG8_STAGE(bufoff, gptr, offs) do { _Pragma("unroll") for (int _i = 0; _i < 2; ++_i) \
        __builtin_amdgcn_global_load_lds((const unsigned*)((gptr) + (offs)[_i]), (LAS unsigned*)(lds + (bufoff) + ldsw + _i * 8192), 16, 0, 0); } while (0)
#define PG8_LDA(dst, b, h) do { _Pragma("unroll") for (int m = 0; m < 4; ++m) _Pragma("unroll") for (int k = 0; k < 2; ++k) dst[m][k] = *(const LAS bf16x8*)(lds + PG8_SA(b, h) + aoff + m * 2048 + k * 1024); } while (0)
#define PG8_LDB(dst, b, h) do { _Pragma("unroll") for (int n = 0; n < 2; ++n) _Pragma("unroll") for (int k = 0; k < 2; ++k) dst[n][k] = *(const LAS bf16x8*)(lds + PG8_SB(b, h) + boff + n * 2048 + k * 1024); } while (0)
#define PG8_MMA(ai, bj, At, Bt) do { __builtin_amdgcn_s_setprio(1); _Pragma("unroll") for (int m = 0; m < 4; ++m) _Pragma("unroll") for (int n = 0; n < 2; ++n) _Pragma("unroll") for (int k = 0; k < 2; ++k) \
        acc[ai][bj][m][n] = __builtin_amdgcn_mfma_f32_16x16x32_bf16(Bt[n][k], At[m][k], acc[ai][bj][m][n], 0, 0, 0); __builtin_amdgcn_s_setprio(0); } while (0)
#define PG8_WAIT_V(n) asm volatile("s_waitcnt vmcnt(" #n ")" ::: "memory")
#define PG8_WAIT_L(n) asm volatile("s_waitcnt lgkmcnt(" #n ")" ::: "memory")
#define PG8_BAR __builtin_amdgcn_s_barrier()
#define PG8_SCHED __builtin_amdgcn_sched_barrier(0)
#define PG8_OFFS(u, oa) do { _Pragma("unroll") for (int h_ = 0; h_ < 2; ++h_) _Pragma("unroll") for (int i_ = 0; i_ < 2; ++i_) { \
        const int ar_ = g.arow[(u).pm * BM + h_ * HALF + Ra[i_]]; oa[h_][i_] = (unsigned)(ar_ * g.lda + (u).acol + Ca[i_]) * 2u; } } while (0)
    unsigned voffA[2], voffB[2];
#pragma unroll
    for (int i = 0; i < 2; ++i) { voffA[i] = (unsigned)(Ra[i] * g.lda + Ca[i]) * 2u; voffB[i] = (unsigned)(Rb[i] * g.ldb + Ca[i]) * 2u; }
    const size_t hstepA = (size_t)HALF * g.lda * 2, hstepB = (size_t)HALF * g.ldb * 2;
#define PG8_ABASE(u) ((const char*)g.A + (GATHER ? (size_t)0 : ((size_t)(u).pm * BM * g.lda + (u).acol) * 2))
#define PG8_BBASE(u) ((const char*)g.Bt + (size_t)(u).pb * BM * g.ldb * 2)
#define PG8_STAGE_A(bufoff, ab, oa, h) do { if constexpr (GATHER) { PG8_STAGE(bufoff, ab, (oa)[h]); } else { PG8_STAGE(bufoff, (ab) + (h) * hstepA, voffA); } } while (0)
#define PG8_STAGE_B(bufoff, bb, h) PG8_STAGE(bufoff, (bb) + (h) * hstepB, voffB)
    Unit cur, nxt; int ui = 0;
    if (!S.next(0, cur)) return;
    f32x4 acc[2][2][4][2];
#pragma unroll
    for (int a = 0; a < 2; ++a)
#pragma unroll
        for (int b = 0; b < 2; ++b)
#pragma unroll
            for (int m = 0; m < 4; ++m)
#pragma unroll
                for (int n = 0; n < 2; ++n) acc[a][b][m][n] = (f32x4){0.f, 0.f, 0.f, 0.f};
    bf16x8 At[4][2], B0[2][2], B1[2][2];
    unsigned oaC[2][2], oaN[2][2];
    if constexpr (GATHER) { PG8_OFFS(cur, oaC); }
    const char* cA = PG8_ABASE(cur); const char* cB = PG8_BBASE(cur);
    PG8_STAGE_B(PG8_SB(0, 0), cB, 0); PG8_STAGE_B(PG8_SB(0, 1), cB, 1); PG8_STAGE_A(PG8_SA(0, 0), cA, oaC, 0); PG8_STAGE_A(PG8_SA(0, 1), cA, oaC, 1);
    if (wr == 1) PG8_BAR;
    PG8_WAIT_V(2); PG8_BAR;
    PG8_STAGE_B(PG8_SB(1, 0), cB + kstep, 0); PG8_STAGE_A(PG8_SA(1, 0), cA + kstep, oaC, 0); PG8_STAGE_B(PG8_SB(1, 1), cB + kstep, 1);
    PG8_WAIT_V(6); PG8_BAR;
    for (;;) {
        const bool has_next = S.next(ui + 1, nxt);
        const char* nA = has_next ? PG8_ABASE(nxt) : cA; const char* nB = has_next ? PG8_BBASE(nxt) : cB;
        if constexpr (GATHER) {
            if (has_next) { PG8_OFFS(nxt, oaN); }
            else {
#pragma unroll
                for (int h_ = 0; h_ < 2; ++h_)
#pragma unroll
                    for (int i_ = 0; i_ < 2; ++i_) oaN[h_][i_] = oaC[h_][i_];
            }
        }
#pragma unroll 1
        for (int t = 0; t < nt; t += 2) {
            const bool last = (t == nt - 2);
            const char* a1 = cA + (size_t)(t + 1) * kstep;
            const char* a2 = last ? nA : cA + (size_t)(t + 2) * kstep; const char* b2 = last ? nB : cB + (size_t)(t + 2) * kstep;
            const char* a3 = a2 + kstep; const char* b3 = b2 + kstep;
            unsigned oa2[2][2];
            if constexpr (GATHER) {
#pragma unroll
                for (int h_ = 0; h_ < 2; ++h_)
#pragma unroll
                    for (int i_ = 0; i_ < 2; ++i_) oa2[h_][i_] = last ? oaN[h_][i_] : oaC[h_][i_];
            }
            PG8_LDB(B0, 0, 0); PG8_LDB(B1, 0, 1); PG8_SCHED; PG8_LDA(At, 0, 0); PG8_STAGE_A(PG8_SA(1, 1), a1, oaC, 1);
            PG8_WAIT_V(8); PG8_WAIT_L(0); PG8_BAR; PG8_MMA(0, 0, At, B0); PG8_MMA(0, 1, At, B1); PG8_BAR; PG8_SCHED;
            PG8_LDA(At, 0, 1); PG8_STAGE_B(PG8_SB(0, 0), b2, 0); PG8_STAGE_B(PG8_SB(0, 1), b2, 1); PG8_STAGE_A(PG8_SA(0, 0), a2, oa2, 0);
            PG8_WAIT_V(8); PG8_WAIT_L(0); PG8_BAR; PG8_MMA(1, 0, At, B0); PG8_MMA(1, 1, At, B1); PG8_BAR; PG8_SCHED;
            PG8_LDB(B0, 1, 0); PG8_LDB(B1, 1, 1); PG8_SCHED; PG8_LDA(At, 1, 0); PG8_STAGE_A(PG8_SA(0, 1), a2, oa2, 1);
            PG8_WAIT_V(8); PG8_WAIT_L(0); PG8_BAR; PG8_MMA(0, 0, At, B0); PG8_MMA(0, 1, At, B1); PG8_BAR; PG8_SCHED;
            PG8_LDA(At, 1, 1); PG8_STAGE_B(PG8_SB(1, 0), b3, 0); PG8_STAGE_B(PG8_SB(1, 1), b3, 1); PG8_STAGE_A(PG8_SA(1, 0), a3, oa2, 0);
            PG8_WAIT_V(8); PG8_WAIT_L(0); PG8_BAR; PG8_MMA(1, 0, At, B0); PG8_MMA(1, 1, At, B1); PG8_BAR; PG8_SCHED;
            if constexpr (Mid::EVERY > 0) { if (((t + 2) % Mid::EVERY) == 0 && (t + 2) < nt) mid(acc, cur, (t + 2) / Mid::EVERY - 1, wr, wc, fr, fq); }
        }
        if constexpr (ALIGN_EPI) { if (wr == 0) PG8_BAR; }
        E(acc, cur, wr, wc, fr, fq);
        if (!has_next) break;
#pragma unroll
        for (int a = 0; a < 2; ++a)
#pragma unroll
            for (int b = 0; b < 2; ++b)
#pragma unroll
                for (int m = 0; m < 4; ++m)
#pragma unroll
                    for (int n = 0; n < 2; ++n) acc[a][b][m][n] = (f32x4){0.f, 0.f, 0.f, 0.f};
        cur = nxt; cA = nA; cB = nB; ++ui;
        if constexpr (GATHER) {
#pragma unroll
            for (int h_ = 0; h_ < 2; ++h_)
#pragma unroll
                for (int i_ = 0; i_ < 2; ++i_) oaC[h_][i_] = oaN[h_][i_];
        }
        if constexpr (ALIGN_EPI) { if (wr == 1) PG8_BAR; }
    }
    PG8_WAIT_V(0);
    if constexpr (!ALIGN_EPI) { if (wr == 0) PG8_BAR; }
    PG8_BAR;
#undef PG8_SA
#undef PG8_SB
#undef PG8_STAGE
#undef PG8_LDA
#undef PG8_LDB
#undef PG8_MMA
#undef PG8_WAIT_V
#undef PG8_WAIT_L
#undef PG8_BAR
#undef PG8_SCHED
#undef PG8_OFFS
#undef PG8_ABASE
#undef PG8_BBASE
#undef PG8_STAGE_A
#undef PG8_STAGE_B
}
}
using pg8::Unit; using pg8::BM; using pg8::HALF;

struct BranchOrder {
    int ntile, G, c;
    DI bool next(int i, Unit& u) const {
        const int L = (i / 3) * G + c; if (L >= ntile) return false;
        const int n = i % 3; u.pm = L >> 2; u.pn = L & 3; u.pb = n * 4 + u.pn; u.acol = n * 1024; u.aux = n; return true;
    }
};
struct ExpertGUOrder {
    const int* tile_e; int nunits, G, c;
    DI bool next(int i, Unit& u) const {
        const int L = i * G + c; if (L >= nunits) return false;
        const int t = L >> 1, hf = L & 1; const int e = tile_e[t];
        u.pm = t; u.pn = hf; u.pb = e * 2 + hf; u.acol = 0; u.aux = e; return true;
    }
};
struct ExpertDownOrder {
    const int* tile_e; int nunits, G, c, round;
    DI bool next(int i, Unit& u) const {
        const int L = i * G + c; if (L >= nunits) return false;
        const int t = L >> 1, cn = L & 1; const int e = tile_e[t];
        u.pm = t; u.pn = cn; u.pb = e * 4 + round * 2 + cn; u.acol = 0; u.aux = e; return true;
    }
};

#define EPI_ARGS const f32x4 (&acc)[2][2][4][2], const Unit& u, int wr, int wc, int fr, int fq
DI u32x4 pack8(const f32x4 v0, const f32x4 v1) { u32x4 w; w.x = cvt_pk_bf16(v0[0], v0[1]); w.y = cvt_pk_bf16(v0[2], v0[3]); w.z = cvt_pk_bf16(v1[0], v1[1]); w.w = cvt_pk_bf16(v1[2], v1[3]); return w; }

struct EpiInProj {
    bf16_t* O; const float* bias;
    DI void operator()(EPI_ARGS) const {
        const int row0 = u.pm * BM + wr * 64 + fr, col0 = u.pn * BM + wc * 32 + 8 * fq;
        const float sc = (u.pn < 4) ? 0.125f * 1.4426950408889634f : ((u.pn >= 28 && u.pn < 32) ? 0.0625f * 1.4426950408889634f : 1.f);
        f32x4 bv[2][2];
#pragma unroll
        for (int bj = 0; bj < 2; ++bj)
#pragma unroll
            for (int n = 0; n < 2; ++n) bv[bj][n] = *(const f32x4*)(bias + col0 + bj * HALF + 4 * n);
#pragma unroll
        for (int ai = 0; ai < 2; ++ai)
#pragma unroll
            for (int m = 0; m < 4; ++m) { bf16_t* rowp = O + (size_t)(row0 + ai * HALF + m * 16) * NU + col0;
#pragma unroll
                for (int bj = 0; bj < 2; ++bj) *(u32x4*)(rowp + bj * HALF) = pack8((acc[ai][bj][m][0] + bv[bj][0]) * sc, (acc[ai][bj][m][1] + bv[bj][1]) * sc); }
    }
};
struct EpiPlain {
    bf16_t* O; int ldc;
    DI void operator()(EPI_ARGS) const {
        const int row0 = u.pm * BM + wr * 64 + fr, col0 = u.pn * BM + wc * 32 + 8 * fq;
#pragma unroll
        for (int ai = 0; ai < 2; ++ai)
#pragma unroll
            for (int m = 0; m < 4; ++m) { bf16_t* rowp = O + (size_t)(row0 + ai * HALF + m * 16) * ldc + col0;
#pragma unroll
                for (int bj = 0; bj < 2; ++bj) *(u32x4*)(rowp + bj * HALF) = pack8(acc[ai][bj][m][0], acc[ai][bj][m][1]); }
    }
};
struct EpiBranch {
    const bf16_t* U; float* F; bf16_t* M;
    DI void operator()(EPI_ARGS) const {
        const int row0 = u.pm * BM + wr * 64 + fr, col0 = u.pn * BM + wc * 32 + 8 * fq, n = u.aux;
#pragma unroll
        for (int ai = 0; ai < 2; ++ai)
#pragma unroll
            for (int m = 0; m < 4; ++m) { const size_t row = (size_t)(row0 + ai * HALF + m * 16);
#pragma unroll
                for (int bj = 0; bj < 2; ++bj) { const int col = col0 + bj * HALF;
                    const u32x4 gw = *(const u32x4*)(U + row * NU + UGT + n * 1024 + col);
                    f32x4 g0 = {sigm(bf_lo(gw.x)), sigm(bf_hi(gw.x)), sigm(bf_lo(gw.y)), sigm(bf_hi(gw.y))};
                    f32x4 g1 = {sigm(bf_lo(gw.z)), sigm(bf_hi(gw.z)), sigm(bf_lo(gw.w)), sigm(bf_hi(gw.w))};
                    f32x4 v0 = acc[ai][bj][m][0] * g0, v1 = acc[ai][bj][m][1] * g1;
                    float* fp = F + row * 1024 + col;
                    if (n > 0) { v0 += *(const f32x4*)fp; v1 += *(const f32x4*)(fp + 4); }
                    if (n < 2) { *(f32x4*)fp = v0; *(f32x4*)(fp + 4) = v1; }
                    else *(u32x4*)(M + row * 1024 + col) = pack8(v0, v1); }
                asm volatile("" ::: "memory"); }
    }
};
DI f32x4 sig_ratio4(float a0, float a1, float a2, float a3, float b0, float b1, float b2, float b3) {
    return (f32x4){(1.f + __expf(-b0)) / (1.f + __expf(-a0)), (1.f + __expf(-b1)) / (1.f + __expf(-a1)), (1.f + __expf(-b2)) / (1.f + __expf(-a2)), (1.f + __expf(-b3)) / (1.f + __expf(-a3))};
}
struct MidBranch { static constexpr int EVERY = 16; const bf16_t* U;
    DI void operator()(f32x4 (&acc)[2][2][4][2], const Unit& u, int n, int wr, int wc, int fr_, int fq_) const {
        int fr = fr_, fq = fq_; asm volatile("" : "+v"(fr), "+v"(fq));
        const int row0 = u.pm * BM + wr * 64 + fr, col0 = u.pn * BM + wc * 32 + 8 * fq;
#pragma unroll
        for (int ai = 0; ai < 2; ++ai)
#pragma unroll
            for (int m = 0; m < 4; ++m) { const bf16_t* gp = U + (size_t)(row0 + ai * HALF + m * 16) * NU + UGT + n * 1024 + col0;
#pragma unroll
                for (int bj = 0; bj < 2; ++bj) { const u32x4 ga = *(const u32x4*)(gp + bj * HALF), gb = *(const u32x4*)(gp + bj * HALF + 1024);
                    acc[ai][bj][m][0] *= sig_ratio4(bf_lo(ga.x), bf_hi(ga.x), bf_lo(ga.y), bf_hi(ga.y), bf_lo(gb.x), bf_hi(gb.x), bf_lo(gb.y), bf_hi(gb.y));
                    acc[ai][bj][m][1] *= sig_ratio4(bf_lo(ga.z), bf_hi(ga.z), bf_lo(ga.w), bf_hi(ga.w), bf_lo(gb.z), bf_hi(gb.z), bf_lo(gb.w), bf_hi(gb.w));
                    asm volatile("" ::: "memory"); } }
    }
};
struct EpiBranch2 {
    const bf16_t* U; bf16_t* M;
    DI void operator()(EPI_ARGS) const {
        const int row0 = u.pm * BM + wr * 64 + fr, col0 = u.pn * BM + wc * 32 + 8 * fq;
#pragma unroll
        for (int ai = 0; ai < 2; ++ai)
#pragma unroll
            for (int m = 0; m < 4; ++m) { const size_t row = (size_t)(row0 + ai * HALF + m * 16);
#pragma unroll
                for (int bj = 0; bj < 2; ++bj) { const int col = col0 + bj * HALF; const u32x4 gw = *(const u32x4*)(U + row * NU + UGT + 2048 + col);
                    const f32x4 g0 = {sigm(bf_lo(gw.x)), sigm(bf_hi(gw.x)), sigm(bf_lo(gw.y)), sigm(bf_hi(gw.y))}, g1 = {sigm(bf_lo(gw.z)), sigm(bf_hi(gw.z)), sigm(bf_lo(gw.w)), sigm(bf_hi(gw.w))};
                    *(u32x4*)(M + row * 1024 + col) = pack8(acc[ai][bj][m][0] * g0, acc[ai][bj][m][1] * g1); }
                asm volatile("" ::: "memory"); }
    }
};
struct EpiOutProj {
    const float* X; float* Z;
    DI void operator()(EPI_ARGS) const {
        const int row0 = u.pm * BM + wr * 64 + fr, col0 = u.pn * BM + wc * 32 + 8 * fq;
#pragma unroll
        for (int ai = 0; ai < 2; ++ai)
#pragma unroll
            for (int m = 0; m < 4; ++m) { const size_t off = (size_t)(row0 + ai * HALF + m * 16) * 1024 + col0;
#pragma unroll
                for (int bj = 0; bj < 2; ++bj) { const float* xp = X + off + bj * HALF; float* zp = Z + off + bj * HALF;
                    *(f32x4*)zp = *(const f32x4*)xp * ALPHA + acc[ai][bj][m][0]; *(f32x4*)(zp + 4) = *(const f32x4*)(xp + 4) * ALPHA + acc[ai][bj][m][1]; }
                asm volatile("" ::: "memory"); }
    }
};
struct EpiF32 {
    float* O; int ldc;
    DI void operator()(EPI_ARGS) const {
        const int row0 = u.pm * BM + wr * 64 + fr, col0 = u.pn * BM + wc * 32 + 8 * fq;
#pragma unroll
        for (int ai = 0; ai < 2; ++ai)
#pragma unroll
            for (int m = 0; m < 4; ++m) { float* rowp = O + (size_t)(row0 + ai * HALF + m * 16) * ldc + col0;
#pragma unroll
                for (int bj = 0; bj < 2; ++bj) { *(f32x4*)(rowp + bj * HALF) = acc[ai][bj][m][0]; *(f32x4*)(rowp + bj * HALF + 4) = acc[ai][bj][m][1]; } }
    }
};
struct EpiGateUp {
    bf16_t* ACT;
    DI void operator()(EPI_ARGS) const {
        const int row0 = u.pm * BM + wr * 64 + fr, col0 = u.pn * HALF + wc * 32 + 8 * fq;
#pragma unroll
        for (int ai = 0; ai < 2; ++ai)
#pragma unroll
            for (int m = 0; m < 4; ++m) { f32x4 v[2];
#pragma unroll
                for (int n = 0; n < 2; ++n) { const f32x4 gt = acc[ai][0][m][n], up = acc[ai][1][m][n];
                    v[n] = (f32x4){silu(gt[0]) * up[0], silu(gt[1]) * up[1], silu(gt[2]) * up[2], silu(gt[3]) * up[3]}; }
                *(u32x4*)(ACT + (size_t)(row0 + ai * HALF + m * 16) * 256 + col0) = pack8(v[0], v[1]); }
    }
};
DI unsigned pk4_fp8(float a, float b, float c, float d) { int p = __builtin_amdgcn_cvt_pk_fp8_f32(a, b, 0, false); return (unsigned)__builtin_amdgcn_cvt_pk_fp8_f32(c, d, p, true); }
constexpr float Y8_SCALE = 32.f, Y8_MAX = 400.f;
struct EpiDown {
    unsigned char* Y; const float* W;
    DI void operator()(EPI_ARGS) const {
        const int row0 = u.pm * BM + wr * 64 + fr, col0 = u.pn * BM + wc * 32 + 8 * fq;
#pragma unroll
        for (int ai = 0; ai < 2; ++ai)
#pragma unroll
            for (int m = 0; m < 4; ++m) { const int row = row0 + ai * HALF + m * 16; const float w = W[row] * Y8_SCALE;
#pragma unroll
                for (int bj = 0; bj < 2; ++bj) { f32x4 v0 = acc[ai][bj][m][0] * w, v1 = acc[ai][bj][m][1] * w;
#pragma unroll
                    for (int e = 0; e < 4; ++e) { v0[e] = __builtin_amdgcn_fmed3f(v0[e], -Y8_MAX, Y8_MAX); v1[e] = __builtin_amdgcn_fmed3f(v1[e], -Y8_MAX, Y8_MAX); }
                    u32x2 o; o.x = pk4_fp8(v0[0], v0[1], v0[2], v0[3]); o.y = pk4_fp8(v1[0], v1[1], v1[2], v1[3]);
                    *(u32x2*)(Y + (size_t)row * 512 + col0 + bj * HALF) = o; }
                asm volatile("" ::: "memory"); }
    }
};
#define RLX_AGENT __ATOMIC_RELAXED, __HIP_MEMORY_SCOPE_AGENT
#define XB_TMO      128
#define XB_XCNT(j)  (256  + 64 * (j))
#define XB_XSUB(j)  (1280 + 64 * (j))
#define XB_XGEN(j)  (2304 + 64 * (j))
#define XB_TOP      3328
#define XB_TOPGEN   3392
#define XCD_BAR_WORDS 3456
#define XB_SPIN_CAP (1u << 18)

__device__ __forceinline__ unsigned xb_ld(unsigned* p)              { return __hip_atomic_load(p, __ATOMIC_RELAXED, __HIP_MEMORY_SCOPE_AGENT); }
__device__ __forceinline__ unsigned xb_add(unsigned* p, unsigned v) { return __hip_atomic_fetch_add(p, v, __ATOMIC_RELAXED, __HIP_MEMORY_SCOPE_AGENT); }
__device__ __forceinline__ unsigned xb_xcc_id() { return (unsigned)__builtin_amdgcn_s_getreg((3 << 11) | 20) & 0xFu; }
#define XB_SPIN(cond, bar) do { unsigned _sp = 0; while (cond) { __builtin_amdgcn_s_sleep(1); \
    if ((++_sp & 255u) == 0u) { if (xb_ld(&(bar)[XB_TMO])) break; if (_sp > XB_SPIN_CAP) { atomicAdd(&(bar)[XB_TMO], 1u); break; } } } } while (0)

struct XcdBarrier {
    unsigned* bar; unsigned x;
    volatile LAS unsigned* st;
};

__device__ __forceinline__ XcdBarrier xcd_barrier_post(unsigned* bar, volatile LAS unsigned* st) {
    XcdBarrier b; b.bar = bar; b.x = xb_xcc_id(); b.st = st;
    if (threadIdx.x == 0) (void)xb_add(&bar[XB_XCNT(b.x)], 1u);
    return b;
}
__device__ __forceinline__ void xcd_barrier_complete(unsigned* bar, unsigned x, unsigned& nloc, unsigned& nx) {
    const unsigned G = gridDim.x * gridDim.y * gridDim.z;
    unsigned sum, cnt, mine, sp = 0u;
    for (;;) {
        sum = 0u; cnt = 0u; mine = 0u;
#pragma unroll
        for (unsigned j = 0; j < 16; ++j) { const unsigned c = xb_ld(&bar[XB_XCNT(j)]); sum += c; cnt += (c > 0u) ? 1u : 0u; mine = (j == x) ? c : mine; }
        if (sum == G) break;
        __builtin_amdgcn_s_sleep(1);
        if ((++sp & 255u) == 0u) { if (xb_ld(&bar[XB_TMO])) break; if (sp > XB_SPIN_CAP) { atomicAdd(&bar[XB_TMO], 1u); break; } }
    }
    nloc = mine > 0u ? mine : 1u; nx = cnt > 0u ? cnt : 1u;
}

__device__ __forceinline__ void xcd_barrier(const XcdBarrier& b) {
    asm volatile("s_waitcnt vmcnt(0)" ::: "memory");
    __syncthreads();
    if (threadIdx.x == 0) {
        unsigned* bar = b.bar; asm volatile("" : "+s"(bar));
        __builtin_amdgcn_s_waitcnt(0);
        volatile LAS unsigned* stp = b.st; asm volatile("" : "+s"(stp));
        unsigned nloc = stp[0], nx = stp[1];
        if (nloc == 0u) { xcd_barrier_complete(bar, b.x, nloc, nx); stp[0] = nloc; stp[1] = nx; }
        const unsigned old = xb_add(&bar[XB_XSUB(b.x)], 1u);
        const unsigned gen = old / nloc;
        if (old + 1u == (gen + 1u) * nloc) {
            __builtin_amdgcn_fence(__ATOMIC_RELEASE, "agent");
            asm volatile("s_waitcnt vmcnt(0)" ::: "memory");
            const unsigned og = xb_add(&bar[XB_TOP], 1u);
            const unsigned tg = og / nx;
            if (og + 1u == (tg + 1u) * nx) xb_add(&bar[XB_TOPGEN], 1u);
            else XB_SPIN(xb_ld(&bar[XB_TOPGEN]) == tg, bar);
            __builtin_amdgcn_fence(__ATOMIC_ACQUIRE, "agent");
            xb_add(&bar[XB_XGEN(b.x)], 1u);
            asm volatile("s_waitcnt vmcnt(0)" ::: "memory");
        } else {
            XB_SPIN(xb_ld(&bar[XB_XGEN(b.x)]) == gen, bar);
            __builtin_amdgcn_fence(__ATOMIC_ACQUIRE, "agent");
            asm volatile("s_waitcnt vmcnt(0)" ::: "memory");
        }
    }
    __syncthreads();
}

struct P {
    const float *x, *mem, *rel_bias, *w_in, *b_in, *conv_w, *diff_lambda, *subln_g, *mlstm_norm_g, *w_mem_kv, *w_branch, *w_out, *ln1_g, *ln1_b,
                *w_router, *router_bias, *w_e_gate, *w_e_up, *w_e_down, *w_s_gate, *w_s_up, *w_s_down, *ln2_g, *ln2_b;
    float* out; unsigned char* ws; int s_lo, s_hi;
};
typedef const P __attribute__((address_space(4)))* PP;
DI PP kargs() { PP k = (PP)__builtin_amdgcn_kernarg_segment_ptr(); asm volatile("" : "+s"(k)); return k; }
DI P load_args(PP k) { P r; const unsigned long long __attribute__((address_space(4)))* s = (const unsigned long long __attribute__((address_space(4)))*)k;
    void** d = (void**)&r;
#pragma unroll
    for (int i = 0; i < 26; ++i) d[i] = (void*)(GAS char*)s[i];
    ((unsigned long long*)&r)[26] = s[26];
    return r; }
static_assert(sizeof(P) == 27 * 8, "P = 26 pointers + 2 ints");
#define WSP(T, off) ((T*)(p.ws + (off)))

DI void transpose_item(const float* W, int ldw, int src_col0, bf16_t* WT, int ldt, int dst_row0, int k0, LAS float* scr, int lane) {
    float v[32];
    const float* src = W + (size_t)(k0 + (lane >> 5)) * ldw + src_col0 + (lane & 31);
#pragma unroll
    for (int i = 0; i < 32; ++i) v[i] = src[(size_t)(2 * i) * ldw];
#pragma unroll
    for (int i = 0; i < 32; ++i) scr[(2 * i + (lane >> 5)) * 33 + (lane & 31)] = v[i];
    LDS_WAIT();
    const int c = lane & 7;
#pragma unroll
    for (int j = 0; j < 4; ++j) { const int n = (lane >> 3) + 8 * j; const LAS float* s = scr + (8 * c) * 33 + n;
        u32x4 o; o.x = cvt_pk_bf16(s[0 * 33], s[1 * 33]); o.y = cvt_pk_bf16(s[2 * 33], s[3 * 33]); o.z = cvt_pk_bf16(s[4 * 33], s[5 * 33]); o.w = cvt_pk_bf16(s[6 * 33], s[7 * 33]);
        *(u32x4*)(WT + (size_t)(dst_row0 + n) * ldt + k0 + 8 * c) = o; }
    LDS_WAIT();
}
DI void transpose_mat(const float* W, int ldw, int src_col0, int K, int N, bf16_t* WT, int ldt, int dst_row0, int gw, int NGW, LAS float* scr, int lane) {
    const int nblk = N / 32, items = (K / 64) * nblk;
    for (int it = gw; it < items; it += NGW) { const int kb = it / nblk, nb = it % nblk; transpose_item(W, ldw, src_col0 + nb * 32, WT, ldt, dst_row0 + nb * 32, kb * 64, scr, lane); }
}
DI void row_to_bf16(const float* src, bf16_t* dst, int lane) {
    const f32x4* s = (const f32x4*)src + lane; u32x2* d = (u32x2*)dst + lane;
#pragma unroll
    for (int j = 0; j < 4; ++j) { const f32x4 v = s[64 * j]; u32x2 o; o.x = cvt_pk_bf16(v[0], v[1]); o.y = cvt_pk_bf16(v[2], v[3]); d[64 * j] = o; }
}

DI void ph_prologue(PP pk_, LAS unsigned char* lds) { const P p = load_args(pk_);
    const int tid = tid_local(), lane = tid & 63, wave = tid >> 6, gw = bid_local() * 8 + wave, NGW = gridDim.x * 8;
    LAS float* scr = (LAS float*)(lds + wave * 16384);
    bf16_t* WinT = WSP(bf16_t, WS_WIN);
    transpose_mat(p.w_in, CIN, 0, 1024, 7168, WinT, 1024, 0, gw, NGW, scr, lane);
    transpose_mat(p.w_in, CIN, 7176, 1024, 4096, WinT, 1024, 7168, gw, NGW, scr, lane);
    transpose_mat(p.w_mem_kv, 2048, 0, 1024, 2048, WSP(bf16_t, WS_WKV), 1024, 0, gw, NGW, scr, lane);
    for (int n = 0; n < 3; ++n) transpose_mat(p.w_branch + (size_t)n * 1024 * 1024, 1024, 0, 1024, 1024, WSP(bf16_t, WS_WBR) + n * 1024, 3072, 0, gw, NGW, scr, lane);
    transpose_mat(p.w_out, 1024, 0, 1024, 1024, WSP(bf16_t, WS_WOUT), 1024, 0, gw, NGW, scr, lane);
    transpose_mat(p.w_router, 256, 0, 1024, 256, WSP(bf16_t, WS_WR), 1024, 0, gw, NGW, scr, lane);
    bf16_t* memb = WSP(bf16_t, WS_MEMB);
    for (int r = gw; r < NBATCH * 256; r += NGW) row_to_bf16(p.mem + (size_t)r * 1024, memb + (size_t)r * 1024, lane);
    float* bias = WSP(float, WS_MISC + MS_BIAS);
    for (int j = bid_local() * 512 + tid; j < NU; j += gridDim.x * 512) bias[j] = p.b_in[j + (j >= 7168 ? 8 : 0)];
    if (gw == 0) {
        const float* lv = p.diff_lambda;
        const float s1 = wave_sum(lv[lane] * lv[64 + lane]), s2 = wave_sum(lv[128 + lane] * lv[192 + lane]);
        if (lane == 0) *WSP(float, WS_MISC + MS_LAM) = expf(s1) - expf(s2) + 0.2f;
    }
}

DI void xconv_item(PP pk_, int g, int item, LAS unsigned char* lds) { const P p = load_args(pk_);
    const int tid = tid_local(), lane = tid & 63, wave = tid >> 6;
    LAS float* wg = (LAS float*)lds;
    __syncthreads();
    for (int i = tid; i < 2048; i += 512) { const int c = i >> 1, hf = i & 1; *(LAS f32x4*)(wg + c * 8 + hf * 4) = *(const f32x4*)(p.w_in + (size_t)c * CIN + 7168 + hf * 4); }
    __syncthreads();
    bf16_t* xb = WSP(bf16_t, WS_XB); float* gif = WSP(float, WS_GIF);
#pragma unroll 1
    for (int rr = 0; rr < 32; ++rr) { const int r = item * 256 + wave * 32 + rr;
        const size_t t = (size_t)g * TG + r;
        const f32x4* xr = (const f32x4*)(p.x + t * 1024) + lane; u32x2* d = (u32x2*)(xb + (size_t)r * 1024) + lane;
        float gs[8];
#pragma unroll
        for (int q = 0; q < 8; ++q) gs[q] = 0.f;
#pragma unroll
        for (int j = 0; j < 4; ++j) { const f32x4 v = xr[64 * j]; u32x2 o; o.x = cvt_pk_bf16(v[0], v[1]); o.y = cvt_pk_bf16(v[2], v[3]); d[64 * j] = o;
#pragma unroll
            for (int e = 0; e < 4; ++e) { const int c = 4 * lane + 256 * j + e; const f32x4 wl = *(const LAS f32x4*)(wg + c * 8), wh = *(const LAS f32x4*)(wg + c * 8 + 4);
                gs[0] += v[e] * wl[0]; gs[1] += v[e] * wl[1]; gs[2] += v[e] * wl[2]; gs[3] += v[e] * wl[3]; gs[4] += v[e] * wh[0]; gs[5] += v[e] * wh[1]; gs[6] += v[e] * wh[2]; gs[7] += v[e] * wh[3]; } }
        float mine = 0.f;
#pragma unroll
        for (int q = 0; q < 8; ++q) { const float s = wave_sum_fast(gs[q]); if (lane == q) mine = s; }
        if (lane < 8) gif[t * 8 + lane] = mine + p.b_in[7168 + lane];
    }
}
DI void ph_xconv(PP pk_, int g, LAS unsigned char* lds) { for (int it = bid_local(); it < TG / 256; it += gridDim.x) xconv_item(pk_, g, it, lds); __syncthreads(); }

DI int t5_bucket(int n) { return n < 16 ? n : min(31, 16 + (int)(__log2f((float)n * 0.0625f) * (16.f / 3.f))); }

typedef float f32x16 __attribute__((ext_vector_type(16)));
typedef __bf16 bf16x2_t __attribute__((ext_vector_type(2)));
typedef short s16x4 __attribute__((ext_vector_type(4)));
constexpr float LOG2E = 1.4426950408889634f;
DI unsigned pk_bf16(float a, float b) { const f32x2 v = {a, b}; return __builtin_bit_cast(unsigned, __builtin_convertvector(v, bf16x2_t)); }
DI int crow(int reg, int hh) { return (reg & 3) + 8 * (reg >> 2) + 4 * hh; }
#define MFMA32(a, b, c) __builtin_amdgcn_mfma_f32_32x32x16_bf16((a), (b), (c), 0, 0, 0)
DI bf16x8 tr_pair(const LAS unsigned char* a0, const LAS unsigned char* a1) {
    const s16x4 lo = __builtin_amdgcn_ds_read_tr16_b64_v4i16((LAS s16x4*)a0), hi = __builtin_amdgcn_ds_read_tr16_b64_v4i16((LAS s16x4*)a1);
    return __builtin_shufflevector(lo, hi, 0, 1, 2, 3, 4, 5, 6, 7);
}
DI bf16x8 pack_half(const f32x16& x, int s2) {
    u32x4 w;
#pragma unroll
    for (int k = 0; k < 4; ++k) w[k] = pk_bf16(x[8 * s2 + 2 * k], x[8 * s2 + 2 * k + 1]);
    return __builtin_bit_cast(bf16x8, w);
}
DI float xhalf_max(float x) { const auto r = __builtin_amdgcn_permlane32_swap(__builtin_bit_cast(int, x), __builtin_bit_cast(int, x), false, false); return fmaxf(__builtin_bit_cast(float, (int)r[0]), __builtin_bit_cast(float, (int)r[1])); }
DI float xhalf_sum(float x) { const auto r = __builtin_amdgcn_permlane32_swap(__builtin_bit_cast(int, x), __builtin_bit_cast(int, x), false, false); return __builtin_bit_cast(float, (int)r[0]) + __builtin_bit_cast(float, (int)r[1]); }
DI int next_item(unsigned* ctr, LAS unsigned char* lds) {
    volatile LAS int* slot = (volatile LAS int*)(lds + LDS_MISC + 64);
    __syncthreads();
    if (threadIdx.x == 0) *slot = (int)__hip_atomic_fetch_add(ctr, 1u, __ATOMIC_RELAXED, __HIP_MEMORY_SCOPE_AGENT);
    __syncthreads();
    return *slot;
}

constexpr int AT_KPITCH = 144, AT_VPITCH = 320, AT_KBYTES = 64 * AT_KPITCH, AT_VOFF = 2 * AT_KBYTES, AT_BUF = AT_VOFF + 64 * AT_VPITCH, AT_BT = 2 * AT_BUF;
DI void attn_tile(const LAS unsigned char* buf, int k0, int qw, int r, int hh, unsigned ka, unsigned va, const LAS float* bt, float cfar, const bf16x8 (&qf)[4], f32x16 (&O)[4], float& mrun, float& lrun) {
    if (k0 <= qw + 31) {
            const bool far = (qw - k0 - 63) >= 128;
            float sinit = far ? cfar : 0.f; asm volatile("" : "+v"(sinit));
            f32x16 S[2];
#pragma unroll
            for (int sub = 0; sub < 2; ++sub)
#pragma unroll
                for (int i = 0; i < 16; ++i) S[sub][i] = sinit;
#pragma unroll
            for (int sub = 0; sub < 2; ++sub)
#pragma unroll
                for (int s = 0; s < 4; ++s) S[sub] = MFMA32(*(const LAS bf16x8*)(buf + ka + sub * 32 * AT_KPITCH + s * 32), qf[s], S[sub]);
            if (!far) {
#pragma unroll
                for (int sub = 0; sub < 2; ++sub)
#pragma unroll
                    for (int i = 0; i < 16; ++i) { const int dist = (qw + r) - (k0 + sub * 32 + crow(i, hh)); S[sub][i] = dist < 0 ? -INFINITY : S[sub][i] + bt[min(dist, 128)]; }
            }
            float mx = fmaxf(S[0][0], S[1][0]);
#pragma unroll
            for (int i = 1; i < 16; ++i) mx = fmaxf(mx, fmaxf(S[0][i], S[1][i]));
            mx = xhalf_max(mx);
            const float mnew = fmaxf(mrun, mx);
            if (__builtin_amdgcn_ballot_w64(mnew > mrun) != 0ull) { const float alpha = __builtin_amdgcn_exp2f(mrun - mnew); lrun *= alpha;
#pragma unroll
                for (int dt = 0; dt < 4; ++dt) O[dt] *= alpha; }
            mrun = mnew;
#pragma unroll
            for (int sub = 0; sub < 2; ++sub)
#pragma unroll
                for (int i = 0; i < 16; ++i) { S[sub][i] = __builtin_amdgcn_exp2f(S[sub][i] - mnew); lrun += S[sub][i]; }
#pragma unroll
            for (int sub = 0; sub < 2; ++sub)
#pragma unroll
                for (int s2 = 0; s2 < 2; ++s2) { const bf16x8 pb = pack_half(S[sub], s2); const LAS unsigned char* vb = buf + va + (sub * 32 + 16 * s2) * AT_VPITCH;
#pragma unroll
                    for (int dt = 0; dt < 4; ++dt) O[dt] = MFMA32(tr_pair(vb + dt * 64, vb + dt * 64 + 8 * AT_VPITCH), pb, O[dt]); }
        }
}
DI void attn_mfma_item(PP pk_, int item, LAS unsigned char* lds) { const P p = load_args(pk_);
    const int tid = tid_local(), lane = tid & 63, wave = __builtin_amdgcn_readfirstlane(tid >> 6), mp = wave & 1, rq = wave >> 1, hh = lane >> 5, r = lane & 31;
    const int qb = item & 15, h = (item >> 4) & 7, b = item >> 7;
    const int q0 = qb * 128, qw = q0 + rq * 32, nt = 2 * qb + 2;
    const bf16_t* U = WSP(bf16_t, WS_U); const size_t rbase = (size_t)b * SEQ;
    LAS float* bt = (LAS float*)(lds + AT_BT);
    __syncthreads();
    if (tid <= 128) bt[tid] = p.rel_bias[t5_bucket(tid) * 8 + h] * LOG2E;
    bf16x8 qf[4];
    { const bf16_t* qp = U + (rbase + qw + r) * NU + UQ + h * 128 + mp * 64 + 8 * hh;
#pragma unroll
      for (int s = 0; s < 4; ++s) qf[s] = *(const bf16x8*)(qp + 16 * s); }
    f32x16 O[4]; { const float z0 = zero_local();
#pragma unroll
    for (int dt = 0; dt < 4; ++dt)
#pragma unroll
        for (int i = 0; i < 16; ++i) O[dt][i] = z0; }
    float mrun = -INFINITY, lrun = 0.f;
    const int row0 = tid >> 4, c16 = tid & 15;
    const bf16_t* gk = U + (rbase + row0) * NU + UK + h * 128 + c16 * 8;
    const bf16_t* gv = U + (rbase + row0) * NU + UV + h * 128 + c16 * 8;
    const unsigned lk = (c16 >> 3) * AT_KBYTES + row0 * AT_KPITCH + (c16 & 7) * 16, lv = AT_VOFF + row0 * AT_VPITCH + c16 * 16;
    u32x4 st[4];
#define AT_LOAD(t_) do { const size_t o_ = (size_t)(t_) * 64 * NU; st[0] = *(const u32x4*)(gk + o_); st[1] = *(const u32x4*)(gk + o_ + (size_t)32 * NU); st[2] = *(const u32x4*)(gv + o_); st[3] = *(const u32x4*)(gv + o_ + (size_t)32 * NU); } while (0)
#define AT_STORE(bufp) do { *(LAS u32x4*)((bufp) + lk) = st[0]; *(LAS u32x4*)((bufp) + lk + 32 * AT_KPITCH) = st[1]; *(LAS u32x4*)((bufp) + lv) = st[2]; *(LAS u32x4*)((bufp) + lv + 32 * AT_VPITCH) = st[3]; } while (0)
    AT_LOAD(0); AT_STORE(lds); __syncthreads();
    const float cfar = bt[128];
    const unsigned ka = mp * AT_KBYTES + r * AT_KPITCH + hh * 16;
    const int i16 = lane & 15;
    const unsigned va = AT_VOFF + (4 * hh + (i16 >> 2)) * AT_VPITCH + (16 * ((lane >> 4) & 1) + 4 * (i16 & 3)) * 2;
    u32x4 st2[4];
#define AT_LOAD2(t_) do { const size_t o_ = (size_t)(t_) * 64 * NU; st2[0] = *(const u32x4*)(gk + o_); st2[1] = *(const u32x4*)(gk + o_ + (size_t)32 * NU); st2[2] = *(const u32x4*)(gv + o_); st2[3] = *(const u32x4*)(gv + o_ + (size_t)32 * NU); } while (0)
#define AT_STORE2(bufp) do { *(LAS u32x4*)((bufp) + lk) = st2[0]; *(LAS u32x4*)((bufp) + lk + 32 * AT_KPITCH) = st2[1]; *(LAS u32x4*)((bufp) + lv) = st2[2]; *(LAS u32x4*)((bufp) + lv + 32 * AT_VPITCH) = st2[3]; } while (0)
    AT_LOAD2(1);
    for (int t = 0; t < nt; t += 2) {
        if (t + 2 < nt) AT_LOAD(t + 2);
        attn_tile(lds, t * 64, qw, r, hh, ka, va, bt, cfar, qf, O, mrun, lrun);
        AT_STORE2(lds + AT_BUF);
        lds_barrier();
        if (t + 3 < nt) AT_LOAD2(t + 3);
        attn_tile(lds + AT_BUF, t * 64 + 64, qw, r, hh, ka, va, bt, cfar, qf, O, mrun, lrun);
        if (t + 2 < nt) AT_STORE(lds);
        lds_barrier();
    }
#undef AT_LOAD2
#undef AT_STORE2
#undef AT_LOAD
#undef AT_STORE
    const float inv = 1.f / xhalf_sum(lrun);
    LAS float* X = (LAS float*)lds;
    if (mp == 1) {
#pragma unroll
        for (int dt = 0; dt < 4; ++dt)
#pragma unroll
            for (int i = 0; i < 16; ++i) X[(rq * 64 + dt * 16 + i) * 64 + lane] = O[dt][i] * inv;
    }
    __syncthreads();
    if (mp == 0) {
        const float lam = *WSP(float, WS_MISC + MS_LAM); float ss = 0.f;
#pragma unroll
        for (int dt = 0; dt < 4; ++dt)
#pragma unroll
            for (int i = 0; i < 16; ++i) { const float v = O[dt][i] * inv - lam * X[(rq * 64 + dt * 16 + i) * 64 + lane]; O[dt][i] = v; ss += v * v; }
        ss = xhalf_sum(ss);
        const float rs = rsqrtf(ss * (1.f / 128.f) + LN_EPS) * 0.8f;
        bf16_t* yp = WSP(bf16_t, WS_Y) + (rbase + qw + r) * 3072 + h * 128;
#pragma unroll
        for (int dt = 0; dt < 4; ++dt)
#pragma unroll
            for (int g4 = 0; g4 < 4; ++g4) { const int dv = dt * 32 + 8 * g4 + 4 * hh; const f32x4 gn = *(const f32x4*)(p.subln_g + dv);
                u32x2 w; w.x = pk_bf16(O[dt][4 * g4] * rs * gn[0], O[dt][4 * g4 + 1] * rs * gn[1]); w.y = pk_bf16(O[dt][4 * g4 + 2] * rs * gn[2], O[dt][4 * g4 + 3] * rs * gn[3]);
                *(u32x2*)(yp + dv) = w; }
    }
}
DI void gate_tables(PP pk_, int g, int chain, LAS unsigned char* lds);
DI void ph_conv(PP pk_, int g, LAS unsigned char* lds) { const P p = load_args(pk_);
    if (bid_local() < BG * 4) gate_tables(pk_, g, bid_local(), lds);
    const int tid = tid_local();
    const bf16_t* U = WSP(bf16_t, WS_U); bf16_t* QKC = WSP(bf16_t, WS_QKC);
    for (int t = bid_local() * 512 + tid; t < (TG / 32) * 256; t += gridDim.x * 512) {
        const int c8 = t & 255, r0 = (t >> 8) * 32, isk = c8 >> 7; const float sc = isk ? 0.0625f : 1.f;
        f32x4 cw[4][2];
#pragma unroll
        for (int j = 0; j < 4; ++j) { cw[j][0] = *(const f32x4*)(p.conv_w + j * 2048 + c8 * 8); cw[j][1] = *(const f32x4*)(p.conv_w + j * 2048 + c8 * 8 + 4); }
        const bf16_t* src = U + (size_t)r0 * NU + UMQ + c8 * 8; bf16_t* dst = QKC + (size_t)r0 * 2048 + c8 * 8;
        const bool head = (r0 & (SEQ - 1)) == 0;
        u32x4 x0 = {0u, 0u, 0u, 0u}, x1 = x0, x2 = x0, x3;
        if (!head) { x0 = *(const u32x4*)(src - 3 * (size_t)NU); x1 = *(const u32x4*)(src - 2 * (size_t)NU); x2 = *(const u32x4*)(src - (size_t)NU); }
#define CONV_OUT(a_, b_, c_, d_, row_) do { float o_[8]; \
        o_[0] = cw[0][0][0] * bf_lo(a_.x) + cw[1][0][0] * bf_lo(b_.x) + cw[2][0][0] * bf_lo(c_.x) + cw[3][0][0] * bf_lo(d_.x); \
        o_[1] = cw[0][0][1] * bf_hi(a_.x) + cw[1][0][1] * bf_hi(b_.x) + cw[2][0][1] * bf_hi(c_.x) + cw[3][0][1] * bf_hi(d_.x); \
        o_[2] = cw[0][0][2] * bf_lo(a_.y) + cw[1][0][2] * bf_lo(b_.y) + cw[2][0][2] * bf_lo(c_.y) + cw[3][0][2] * bf_lo(d_.y); \
        o_[3] = cw[0][0][3] * bf_hi(a_.y) + cw[1][0][3] * bf_hi(b_.y) + cw[2][0][3] * bf_hi(c_.y) + cw[3][0][3] * bf_hi(d_.y); \
        o_[4] = cw[0][1][0] * bf_lo(a_.z) + cw[1][1][0] * bf_lo(b_.z) + cw[2][1][0] * bf_lo(c_.z) + cw[3][1][0] * bf_lo(d_.z); \
        o_[5] = cw[0][1][1] * bf_hi(a_.z) + cw[1][1][1] * bf_hi(b_.z) + cw[2][1][1] * bf_hi(c_.z) + cw[3][1][1] * bf_hi(d_.z); \
        o_[6] = cw[0][1][2] * bf_lo(a_.w) + cw[1][1][2] * bf_lo(b_.w) + cw[2][1][2] * bf_lo(c_.w) + cw[3][1][2] * bf_lo(d_.w); \
        o_[7] = cw[0][1][3] * bf_hi(a_.w) + cw[1][1][3] * bf_hi(b_.w) + cw[2][1][3] * bf_hi(c_.w) + cw[3][1][3] * bf_hi(d_.w); \
        u32x4 w_; w_.x = pk_bf16(silu(o_[0]) * sc, silu(o_[1]) * sc); w_.y = pk_bf16(silu(o_[2]) * sc, silu(o_[3]) * sc); w_.z = pk_bf16(silu(o_[4]) * sc, silu(o_[5]) * sc); w_.w = pk_bf16(silu(o_[6]) * sc, silu(o_[7]) * sc); \
        *(u32x4*)(dst + (size_t)(row_) * 2048) = w_; } while (0)
#pragma unroll 1
        for (int i = 0; i < 32; i += 4) {
            const u32x4 y0 = *(const u32x4*)(src + (size_t)(i) * NU), y1 = *(const u32x4*)(src + (size_t)(i + 1) * NU), y2 = *(const u32x4*)(src + (size_t)(i + 2) * NU), y3 = *(const u32x4*)(src + (size_t)(i + 3) * NU);
            x3 = y0; CONV_OUT(x0, x1, x2, x3, i);
            CONV_OUT(x1, x2, y0, y1, i + 1);
            CONV_OUT(x2, y0, y1, y2, i + 2);
            CONV_OUT(y0, y1, y2, y3, i + 3);
            x0 = y1; x1 = y2; x2 = y3;
        }
#undef CONV_OUT
    }
}
constexpr int ML_QP = 528, ML_KP = 576, ML_VP = 576, ML_WP = 144;
constexpr int ML_Q = 0, ML_K = ML_Q + 64 * ML_QP, ML_V = ML_K + 64 * ML_KP, ML_W = ML_V + 64 * ML_VP, ML_TAB = ML_W + 64 * ML_WP;
constexpr int T_BCUM = 0, T_A = 256, T_MROW = 512, T_IW = 768, T_WS = 1024, T_RS = 1280, T_ND = 2304, T_GI = 2560, T_GF = 2816, T_N = 3072, T_SC = 4096, T_INVD = 4352, T_NP = 4608;
static_assert(ML_TAB + 4608 + 2048 <= LDS_RING, "mLSTM LDS map");
#ifndef ML_NSEG
#define ML_NSEG 1
#endif
constexpr int NSEG = ML_NSEG, SEGCH = (SEQ / 64) / NSEG;
constexpr size_t WS_GT = WS_R + 836 * MiB, WS_LST = WS_R + 840 * MiB;
constexpr int GT_STRIDE = 384, LST_STRIDE = 128 * 512 + 256;
static_assert(WS_LST + (size_t)BG * 4 * (NSEG - 1) * LST_STRIDE * 4 <= WS_END, "segment states fit");
DI void gate_tables(PP pk_, int g, int chain, LAS unsigned char* lds) { const P p = load_args(pk_);
    const int tid = tid_local(), lane = tid & 63, w = tid >> 6, h = chain & 3, b = chain >> 2;
    const float* gif = WSP(float, WS_GIF); float* GT = WSP(float, WS_GT) + (size_t)chain * 32 * GT_STRIDE;
    const size_t tbase = ((size_t)g * BG + b) * SEQ;
    LAS float* tot = (LAS float*)lds; LAS float* amx = tot + 32;
    float bc[4], aa[4], pm[4];
    __syncthreads();
#pragma unroll
    for (int k = 0; k < 4; ++k) { const int c = w + 8 * k; const float ip = gif[(tbase + c * 64 + lane) * 8 + h], fp = gif[(tbase + c * 64 + lane) * 8 + 4 + h];
        float x = fminf(fp, 0.f) - log1pf(expf(-fabsf(fp)));
#pragma unroll
        for (int o = 1; o < 64; o <<= 1) { const float t = bperm(x, lane - o); if (lane >= o) x += t; }
        float y = ip - x; const float a0 = y;
#pragma unroll
        for (int o = 1; o < 64; o <<= 1) { const float t = bperm(y, lane - o); if (lane >= o) y = fmaxf(y, t); }
        bc[k] = x; aa[k] = a0; pm[k] = y;
        if (lane == 63) { tot[c] = x; amx[c] = y; } }
    __syncthreads();
    float mst = 0.f, min_[4];
    for (int c = 0; c < 32; ++c) {
#pragma unroll
        for (int k = 0; k < 4; ++k) if (c == w + 8 * k) min_[k] = mst;
        mst = tot[c] + fmaxf(mst, amx[c]); }
#pragma unroll
    for (int k = 0; k < 4; ++k) { const int c = w + 8 * k; const float m0 = min_[k], total = tot[c], amax = amx[c];
        const float mrow = bc[k] + fmaxf(m0, pm[k]), iw = expf(bc[k] + m0 - mrow), mnew = total + fmaxf(m0, amax), decay = expf(total + m0 - mnew), ws = expf(total + aa[k] - mnew);
        float* o = GT + (size_t)c * GT_STRIDE; o[lane] = bc[k]; o[64 + lane] = aa[k]; o[128 + lane] = mrow; o[192 + lane] = iw; o[256 + lane] = ws; if (lane == 0) o[320] = decay; }
    __syncthreads();
}

template <int mode> DI void mlstm_seg_item(PP pk_, int g, int chain, int seg, LAS unsigned char* lds) { const P p = load_args(pk_);
    const int tid0 = tid_local(), w = __builtin_amdgcn_readfirstlane(tid0 >> 6);
    const int h = chain & 3, b = chain >> 2;
    const bf16_t* U = WSP(bf16_t, WS_U); bf16_t* HB = WSP(bf16_t, WS_MRG); const bf16_t* QKC = WSP(bf16_t, WS_QKC);
    const float* GT = WSP(float, WS_GT) + (size_t)chain * 32 * GT_STRIDE; float* LS = WSP(float, WS_LST) + (size_t)chain * (NSEG - 1) * LST_STRIDE;
    const size_t rbase = (size_t)b * SEQ;
    LAS unsigned char* TB = lds + ML_TAB;
#define TABF(off) ((LAS float*)(TB + (off)))
    f32x16 C[8]; { const float z0 = zero_local();
#pragma unroll
    for (int kt = 0; kt < 8; ++kt)
#pragma unroll
        for (int i = 0; i < 16; ++i) C[kt][i] = z0; }
    __syncthreads();
    { float nn = 0.f;
      if (mode == 1 && seg > 0) {
          const f32x4* Lq = (const f32x4*)(LS + (size_t)(seg - 1) * LST_STRIDE + (size_t)tid0 * 128);
#pragma unroll
          for (int kt = 0; kt < 8; ++kt)
#pragma unroll
              for (int i4 = 0; i4 < 4; ++i4) { const f32x4 l = Lq[kt * 4 + i4]; C[kt][4 * i4] = l[0]; C[kt][4 * i4 + 1] = l[1]; C[kt][4 * i4 + 2] = l[2]; C[kt][4 * i4 + 3] = l[3]; }
          if (tid0 < 256) nn = LS[(size_t)(seg - 1) * LST_STRIDE + 128 * 512 + tid0]; }
      if (tid0 < 256) TABF(T_N)[tid0] = nn; }
    const int ch0 = mode == 1 ? seg * SEGCH : 0, nch = mode == 1 ? SEGCH : SEQ / 64;
    u32x4 pq[2]; float tq[6] = {0.f, 0.f, 0.f, 0.f, 0.f, 0.f};
#define ML_PQ(ch_, tv_) do { if ((tv_) < 64) { const float* gt_ = GT + (size_t)(ch_) * GT_STRIDE + (tv_); tq[0] = gt_[0]; tq[1] = gt_[64]; tq[2] = gt_[128]; tq[3] = gt_[192]; tq[4] = gt_[256]; tq[5] = GT[(size_t)(ch_) * GT_STRIDE + 320]; } _Pragma("unroll") for (int i_ = 0; i_ < 2; ++i_) { const int pc_ = (tv_) + 512 * i_, s_ = pc_ >> 5, cc_ = pc_ & 31; pq[i_] = *(const u32x4*)(QKC + (rbase + (ch_) * 64 + s_) * 2048 + h * 256 + cc_ * 8); } } while (0)
    if (mode == 1) ML_PQ(ch0, tid0);
    u32x4 pk[4], pv[4];
#define ML_PF(ch_, tv_) do { _Pragma("unroll") for (int i_ = 0; i_ < 4; ++i_) { const int pc_ = (tv_) + 512 * i_, s_ = pc_ >> 5, cc_ = pc_ & 31; const size_t row_ = rbase + (ch_) * 64 + s_; \
        pk[i_] = *(const u32x4*)(QKC + row_ * 2048 + 1024 + h * 256 + cc_ * 8); pv[i_] = *(const u32x4*)(U + row_ * NU + UMV + h * 256 + cc_ * 8); } } while (0)
    if (mode == 0) ML_PF(0, tid0);
    for (int ch = ch0; ch < ch0 + nch; ++ch) {
        int tid = tid0; asm volatile("" : "+v"(tid));
        const int lane = tid & 63, hh = lane >> 5, r = lane & 31, i16 = lane & 15, l4 = lane >> 4;
        lds_barrier();
        if (mode == 0 && ch > 0 && (ch % SEGCH) == 0) {
            const int sg = ch / SEGCH - 1;
            f32x4* Lq = (f32x4*)(LS + (size_t)sg * LST_STRIDE + (size_t)tid * 128);
#pragma unroll
            for (int kt = 0; kt < 8; ++kt)
#pragma unroll
                for (int i4 = 0; i4 < 4; ++i4) Lq[kt * 4 + i4] = (f32x4){C[kt][4 * i4], C[kt][4 * i4 + 1], C[kt][4 * i4 + 2], C[kt][4 * i4 + 3]};
            if (tid < 256) LS[(size_t)sg * LST_STRIDE + 128 * 512 + tid] = TABF(T_N)[tid];
        }
        {
#pragma unroll
            for (int i = 0; i < 4; ++i) { const int pc = tid + 512 * i, s = pc >> 5, cc = pc & 31;
                if (mode == 1) *(LAS u32x4*)(lds + ML_Q + s * ML_QP + cc * 16) = i < 2 ? pq[i & 1] : *(const u32x4*)(QKC + (rbase + ch * 64 + s) * 2048 + h * 256 + cc * 8);
                *(LAS u32x4*)(lds + ML_K + s * ML_KP + cc * 16) = mode == 0 ? pk[i] : *(const u32x4*)(QKC + (rbase + ch * 64 + s) * 2048 + 1024 + h * 256 + cc * 8); }
            if (mode == 1) { if (tid < 64) { TABF(T_BCUM)[tid] = tq[0]; TABF(T_A)[tid] = tq[1]; TABF(T_MROW)[tid] = tq[2]; TABF(T_IW)[tid] = tq[3]; TABF(T_WS)[tid] = tq[4]; if (tid == 0) TABF(T_SC)[1] = tq[5]; } }
            else if (tid < 64) { const float* gt = GT + (size_t)ch * GT_STRIDE + tid; TABF(T_BCUM)[tid] = gt[0]; TABF(T_A)[tid] = gt[64]; TABF(T_MROW)[tid] = gt[128]; TABF(T_IW)[tid] = gt[192]; TABF(T_WS)[tid] = gt[256]; if (tid == 0) TABF(T_SC)[1] = gt[320]; }
        }
        u32x4 vf[4];
#pragma unroll
        for (int i = 0; i < 4; ++i) { const int pc = tid + 512 * i, s = pc >> 5, cc = pc & 31; vf[i] = mode == 0 ? pv[i] : *(const u32x4*)(U + (rbase + ch * 64 + s) * NU + UMV + h * 256 + cc * 8); }
        if (mode == 0 && ch + 1 < ch0 + nch) ML_PF(ch + 1, tid);
        const unsigned vtr = ML_V + (8 * hh + (i16 >> 2)) * ML_VP + (32 * w + 16 * (l4 & 1) + 4 * (i16 & 3)) * 2;
        if (mode == 1) {
        lds_barrier();
        f32x4 S2[2];
#pragma unroll
        for (int tt = 0; tt < 2; ++tt) { const int tile = 2 * w + tt, jt = tile >> 2, st = tile & 3; f32x4 s = {0.f, 0.f, 0.f, 0.f};
            const LAS unsigned char* qa = lds + ML_Q + (jt * 16 + i16) * ML_QP + l4 * 16; const LAS unsigned char* ka = lds + ML_K + (st * 16 + i16) * ML_KP + l4 * 16;
#pragma unroll
            for (int c = 0; c < 8; ++c) s = __builtin_amdgcn_mfma_f32_16x16x32_bf16(*(const LAS bf16x8*)(qa + c * 64), *(const LAS bf16x8*)(ka + c * 64), s, 0, 0, 0);
            S2[tt] = s; }
        { const f32x4 nv = *(const LAS f32x4*)(TABF(T_N) + 4 * lane);
#pragma unroll
          for (int jj = 0; jj < 8; ++jj) { const int j = 8 * w + jj; const u32x2 qw = *(const LAS u32x2*)(lds + ML_Q + j * ML_QP + lane * 8);
              const float d = wave_sum_fast(bf_lo(qw.x) * nv[0] + bf_hi(qw.x) * nv[1] + bf_lo(qw.y) * nv[2] + bf_hi(qw.y) * nv[3]); if (lane == 0) TABF(T_ND)[j] = d; } }
#pragma unroll
        for (int tt = 0; tt < 2; ++tt) { const int tile = 2 * w + tt, jt = tile >> 2, st = tile & 3, s = st * 16 + i16; const float as = TABF(T_A)[s];
#pragma unroll
            for (int rg = 0; rg < 4; ++rg) { const int j = jt * 16 + l4 * 4 + rg;
                float val = s <= j ? __expf(TABF(T_BCUM)[j] + as - TABF(T_MROW)[j]) * S2[tt][rg] : 0.f;
                *(LAS bf16_t*)(lds + ML_W + j * ML_WP + s * 2) = (bf16_t)(pk_bf16(val, 0.f) & 0xffffu);
                val = row16_sum(val);
                if (i16 == 0) TABF(T_RS)[j * 4 + st] = val; } }
        }
#pragma unroll
        for (int i = 0; i < 4; ++i) { const int pc = tid + 512 * i, s = pc >> 5, cc = pc & 31; *(LAS u32x4*)(lds + ML_V + s * ML_VP + cc * 16) = vf[i]; }
        lds_barrier();
        if (mode == 1) {
        if (tid < 64) { const int j = tid; const f32x4 rs = *(const LAS f32x4*)(TABF(T_RS) + 4 * j);
            const float den = TABF(T_IW)[j] * TABF(T_ND)[j] + ((rs[0] + rs[1]) + (rs[2] + rs[3]));
            TABF(T_INVD)[j] = 1.f / fmaxf(fabsf(den), expf(-TABF(T_MROW)[j])); }
        f32x16 acc[2]; { const float z0 = zero_local();
#pragma unroll
        for (int jt2 = 0; jt2 < 2; ++jt2)
#pragma unroll
            for (int i = 0; i < 16; ++i) acc[jt2][i] = z0; }
#pragma unroll
        for (int kt = 0; kt < 8; ++kt) { __builtin_amdgcn_sched_barrier(0);
#pragma unroll
            for (int s = 0; s < 2; ++s) { const bf16x8 bfr = pack_half(C[kt], s);
#pragma unroll
                for (int jt2 = 0; jt2 < 2; ++jt2) { const LAS unsigned char* qa = lds + ML_Q + (jt2 * 32 + r) * ML_QP + (kt * 32 + 16 * s + 4 * hh) * 2;
                    const s16x4 lo = *(const LAS s16x4*)qa, hi = *(const LAS s16x4*)(qa + 16);
                    acc[jt2] = MFMA32(__builtin_shufflevector(lo, hi, 0, 1, 2, 3, 4, 5, 6, 7), bfr, acc[jt2]); } } }
        __builtin_amdgcn_sched_barrier(0);
#pragma unroll
        for (int jt2 = 0; jt2 < 2; ++jt2)
#pragma unroll
            for (int i = 0; i < 16; ++i) acc[jt2][i] *= TABF(T_IW)[jt2 * 32 + crow(i, hh)];
#pragma unroll
        for (int ks = 0; ks < 4; ++ks) { const bf16x8 bv = tr_pair(lds + vtr + 16 * ks * ML_VP, lds + vtr + (16 * ks + 4) * ML_VP);
#pragma unroll
            for (int jt2 = 0; jt2 < 2; ++jt2) acc[jt2] = MFMA32(*(const LAS bf16x8*)(lds + ML_W + (jt2 * 32 + r) * ML_WP + (16 * ks + 8 * hh) * 2), bv, acc[jt2]); }
        lds_barrier();
#pragma unroll
        for (int jt2 = 0; jt2 < 2; ++jt2)
#pragma unroll
            for (int i = 0; i < 16; ++i) { const int j = jt2 * 32 + crow(i, hh); *(LAS bf16_t*)(lds + ML_Q + j * 512 + (32 * w + r) * 2) = (bf16_t)(pk_bf16(acc[jt2][i] * TABF(T_INVD)[j], 0.f) & 0xffffu); }
        }
        const float decay = TABF(T_SC)[1];
        { const int dk = tid & 255, sh = tid >> 8; float nn = 0.f;
#pragma unroll 8
          for (int s = 32 * sh; s < 32 * sh + 32; ++s) nn += TABF(T_WS)[s] * bf2f(*(const LAS bf16_t*)(lds + ML_K + s * ML_KP + dk * 2));
          TABF(T_NP)[tid] = nn; }
#pragma unroll
        for (int kt = 0; kt < 8; ++kt) C[kt] *= decay;
        const unsigned ktr = ML_K + (8 * hh + (i16 >> 2)) * ML_KP + (16 * (l4 & 1) + 4 * (i16 & 3)) * 2;
#pragma unroll
        for (int ks = 0; ks < 4; ++ks) { __builtin_amdgcn_sched_barrier(0); const bf16x8 bv = tr_pair(lds + vtr + 16 * ks * ML_VP, lds + vtr + (16 * ks + 4) * ML_VP);
            const u32x4 bw = __builtin_bit_cast(u32x4, bv); const f32x4 w0 = *(const LAS f32x4*)(TABF(T_WS) + 16 * ks + 8 * hh), w1 = *(const LAS f32x4*)(TABF(T_WS) + 16 * ks + 8 * hh + 4);
            u32x4 sw; sw.x = pk_bf16(bf_lo(bw.x) * w0[0], bf_hi(bw.x) * w0[1]); sw.y = pk_bf16(bf_lo(bw.y) * w0[2], bf_hi(bw.y) * w0[3]); sw.z = pk_bf16(bf_lo(bw.z) * w1[0], bf_hi(bw.z) * w1[1]); sw.w = pk_bf16(bf_lo(bw.w) * w1[2], bf_hi(bw.w) * w1[3]);
            const bf16x8 bs = __builtin_bit_cast(bf16x8, sw);
#pragma unroll
            for (int kt = 0; kt < 8; ++kt) C[kt] = MFMA32(tr_pair(lds + ktr + 16 * ks * ML_KP + kt * 64, lds + ktr + (16 * ks + 4) * ML_KP + kt * 64), bs, C[kt]); }
        lds_barrier();
        if (tid < 256) TABF(T_N)[tid] = TABF(T_N)[tid] * decay + (TABF(T_NP)[tid] + TABF(T_NP)[tid + 256]);
        if (mode == 1) {
#pragma unroll
            for (int i = 0; i < 4; ++i) { const int pc = tid + 512 * i, s = pc >> 5, cc = pc & 31; *(u32x4*)(HB + (rbase + ch * 64 + s) * 1024 + h * 256 + cc * 8) = *(const LAS u32x4*)(lds + ML_Q + s * 512 + cc * 16); }
            if (ch + 1 < ch0 + nch) ML_PQ(ch + 1, tid);
        }
    }
#undef TABF
#undef ML_PF
#undef ML_PQ
}
constexpr int XA_KP = 528, XA_VP = 576, XA_VOFF = 32 * XA_KP, XA_BUF = XA_VOFF + 32 * XA_VP;
static_assert(2 * XA_BUF <= LDS_RING, "xattn LDS map");
DI void xattn_tile(const LAS unsigned char* buf, unsigned ka, unsigned va, const bf16x8 (&qf)[16], f32x16 (&O)[4], float& mrun, float& lrun) {
        f32x16 S; { const float z0 = zero_local();
#pragma unroll
        for (int i = 0; i < 16; ++i) S[i] = z0; }
#pragma unroll
        for (int s = 0; s < 16; ++s) S = MFMA32(*(const LAS bf16x8*)(buf + ka + s * 32), qf[s], S);
        float mx = S[0];
#pragma unroll
        for (int i = 1; i < 16; ++i) mx = fmaxf(mx, S[i]);
        mx = xhalf_max(mx);
        const float mnew = fmaxf(mrun, mx);
        if (__builtin_amdgcn_ballot_w64(mnew > mrun) != 0ull) { const float alpha = __builtin_amdgcn_exp2f(mrun - mnew); lrun *= alpha;
#pragma unroll
            for (int dt = 0; dt < 4; ++dt) O[dt] *= alpha; }
        mrun = mnew;
#pragma unroll
        for (int i = 0; i < 16; ++i) { S[i] = __builtin_amdgcn_exp2f(S[i] - mnew); lrun += S[i]; }
#pragma unroll
        for (int s2 = 0; s2 < 2; ++s2) { const bf16x8 pb = pack_half(S, s2); const LAS unsigned char* vb = buf + va + 16 * s2 * XA_VP;
#pragma unroll
            for (int dt = 0; dt < 4; ++dt) O[dt] = MFMA32(tr_pair(vb + dt * 64, vb + dt * 64 + 8 * XA_VP), pb, O[dt]); }
}
DI void xattn_mfma_item(PP pk_, int g, int item, LAS unsigned char* lds) { const P p = load_args(pk_);
    const int tid = tid_local(), lane = tid & 63, wave = __builtin_amdgcn_readfirstlane(tid >> 6), dvh = wave & 1, rq = wave >> 1, hh = lane >> 5, r = lane & 31;
    const int qb = item & 15, h = (item >> 4) & 3, b = item >> 6;
    const bf16_t* U = WSP(bf16_t, WS_U); const bf16_t* KV = WSP(bf16_t, WS_KVM) + (size_t)(g * BG + b) * 256 * 2048 + h * 256;
    const size_t qrow = (size_t)b * SEQ + qb * 128 + rq * 32 + r;
    bf16x8 qf[16];
    { const bf16_t* qp = U + qrow * NU + UCQ + h * 256 + 8 * hh;
#pragma unroll
      for (int s = 0; s < 16; ++s) qf[s] = *(const bf16x8*)(qp + 16 * s); }
    f32x16 O[4]; { const float z0 = zero_local();
#pragma unroll
    for (int dt = 0; dt < 4; ++dt)
#pragma unroll
        for (int i = 0; i < 16; ++i) O[dt][i] = z0; }
    float mrun = -INFINITY, lrun = 0.f;
    const int row0 = tid >> 5, c32 = tid & 31;
    const bf16_t* gk = KV + (size_t)row0 * 2048 + c32 * 8;
    const unsigned lk = row0 * XA_KP + c32 * 16, lv = XA_VOFF + row0 * XA_VP + c32 * 16;
    u32x4 st[4];
#define XA_LOAD(t_) do { const bf16_t* s_ = gk + (size_t)(t_) * 32 * 2048; st[0] = *(const u32x4*)s_; st[1] = *(const u32x4*)(s_ + 16 * 2048); st[2] = *(const u32x4*)(s_ + 1024); st[3] = *(const u32x4*)(s_ + 16 * 2048 + 1024); } while (0)
#define XA_STORE(bufp) do { *(LAS u32x4*)((bufp) + lk) = st[0]; *(LAS u32x4*)((bufp) + lk + 16 * XA_KP) = st[1]; *(LAS u32x4*)((bufp) + lv) = st[2]; *(LAS u32x4*)((bufp) + lv + 16 * XA_VP) = st[3]; } while (0)
    __syncthreads();
    XA_LOAD(0); XA_STORE(lds); __syncthreads();
    const unsigned ka = r * XA_KP + hh * 16;
    const int i16 = lane & 15;
    const unsigned va = XA_VOFF + (4 * hh + (i16 >> 2)) * XA_VP + (dvh * 128 + 16 * ((lane >> 4) & 1) + 4 * (i16 & 3)) * 2;
    u32x4 st2[4];
#define XA_LOAD2(t_) do { const bf16_t* s_ = gk + (size_t)(t_) * 32 * 2048; st2[0] = *(const u32x4*)s_; st2[1] = *(const u32x4*)(s_ + 16 * 2048); st2[2] = *(const u32x4*)(s_ + 1024); st2[3] = *(const u32x4*)(s_ + 16 * 2048 + 1024); } while (0)
#define XA_STORE2(bufp) do { *(LAS u32x4*)((bufp) + lk) = st2[0]; *(LAS u32x4*)((bufp) + lk + 16 * XA_KP) = st2[1]; *(LAS u32x4*)((bufp) + lv) = st2[2]; *(LAS u32x4*)((bufp) + lv + 16 * XA_VP) = st2[3]; } while (0)
    XA_LOAD2(1);
#pragma unroll 1
    for (int t = 0; t < 8; t += 2) {
        if (t + 2 < 8) XA_LOAD(t + 2);
        xattn_tile(lds, ka, va, qf, O, mrun, lrun);
        XA_STORE2(lds + XA_BUF);
        lds_barrier();
        if (t + 3 < 8) XA_LOAD2(t + 3);
        xattn_tile(lds + XA_BUF, ka, va, qf, O, mrun, lrun);
        if (t + 2 < 8) XA_STORE(lds);
        lds_barrier();
    }
#undef XA_LOAD2
#undef XA_STORE2
#undef XA_LOAD
#undef XA_STORE
    const float inv = 1.f / xhalf_sum(lrun);
    bf16_t* yp = WSP(bf16_t, WS_Y) + qrow * 3072 + 2048 + h * 256 + dvh * 128;
#pragma unroll
    for (int dt = 0; dt < 4; ++dt)
#pragma unroll
        for (int g4 = 0; g4 < 4; ++g4) { const int dv = dt * 32 + 8 * g4 + 4 * hh;
            u32x2 w; w.x = pk_bf16(O[dt][4 * g4] * inv, O[dt][4 * g4 + 1] * inv); w.y = pk_bf16(O[dt][4 * g4 + 2] * inv, O[dt][4 * g4 + 3] * inv);
            *(u32x2*)(yp + dv) = w; }
}
#ifndef ATTN_NAIVE
#define ATTN_NAIVE 0
#endif
#ifndef XATTN_NAIVE
#define XATTN_NAIVE 0
#endif
#ifndef MLSTM_NAIVE
#define MLSTM_NAIVE 0
#endif
DI void wd_item(PP pk_, int e, LAS unsigned char* lds);
DI void ph_mix(PP pk_, int g, int rep, LAS unsigned char* lds) { const P p = load_args(pk_);
    constexpr int N_ML = BG * 4, N_AT = BG * 8 * 16, N_XA = BG * 4 * 16;
    const int N_XC = (g + 1 < NGRP) ? TG / 256 : 0;
    const int wd0 = (257 * g) / NGRP, N_WD = (257 * (g + 1)) / NGRP - wd0;
    unsigned* ctr = WSP(unsigned, WS_CTL) + CW_Q + 64 * (g + NGRP * rep);
    for (;;) {
        const int it = next_item(ctr, lds);
        if (it >= N_ML + N_AT + N_XA + N_XC + N_WD) break;
#ifdef PROBE_MIX_ONLY
        if (rep > 0 && PROBE_MIX_ONLY >= 0) { const int ty = it < N_ML ? 0 : (it < N_ML + N_AT ? 1 : 2); if (ty != PROBE_MIX_ONLY) continue; }
#endif
        if (it < N_ML) mlstm_seg_item<1>(pk_, g, it, 0, lds);
        else if (it < N_ML + N_AT) { const int ix = it - N_ML; attn_mfma_item(pk_, ((ix & 63) << 4) | (15 - (ix >> 6)), lds); }
        else if (it < N_ML + N_AT + N_XA) xattn_mfma_item(pk_, g, it - N_ML - N_AT, lds);
        else if (it < N_ML + N_AT + N_XA + N_XC) xconv_item(pk_, g + 1, it - (N_ML + N_AT + N_XA), lds);
        else wd_item(pk_, wd0 + it - (N_ML + N_AT + N_XA + N_XC), lds);
    }
}

DI void ph_mlstm_out(PP pk_, int g, LAS unsigned char* lds) { const P p = load_args(pk_);
    const int tid = tid_local(), lane = tid & 63, wave = tid >> 6, gw = bid_local() * 8 + wave, NGW = gridDim.x * 8;
    const bf16_t* HB = WSP(bf16_t, WS_MRG); const bf16_t* U = WSP(bf16_t, WS_U); bf16_t* Y = WSP(bf16_t, WS_Y);
    for (int r = gw; r < TG; r += NGW) {
        u32x2 hw[4], ow[4]; f32x4 gn[4];
#pragma unroll
        for (int h = 0; h < 4; ++h) { hw[h] = *((const u32x2*)(HB + (size_t)r * 1024 + h * 256) + lane); ow[h] = *((const u32x2*)(U + (size_t)r * NU + UMO + h * 256) + lane); gn[h] = *((const f32x4*)(p.mlstm_norm_g + h * 256) + lane); }
#pragma unroll
        for (int h = 0; h < 4; ++h) {
            const f32x4 v = {bf_lo(hw[h].x), bf_hi(hw[h].x), bf_lo(hw[h].y), bf_hi(hw[h].y)};
            const float mu = wave_sum_fast((v[0] + v[1]) + (v[2] + v[3])) * (1.f / 256.f); const f32x4 d = v - mu;
            const float rstd = rsqrtf(wave_sum_fast((d[0] * d[0] + d[1] * d[1]) + (d[2] * d[2] + d[3] * d[3])) * (1.f / 256.f) + LN_EPS);
            u32x2 o; o.x = cvt_pk_bf16(d[0] * rstd * gn[h][0] * sigm(bf_lo(ow[h].x)), d[1] * rstd * gn[h][1] * sigm(bf_hi(ow[h].x))); o.y = cvt_pk_bf16(d[2] * rstd * gn[h][2] * sigm(bf_lo(ow[h].y)), d[3] * rstd * gn[h][3] * sigm(bf_hi(ow[h].y)));
            *((u32x2*)(Y + (size_t)r * 3072 + 1024 + h * 256) + lane) = o; }
    }
}

DI void ph_ln1(PP pk_, int g, LAS unsigned char* lds) { const P p = load_args(pk_);
    const int tid = tid_local(), lane = tid & 63, wave = tid >> 6, gw = bid_local() * 8 + wave, NGW = gridDim.x * 8;
    const float* Z = WSP(float, WS_Z); bf16_t* X1 = WSP(bf16_t, WS_X1B) + (size_t)g * TG * 1024;
    for (int r0 = gw * 2; r0 < TG; r0 += NGW * 2) {
        f32x4 v[2][4];
#pragma unroll
        for (int q = 0; q < 2; ++q)
#pragma unroll
            for (int j = 0; j < 4; ++j) v[q][j] = *((const f32x4*)(Z + (size_t)(r0 + q) * 1024) + lane + 64 * j);
#pragma unroll
        for (int q = 0; q < 2; ++q) { float s = 0.f;
#pragma unroll
            for (int j = 0; j < 4; ++j) s += (v[q][j][0] + v[q][j][1]) + (v[q][j][2] + v[q][j][3]);
            const float mu = wave_sum(s) * (1.f / 1024.f); float s2 = 0.f;
#pragma unroll
            for (int j = 0; j < 4; ++j) { v[q][j] = v[q][j] - mu; s2 += (v[q][j][0] * v[q][j][0] + v[q][j][1] * v[q][j][1]) + (v[q][j][2] * v[q][j][2] + v[q][j][3] * v[q][j][3]); }
            const float rstd = rsqrtf(wave_sum(s2) * (1.f / 1024.f) + LN_EPS);
            u32x2* d = (u32x2*)(X1 + (size_t)(r0 + q) * 1024) + lane;
#pragma unroll
            for (int j = 0; j < 4; ++j) { const f32x4 gn = *((const f32x4*)p.ln1_g + lane + 64 * j), bb = *((const f32x4*)p.ln1_b + lane + 64 * j); const f32x4 o = v[q][j] * rstd * gn + bb;
                u32x2 w; w.x = cvt_pk_bf16(o[0], o[1]); w.y = cvt_pk_bf16(o[2], o[3]); d[64 * j] = w; } }
    }
}
DI void ph_expert_weights(PP pk_, LAS unsigned char* lds) { const P p = load_args(pk_);
    const int tid = tid_local(), lane = tid & 63, wave = tid >> 6, gw = bid_local() * 8 + wave, NGW = gridDim.x * 8;
    LAS float* scr = (LAS float*)(lds + wave * 16384);
    bf16_t* WGU = WSP(bf16_t, WS_WGU); bf16_t* WD = WSP(bf16_t, WS_WD);
    for (int it = gw; it < 257 * 256; it += NGW) { const int e = it >> 8, r = it & 255, isup = r >> 7, kb = (r >> 3) & 15, nb = r & 7;
        const float* W = (e < 256) ? ((isup ? p.w_e_up : p.w_e_gate) + (size_t)e * 1024 * 256) : (isup ? p.w_s_up : p.w_s_gate);
        const int n0 = nb * 32, drow = (n0 >> 7) * 256 + (n0 & 127) + isup * 128;
        transpose_item(W, 256, n0, WGU + (size_t)e * 512 * 1024, 1024, drow, kb * 64, scr, lane); }
}
DI void wd_item(PP pk_, int e, LAS unsigned char* lds) { const P p = load_args(pk_);
    const int tid = tid_local(), lane = tid & 63, wave = tid >> 6;
    __syncthreads();
    LAS float* scr = (LAS float*)(lds + wave * 16384);
    bf16_t* WD = WSP(bf16_t, WS_WD);
    const float* W = (e < 256) ? (p.w_e_down + (size_t)e * 256 * 1024) : p.w_s_down;
#pragma unroll 1
    for (int r = wave; r < 128; r += 8) { const int kb = r >> 5, nb = r & 31; transpose_item(W, 1024, nb * 32, WD + (size_t)e * 1024 * 256, 256, nb * 32, kb * 64, scr, lane); }
}

DI void ph_topk(PP pk_, LAS unsigned char* lds) { const P p = load_args(pk_);
    const int tid = tid_local(), lane = tid & 63, wave = tid >> 6, gw = bid_local() * 8 + wave, NGW = gridDim.x * 8;
    const float* LG = WSP(float, WS_LOGIT); int* TKI = WSP(int, WS_TKI); float* TKW = WSP(float, WS_TKW); unsigned* cnt = WSP(unsigned, WS_CTL) + CW_CNT;
    int* tokof = WSP(int, WS_TOKOF); float* wof = WSP(float, WS_WOF);
    for (int i = bid_local() * 512 + tid; i < MAXRT * 256; i += gridDim.x * 512) { tokof[i] = 0; wof[i] = 0.f; }
    const f32x4 rb = *((const f32x4*)p.router_bias + lane);
    for (int t = gw; t < T_ALL; t += NGW) {
        const f32x4 lg = *((const f32x4*)(LG + (size_t)t * 256) + lane);
        float sc[4], ch[4];
#pragma unroll
        for (int j = 0; j < 4; ++j) { sc[j] = 1.f / (1.f + expf(-lg[j])); ch[j] = sc[j] + rb[j]; }
        const float m01 = fmaxf(ch[0], ch[1]), n01 = fminf(ch[0], ch[1]), m23 = fmaxf(ch[2], ch[3]), n23 = fminf(ch[2], ch[3]);
        float a1 = fmaxf(m01, m23), a2 = fmaxf(fminf(m01, m23), fmaxf(n01, n23));
#pragma unroll
        for (int o = 1; o < 8; o <<= 1) { const float b1 = __shfl_xor(a1, o), b2 = __shfl_xor(a2, o); const float n1 = fmaxf(a1, b1), n2 = fmaxf(fminf(a1, b1), fmaxf(a2, b2)); a1 = n1; a2 = n2; }
        const float gs = a1 + a2; const int myg = lane >> 3; int rank = 0;
#pragma unroll
        for (int g2 = 0; g2 < 8; ++g2) { const float og = __shfl(gs, 8 * g2); rank += (og > gs || (og == gs && g2 < myg)) ? 1 : 0; }
        if (rank >= 4) { ch[0] = -INFINITY; ch[1] = -INFINITY; ch[2] = -INFINITY; ch[3] = -INFINITY; }
        int myidx = 0; float mys = 0.f, ssum = 0.f;
#pragma unroll
        for (int r = 0; r < 8; ++r) {
            float bv = ch[0]; int bi = 4 * lane;
#pragma unroll
            for (int j = 1; j < 4; ++j) if (ch[j] > bv) { bv = ch[j]; bi = 4 * lane + j; }
#pragma unroll
            for (int o = 32; o >= 1; o >>= 1) { const float ov = __shfl_xor(bv, o); const int oi = __shfl_xor(bi, o); if (ov > bv || (ov == bv && oi < bi)) { bv = ov; bi = oi; } }
            const int jl = bi & 3; const float scsel = jl == 0 ? sc[0] : (jl == 1 ? sc[1] : (jl == 2 ? sc[2] : sc[3]));
            const float sv = __shfl(scsel, bi >> 2);
            if ((bi >> 2) == lane) { if (jl == 0) ch[0] = -INFINITY; else if (jl == 1) ch[1] = -INFINITY; else if (jl == 2) ch[2] = -INFINITY; else ch[3] = -INFINITY; }
            ssum += sv; if (lane == r) { myidx = bi; mys = sv; }
        }
        if (lane < 8) { TKI[(size_t)t * 8 + lane] = myidx; TKW[(size_t)t * 8 + lane] = mys / (ssum + 1e-20f) * 2.5f; atomicAdd(cnt + myidx, 1u); }
    }
}

DI void ph_slots(PP pk_, LAS unsigned char* lds) { const P p = load_args(pk_);
    const int tid = tid_local();
    const unsigned* cnt = WSP(unsigned, WS_CTL) + CW_CNT; int* tbase = WSP(int, WS_MISC + MS_TBASE); int* nt = WSP(int, WS_MISC + MS_NT); int* tile_e = WSP(int, WS_MISC + MS_TILEE);
    LAS int* sb = (LAS int*)lds;
    __syncthreads();
    if (tid < 256) sb[tid] = (int)((cnt[tid] + 255u) >> 8);
    __syncthreads();
    if (tid == 0) { int a = 0; for (int e = 0; e < 256; ++e) { const int n = sb[e]; sb[e] = a; a += n; } sb[256] = a; }
    __syncthreads();
    const int nrt = sb[256];
    if (bid_local() == 0) {
        if (tid < 256) { const int b0 = sb[tid], b1 = sb[tid + 1]; tbase[tid] = b0; for (int t = b0; t < b1; ++t) tile_e[t] = tid; tile_e[nrt + tid] = 256; }
        if (tid == 0) { tbase[256] = nrt; nt[0] = nrt; nt[1] = nrt + 256; }
    }
    const int* TKI = WSP(int, WS_TKI); const float* TKW = WSP(float, WS_TKW); unsigned* cur = WSP(unsigned, WS_CTL) + CW_CUR;
    int* tokof = WSP(int, WS_TOKOF); float* wof = WSP(float, WS_WOF); int* slotof = WSP(int, WS_SLOTOF);
    const int s0 = nrt * 256;
    for (int i = bid_local() * 512 + tid; i < T_ALL * 8; i += gridDim.x * 512) { const int e = TKI[i]; const int slot = sb[e] * 256 + (int)atomicAdd(cur + e, 1u); tokof[slot] = i >> 3; wof[slot] = TKW[i]; slotof[i] = slot; }
    for (int t = bid_local() * 512 + tid; t < T_ALL; t += gridDim.x * 512) { tokof[s0 + t] = t; wof[s0 + t] = 1.f; }
    __syncthreads();
}

DI void ph_combine(PP pk_, int round, LAS unsigned char* lds) { const P p = load_args(pk_);
    const int tid = tid_local();
    const unsigned char* Y = WSP(unsigned char, WS_YCH); const bf16_t* X1 = WSP(bf16_t, WS_X1B); const int* slotof = WSP(int, WS_SLOTOF); const int s0 = WSP(int, WS_MISC + MS_TBASE)[256] * 256;
    for (int i0 = bid_local() * 512 + tid; i0 < T_ALL * 32; i0 += gridDim.x * 512) {
        int slot[2][9]; u32x4 xw[2];
#pragma unroll
        for (int q = 0; q < 2; ++q) { const int i = i0 + q * (T_ALL * 32), t = i >> 6, c8 = (i & 63) * 8; xw[q] = *(const u32x4*)(X1 + (size_t)t * 1024 + round * 512 + c8);
            const u32x4 sa = *(const u32x4*)(slotof + (size_t)t * 8), sb = *(const u32x4*)(slotof + (size_t)t * 8 + 4);
            slot[q][0] = sa.x; slot[q][1] = sa.y; slot[q][2] = sa.z; slot[q][3] = sa.w; slot[q][4] = sb.x; slot[q][5] = sb.y; slot[q][6] = sb.z; slot[q][7] = sb.w; slot[q][8] = s0 + t; }
        u32x2 yw[2][9];
#pragma unroll
        for (int q = 0; q < 2; ++q) { const int c8 = ((i0 + q * (T_ALL * 32)) & 63) * 8;
#pragma unroll
            for (int k = 0; k < 9; ++k) yw[q][k] = *(const u32x2*)(Y + (size_t)slot[q][k] * 512 + c8); }
#pragma unroll
        for (int q = 0; q < 2; ++q) { const int i = i0 + q * (T_ALL * 32), t = i >> 6, c8 = (i & 63) * 8;
            float a[8];
#pragma unroll
            for (int e = 0; e < 8; ++e) a[e] = 0.f;
#pragma unroll
            for (int k = 0; k < 9; ++k) { const u32x2 w = yw[q][k];
                const f32x2 v0 = __builtin_amdgcn_cvt_pk_f32_fp8((int)w.x, false), v1 = __builtin_amdgcn_cvt_pk_f32_fp8((int)w.x, true), v2 = __builtin_amdgcn_cvt_pk_f32_fp8((int)w.y, false), v3 = __builtin_amdgcn_cvt_pk_f32_fp8((int)w.y, true);
                a[0] += v0[0]; a[1] += v0[1]; a[2] += v1[0]; a[3] += v1[1]; a[4] += v2[0]; a[5] += v2[1]; a[6] += v3[0]; a[7] += v3[1]; }
            constexpr float is = 1.f / Y8_SCALE; const u32x4 x = xw[q];
            float* op = p.out + (size_t)t * 1024 + round * 512 + c8;
            *(f32x4*)op = (f32x4){bf_lo(x.x) * ALPHA + a[0] * is, bf_hi(x.x) * ALPHA + a[1] * is, bf_lo(x.y) * ALPHA + a[2] * is, bf_hi(x.y) * ALPHA + a[3] * is};
            *(f32x4*)(op + 4) = (f32x4){bf_lo(x.z) * ALPHA + a[4] * is, bf_hi(x.z) * ALPHA + a[5] * is, bf_lo(x.w) * ALPHA + a[6] * is, bf_hi(x.w) * ALPHA + a[7] * is}; }
    }
}

DI void ph_ln2(PP pk_, LAS unsigned char* lds) { const P p = load_args(pk_);
    const int tid = tid_local(), lane = tid & 63, wave = tid >> 6, gw = bid_local() * 8 + wave, NGW = gridDim.x * 8;
    for (int r0 = gw * 2; r0 < T_ALL; r0 += NGW * 2) {
        f32x4 v[2][4];
#pragma unroll
        for (int q = 0; q < 2; ++q)
#pragma unroll
            for (int j = 0; j < 4; ++j) v[q][j] = *((const f32x4*)(p.out + (size_t)(r0 + q) * 1024) + lane + 64 * j);
#pragma unroll
        for (int q = 0; q < 2; ++q) { float s = 0.f;
#pragma unroll
            for (int j = 0; j < 4; ++j) s += (v[q][j][0] + v[q][j][1]) + (v[q][j][2] + v[q][j][3]);
            const float mu = wave_sum(s) * (1.f / 1024.f); float s2 = 0.f;
#pragma unroll
            for (int j = 0; j < 4; ++j) { v[q][j] = v[q][j] - mu; s2 += (v[q][j][0] * v[q][j][0] + v[q][j][1] * v[q][j][1]) + (v[q][j][2] * v[q][j][2] + v[q][j][3] * v[q][j][3]); }
            const float rstd = rsqrtf(wave_sum(s2) * (1.f / 1024.f) + LN_EPS);
            f32x4* zr = (f32x4*)(p.out + (size_t)(r0 + q) * 1024) + lane;
#pragma unroll
            for (int j = 0; j < 4; ++j) { const f32x4 gn = *((const f32x4*)p.ln2_g + lane + 64 * j), bb = *((const f32x4*)p.ln2_b + lane + 64 * j); zr[64 * j] = v[q][j] * rstd * gn + bb; } }
    }
}

__global__ void __launch_bounds__(512, 2) fwd(P p_unused) {
    extern __shared__ __attribute__((aligned(16))) unsigned char lds_raw[];
    LAS unsigned char* lds = (LAS unsigned char*)lds_raw;
    const int tid = threadIdx.x, G = gridDim.x;
#define bid bid_local()
    volatile LAS unsigned* MISC = (volatile LAS unsigned*)(lds + LDS_MISC);
    if (tid < 32) MISC[tid] = 0u;
    __syncthreads();
    XcdBarrier bar; { unsigned* bw = (unsigned*)(kargs()->ws + WS_CTL) + CW_BAR; bar.bar = bw; bar.x = 0; bar.st = nullptr; bar = xcd_barrier_post(bw, MISC + 8); }
#ifndef PROBE_TYPE
#define PROBE_TYPE -1
#define PROBE_REPS 1
#endif
#define STEP_BEGIN(type) { const int reps_ = ((type) == PROBE_TYPE) ? PROBE_REPS : 1; for (int rep_ = 0; rep_ < reps_; ++rep_) { PP pk_ = kargs(); const P p = load_args(pk_);
#define STEP_END xcd_barrier(bar); } }
#define STEP_END_LAST if (rep_ + 1 < reps_) xcd_barrier(bar); } }

    STEP_BEGIN(0) ph_prologue(pk_, lds); __syncthreads(); ph_xconv(pk_, 0, lds); STEP_END
    for (int g = 0; g < NGRP; ++g) {
        STEP_BEGIN(2) {
            if (g > 0) { ph_ln1(pk_, g - 1, lds); __syncthreads(); }
            pg8::Gemm gm{WSP(bf16_t, WS_XB), WSP(bf16_t, WS_WIN), 1024, 1024, 1024, nullptr}; pg8::StaticOrder S; S.init(TG, NU, G, bid);
            EpiInProj E{WSP(bf16_t, WS_U), WSP(float, WS_MISC + MS_BIAS)};
            pg8::gemm_phase<EpiInProj, pg8::StaticOrder, true>(lds, gm, S, E);
            if (g == 0) {
                pg8::Gemm gk{WSP(bf16_t, WS_MEMB), WSP(bf16_t, WS_WKV), 1024, 1024, 1024, nullptr}; pg8::StaticOrder S2; S2.init(NBATCH * 256, 2048, G, bid);
                EpiPlain E2{WSP(bf16_t, WS_KVM), 2048};
                pg8::gemm_phase<EpiPlain, pg8::StaticOrder, true>(lds, gk, S2, E2);
            }
        } STEP_END
        STEP_BEGIN(4) ph_conv(pk_, g, lds); STEP_END
        STEP_BEGIN(3) ph_mix(pk_, g, rep_, lds); STEP_END
        STEP_BEGIN(16) ph_mlstm_out(pk_, g, lds); STEP_END
        STEP_BEGIN(5) {
            pg8::Gemm gm{WSP(bf16_t, WS_Y), WSP(bf16_t, WS_WBR), 3072, 3072, 3072, nullptr}; pg8::StaticOrder S; S.init(TG, 1024, G, bid);
            EpiBranch2 E{WSP(bf16_t, WS_U), WSP(bf16_t, WS_MRG)}; MidBranch MB{WSP(bf16_t, WS_U)};
            pg8::gemm_phase<EpiBranch2, pg8::StaticOrder, true, false, MidBranch>(lds, gm, S, E, MB);
        } STEP_END
        STEP_BEGIN(6) {
            pg8::Gemm gm{WSP(bf16_t, WS_MRG), WSP(bf16_t, WS_WOUT), 1024, 1024, 1024, nullptr}; pg8::StaticOrder S; S.init(TG, 1024, G, bid);
            EpiOutProj E{p.x + (size_t)g * TG * 1024, WSP(float, WS_Z)};
            pg8::gemm_phase<EpiOutProj, pg8::StaticOrder, true>(lds, gm, S, E);
        } STEP_END
        if (g == NGRP - 1) { STEP_BEGIN(7) ph_ln1(pk_, g, lds); STEP_END }
    }
    STEP_BEGIN(8) {
        pg8::Gemm gm{WSP(bf16_t, WS_X1B), WSP(bf16_t, WS_WR), 1024, 1024, 1024, nullptr}; pg8::StaticOrder S; S.init(T_ALL, 256, G, bid);
        EpiF32 E{WSP(float, WS_LOGIT), 256};
        pg8::gemm_phase<EpiF32, pg8::StaticOrder, true>(lds, gm, S, E);
        ph_expert_weights(pk_, lds);
    } STEP_END
    STEP_BEGIN(9) ph_topk(pk_, lds); STEP_END
    STEP_BEGIN(11) ph_slots(pk_, lds); STEP_END
    STEP_BEGIN(12) {
        const int* ntp = WSP(int, WS_MISC + MS_NT);
        pg8::Gemm gm{WSP(bf16_t, WS_X1B), WSP(bf16_t, WS_WGU), 1024, 1024, 1024, WSP(int, WS_TOKOF)}; ExpertGUOrder S{WSP(int, WS_MISC + MS_TILEE), ntp[1] * 2, G, (G % 8 == 0) ? (bid % 8) * (G / 8) + bid / 8 : bid};
        EpiGateUp E{WSP(bf16_t, WS_ACT)};
        pg8::gemm_phase<EpiGateUp, ExpertGUOrder, true, true>(lds, gm, S, E);
    } STEP_END
    for (int r = 0; r < 2; ++r) {
        STEP_BEGIN(13) {
            const int* ntp = WSP(int, WS_MISC + MS_NT);
            pg8::Gemm gm{WSP(bf16_t, WS_ACT), WSP(bf16_t, WS_WD), 256, 256, 256, nullptr}; ExpertDownOrder S{WSP(int, WS_MISC + MS_TILEE), ntp[1] * 2, G, (G % 8 == 0) ? (bid % 8) * (G / 8) + bid / 8 : bid, r};
            EpiDown E{WSP(unsigned char, WS_YCH), WSP(float, WS_WOF)};
            pg8::gemm_phase<EpiDown, ExpertDownOrder, true>(lds, gm, S, E);
        } STEP_END
        STEP_BEGIN(14) ph_combine(pk_, r, lds); STEP_END
    }
    STEP_BEGIN(15) ph_ln2(pk_, lds); STEP_END_LAST
}
constexpr int NSTEPS = 1 + NGRP * 6 + 1 + 4 + 4 + 1;

extern "C" void kernel_launch(void* const* d_in, const int* in_sizes, int n_in, void* d_out, int out_size, void* d_ws, size_t ws_size, hipStream_t stream) {
    static int grid = 0;
    if (grid == 0) {
        int dev = 0, cus = 0;
        if (hipGetDevice(&dev) != hipSuccess || hipDeviceGetAttribute(&cus, hipDeviceAttributeMultiprocessorCount, dev) != hipSuccess) { fprintf(stderr, "kernel_launch: device query failed\n"); grid = -1; return; }
        if (hipFuncSetAttribute((const void*)fwd, hipFuncAttributeMaxDynamicSharedMemorySize, LDS_BYTES) != hipSuccess) { fprintf(stderr, "kernel_launch: hipFuncSetAttribute failed\n"); grid = -1; return; }
        if (n_in != 24 || ws_size < WS_END) fprintf(stderr, "kernel_launch: n_in %d ws %zu (need %zu)\n", n_in, ws_size, (size_t)WS_END);
        grid = cus;
    }
    if (grid < 0) return;
    (void)hipMemsetAsync((char*)d_ws + WS_CTL, 0, CTL_BYTES, stream);
    P p{};
    const float** pp = (const float**)&p;
    for (int i = 0; i < 24; ++i) pp[i] = (const float*)d_in[i];
    p.out = (float*)d_out; p.ws = (unsigned char*)d_ws;
    p.s_lo = 0; p.s_hi = NSTEPS; hipLaunchKernelGGL(fwd, dim3(grid), dim3(512), LDS_BYTES, stream, p);
}
```

```cpp
#define ONE_LAUNCH 1
#include <hip/hip_runtime.h>
#include <cstdio>
#include <cstdint>
#define DI __device__ __forceinline__
#define LAS __attribute__((address_space(3)))
#define GAS __attribute__((address_space(1)))
typedef unsigned short bf16_t;
typedef short bf16x8 __attribute__((ext_vector_type(8)));
typedef float f32x4 __attribute__((ext_vector_type(4)));
typedef float f32x2 __attribute__((ext_vector_type(2)));
typedef unsigned u32x4 __attribute__((ext_vector_type(4)));
typedef unsigned u32x2 __attribute__((ext_vector_type(2)));

constexpr int T_ALL = 65536, DM = 1024, SEQ = 2048, NBATCH = 32, NGRP = 4, TG = T_ALL / NGRP, BG = NBATCH / NGRP;
constexpr int NU = 11264, CIN = 11272;
constexpr int UQ = 0, UK = 1024, UV = 2048, UMQ = 3072, UMK = 4096, UMV = 5120, UMO = 6144, UCQ = 7168, UGT = 8192;
constexpr int NEXP = 256, MAXRT = 2304, MAXTILES = MAXRT + 256, MAXSLOTS = MAXTILES * 256;
constexpr float ALPHA = 1.189207115002721f;
constexpr float LN_EPS = 1e-5f;

constexpr size_t MiB = 1ull << 20;
constexpr size_t WS_CTL = 0, CTL_BYTES = 1 * MiB;
constexpr size_t WS_MISC = 1 * MiB;
constexpr size_t WS_WIN = 2 * MiB, WS_WKV = 24 * MiB, WS_WBR = 28 * MiB, WS_WOUT = 34 * MiB, WS_WR = 36 * MiB;
constexpr size_t WS_GIF = 38 * MiB, WS_MEMB = 40 * MiB, WS_KVM = 56 * MiB, WS_X1B = 88 * MiB, WS_R = 216 * MiB;
constexpr size_t WS_XB = WS_R, WS_U = WS_R + 32 * MiB, WS_Y = WS_R + 384 * MiB, WS_F32 = WS_R + 480 * MiB, WS_MRG = WS_R + 544 * MiB, WS_Z = WS_R + 576 * MiB, WS_QKC = WS_R + 640 * MiB;
constexpr size_t WS_TKI = WS_R, WS_TKW = WS_R + 2 * MiB, WS_SLOTOF = WS_R + 4 * MiB, WS_TOKOF = WS_R + 6 * MiB, WS_WOF = WS_R + 9 * MiB;
constexpr size_t WS_LOGIT = WS_R + 16 * MiB, WS_WGU = WS_R + 80 * MiB, WS_WD = WS_R + 704 * MiB  , WS_ACT = WS_R + 337 * MiB, WS_YCH = WS_R + 16 * MiB;
constexpr size_t WS_END = WS_R + 900 * MiB;
constexpr size_t MS_BIAS = 0, MS_LAM = 48 * 1024, MS_TBASE = 52 * 1024, MS_NT = 56 * 1024, MS_TILEE = 64 * 1024;
constexpr int CW_CNT = 1024, CW_CUR = 2048, CW_BAR = 8192, CW_Q = 16384;

constexpr int LDS_RING = 147456, LDS_MISC = LDS_RING + 320, LDS_BYTES = 155648;

DI float bf_lo(unsigned w) { return __uint_as_float(w << 16); }
DI float bf_hi(unsigned w) { return __uint_as_float(w & 0xffff0000u); }
DI float bf2f(bf16_t b) { return __uint_as_float((unsigned)b << 16); }
DI unsigned cvt_pk_bf16(float lo, float hi) { unsigned r; asm("v_cvt_pk_bf16_f32 %0, %1, %2" : "=v"(r) : "v"(lo), "v"(hi)); return r; }
template <int CTRL> DI float dppf(float v) { return __builtin_bit_cast(float, __builtin_amdgcn_update_dpp(0, __builtin_bit_cast(int, v), CTRL, 0xf, 0xf, true)); }
DI float row16_sum(float v) { v += dppf<0xB1>(v); v += dppf<0x4E>(v); v += dppf<0x124>(v); v += dppf<0x128>(v); return v; }
DI float rdlane(float v, int l) { return __builtin_bit_cast(float, __builtin_amdgcn_readlane(__builtin_bit_cast(int, v), l)); }
DI float wave_sum_fast(float v) { v = row16_sum(v); return (rdlane(v, 0) + rdlane(v, 16)) + (rdlane(v, 32) + rdlane(v, 48)); }
DI float wave_sum(float v) { return wave_sum_fast(v); }
DI float row16_max(float v) { v = fmaxf(v, dppf<0xB1>(v)); v = fmaxf(v, dppf<0x4E>(v)); v = fmaxf(v, dppf<0x124>(v)); v = fmaxf(v, dppf<0x128>(v)); return v; }
DI float wave_max(float v) { v = row16_max(v); return fmaxf(fmaxf(rdlane(v, 0), rdlane(v, 16)), fmaxf(rdlane(v, 32), rdlane(v, 48))); }
DI float bperm(float v, int src) { return __builtin_bit_cast(float, __builtin_amdgcn_ds_bpermute(src << 2, __builtin_bit_cast(int, v))); }
DI int bperm_i(int v, int src) { return __builtin_amdgcn_ds_bpermute(src << 2, v); }
DI float sigm(float x) { return 1.f / (1.f + __expf(-x)); }
DI float silu(float x) { return x / (1.f + __expf(-x)); }
DI float zero_local() { float z = 0.f; asm volatile("" : "+v"(z)); return z; }
DI int bid_local() { int b = blockIdx.x; asm volatile("" : "+s"(b)); return b; }
DI int tid_local() { int t = threadIdx.x; asm volatile("" : "+v"(t)); return t; }
DI void lds_barrier() { asm volatile("s_waitcnt lgkmcnt(0)" ::: "memory"); __builtin_amdgcn_s_barrier(); asm volatile("" ::: "memory"); }
#define LDS_WAIT() asm volatile("s_waitcnt lgkmcnt(0)" ::: "memory")
namespace pg8 {
constexpr int BM = 256, BK = 64, HALF = 128, HTB = HALF * BK * 2, STAGE_BYTES = 8 * HTB, NXCD = 8, WGM = 8;
__host__ __device__ __forceinline__ int lds_byte(int r, int c) { const int st = (r >> 4) * 2 + (c >> 5), rr = r & 15, cc = c & 31, ob = rr * 64 + cc * 2; return st * 1024 + (ob ^ (((ob >> 9) & 1) << 5)); }
__host__ __device__ __forceinline__ void stage_rc(int b, int& R, int& C) { const int st = b / 1024, sb = b % 1024, swz = sb ^ (((sb >> 9) & 1) << 5); R = (st >> 1) * 16 + swz / 64; C = (st & 1) * 32 + (swz % 64) / 2; }
__host__ __device__ __forceinline__ int perm32(int rho) { const int n = rho >> 4, i = rho & 15; return 8 * (i >> 2) + 4 * n + (i & 3); }

struct Unit { int pm, pn, pb, acol, aux; };
struct Gemm { const bf16_t* A; const bf16_t* Bt; int lda, ldb, K; const int* arow; };

struct StaticOrder {
    int nM, nN, nwg, G, c;
    DI void init(int M, int N, int G_, int c_) { nM = M / BM; nN = N / BM; nwg = nM * nN; G = G_; c = c_; }
    DI bool next(int i, Unit& u) const {
        const long L = (long)i * G + c; if (L >= nwg) return false;
        int wgid = (int)L; { const int q = nwg / NXCD, r = nwg % NXCD, xcd = wgid % NXCD, off = wgid / NXCD; wgid = (xcd < r ? xcd * (q + 1) : r * (q + 1) + (xcd - r) * q) + off; }
        const int nig = WGM * nN, gid = wgid / nig, fm = gid * WGM, gsz = (nM - fm) < WGM ? (nM - fm) : WGM;
        u.pm = fm + ((wgid % nig) % gsz); u.pn = (wgid % nig) / gsz; u.pb = u.pn; u.acol = 0; u.aux = 0; return true;
    }
};

struct NoMid { static constexpr int EVERY = 0; DI void operator()(f32x4 (&)[2][2][4][2], const Unit&, int, int, int, int, int) const {} };
template <class Epi, class Sched, bool ALIGN_EPI, bool GATHER = false, class Mid = NoMid>
DI void gemm_phase(LAS unsigned char* lds, const Gemm g, const Sched& S, const Epi& E, const Mid& mid = Mid()) {
    const int tid = tid_local(), wid = __builtin_amdgcn_readfirstlane(tid >> 6), lane = tid & 63, wr = wid >> 2, wc = wid & 3, fr = lane & 15, fq = lane >> 4;
    const int nt = g.K / BK;
    int Ra[2], Ca[2], Rb[2];
#pragma unroll
    for (int i = 0; i < 2; ++i) { int R, C; stage_rc(tid * 16 + i * 8192, R, C); Ra[i] = R; Ca[i] = C; Rb[i] = (R & ~31) + perm32(R & 31); }
    const size_t kstep = (size_t)(BK * 2);
    const unsigned ldsw = (unsigned)wid * 1024u;
    const int aoff = lds_byte(wr * 64 + fr, fq * 8), boff = lds_byte(wc * 32 + fr, fq * 8);
#define PG8_SA(b, h) (((b) * 2 + (h)) * HTB)
#define PG8_SB(b, h) ((4 + (b) * 2 + (h)) * HTB)
#define PG8_STAGE(bufoff, gptr, offs) do { _Pragma("unroll") for (int _i = 0; _i < 2; ++_i) \
        __builtin_amdgcn_global_load_lds((const unsigned*)((gptr) + (offs)[_i]), (LAS unsigned*)(lds + (bufoff) + ldsw + _i * 8192), 16, 0, 0); } while (0)
#define PG8_LDA(dst, b, h) do { _Pragma("unroll") for (int m = 0; m < 4; ++m) _Pragma("unroll") for (int k = 0; k < 2; ++k) dst[m][k] = *(const LAS bf16x8*)(lds + PG8_SA(b, h) + aoff + m * 2048 + k * 1024); } while (0)
#define PG8_LDB(dst, b, h) do { _Pragma("unroll") for (int n = 0; n < 2; ++n) _Pragma("unroll") for (int k = 0; k < 2; ++k) dst[n][k] = *(const LAS bf16x8*)(lds + PG8_SB(b, h) + boff + n * 2048 + k * 1024); } while (0)
#define PG8_MMA(ai, bj, At, Bt) do { __builtin_amdgcn_s_setprio(1); _Pragma("unroll") for (int m = 0; m < 4; ++m) _Pragma("unroll") for (int n = 0; n < 2; ++n) _Pragma("unroll") for (int k = 0; k < 2; ++k) \
        acc[ai][bj][m][n] = __builtin_amdgcn_mfma_f32_16x16x32_bf16(Bt[n][k], At[m][k], acc[ai][bj][m][n], 0, 0, 0); __builtin_amdgcn_s_setprio(0); } while (0)
#define PG8_WAIT_V(n) asm volatile("s_waitcnt vmcnt(" #n ")" ::: "memory")
#define PG8_WAIT_L(n) asm volatile("s_waitcnt lgkmcnt(" #n ")" ::: "memory")
#define PG8_BAR __builtin_amdgcn_s_barrier()
#define PG8_SCHED __builtin_amdgcn_sched_barrier(0)
#define PG8_OFFS(u, oa) do { _Pragma("unroll") for (int h_ = 0; h_ < 2; ++h_) _Pragma("unroll") for (int i_ = 0; i_ < 2; ++i_) { \
        const int ar_ = g.arow[(u).pm * BM + h_ * HALF + Ra[i_]]; oa[h_][i_] = (unsigned)(ar_ * g.lda + (u).acol + Ca[i_]) * 2u; } } while (0)
    unsigned voffA[2], voffB[2];
#pragma unroll
    for (int i = 0; i < 2; ++i) { voffA[i] = (unsigned)(Ra[i] * g.lda + Ca[i]) * 2u; voffB[i] = (unsigned)(Rb[i] * g.ldb + Ca[i]) * 2u; }
    const size_t hstepA = (size_t)HALF * g.lda * 2, hstepB = (size_t)HALF * g.ldb * 2;
#define PG8_ABASE(u) ((const char*)g.A + (GATHER ? (size_t)0 : ((size_t)(u).pm * BM * g.lda + (u).acol) * 2))
#define PG8_BBASE(u) ((const char*)g.Bt + (size_t)(u).pb * BM * g.ldb * 2)
#define PG8_STAGE_A(bufoff, ab, oa, h) do { if constexpr (GATHER) { PG8_STAGE(bufoff, ab, (oa)[h]); } else { PG8_STAGE(bufoff, (ab) + (h) * hstepA, voffA); } } while (0)
#define PG8_STAGE_B(bufoff, bb, h) PG8_STAGE(bufoff, (bb) + (h) * hstepB, voffB)
    Unit cur, nxt; int ui = 0;
    if (!S.next(0, cur)) return;
    f32x4 acc[2][2][4][2];
#pragma unroll
    for (int a = 0; a < 2; ++a)
#pragma unroll
        for (int b = 0; b < 2; ++b)
#pragma unroll
            for (int m = 0; m < 4; ++m)
#pragma unroll
                for (int n = 0; n < 2; ++n) acc[a][b][m][n] = (f32x4){0.f, 0.f, 0.f, 0.f};
    bf16x8 At[4][2], B0[2][2], B1[2][2];
    unsigned oaC[2][2], oaN[2][2];
    if constexpr (GATHER) { PG8_OFFS(cur, oaC); }
    const char* cA = PG8_ABASE(cur); const char* cB = PG8_BBASE(cur);
    PG8_STAGE_B(PG8_SB(0, 0), cB, 0); PG8_STAGE_B(PG8_SB(0, 1), cB, 1); PG8_STAGE_A(PG8_SA(0, 0), cA, oaC, 0); PG8_STAGE_A(PG8_SA(0, 1), cA, oaC, 1);
    if (wr == 1) PG8_BAR;
    PG8_WAIT_V(2); PG8_BAR;
    PG8_STAGE_B(PG8_SB(1, 0), cB + kstep, 0); PG8_STAGE_A(PG8_SA(1, 0), cA + kstep, oaC, 0); PG8_STAGE_B(PG8_SB(1, 1), cB + kstep, 1);
    PG8_WAIT_V(6); PG8_BAR;
    for (;;) {
        const bool has_next = S.next(ui + 1, nxt);
        const char* nA = has_next ? PG8_ABASE(nxt) : cA; const char* nB = has_next ? PG8_BBASE(nxt) : cB;
        if constexpr (GATHER) {
            if (has_next) { PG8_OFFS(nxt, oaN); }
            else {
#pragma unroll
                for (int h_ = 0; h_ < 2; ++h_)
#pragma unroll
                    for (int i_ = 0; i_ < 2; ++i_) oaN[h_][i_] = oaC[h_][i_];
            }
        }
#pragma unroll 1
        for (int t = 0; t < nt; t += 2) {
            const bool last = (t == nt - 2);
            const char* a1 = cA + (size_t)(t + 1) * kstep;
            const char* a2 = last ? nA : cA + (size_t)(t + 2) * kstep; const char* b2 = last ? nB : cB + (size_t)(t + 2) * kstep;
            const char* a3 = a2 + kstep; const char* b3 = b2 + kstep;
            unsigned oa2[2][2];
            if constexpr (GATHER) {
#pragma unroll
                for (int h_ = 0; h_ < 2; ++h_)
#pragma unroll
                    for (int i_ = 0; i_ < 2; ++i_) oa2[h_][i_] = last ? oaN[h_][i_] : oaC[h_][i_];
            }
            PG8_LDB(B0, 0, 0); PG8_LDB(B1, 0, 1); PG8_SCHED; PG8_LDA(At, 0, 0); PG8_STAGE_A(PG8_SA(1, 1), a1, oaC, 1);
            PG8_WAIT_V(8); PG8_WAIT_L(0); PG8_BAR; PG8_MMA(0, 0, At, B0); PG8_MMA(0, 1, At, B1); PG8_BAR; PG8_SCHED;
            PG8_LDA(At, 0, 1); PG8_STAGE_B(PG8_SB(0, 0), b2, 0); PG8_STAGE_B(PG8_SB(0, 1), b2, 1); PG8_STAGE_A(PG8_SA(0, 0), a2, oa2, 0);
            PG8_WAIT_V(8); PG8_WAIT_L(0); PG8_BAR; PG8_MMA(1, 0, At, B0); PG8_MMA(1, 1, At, B1); PG8_BAR; PG8_SCHED;
            PG8_LDB(B0, 1, 0); PG8_LDB(B1, 1, 1); PG8_SCHED; PG8_LDA(At, 1, 0); PG8_STAGE_A(PG8_SA(0, 1), a2, oa2, 1);
            PG8_WAIT_V(8); PG8_WAIT_L(0); PG8_BAR; PG8_MMA(0, 0, At, B0); PG8_MMA(0, 1, At, B1); PG8_BAR; PG8_SCHED;
            PG8_LDA(At, 1, 1); PG8_STAGE_B(PG8_SB(1, 0), b3, 0); PG8_STAGE_B(PG8_SB(1, 1), b3, 1); PG8_STAGE_A(PG8_SA(1, 0), a3, oa2, 0);
            PG8_WAIT_V(8); PG8_WAIT_L(0); PG8_BAR; PG8_MMA(1, 0, At, B0); PG8_MMA(1, 1, At, B1); PG8_BAR; PG8_SCHED;
            if constexpr (Mid::EVERY > 0) { if (((t + 2) % Mid::EVERY) == 0 && (t + 2) < nt) mid(acc, cur, (t + 2) / Mid::EVERY - 1, wr, wc, fr, fq); }
        }
        if constexpr (ALIGN_EPI) { if (wr == 0) PG8_BAR; }
        E(acc, cur, wr, wc, fr, fq);
        if (!has_next) break;
#pragma unroll
        for (int a = 0; a < 2; ++a)
#pragma unroll
            for (int b = 0; b < 2; ++b)
#pragma unroll
                for (int m = 0; m < 4; ++m)
#pragma unroll
                    for (int n = 0; n < 2; ++n) acc[a][b][m][n] = (f32x4){0.f, 0.f, 0.f, 0.f};
        cur = nxt; cA = nA; cB = nB; ++ui;
        if constexpr (GATHER) {
#pragma unroll
            for (int h_ = 0; h_ < 2; ++h_)
#pragma unroll
                for (int i_ = 0; i_ < 2; ++i_) oaC[h_][i_] = oaN[h_][i_];
        }
        if constexpr (ALIGN_EPI) { if (wr == 1) PG8_BAR; }
    }
    PG8_WAIT_V(0);
    if constexpr (!ALIGN_EPI) { if (wr == 0) PG8_BAR; }
    PG8_BAR;
#undef PG8_SA
#undef PG8_SB
#undef PG8_STAGE
#undef PG8_LDA
#undef PG8_LDB
#undef PG8_MMA
#undef PG8_WAIT_V
#undef PG8_WAIT_L
#undef PG8_BAR
#undef PG8_SCHED
#undef PG8_OFFS
#undef PG8_ABASE
#undef PG8_BBASE
#undef PG8_STAGE_A
#undef PG8_STAGE_B
}
}
using pg8::Unit; using pg8::BM; using pg8::HALF;

struct BranchOrder {
    int ntile, G, c;
    DI bool next(int i, Unit& u) const {
        const int L = (i / 3) * G + c; if (L >= ntile) return false;
        const int n = i % 3; u.pm = L >> 2; u.pn = L & 3; u.pb = n * 4 + u.pn; u.acol = n * 1024; u.aux = n; return true;
    }
};
struct ExpertGUOrder {
    const int* tile_e; int nunits, G, c;
    DI bool next(int i, Unit& u) const {
        const int L = i * G + c; if (L >= nunits) return false;
        const int t = L >> 1, hf = L & 1; const int e = tile_e[t];
        u.pm = t; u.pn = hf; u.pb = e * 2 + hf; u.acol = 0; u.aux = e; return true;
    }
};
struct ExpertDownOrder {
    const int* tile_e; int nunits, G, c, round;
    DI bool next(int i, Unit& u) const {
        const int L = i * G + c; if (L >= nunits) return false;
        const int t = L >> 1, cn = L & 1; const int e = tile_e[t];
        u.pm = t; u.pn = cn; u.pb = e * 4 + round * 2 + cn; u.acol = 0; u.aux = e; return true;
    }
};

#define EPI_ARGS const f32x4 (&acc)[2][2][4][2], const Unit& u, int wr, int wc, int fr, int fq
DI u32x4 pack8(const f32x4 v0, const f32x4 v1) { u32x4 w; w.x = cvt_pk_bf16(v0[0], v0[1]); w.y = cvt_pk_bf16(v0[2], v0[3]); w.z = cvt_pk_bf16(v1[0], v1[1]); w.w = cvt_pk_bf16(v1[2], v1[3]); return w; }

struct EpiInProj {
    bf16_t* O; const float* bias;
    DI void operator()(EPI_ARGS) const {
        const int row0 = u.pm * BM + wr * 64 + fr, col0 = u.pn * BM + wc * 32 + 8 * fq;
        const float sc = (u.pn < 4) ? 0.125f * 1.4426950408889634f : ((u.pn >= 28 && u.pn < 32) ? 0.0625f * 1.4426950408889634f : 1.f);
        f32x4 bv[2][2];
#pragma unroll
        for (int bj = 0; bj < 2; ++bj)
#pragma unroll
            for (int n = 0; n < 2; ++n) bv[bj][n] = *(const f32x4*)(bias + col0 + bj * HALF + 4 * n);
#pragma unroll
        for (int ai = 0; ai < 2; ++ai)
#pragma unroll
            for (int m = 0; m < 4; ++m) { bf16_t* rowp = O + (size_t)(row0 + ai * HALF + m * 16) * NU + col0;
#pragma unroll
                for (int bj = 0; bj < 2; ++bj) *(u32x4*)(rowp + bj * HALF) = pack8((acc[ai][bj][m][0] + bv[bj][0]) * sc, (acc[ai][bj][m][1] + bv[bj][1]) * sc); }
    }
};
struct EpiPlain {
    bf16_t* O; int ldc;
    DI void operator()(EPI_ARGS) const {
        const int row0 = u.pm * BM + wr * 64 + fr, col0 = u.pn * BM + wc * 32 + 8 * fq;
#pragma unroll
        for (int ai = 0; ai < 2; ++ai)
#pragma unroll
            for (int m = 0; m < 4; ++m) { bf16_t* rowp = O + (size_t)(row0 + ai * HALF + m * 16) * ldc + col0;
#pragma unroll
                for (int bj = 0; bj < 2; ++bj) *(u32x4*)(rowp + bj * HALF) = pack8(acc[ai][bj][m][0], acc[ai][bj][m][1]); }
    }
};
struct EpiBranch {
    const bf16_t* U; float* F; bf16_t* M;
    DI void operator()(EPI_ARGS) const {
        const int row0 = u.pm * BM + wr * 64 + fr, col0 = u.pn * BM + wc * 32 + 8 * fq, n = u.aux;
#pragma unroll
        for (int ai = 0; ai < 2; ++ai)
#pragma unroll
            for (int m = 0; m < 4; ++m) { const size_t row = (size_t)(row0 + ai * HALF + m * 16);
#pragma unroll
                for (int bj = 0; bj < 2; ++bj) { const int col = col0 + bj * HALF;
                    const u32x4 gw = *(const u32x4*)(U + row * NU + UGT + n * 1024 + col);
                    f32x4 g0 = {sigm(bf_lo(gw.x)), sigm(bf_hi(gw.x)), sigm(bf_lo(gw.y)), sigm(bf_hi(gw.y))};
                    f32x4 g1 = {sigm(bf_lo(gw.z)), sigm(bf_hi(gw.z)), sigm(bf_lo(gw.w)), sigm(bf_hi(gw.w))};
                    f32x4 v0 = acc[ai][bj][m][0] * g0, v1 = acc[ai][bj][m][1] * g1;
                    float* fp = F + row * 1024 + col;
                    if (n > 0) { v0 += *(const f32x4*)fp; v1 += *(const f32x4*)(fp + 4); }
                    if (n < 2) { *(f32x4*)fp = v0; *(f32x4*)(fp + 4) = v1; }
                    else *(u32x4*)(M + row * 1024 + col) = pack8(v0, v1); }
                asm volatile("" ::: "memory"); }
    }
};
DI f32x4 sig_ratio4(float a0, float a1, float a2, float a3, float b0, float b1, float b2, float b3) {
    return (f32x4){(1.f + __expf(-b0)) / (1.f + __expf(-a0)), (1.f + __expf(-b1)) / (1.f + __expf(-a1)), (1.f + __expf(-b2)) / (1.f + __expf(-a2)), (1.f + __expf(-b3)) / (1.f + __expf(-a3))};
}
struct MidBranch { static constexpr int EVERY = 16; const bf16_t* U;
    DI void operator()(f32x4 (&acc)[2][2][4][2], const Unit& u, int n, int wr, int wc, int fr_, int fq_) const {
        int fr = fr_, fq = fq_; asm volatile("" : "+v"(fr), "+v"(fq));
        const int row0 = u.pm * BM + wr * 64 + fr, col0 = u.pn * BM + wc * 32 + 8 * fq;
#pragma unroll
        for (int ai = 0; ai < 2; ++ai)
#pragma unroll
            for (int m = 0; m < 4; ++m) { const bf16_t* gp = U + (size_t)(row0 + ai * HALF + m * 16) * NU + UGT + n * 1024 + col0;
#pragma unroll
                for (int bj = 0; bj < 2; ++bj) { const u32x4 ga = *(const u32x4*)(gp + bj * HALF), gb = *(const u32x4*)(gp + bj * HALF + 1024);
                    acc[ai][bj][m][0] *= sig_ratio4(bf_lo(ga.x), bf_hi(ga.x), bf_lo(ga.y), bf_hi(ga.y), bf_lo(gb.x), bf_hi(gb.x), bf_lo(gb.y), bf_hi(gb.y));
                    acc[ai][bj][m][1] *= sig_ratio4(bf_lo(ga.z), bf_hi(ga.z), bf_lo(ga.w), bf_hi(ga.w), bf_lo(gb.z), bf_hi(gb.z), bf_lo(gb.w), bf_hi(gb.w));
                    asm volatile("" ::: "memory"); } }
    }
};
struct EpiBranch2 {
    const bf16_t* U; bf16_t* M;
    DI void operator()(EPI_ARGS) const {
        const int row0 = u.pm * BM + wr * 64 + fr, col0 = u.pn * BM + wc * 32 + 8 * fq;
#pragma unroll
        for (int ai = 0; ai < 2; ++ai)
#pragma unroll
            for (int m = 0; m < 4; ++m) { const size_t row = (size_t)(row0 + ai * HALF + m * 16);
#pragma unroll
                for (int bj = 0; bj < 2; ++bj) { const int col = col0 + bj * HALF; const u32x4 gw = *(const u32x4*)(U + row * NU + UGT + 2048 + col);
                    const f32x4 g0 = {sigm(bf_lo(gw.x)), sigm(bf_hi(gw.x)), sigm(bf_lo(gw.y)), sigm(bf_hi(gw.y))}, g1 = {sigm(bf_lo(gw.z)), sigm(bf_hi(gw.z)), sigm(bf_lo(gw.w)), sigm(bf_hi(gw.w))};
                    *(u32x4*)(M + row * 1024 + col) = pack8(acc[ai][bj][m][0] * g0, acc[ai][bj][m][1] * g1); }
                asm volatile("" ::: "memory"); }
    }
};
struct EpiOutProj {
    const float* X; float* Z;
    DI void operator()(EPI_ARGS) const {
        const int row0 = u.pm * BM + wr * 64 + fr, col0 = u.pn * BM + wc * 32 + 8 * fq;
#pragma unroll
        for (int ai = 0; ai < 2; ++ai)
#pragma unroll
            for (int m = 0; m < 4; ++m) { const size_t off = (size_t)(row0 + ai * HALF + m * 16) * 1024 + col0;
#pragma unroll
                for (int bj = 0; bj < 2; ++bj) { const float* xp = X + off + bj * HALF; float* zp = Z + off + bj * HALF;
                    *(f32x4*)zp = *(const f32x4*)xp * ALPHA + acc[ai][bj][m][0]; *(f32x4*)(zp + 4) = *(const f32x4*)(xp + 4) * ALPHA + acc[ai][bj][m][1]; }
                asm volatile("" ::: "memory"); }
    }
};
struct EpiF32 {
    float* O; int ldc;
    DI void operator()(EPI_ARGS) const {
        const int row0 = u.pm * BM + wr * 64 + fr, col0 = u.pn * BM + wc * 32 + 8 * fq;
#pragma unroll
        for (int ai = 0; ai < 2; ++ai)
#pragma unroll
            for (int m = 0; m < 4; ++m) { float* rowp = O + (size_t)(row0 + ai * HALF + m * 16) * ldc + col0;
#pragma unroll
                for (int bj = 0; bj < 2; ++bj) { *(f32x4*)(rowp + bj * HALF) = acc[ai][bj][m][0]; *(f32x4*)(rowp + bj * HALF + 4) = acc[ai][bj][m][1]; } }
    }
};
struct EpiGateUp {
    bf16_t* ACT;
    DI void operator()(EPI_ARGS) const {
        const int row0 = u.pm * BM + wr * 64 + fr, col0 = u.pn * HALF + wc * 32 + 8 * fq;
#pragma unroll
        for (int ai = 0; ai < 2; ++ai)
#pragma unroll
            for (int m = 0; m < 4; ++m) { f32x4 v[2];
#pragma unroll
                for (int n = 0; n < 2; ++n) { const f32x4 gt = acc[ai][0][m][n], up = acc[ai][1][m][n];
                    v[n] = (f32x4){silu(gt[0]) * up[0], silu(gt[1]) * up[1], silu(gt[2]) * up[2], silu(gt[3]) * up[3]}; }
                *(u32x4*)(ACT + (size_t)(row0 + ai * HALF + m * 16) * 256 + col0) = pack8(v[0], v[1]); }
    }
};
DI unsigned pk4_fp8(float a, float b, float c, float d) { int p = __builtin_amdgcn_cvt_pk_fp8_f32(a, b, 0, false); return (unsigned)__builtin_amdgcn_cvt_pk_fp8_f32(c, d, p, true); }
constexpr float Y8_SCALE = 32.f, Y8_MAX = 400.f;
struct EpiDown {
    unsigned char* Y; const float* W;
    DI void operator()(EPI_ARGS) const {
        const int row0 = u.pm * BM + wr * 64 + fr, col0 = u.pn * BM + wc * 32 + 8 * fq;
#pragma unroll
        for (int ai = 0; ai < 2; ++ai)
#pragma unroll
            for (int m = 0; m < 4; ++m) { const int row = row0 + ai * HALF + m * 16; const float w = W[row] * Y8_SCALE;
#pragma unroll
                for (int bj = 0; bj < 2; ++bj) { f32x4 v0 = acc[ai][bj][m][0] * w, v1 = acc[ai][bj][m][1] * w;
#pragma unroll
                    for (int e = 0; e < 4; ++e) { v0[e] = __builtin_amdgcn_fmed3f(v0[e], -Y8_MAX, Y8_MAX); v1[e] = __builtin_amdgcn_fmed3f(v1[e], -Y8_MAX, Y8_MAX); }
                    u32x2 o; o.x = pk4_fp8(v0[0], v0[1], v0[2], v0[3]); o.y = pk4_fp8(v1[0], v1[1], v1[2], v1[3]);
                    *(u32x2*)(Y + (size_t)row * 512 + col0 + bj * HALF) = o; }
                asm volatile("" ::: "memory"); }
    }
};
#define RLX_AGENT __ATOMIC_RELAXED, __HIP_MEMORY_SCOPE_AGENT
#define XB_TMO      128
#define XB_XCNT(j)  (256  + 64 * (j))
#define XB_XSUB(j)  (1280 + 64 * (j))
#define XB_XGEN(j)  (2304 + 64 * (j))
#define XB_TOP      3328
#define XB_TOPGEN   3392
#define XCD_BAR_WORDS 3456
#define XB_SPIN_CAP (1u << 18)

__device__ __forceinline__ unsigned xb_ld(unsigned* p)              { return __hip_atomic_load(p, __ATOMIC_RELAXED, __HIP_MEMORY_SCOPE_AGENT); }
__device__ __forceinline__ unsigned xb_add(unsigned* p, unsigned v) { return __hip_atomic_fetch_add(p, v, __ATOMIC_RELAXED, __HIP_MEMORY_SCOPE_AGENT); }
__device__ __forceinline__ unsigned xb_xcc_id() { return (unsigned)__builtin_amdgcn_s_getreg((3 << 11) | 20) & 0xFu; }
#define XB_SPIN(cond, bar) do { unsigned _sp = 0; while (cond) { __builtin_amdgcn_s_sleep(1); \
    if ((++_sp & 255u) == 0u) { if (xb_ld(&(bar)[XB_TMO])) break; if (_sp > XB_SPIN_CAP) { atomicAdd(&(bar)[XB_TMO], 1u); break; } } } } while (0)

struct XcdBarrier {
    unsigned* bar; unsigned x;
    volatile LAS unsigned* st;
};

__device__ __forceinline__ XcdBarrier xcd_barrier_post(unsigned* bar, volatile LAS unsigned* st) {
    XcdBarrier b; b.bar = bar; b.x = xb_xcc_id(); b.st = st;
    if (threadIdx.x == 0) (void)xb_add(&bar[XB_XCNT(b.x)], 1u);
    return b;
}
__device__ __forceinline__ void xcd_barrier_complete(unsigned* bar, unsigned x, unsigned& nloc, unsigned& nx) {
    const unsigned G = gridDim.x * gridDim.y * gridDim.z;
    unsigned sum, cnt, mine, sp = 0u;
    for (;;) {
        sum = 0u; cnt = 0u; mine = 0u;
#pragma unroll
        for (unsigned j = 0; j < 16; ++j) { const unsigned c = xb_ld(&bar[XB_XCNT(j)]); sum += c; cnt += (c > 0u) ? 1u : 0u; mine = (j == x) ? c : mine; }
        if (sum == G) break;
        __builtin_amdgcn_s_sleep(1);
        if ((++sp & 255u) == 0u) { if (xb_ld(&bar[XB_TMO])) break; if (sp > XB_SPIN_CAP) { atomicAdd(&bar[XB_TMO], 1u); break; } }
    }
    nloc = mine > 0u ? mine : 1u; nx = cnt > 0u ? cnt : 1u;
}

__device__ __forceinline__ void xcd_barrier(const XcdBarrier& b) {
    asm volatile("s_waitcnt vmcnt(0)" ::: "memory");
    __syncthreads();
    if (threadIdx.x == 0) {
        unsigned* bar = b.bar; asm volatile("" : "+s"(bar));
        __builtin_amdgcn_s_waitcnt(0);
        volatile LAS unsigned* stp = b.st; asm volatile("" : "+s"(stp));
        unsigned nloc = stp[0], nx = stp[1];
        if (nloc == 0u) { xcd_barrier_complete(bar, b.x, nloc, nx); stp[0] = nloc; stp[1] = nx; }
        const unsigned old = xb_add(&bar[XB_XSUB(b.x)], 1u);
        const unsigned gen = old / nloc;
        if (old + 1u == (gen + 1u) * nloc) {
            __builtin_amdgcn_fence(__ATOMIC_RELEASE, "agent");
            asm volatile("s_waitcnt vmcnt(0)" ::: "memory");
            const unsigned og = xb_add(&bar[XB_TOP], 1u);
            const unsigned tg = og / nx;
            if (og + 1u == (tg + 1u) * nx) xb_add(&bar[XB_TOPGEN], 1u);
            else XB_SPIN(xb_ld(&bar[XB_TOPGEN]) == tg, bar);
            __builtin_amdgcn_fence(__ATOMIC_ACQUIRE, "agent");
            xb_add(&bar[XB_XGEN(b.x)], 1u);
            asm volatile("s_waitcnt vmcnt(0)" ::: "memory");
        } else {
            XB_SPIN(xb_ld(&bar[XB_XGEN(b.x)]) == gen, bar);
            __builtin_amdgcn_fence(__ATOMIC_ACQUIRE, "agent");
            asm volatile("s_waitcnt vmcnt(0)" ::: "memory");
        }
    }
    __syncthreads();
}

struct P {
    const float *x, *mem, *rel_bias, *w_in, *b_in, *conv_w, *diff_lambda, *subln_g, *mlstm_norm_g, *w_mem_kv, *w_branch, *w_out, *ln1_g, *ln1_b,
                *w_router, *router_bias, *w_e_gate, *w_e_up, *w_e_down, *w_s_gate, *w_s_up, *w_s_down, *ln2_g, *ln2_b;
    float* out; unsigned char* ws; int s_lo, s_hi;
};
typedef const P __attribute__((address_space(4)))* PP;
DI PP kargs() { PP k = (PP)__builtin_amdgcn_kernarg_segment_ptr(); asm volatile("" : "+s"(k)); return k; }
DI P load_args(PP k) { P r; const unsigned long long __attribute__((address_space(4)))* s = (const unsigned long long __attribute__((address_space(4)))*)k;
    void** d = (void**)&r;
#pragma unroll
    for (int i = 0; i < 26; ++i) d[i] = (void*)(GAS char*)s[i];
    ((unsigned long long*)&r)[26] = s[26];
    return r; }
static_assert(sizeof(P) == 27 * 8, "P = 26 pointers + 2 ints");
#define WSP(T, off) ((T*)(p.ws + (off)))

DI void transpose_item(const float* W, int ldw, int src_col0, bf16_t* WT, int ldt, int dst_row0, int k0, LAS float* scr, int lane) {
    float v[32];
    const float* src = W + (size_t)(k0 + (lane >> 5)) * ldw + src_col0 + (lane & 31);
#pragma unroll
    for (int i = 0; i < 32; ++i) v[i] = src[(size_t)(2 * i) * ldw];
#pragma unroll
    for (int i = 0; i < 32; ++i) scr[(2 * i + (lane >> 5)) * 33 + (lane & 31)] = v[i];
    LDS_WAIT();
    const int c = lane & 7;
#pragma unroll
    for (int j = 0; j < 4; ++j) { const int n = (lane >> 3) + 8 * j; const LAS float* s = scr + (8 * c) * 33 + n;
        u32x4 o; o.x = cvt_pk_bf16(s[0 * 33], s[1 * 33]); o.y = cvt_pk_bf16(s[2 * 33], s[3 * 33]); o.z = cvt_pk_bf16(s[4 * 33], s[5 * 33]); o.w = cvt_pk_bf16(s[6 * 33], s[7 * 33]);
        *(u32x4*)(WT + (size_t)(dst_row0 + n) * ldt + k0 + 8 * c) = o; }
    LDS_WAIT();
}
DI void transpose_mat(const float* W, int ldw, int src_col0, int K, int N, bf16_t* WT, int ldt, int dst_row0, int gw, int NGW, LAS float* scr, int lane) {
    const int nblk = N / 32, items = (K / 64) * nblk;
    for (int it = gw; it < items; it += NGW) { const int kb = it / nblk, nb = it % nblk; transpose_item(W, ldw, src_col0 + nb * 32, WT, ldt, dst_row0 + nb * 32, kb * 64, scr, lane); }
}
DI void row_to_bf16(const float* src, bf16_t* dst, int lane) {
    const f32x4* s = (const f32x4*)src + lane; u32x2* d = (u32x2*)dst + lane;
#pragma unroll
    for (int j = 0; j < 4; ++j) { const f32x4 v = s[64 * j]; u32x2 o; o.x = cvt_pk_bf16(v[0], v[1]); o.y = cvt_pk_bf16(v[2], v[3]); d[64 * j] = o; }
}

DI void ph_prologue(PP pk_, LAS unsigned char* lds) { const P p = load_args(pk_);
    const int tid = tid_local(), lane = tid & 63, wave = tid >> 6, gw = bid_local() * 8 + wave, NGW = gridDim.x * 8;
    LAS float* scr = (LAS float*)(lds + wave * 16384);
    bf16_t* WinT = WSP(bf16_t, WS_WIN);
    transpose_mat(p.w_in, CIN, 0, 1024, 7168, WinT, 1024, 0, gw, NGW, scr, lane);
    transpose_mat(p.w_in, CIN, 7176, 1024, 4096, WinT, 1024, 7168, gw, NGW, scr, lane);
    transpose_mat(p.w_mem_kv, 2048, 0, 1024, 2048, WSP(bf16_t, WS_WKV), 1024, 0, gw, NGW, scr, lane);
    for (int n = 0; n < 3; ++n) transpose_mat(p.w_branch + (size_t)n * 1024 * 1024, 1024, 0, 1024, 1024, WSP(bf16_t, WS_WBR) + n * 1024, 3072, 0, gw, NGW, scr, lane);
    transpose_mat(p.w_out, 1024, 0, 1024, 1024, WSP(bf16_t, WS_WOUT), 1024, 0, gw, NGW, scr, lane);
    transpose_mat(p.w_router, 256, 0, 1024, 256, WSP(bf16_t, WS_WR), 1024, 0, gw, NGW, scr, lane);
    bf16_t* memb = WSP(bf16_t, WS_MEMB);
    for (int r = gw; r < NBATCH * 256; r += NGW) row_to_bf16(p.mem + (size_t)r * 1024, memb + (size_t)r * 1024, lane);
    float* bias = WSP(float, WS_MISC + MS_BIAS);
    for (int j = bid_local() * 512 + tid; j < NU; j += gridDim.x * 512) bias[j] = p.b_in[j + (j >= 7168 ? 8 : 0)];
    if (gw == 0) {
        const float* lv = p.diff_lambda;
        const float s1 = wave_sum(lv[lane] * lv[64 + lane]), s2 = wave_sum(lv[128 + lane] * lv[192 + lane]);
        if (lane == 0) *WSP(float, WS_MISC + MS_LAM) = expf(s1) - expf(s2) + 0.2f;
    }
}

DI void xconv_item(PP pk_, int g, int item, LAS unsigned char* lds) { const P p = load_args(pk_);
    const int tid = tid_local(), lane = tid & 63, wave = tid >> 6;
    LAS float* wg = (LAS float*)lds;
    __syncthreads();
    for (int i = tid; i < 2048; i += 512) { const int c = i >> 1, hf = i & 1; *(LAS f32x4*)(wg + c * 8 + hf * 4) = *(const f32x4*)(p.w_in + (size_t)c * CIN + 7168 + hf * 4); }
    __syncthreads();
    bf16_t* xb = WSP(bf16_t, WS_XB); float* gif = WSP(float, WS_GIF);
#pragma unroll 1
    for (int rr = 0; rr < 32; ++rr) { const int r = item * 256 + wave * 32 + rr;
        const size_t t = (size_t)g * TG + r;
        const f32x4* xr = (const f32x4*)(p.x + t * 1024) + lane; u32x2* d = (u32x2*)(xb + (size_t)r * 1024) + lane;
        float gs[8];
#pragma unroll
        for (int q = 0; q < 8; ++q) gs[q] = 0.f;
#pragma unroll
        for (int j = 0; j < 4; ++j) { const f32x4 v = xr[64 * j]; u32x2 o; o.x = cvt_pk_bf16(v[0], v[1]); o.y = cvt_pk_bf16(v[2], v[3]); d[64 * j] = o;
#pragma unroll
            for (int e = 0; e < 4; ++e) { const int c = 4 * lane + 256 * j + e; const f32x4 wl = *(const LAS f32x4*)(wg + c * 8), wh = *(const LAS f32x4*)(wg + c * 8 + 4);
                gs[0] += v[e] * wl[0]; gs[1] += v[e] * wl[1]; gs[2] += v[e] * wl[2]; gs[3] += v[e] * wl[3]; gs[4] += v[e] * wh[0]; gs[5] += v[e] * wh[1]; gs[6] += v[e] * wh[2]; gs[7] += v[e] * wh[3]; } }
        float mine = 0.f;
#pragma unroll
        for (int q = 0; q < 8; ++q) { const float s = wave_sum_fast(gs[q]); if (lane == q) mine = s; }
        if (lane < 8) gif[t * 8 + lane] = mine + p.b_in[7168 + lane];
    }
}
DI void ph_xconv(PP pk_, int g, LAS unsigned char* lds) { for (int it = bid_local(); it < TG / 256; it += gridDim.x) xconv_item(pk_, g, it, lds); __syncthreads(); }

DI int t5_bucket(int n) { return n < 16 ? n : min(31, 16 + (int)(__log2f((float)n * 0.0625f) * (16.f / 3.f))); }

typedef float f32x16 __attribute__((ext_vector_type(16)));
typedef __bf16 bf16x2_t __attribute__((ext_vector_type(2)));
typedef short s16x4 __attribute__((ext_vector_type(4)));
constexpr float LOG2E = 1.4426950408889634f;
DI unsigned pk_bf16(float a, float b) { const f32x2 v = {a, b}; return __builtin_bit_cast(unsigned, __builtin_convertvector(v, bf16x2_t)); }
DI int crow(int reg, int hh) { return (reg & 3) + 8 * (reg >> 2) + 4 * hh; }
#define MFMA32(a, b, c) __builtin_amdgcn_mfma_f32_32x32x16_bf16((a), (b), (c), 0, 0, 0)
DI bf16x8 tr_pair(const LAS unsigned char* a0, const LAS unsigned char* a1) {
    const s16x4 lo = __builtin_amdgcn_ds_read_tr16_b64_v4i16((LAS s16x4*)a0), hi = __builtin_amdgcn_ds_read_tr16_b64_v4i16((LAS s16x4*)a1);
    return __builtin_shufflevector(lo, hi, 0, 1, 2, 3, 4, 5, 6, 7);
}
DI bf16x8 pack_half(const f32x16& x, int s2) {
    u32x4 w;
#pragma unroll
    for (int k = 0; k < 4; ++k) w[k] = pk_bf16(x[8 * s2 + 2 * k], x[8 * s2 + 2 * k + 1]);
    return __builtin_bit_cast(bf16x8, w);
}
DI float xhalf_max(float x) { const auto r = __builtin_amdgcn_permlane32_swap(__builtin_bit_cast(int, x), __builtin_bit_cast(int, x), false, false); return fmaxf(__builtin_bit_cast(float, (int)r[0]), __builtin_bit_cast(float, (int)r[1])); }
DI float xhalf_sum(float x) { const auto r = __builtin_amdgcn_permlane32_swap(__builtin_bit_cast(int, x), __builtin_bit_cast(int, x), false, false); return __builtin_bit_cast(float, (int)r[0]) + __builtin_bit_cast(float, (int)r[1]); }
DI int next_item(unsigned* ctr, LAS unsigned char* lds) {
    volatile LAS int* slot = (volatile LAS int*)(lds + LDS_MISC + 64);
    __syncthreads();
    if (threadIdx.x == 0) *slot = (int)__hip_atomic_fetch_add(ctr, 1u, __ATOMIC_RELAXED, __HIP_MEMORY_SCOPE_AGENT);
    __syncthreads();
    return *slot;
}

constexpr int AT_KPITCH = 144, AT_VPITCH = 320, AT_KBYTES = 64 * AT_KPITCH, AT_VOFF = 2 * AT_KBYTES, AT_BUF = AT_VOFF + 64 * AT_VPITCH, AT_BT = 2 * AT_BUF;
DI void attn_tile(const LAS unsigned char* buf, int k0, int qw, int r, int hh, unsigned ka, unsigned va, const LAS float* bt, float cfar, const bf16x8 (&qf)[4], f32x16 (&O)[4], float& mrun, float& lrun) {
    if (k0 <= qw + 31) {
            const bool far = (qw - k0 - 63) >= 128, first = (k0 == 0);
            float sinit = (far ? cfar : 0.f) - (first ? 0.f : mrun); asm volatile("" : "+v"(sinit));
            f32x16 S[2];
#pragma unroll
            for (int sub = 0; sub < 2; ++sub)
#pragma unroll
                for (int i = 0; i < 16; ++i) S[sub][i] = sinit;
#pragma unroll
            for (int s = 0; s < 4; ++s)
#pragma unroll
                for (int sub = 0; sub < 2; ++sub) S[sub] = MFMA32(*(const LAS bf16x8*)(buf + ka + sub * 32 * AT_KPITCH + s * 32), qf[s], S[sub]);
            if (!far) {
#pragma unroll
                for (int sub = 0; sub < 2; ++sub) { float bv[16];
#pragma unroll
                    for (int i = 0; i < 16; ++i) { const int dist = (qw + r) - (k0 + sub * 32 + crow(i, hh)); bv[i] = bt[min(max(dist, 0), 128)]; }
#pragma unroll
                    for (int i = 0; i < 16; ++i) asm volatile("" : "+v"(bv[i]));
#pragma unroll
                    for (int i = 0; i < 16; ++i) { const int dist = (qw + r) - (k0 + sub * 32 + crow(i, hh)); S[sub][i] = dist < 0 ? -INFINITY : S[sub][i] + bv[i]; } }
            }
            float mx = fmaxf(S[0][0], S[1][0]);
#pragma unroll
            for (int i = 1; i < 16; ++i) mx = fmaxf(mx, fmaxf(S[0][i], S[1][i]));
            mx = xhalf_max(mx);
            if (first || __builtin_amdgcn_ballot_w64(mx > 6.f) != 0ull) {
                const float delta = first ? mx : fmaxf(mx, 0.f), alpha = first ? 1.f : __builtin_amdgcn_exp2f(-delta);
                mrun = (first ? 0.f : mrun) + delta; lrun *= alpha;
#pragma unroll
                for (int dt = 0; dt < 4; ++dt) O[dt] *= alpha;
#pragma unroll
                for (int sub = 0; sub < 2; ++sub)
#pragma unroll
                    for (int i = 0; i < 16; ++i) S[sub][i] -= delta;
            }
#pragma unroll
            for (int sub = 0; sub < 2; ++sub)
#pragma unroll
                for (int i = 0; i < 16; ++i) { S[sub][i] = __builtin_amdgcn_exp2f(S[sub][i]); lrun += S[sub][i]; }
#pragma unroll
            for (int sub = 0; sub < 2; ++sub)
#pragma unroll
                for (int s2 = 0; s2 < 2; ++s2) { const bf16x8 pb = pack_half(S[sub], s2); const LAS unsigned char* vb = buf + va + (sub * 32 + 16 * s2) * AT_VPITCH;
#pragma unroll
                    for (int dt = 0; dt < 4; ++dt) O[dt] = MFMA32(tr_pair(vb + dt * 64, vb + dt * 64 + 8 * AT_VPITCH), pb, O[dt]); }
        }
}
DI void attn_mfma_item(PP pk_, int item, LAS unsigned char* lds) { const P p = load_args(pk_);
    const int tid = tid_local(), lane = tid & 63, wave = __builtin_amdgcn_readfirstlane(tid >> 6), mp = wave & 1, rq = wave >> 1, hh = lane >> 5, r = lane & 31;
    const int qb = item & 15, h = (item >> 4) & 7, b = item >> 7;
    const int q0 = qb * 128, qw = q0 + rq * 32, nt = 2 * qb + 2;
    const bf16_t* U = WSP(bf16_t, WS_U); const size_t rbase = (size_t)b * SEQ;
    LAS float* bt = (LAS float*)(lds + AT_BT);
    __syncthreads();
    if (tid <= 128) bt[tid] = p.rel_bias[t5_bucket(tid) * 8 + h] * LOG2E;
    bf16x8 qf[4];
    { const bf16_t* qp = U + (rbase + qw + r) * NU + UQ + h * 128 + mp * 64 + 8 * hh;
#pragma unroll
      for (int s = 0; s < 4; ++s) qf[s] = *(const bf16x8*)(qp + 16 * s); }
    f32x16 O[4]; { const float z0 = zero_local();
#pragma unroll
    for (int dt = 0; dt < 4; ++dt)
#pragma unroll
        for (int i = 0; i < 16; ++i) O[dt][i] = z0; }
    float mrun = -INFINITY, lrun = 0.f;
    const int row0 = tid >> 4, c16 = tid & 15;
    const bf16_t* gk = U + (rbase + row0) * NU + UK + h * 128 + c16 * 8;
    const bf16_t* gv = U + (rbase + row0) * NU + UV + h * 128 + c16 * 8;
    const unsigned lk = (c16 >> 3) * AT_KBYTES + row0 * AT_KPITCH + (c16 & 7) * 16, lv = AT_VOFF + row0 * AT_VPITCH + c16 * 16;
    u32x4 st[4];
#define AT_LOAD(t_) do { const size_t o_ = (size_t)(t_) * 64 * NU; st[0] = *(const u32x4*)(gk + o_); st[1] = *(const u32x4*)(gk + o_ + (size_t)32 * NU); st[2] = *(const u32x4*)(gv + o_); st[3] = *(const u32x4*)(gv + o_ + (size_t)32 * NU); } while (0)
#define AT_STORE(bufp) do { *(LAS u32x4*)((bufp) + lk) = st[0]; *(LAS u32x4*)((bufp) + lk + 32 * AT_KPITCH) = st[1]; *(LAS u32x4*)((bufp) + lv) = st[2]; *(LAS u32x4*)((bufp) + lv + 32 * AT_VPITCH) = st[3]; } while (0)
    AT_LOAD(0); AT_STORE(lds); __syncthreads();
    const float cfar = bt[128];
    const unsigned ka = mp * AT_KBYTES + r * AT_KPITCH + hh * 16;
    const int i16 = lane & 15;
    const unsigned va = AT_VOFF + (4 * hh + (i16 >> 2)) * AT_VPITCH + (16 * ((lane >> 4) & 1) + 4 * (i16 & 3)) * 2;
    u32x4 st2[4];
#define AT_LOAD2(t_) do { const size_t o_ = (size_t)(t_) * 64 * NU; st2[0] = *(const u32x4*)(gk + o_); st2[1] = *(const u32x4*)(gk + o_ + (size_t)32 * NU); st2[2] = *(const u32x4*)(gv + o_); st2[3] = *(const u32x4*)(gv + o_ + (size_t)32 * NU); } while (0)
#define AT_STORE2(bufp) do { *(LAS u32x4*)((bufp) + lk) = st2[0]; *(LAS u32x4*)((bufp) + lk + 32 * AT_KPITCH) = st2[1]; *(LAS u32x4*)((bufp) + lv) = st2[2]; *(LAS u32x4*)((bufp) + lv + 32 * AT_VPITCH) = st2[3]; } while (0)
    AT_LOAD2(1);
    for (int t = 0; t < nt; t += 2) {
        if (t + 2 < nt) AT_LOAD(t + 2);
        attn_tile(lds, t * 64, qw, r, hh, ka, va, bt, cfar, qf, O, mrun, lrun);
        AT_STORE2(lds + AT_BUF);
        lds_barrier();
        if (t + 3 < nt) AT_LOAD2(t + 3);
        attn_tile(lds + AT_BUF, t * 64 + 64, qw, r, hh, ka, va, bt, cfar, qf, O, mrun, lrun);
        if (t + 2 < nt) AT_STORE(lds);
        lds_barrier();
    }
#undef AT_LOAD2
#undef AT_STORE2
#undef AT_LOAD
#undef AT_STORE
    const float inv = 1.f / xhalf_sum(lrun);
    LAS float* X = (LAS float*)lds;
    if (mp == 1) {
#pragma unroll
        for (int dt = 0; dt < 4; ++dt)
#pragma unroll
            for (int i = 0; i < 16; ++i) X[(rq * 64 + dt * 16 + i) * 64 + lane] = O[dt][i] * inv;
    }
    __syncthreads();
    if (mp == 0) {
        const float lam = *WSP(float, WS_MISC + MS_LAM); float ss = 0.f;
#pragma unroll
        for (int dt = 0; dt < 4; ++dt)
#pragma unroll
            for (int i = 0; i < 16; ++i) { const float v = O[dt][i] * inv - lam * X[(rq * 64 + dt * 16 + i) * 64 + lane]; O[dt][i] = v; ss += v * v; }
        ss = xhalf_sum(ss);
        const float rs = rsqrtf(ss * (1.f / 128.f) + LN_EPS) * 0.8f;
        bf16_t* yp = WSP(bf16_t, WS_Y) + (rbase + qw + r) * 3072 + h * 128;
#pragma unroll
        for (int dt = 0; dt < 4; ++dt)
#pragma unroll
            for (int g4 = 0; g4 < 4; ++g4) { const int dv = dt * 32 + 8 * g4 + 4 * hh; const f32x4 gn = *(const f32x4*)(p.subln_g + dv);
                u32x2 w; w.x = pk_bf16(O[dt][4 * g4] * rs * gn[0], O[dt][4 * g4 + 1] * rs * gn[1]); w.y = pk_bf16(O[dt][4 * g4 + 2] * rs * gn[2], O[dt][4 * g4 + 3] * rs * gn[3]);
                *(u32x2*)(yp + dv) = w; }
    }
}
DI void gate_tables(PP pk_, int g, int chain, LAS unsigned char* lds);
DI void ph_conv(PP pk_, int g, LAS unsigned char* lds) { const P p = load_args(pk_);
    if (bid_local() < BG * 4) gate_tables(pk_, g, bid_local(), lds);
    const int tid = tid_local();
    const bf16_t* U = WSP(bf16_t, WS_U); bf16_t* QKC = WSP(bf16_t, WS_QKC);
    for (int t = bid_local() * 512 + tid; t < (TG / 32) * 256; t += gridDim.x * 512) {
        const int c8 = t & 255, r0 = (t >> 8) * 32, isk = c8 >> 7; const float sc = isk ? 0.0625f : 1.f;
        f32x4 cw[4][2];
#pragma unroll
        for (int j = 0; j < 4; ++j) { cw[j][0] = *(const f32x4*)(p.conv_w + j * 2048 + c8 * 8); cw[j][1] = *(const f32x4*)(p.conv_w + j * 2048 + c8 * 8 + 4); }
        const bf16_t* src = U + (size_t)r0 * NU + UMQ + c8 * 8; bf16_t* dst = QKC + (size_t)r0 * 2048 + c8 * 8;
        const bool head = (r0 & (SEQ - 1)) == 0;
        u32x4 x0 = {0u, 0u, 0u, 0u}, x1 = x0, x2 = x0, x3;
        if (!head) { x0 = *(const u32x4*)(src - 3 * (size_t)NU); x1 = *(const u32x4*)(src - 2 * (size_t)NU); x2 = *(const u32x4*)(src - (size_t)NU); }
#define CONV_OUT(a_, b_, c_, d_, row_) do { float o_[8]; \
        o_[0] = cw[0][0][0] * bf_lo(a_.x) + cw[1][0][0] * bf_lo(b_.x) + cw[2][0][0] * bf_lo(c_.x) + cw[3][0][0] * bf_lo(d_.x); \
        o_[1] = cw[0][0][1] * bf_hi(a_.x) + cw[1][0][1] * bf_hi(b_.x) + cw[2][0][1] * bf_hi(c_.x) + cw[3][0][1] * bf_hi(d_.x); \
        o_[2] = cw[0][0][2] * bf_lo(a_.y) + cw[1][0][2] * bf_lo(b_.y) + cw[2][0][2] * bf_lo(c_.y) + cw[3][0][2] * bf_lo(d_.y); \
        o_[3] = cw[0][0][3] * bf_hi(a_.y) + cw[1][0][3] * bf_hi(b_.y) + cw[2][0][3] * bf_hi(c_.y) + cw[3][0][3] * bf_hi(d_.y); \
        o_[4] = cw[0][1][0] * bf_lo(a_.z) + cw[1][1][0] * bf_lo(b_.z) + cw[2][1][0] * bf_lo(c_.z) + cw[3][1][0] * bf_lo(d_.z); \
        o_[5] = cw[0][1][1] * bf_hi(a_.z) + cw[1][1][1] * bf_hi(b_.z) + cw[2][1][1] * bf_hi(c_.z) + cw[3][1][1] * bf_hi(d_.z); \
        o_[6] = cw[0][1][2] * bf_lo(a_.w) + cw[1][1][2] * bf_lo(b_.w) + cw[2][1][2] * bf_lo(c_.w) + cw[3][1][2] * bf_lo(d_.w); \
        o_[7] = cw[0][1][3] * bf_hi(a_.w) + cw[1][1][3] * bf_hi(b_.w) + cw[2][1][3] * bf_hi(c_.w) + cw[3][1][3] * bf_hi(d_.w); \
        u32x4 w_; w_.x = pk_bf16(silu(o_[0]) * sc, silu(o_[1]) * sc); w_.y = pk_bf16(silu(o_[2]) * sc, silu(o_[3]) * sc); w_.z = pk_bf16(silu(o_[4]) * sc, silu(o_[5]) * sc); w_.w = pk_bf16(silu(o_[6]) * sc, silu(o_[7]) * sc); \
        *(u32x4*)(dst + (size_t)(row_) * 2048) = w_; } while (0)
#pragma unroll 1
        for (int i = 0; i < 32; i += 4) {
            const u32x4 y0 = *(const u32x4*)(src + (size_t)(i) * NU), y1 = *(const u32x4*)(src + (size_t)(i + 1) * NU), y2 = *(const u32x4*)(src + (size_t)(i + 2) * NU), y3 = *(const u32x4*)(src + (size_t)(i + 3) * NU);
            x3 = y0; CONV_OUT(x0, x1, x2, x3, i);
            CONV_OUT(x1, x2, y0, y1, i + 1);
            CONV_OUT(x2, y0, y1, y2, i + 2);
            CONV_OUT(y0, y1, y2, y3, i + 3);
            x0 = y1; x1 = y2; x2 = y3;
        }
#undef CONV_OUT
    }
}
constexpr int ML_QP = 528, ML_KP = 576, ML_VP = 576, ML_WP = 144;
constexpr int ML_Q = 0, ML_K = ML_Q + 64 * ML_QP, ML_V = ML_K + 64 * ML_KP, ML_W = ML_V + 64 * ML_VP, ML_TAB = ML_W + 64 * ML_WP;
constexpr int T_BCUM = 0, T_A = 256, T_MROW = 512, T_IW = 768, T_WS = 1024, T_RS = 1280, T_ND = 2304, T_GI = 2560, T_GF = 2816, T_N = 3072, T_SC = 4096, T_INVD = 4352, T_NP = 4608;
static_assert(ML_TAB + 4608 + 2048 <= LDS_RING, "mLSTM LDS map");
#ifndef ML_NSEG
#define ML_NSEG 1
#endif
constexpr int NSEG = ML_NSEG, SEGCH = (SEQ / 64) / NSEG;
constexpr size_t WS_GT = WS_R + 836 * MiB, WS_LST = WS_R + 840 * MiB;
constexpr int GT_STRIDE = 384, LST_STRIDE = 128 * 512 + 256;
static_assert(WS_LST + (size_t)BG * 4 * (NSEG - 1) * LST_STRIDE * 4 <= WS_END, "segment states fit");
DI void gate_tables(PP pk_, int g, int chain, LAS unsigned char* lds) { const P p = load_args(pk_);
    const int tid = tid_local(), lane = tid & 63, w = tid >> 6, h = chain & 3, b = chain >> 2;
    const float* gif = WSP(float, WS_GIF); float* GT = WSP(float, WS_GT) + (size_t)chain * 32 * GT_STRIDE;
    const size_t tbase = ((size_t)g * BG + b) * SEQ;
    LAS float* tot = (LAS float*)lds; LAS float* amx = tot + 32;
    float bc[4], aa[4], pm[4];
    __syncthreads();
#pragma unroll
    for (int k = 0; k < 4; ++k) { const int c = w + 8 * k; const float ip = gif[(tbase + c * 64 + lane) * 8 + h], fp = gif[(tbase + c * 64 + lane) * 8 + 4 + h];
        float x = fminf(fp, 0.f) - log1pf(expf(-fabsf(fp)));
#pragma unroll
        for (int o = 1; o < 64; o <<= 1) { const float t = bperm(x, lane - o); if (lane >= o) x += t; }
        float y = ip - x; const float a0 = y;
#pragma unroll
        for (int o = 1; o < 64; o <<= 1) { const float t = bperm(y, lane - o); if (lane >= o) y = fmaxf(y, t); }
        bc[k] = x; aa[k] = a0; pm[k] = y;
        if (lane == 63) { tot[c] = x; amx[c] = y; } }
    __syncthreads();
    float mst = 0.f, min_[4];
    for (int c = 0; c < 32; ++c) {
#pragma unroll
        for (int k = 0; k < 4; ++k) if (c == w + 8 * k) min_[k] = mst;
        mst = tot[c] + fmaxf(mst, amx[c]); }
#pragma unroll
    for (int k = 0; k < 4; ++k) { const int c = w + 8 * k; const float m0 = min_[k], total = tot[c], amax = amx[c];
        const float mrow = bc[k] + fmaxf(m0, pm[k]), iw = expf(bc[k] + m0 - mrow), mnew = total + fmaxf(m0, amax), decay = expf(total + m0 - mnew), ws = expf(total + aa[k] - mnew);
        float* o = GT + (size_t)c * GT_STRIDE; o[lane] = bc[k]; o[64 + lane] = aa[k]; o[128 + lane] = mrow; o[192 + lane] = iw; o[256 + lane] = ws; if (lane == 0) o[320] = decay; }
    __syncthreads();
}

template <int mode> DI void mlstm_seg_item(PP pk_, int g, int chain, int seg, LAS unsigned char* lds) { const P p = load_args(pk_);
    const int tid0 = tid_local(), w = __builtin_amdgcn_readfirstlane(tid0 >> 6);
    const int h = chain & 3, b = chain >> 2;
    const bf16_t* U = WSP(bf16_t, WS_U); bf16_t* HB = WSP(bf16_t, WS_MRG); const bf16_t* QKC = WSP(bf16_t, WS_QKC);
    const float* GT = WSP(float, WS_GT) + (size_t)chain * 32 * GT_STRIDE; float* LS = WSP(float, WS_LST) + (size_t)chain * (NSEG - 1) * LST_STRIDE;
    const size_t rbase = (size_t)b * SEQ;
    LAS unsigned char* TB = lds + ML_TAB;
#define TABF(off) ((LAS float*)(TB + (off)))
    f32x16 C[8]; { const float z0 = zero_local();
#pragma unroll
    for (int kt = 0; kt < 8; ++kt)
#pragma unroll
        for (int i = 0; i < 16; ++i) C[kt][i] = z0; }
    __syncthreads();
    { float nn = 0.f;
      if (mode == 1 && seg > 0) {
          const f32x4* Lq = (const f32x4*)(LS + (size_t)(seg - 1) * LST_STRIDE + (size_t)tid0 * 128);
#pragma unroll
          for (int kt = 0; kt < 8; ++kt)
#pragma unroll
              for (int i4 = 0; i4 < 4; ++i4) { const f32x4 l = Lq[kt * 4 + i4]; C[kt][4 * i4] = l[0]; C[kt][4 * i4 + 1] = l[1]; C[kt][4 * i4 + 2] = l[2]; C[kt][4 * i4 + 3] = l[3]; }
          if (tid0 < 256) nn = LS[(size_t)(seg - 1) * LST_STRIDE + 128 * 512 + tid0]; }
      if (tid0 < 256) TABF(T_N)[tid0] = nn; }
    const int ch0 = mode == 1 ? seg * SEGCH : 0, nch = mode == 1 ? SEGCH : SEQ / 64;
    u32x4 pq[2]; float tq[6] = {0.f, 0.f, 0.f, 0.f, 0.f, 0.f};
#define ML_PQ(ch_, tv_) do { if ((tv_) < 64) { const float* gt_ = GT + (size_t)(ch_) * GT_STRIDE + (tv_); tq[0] = gt_[0]; tq[1] = gt_[64]; tq[2] = gt_[128]; tq[3] = gt_[192]; tq[4] = gt_[256]; tq[5] = GT[(size_t)(ch_) * GT_STRIDE + 320]; } _Pragma("unroll") for (int i_ = 0; i_ < 2; ++i_) { const int pc_ = (tv_) + 512 * i_, s_ = pc_ >> 5, cc_ = pc_ & 31; pq[i_] = *(const u32x4*)(QKC + (rbase + (ch_) * 64 + s_) * 2048 + h * 256 + cc_ * 8); } } while (0)
    if (mode == 1) ML_PQ(ch0, tid0);
    u32x4 pk[4], pv[4];
#define ML_PF(ch_, tv_) do { _Pragma("unroll") for (int i_ = 0; i_ < 4; ++i_) { const int pc_ = (tv_) + 512 * i_, s_ = pc_ >> 5, cc_ = pc_ & 31; const size_t row_ = rbase + (ch_) * 64 + s_; \
        pk[i_] = *(const u32x4*)(QKC + row_ * 2048 + 1024 + h * 256 + cc_ * 8); pv[i_] = *(const u32x4*)(U + row_ * NU + UMV + h * 256 + cc_ * 8); } } while (0)
    if (mode == 0) ML_PF(0, tid0);
    for (int ch = ch0; ch < ch0 + nch; ++ch) {
        int tid = tid0; asm volatile("" : "+v"(tid));
        const int lane = tid & 63, hh = lane >> 5, r = lane & 31, i16 = lane & 15, l4 = lane >> 4;
        lds_barrier();
        if (mode == 0 && ch > 0 && (ch % SEGCH) == 0) {
            const int sg = ch / SEGCH - 1;
            f32x4* Lq = (f32x4*)(LS + (size_t)sg * LST_STRIDE + (size_t)tid * 128);
#pragma unroll
            for (int kt = 0; kt < 8; ++kt)
#pragma unroll
                for (int i4 = 0; i4 < 4; ++i4) Lq[kt * 4 + i4] = (f32x4){C[kt][4 * i4], C[kt][4 * i4 + 1], C[kt][4 * i4 + 2], C[kt][4 * i4 + 3]};
            if (tid < 256) LS[(size_t)sg * LST_STRIDE + 128 * 512 + tid] = TABF(T_N)[tid];
        }
        {
#pragma unroll
            for (int i = 0; i < 4; ++i) { const int pc = tid + 512 * i, s = pc >> 5, cc = pc & 31;
                if (mode == 1) *(LAS u32x4*)(lds + ML_Q + s * ML_QP + cc * 16) = i < 2 ? pq[i & 1] : *(const u32x4*)(QKC + (rbase + ch * 64 + s) * 2048 + h * 256 + cc * 8);
                *(LAS u32x4*)(lds + ML_K + s * ML_KP + cc * 16) = mode == 0 ? pk[i] : *(const u32x4*)(QKC + (rbase + ch * 64 + s) * 2048 + 1024 + h * 256 + cc * 8); }
            if (mode == 1) { if (tid < 64) { TABF(T_BCUM)[tid] = tq[0]; TABF(T_A)[tid] = tq[1]; TABF(T_MROW)[tid] = tq[2]; TABF(T_IW)[tid] = tq[3]; TABF(T_WS)[tid] = tq[4]; if (tid == 0) TABF(T_SC)[1] = tq[5]; } }
            else if (tid < 64) { const float* gt = GT + (size_t)ch * GT_STRIDE + tid; TABF(T_BCUM)[tid] = gt[0]; TABF(T_A)[tid] = gt[64]; TABF(T_MROW)[tid] = gt[128]; TABF(T_IW)[tid] = gt[192]; TABF(T_WS)[tid] = gt[256]; if (tid == 0) TABF(T_SC)[1] = gt[320]; }
        }
        u32x4 vf[4];
#pragma unroll
        for (int i = 0; i < 4; ++i) { const int pc = tid + 512 * i, s = pc >> 5, cc = pc & 31; vf[i] = mode == 0 ? pv[i] : *(const u32x4*)(U + (rbase + ch * 64 + s) * NU + UMV + h * 256 + cc * 8); }
        if (mode == 0 && ch + 1 < ch0 + nch) ML_PF(ch + 1, tid);
        const unsigned vtr = ML_V + (8 * hh + (i16 >> 2)) * ML_VP + (32 * w + 16 * (l4 & 1) + 4 * (i16 & 3)) * 2;
        if (mode == 1) {
        lds_barrier();
        f32x4 S2[2];
#pragma unroll
        for (int tt = 0; tt < 2; ++tt) { const int tile = 2 * w + tt, jt = tile >> 2, st = tile & 3; f32x4 s = {0.f, 0.f, 0.f, 0.f};
            const LAS unsigned char* qa = lds + ML_Q + (jt * 16 + i16) * ML_QP + l4 * 16; const LAS unsigned char* ka = lds + ML_K + (st * 16 + i16) * ML_KP + l4 * 16;
#pragma unroll
            for (int c = 0; c < 8; ++c) s = __builtin_amdgcn_mfma_f32_16x16x32_bf16(*(const LAS bf16x8*)(qa + c * 64), *(const LAS bf16x8*)(ka + c * 64), s, 0, 0, 0);
            S2[tt] = s; }
        { const f32x4 nv = *(const LAS f32x4*)(TABF(T_N) + 4 * lane);
#pragma unroll
          for (int jj = 0; jj < 8; ++jj) { const int j = 8 * w + jj; const u32x2 qw = *(const LAS u32x2*)(lds + ML_Q + j * ML_QP + lane * 8);
              const float d = wave_sum_fast(bf_lo(qw.x) * nv[0] + bf_hi(qw.x) * nv[1] + bf_lo(qw.y) * nv[2] + bf_hi(qw.y) * nv[3]); if (lane == 0) TABF(T_ND)[j] = d; } }
#pragma unroll
        for (int tt = 0; tt < 2; ++tt) { const int tile = 2 * w + tt, jt = tile >> 2, st = tile & 3, s = st * 16 + i16; const float as = TABF(T_A)[s];
#pragma unroll
            for (int rg = 0; rg < 4; ++rg) { const int j = jt * 16 + l4 * 4 + rg;
                float val = s <= j ? __expf(TABF(T_BCUM)[j] + as - TABF(T_MROW)[j]) * S2[tt][rg] : 0.f;
                *(LAS bf16_t*)(lds + ML_W + j * ML_WP + s * 2) = (bf16_t)(pk_bf16(val, 0.f) & 0xffffu);
                val = row16_sum(val);
                if (i16 == 0) TABF(T_RS)[j * 4 + st] = val; } }
        }
#pragma unroll
        for (int i = 0; i < 4; ++i) { const int pc = tid + 512 * i, s = pc >> 5, cc = pc & 31; *(LAS u32x4*)(lds + ML_V + s * ML_VP + cc * 16) = vf[i]; }
        lds_barrier();
        if (mode == 1) {
        if (tid < 64) { const int j = tid; const f32x4 rs = *(const LAS f32x4*)(TABF(T_RS) + 4 * j);
            const float den = TABF(T_IW)[j] * TABF(T_ND)[j] + ((rs[0] + rs[1]) + (rs[2] + rs[3]));
            TABF(T_INVD)[j] = 1.f / fmaxf(fabsf(den), expf(-TABF(T_MROW)[j])); }
        f32x16 acc[2]; { const float z0 = zero_local();
#pragma unroll
        for (int jt2 = 0; jt2 < 2; ++jt2)
#pragma unroll
            for (int i = 0; i < 16; ++i) acc[jt2][i] = z0; }
#pragma unroll
        for (int kt = 0; kt < 8; ++kt) { __builtin_amdgcn_sched_barrier(0);
#pragma unroll
            for (int s = 0; s < 2; ++s) { const bf16x8 bfr = pack_half(C[kt], s);
#pragma unroll
                for (int jt2 = 0; jt2 < 2; ++jt2) { const LAS unsigned char* qa = lds + ML_Q + (jt2 * 32 + r) * ML_QP + (kt * 32 + 16 * s + 4 * hh) * 2;
                    const s16x4 lo = *(const LAS s16x4*)qa, hi = *(const LAS s16x4*)(qa + 16);
                    acc[jt2] = MFMA32(__builtin_shufflevector(lo, hi, 0, 1, 2, 3, 4, 5, 6, 7), bfr, acc[jt2]); } } }
        __builtin_amdgcn_sched_barrier(0);
#pragma unroll
        for (int jt2 = 0; jt2 < 2; ++jt2)
#pragma unroll
            for (int i = 0; i < 16; ++i) acc[jt2][i] *= TABF(T_IW)[jt2 * 32 + crow(i, hh)];
#pragma unroll
        for (int ks = 0; ks < 4; ++ks) { const bf16x8 bv = tr_pair(lds + vtr + 16 * ks * ML_VP, lds + vtr + (16 * ks + 4) * ML_VP);
#pragma unroll
            for (int jt2 = 0; jt2 < 2; ++jt2) acc[jt2] = MFMA32(*(const LAS bf16x8*)(lds + ML_W + (jt2 * 32 + r) * ML_WP + (16 * ks + 8 * hh) * 2), bv, acc[jt2]); }
        lds_barrier();
#pragma unroll
        for (int jt2 = 0; jt2 < 2; ++jt2)
#pragma unroll
            for (int i = 0; i < 16; ++i) { const int j = jt2 * 32 + crow(i, hh); *(LAS bf16_t*)(lds + ML_Q + j * 512 + (32 * w + r) * 2) = (bf16_t)(pk_bf16(acc[jt2][i] * TABF(T_INVD)[j], 0.f) & 0xffffu); }
        }
        const float decay = TABF(T_SC)[1];
        { const int dk = tid & 255, sh = tid >> 8; float nn = 0.f;
#pragma unroll 8
          for (int s = 32 * sh; s < 32 * sh + 32; ++s) nn += TABF(T_WS)[s] * bf2f(*(const LAS bf16_t*)(lds + ML_K + s * ML_KP + dk * 2));
          TABF(T_NP)[tid] = nn; }
#pragma unroll
        for (int kt = 0; kt < 8; ++kt) C[kt] *= decay;
        const unsigned ktr = ML_K + (8 * hh + (i16 >> 2)) * ML_KP + (16 * (l4 & 1) + 4 * (i16 & 3)) * 2;
#pragma unroll
        for (int ks = 0; ks < 4; ++ks) { __builtin_amdgcn_sched_barrier(0); const bf16x8 bv = tr_pair(lds + vtr + 16 * ks * ML_VP, lds + vtr + (16 * ks + 4) * ML_VP);
            const u32x4 bw = __builtin_bit_cast(u32x4, bv); const f32x4 w0 = *(const LAS f32x4*)(TABF(T_WS) + 16 * ks + 8 * hh), w1 = *(const LAS f32x4*)(TABF(T_WS) + 16 * ks + 8 * hh + 4);
            u32x4 sw; sw.x = pk_bf16(bf_lo(bw.x) * w0[0], bf_hi(bw.x) * w0[1]); sw.y = pk_bf16(bf_lo(bw.y) * w0[2], bf_hi(bw.y) * w0[3]); sw.z = pk_bf16(bf_lo(bw.z) * w1[0], bf_hi(bw.z) * w1[1]); sw.w = pk_bf16(bf_lo(bw.w) * w1[2], bf_hi(bw.w) * w1[3]);
            const bf16x8 bs = __builtin_bit_cast(bf16x8, sw);
#pragma unroll
            for (int kt = 0; kt < 8; ++kt) C[kt] = MFMA32(tr_pair(lds + ktr + 16 * ks * ML_KP + kt * 64, lds + ktr + (16 * ks + 4) * ML_KP + kt * 64), bs, C[kt]); }
        lds_barrier();
        if (tid < 256) TABF(T_N)[tid] = TABF(T_N)[tid] * decay + (TABF(T_NP)[tid] + TABF(T_NP)[tid + 256]);
        if (mode == 1) {
#pragma unroll
            for (int i = 0; i < 4; ++i) { const int pc = tid + 512 * i, s = pc >> 5, cc = pc & 31; *(u32x4*)(HB + (rbase + ch * 64 + s) * 1024 + h * 256 + cc * 8) = *(const LAS u32x4*)(lds + ML_Q + s * 512 + cc * 16); }
            if (ch + 1 < ch0 + nch) ML_PQ(ch + 1, tid);
        }
    }
#undef TABF
#undef ML_PF
#undef ML_PQ
}
constexpr int M2_QP = 528, M2_KP = 576, M2_VP = 320, M2_WP = 144;
constexpr int M2_Q = 0, M2_K = M2_Q + 64 * M2_QP, M2_V = M2_K + 64 * M2_KP, M2_W = M2_V + 64 * M2_VP, M2_TAB = M2_W + 64 * M2_WP, M2_X = M2_TAB + 7168;
static_assert(M2_X + 32768 <= LDS_RING, "split-mLSTM LDS map");
DI void mlstm_half_item(PP pk_, int g, int item, LAS unsigned char* lds) { const P p = load_args(pk_);
    const int tid0 = tid_local(), w = __builtin_amdgcn_readfirstlane(tid0 >> 6), vs = w & 3, kh = w >> 2;
    const int half = item & 1, chain = item >> 1, h = chain & 3, b = chain >> 2;
    const bf16_t* U = WSP(bf16_t, WS_U); bf16_t* HB = WSP(bf16_t, WS_MRG); const bf16_t* QKC = WSP(bf16_t, WS_QKC);
    const float* GT = WSP(float, WS_GT) + (size_t)chain * 32 * GT_STRIDE;
    const size_t rbase = (size_t)b * SEQ;
    LAS unsigned char* TB = lds + M2_TAB;
#define TABF(off) ((LAS float*)(TB + (off)))
    f32x16 C[4]; { const float z0 = zero_local();
#pragma unroll
    for (int kt = 0; kt < 4; ++kt)
#pragma unroll
        for (int i = 0; i < 16; ++i) C[kt][i] = z0; }
    __syncthreads();
    if (tid0 < 256) TABF(T_N)[tid0] = 0.f;
    u32x4 pq[4], pk[4], pv[2]; float tq[6] = {0.f, 0.f, 0.f, 0.f, 0.f, 0.f};
#define M2_PF(ch_, tv_) do { if ((tv_) < 64) { const float* gt_ = GT + (size_t)(ch_) * GT_STRIDE + (tv_); tq[0] = gt_[0]; tq[1] = gt_[64]; tq[2] = gt_[128]; tq[3] = gt_[192]; tq[4] = gt_[256]; tq[5] = GT[(size_t)(ch_) * GT_STRIDE + 320]; } \
        _Pragma("unroll") for (int i_ = 0; i_ < 4; ++i_) { const int pc_ = (tv_) + 512 * i_, s_ = pc_ >> 5, cc_ = pc_ & 31; const bf16_t* r_ = QKC + (rbase + (ch_) * 64 + s_) * 2048 + h * 256 + cc_ * 8; pq[i_] = *(const u32x4*)r_; pk[i_] = *(const u32x4*)(r_ + 1024); } \
        _Pragma("unroll") for (int i_ = 0; i_ < 2; ++i_) { const int pc_ = (tv_) + 512 * i_, s_ = pc_ >> 4, cc_ = pc_ & 15; pv[i_] = *(const u32x4*)(U + (rbase + (ch_) * 64 + s_) * NU + UMV + h * 256 + half * 128 + cc_ * 8); } } while (0)
    M2_PF(0, tid0);
    for (int ch = 0; ch < SEQ / 64; ++ch) {
        int tid = tid0; asm volatile("" : "+v"(tid));
        const int lane = tid & 63, hh = lane >> 5, r = lane & 31, i16 = lane & 15, l4 = lane >> 4;
        lds_barrier();
#pragma unroll
        for (int i = 0; i < 4; ++i) { const int pc = tid + 512 * i, s = pc >> 5, cc = pc & 31; *(LAS u32x4*)(lds + M2_Q + s * M2_QP + cc * 16) = pq[i]; *(LAS u32x4*)(lds + M2_K + s * M2_KP + cc * 16) = pk[i]; }
#pragma unroll
        for (int i = 0; i < 2; ++i) { const int pc = tid + 512 * i, s = pc >> 4, cc = pc & 15; *(LAS u32x4*)(lds + M2_V + s * M2_VP + cc * 16) = pv[i]; }
        if (tid < 64) { TABF(T_BCUM)[tid] = tq[0]; TABF(T_A)[tid] = tq[1]; TABF(T_MROW)[tid] = tq[2]; TABF(T_IW)[tid] = tq[3]; TABF(T_WS)[tid] = tq[4]; if (tid == 0) TABF(T_SC)[1] = tq[5]; }
        if (ch + 1 < SEQ / 64) M2_PF(ch + 1, tid);
        lds_barrier();
        f32x4 S2[2];
#pragma unroll
        for (int tt = 0; tt < 2; ++tt) { const int tile = 2 * w + tt, jt = tile >> 2, st = tile & 3; f32x4 s = {0.f, 0.f, 0.f, 0.f};
            const LAS unsigned char* qa = lds + M2_Q + (jt * 16 + i16) * M2_QP + l4 * 16; const LAS unsigned char* ka = lds + M2_K + (st * 16 + i16) * M2_KP + l4 * 16;
#pragma unroll
            for (int c = 0; c < 8; ++c) s = __builtin_amdgcn_mfma_f32_16x16x32_bf16(*(const LAS bf16x8*)(qa + c * 64), *(const LAS bf16x8*)(ka + c * 64), s, 0, 0, 0);
            S2[tt] = s; }
        { const f32x4 nv = *(const LAS f32x4*)(TABF(T_N) + 4 * lane);
#pragma unroll
          for (int jj = 0; jj < 8; ++jj) { const int j = 8 * w + jj; const u32x2 qw = *(const LAS u32x2*)(lds + M2_Q + j * M2_QP + lane * 8);
              const float d = wave_sum_fast(bf_lo(qw.x) * nv[0] + bf_hi(qw.x) * nv[1] + bf_lo(qw.y) * nv[2] + bf_hi(qw.y) * nv[3]); if (lane == 0) TABF(T_ND)[j] = d; } }
#pragma unroll
        for (int tt = 0; tt < 2; ++tt) { const int tile = 2 * w + tt, jt = tile >> 2, st = tile & 3, s = st * 16 + i16; const float as = TABF(T_A)[s];
#pragma unroll
            for (int rg = 0; rg < 4; ++rg) { const int j = jt * 16 + l4 * 4 + rg;
                float val = s <= j ? __expf(TABF(T_BCUM)[j] + as - TABF(T_MROW)[j]) * S2[tt][rg] : 0.f;
                *(LAS bf16_t*)(lds + M2_W + j * M2_WP + s * 2) = (bf16_t)(pk_bf16(val, 0.f) & 0xffffu);
                val = row16_sum(val);
                if (i16 == 0) TABF(T_RS)[j * 4 + st] = val; } }
        lds_barrier();
        if (tid < 64) { const int j = tid; const f32x4 rs = *(const LAS f32x4*)(TABF(T_RS) + 4 * j);
            const float den = TABF(T_IW)[j] * TABF(T_ND)[j] + ((rs[0] + rs[1]) + (rs[2] + rs[3]));
            TABF(T_INVD)[j] = 1.f / fmaxf(fabsf(den), expf(-TABF(T_MROW)[j])); }
        f32x16 acc[2]; { const float z0 = zero_local();
#pragma unroll
        for (int jt2 = 0; jt2 < 2; ++jt2)
#pragma unroll
            for (int i = 0; i < 16; ++i) acc[jt2][i] = z0; }
#pragma unroll
        for (int kt = 0; kt < 4; ++kt)
#pragma unroll
            for (int s = 0; s < 2; ++s) { const bf16x8 bfr = pack_half(C[kt], s);
#pragma unroll
                for (int jt2 = 0; jt2 < 2; ++jt2) { const LAS unsigned char* qa = lds + M2_Q + (jt2 * 32 + r) * M2_QP + (128 * kh + kt * 32 + 16 * s + 4 * hh) * 2;
                    const s16x4 lo = *(const LAS s16x4*)qa, hi = *(const LAS s16x4*)(qa + 16);
                    acc[jt2] = MFMA32(__builtin_shufflevector(lo, hi, 0, 1, 2, 3, 4, 5, 6, 7), bfr, acc[jt2]); } }
        { LAS float* X = (LAS float*)(lds + M2_X);
#pragma unroll
          for (int i = 0; i < 16; ++i) X[(w * 16 + i) * 64 + lane] = kh == 0 ? acc[1][i] : acc[0][i]; }
        lds_barrier();
        f32x16 num;
        { const LAS float* X = (const LAS float*)(lds + M2_X);
#pragma unroll
          for (int i = 0; i < 16; ++i) num[i] = ((kh == 0 ? acc[0][i] : acc[1][i]) + X[((w ^ 4) * 16 + i) * 64 + lane]) * TABF(T_IW)[kh * 32 + crow(i, hh)]; }
        const unsigned vtr = M2_V + (8 * hh + (i16 >> 2)) * M2_VP + (32 * vs + 16 * (l4 & 1) + 4 * (i16 & 3)) * 2;
#pragma unroll
        for (int ks = 0; ks < 4; ++ks) num = MFMA32(*(const LAS bf16x8*)(lds + M2_W + (kh * 32 + r) * M2_WP + (16 * ks + 8 * hh) * 2), tr_pair(lds + vtr + 16 * ks * M2_VP, lds + vtr + (16 * ks + 4) * M2_VP), num);
        lds_barrier();
#pragma unroll
        for (int i = 0; i < 16; ++i) { const int j = kh * 32 + crow(i, hh); *(LAS bf16_t*)(lds + M2_Q + j * 256 + (32 * vs + r) * 2) = (bf16_t)(pk_bf16(num[i] * TABF(T_INVD)[j], 0.f) & 0xffffu); }
        const float decay = TABF(T_SC)[1];
        { const int dk = tid & 255, sh = tid >> 8; float nn = 0.f;
#pragma unroll 8
          for (int s = 32 * sh; s < 32 * sh + 32; ++s) nn += TABF(T_WS)[s] * bf2f(*(const LAS bf16_t*)(lds + M2_K + s * M2_KP + dk * 2));
          TABF(T_NP)[tid] = nn; }
#pragma unroll
        for (int kt = 0; kt < 4; ++kt) C[kt] *= decay;
        const unsigned ktr = M2_K + (8 * hh + (i16 >> 2)) * M2_KP + (128 * kh + 16 * (l4 & 1) + 4 * (i16 & 3)) * 2;
#pragma unroll
        for (int ks = 0; ks < 4; ++ks) { const bf16x8 bv = tr_pair(lds + vtr + 16 * ks * M2_VP, lds + vtr + (16 * ks + 4) * M2_VP);
            const u32x4 bw = __builtin_bit_cast(u32x4, bv); const f32x4 w0 = *(const LAS f32x4*)(TABF(T_WS) + 16 * ks + 8 * hh), w1 = *(const LAS f32x4*)(TABF(T_WS) + 16 * ks + 8 * hh + 4);
            u32x4 sw; sw.x = pk_bf16(bf_lo(bw.x) * w0[0], bf_hi(bw.x) * w0[1]); sw.y = pk_bf16(bf_lo(bw.y) * w0[2], bf_hi(bw.y) * w0[3]); sw.z = pk_bf16(bf_lo(bw.z) * w1[0], bf_hi(bw.z) * w1[1]); sw.w = pk_bf16(bf_lo(bw.w) * w1[2], bf_hi(bw.w) * w1[3]);
            const bf16x8 bs = __builtin_bit_cast(bf16x8, sw);
#pragma unroll
            for (int kt = 0; kt < 4; ++kt) C[kt] = MFMA32(tr_pair(lds + ktr + 16 * ks * M2_KP + kt * 64, lds + ktr + (16 * ks + 4) * M2_KP + kt * 64), bs, C[kt]); }
        lds_barrier();
        if (tid < 256) TABF(T_N)[tid] = TABF(T_N)[tid] * decay + (TABF(T_NP)[tid] + TABF(T_NP)[tid + 256]);
#pragma unroll
        for (int i = 0; i < 2; ++i) { const int pc = tid + 512 * i, s = pc >> 4, cc = pc & 15; *(u32x4*)(HB + (rbase + ch * 64 + s) * 1024 + h * 256 + half * 128 + cc * 8) = *(const LAS u32x4*)(lds + M2_Q + s * 256 + cc * 16); }
    }
#undef TABF
#undef M2_PF
}
constexpr int XA_KP = 528, XA_VP = 576, XA_VOFF = 32 * XA_KP, XA_BUF = XA_VOFF + 32 * XA_VP;
static_assert(2 * XA_BUF <= LDS_RING, "xattn LDS map");
DI void xattn_tile(const LAS unsigned char* buf, unsigned ka, unsigned va, const bf16x8 (&qf)[16], f32x16 (&O)[4], float& mrun, float& lrun) {
        f32x16 S, S1; { const float z0 = zero_local();
#pragma unroll
        for (int i = 0; i < 16; ++i) { S[i] = z0; S1[i] = z0; } }
#pragma unroll
        for (int s = 0; s < 16; s += 2) { S = MFMA32(*(const LAS bf16x8*)(buf + ka + s * 32), qf[s], S); S1 = MFMA32(*(const LAS bf16x8*)(buf + ka + (s + 1) * 32), qf[s + 1], S1); }
        S += S1;
        float mx = S[0];
#pragma unroll
        for (int i = 1; i < 16; ++i) mx = fmaxf(mx, S[i]);
        mx = xhalf_max(mx);
        const float mnew = fmaxf(mrun, mx);
        if (__builtin_amdgcn_ballot_w64(mnew > mrun) != 0ull) { const float alpha = __builtin_amdgcn_exp2f(mrun - mnew); lrun *= alpha;
#pragma unroll
            for (int dt = 0; dt < 4; ++dt) O[dt] *= alpha; }
        mrun = mnew;
#pragma unroll
        for (int i = 0; i < 16; ++i) { S[i] = __builtin_amdgcn_exp2f(S[i] - mnew); lrun += S[i]; }
#pragma unroll
        for (int s2 = 0; s2 < 2; ++s2) { const bf16x8 pb = pack_half(S, s2); const LAS unsigned char* vb = buf + va + 16 * s2 * XA_VP;
#pragma unroll
            for (int dt = 0; dt < 4; ++dt) O[dt] = MFMA32(tr_pair(vb + dt * 64, vb + dt * 64 + 8 * XA_VP), pb, O[dt]); }
}
DI void xattn_mfma_item(PP pk_, int g, int item, LAS unsigned char* lds) { const P p = load_args(pk_);
    const int tid = tid_local(), lane = tid & 63, wave = __builtin_amdgcn_readfirstlane(tid >> 6), dvh = wave & 1, rq = wave >> 1, hh = lane >> 5, r = lane & 31;
    const int qb = item & 15, h = (item >> 4) & 3, b = item >> 6;
    const bf16_t* U = WSP(bf16_t, WS_U); const bf16_t* KV = WSP(bf16_t, WS_KVM) + (size_t)(g * BG + b) * 256 * 2048 + h * 256;
    const size_t qrow = (size_t)b * SEQ + qb * 128 + rq * 32 + r;
    bf16x8 qf[16];
    { const bf16_t* qp = U + qrow * NU + UCQ + h * 256 + 8 * hh;
#pragma unroll
      for (int s = 0; s < 16; ++s) qf[s] = *(const bf16x8*)(qp + 16 * s); }
    f32x16 O[4]; { const float z0 = zero_local();
#pragma unroll
    for (int dt = 0; dt < 4; ++dt)
#pragma unroll
        for (int i = 0; i < 16; ++i) O[dt][i] = z0; }
    float mrun = -INFINITY, lrun = 0.f;
    const int row0 = tid >> 5, c32 = tid & 31;
    const bf16_t* gk = KV + (size_t)row0 * 2048 + c32 * 8;
    const unsigned lk = row0 * XA_KP + c32 * 16, lv = XA_VOFF + row0 * XA_VP + c32 * 16;
    u32x4 st[4];
#define XA_LOAD(t_) do { const bf16_t* s_ = gk + (size_t)(t_) * 32 * 2048; st[0] = *(const u32x4*)s_; st[1] = *(const u32x4*)(s_ + 16 * 2048); st[2] = *(const u32x4*)(s_ + 1024); st[3] = *(const u32x4*)(s_ + 16 * 2048 + 1024); } while (0)
#define XA_STORE(bufp) do { *(LAS u32x4*)((bufp) + lk) = st[0]; *(LAS u32x4*)((bufp) + lk + 16 * XA_KP) = st[1]; *(LAS u32x4*)((bufp) + lv) = st[2]; *(LAS u32x4*)((bufp) + lv + 16 * XA_VP) = st[3]; } while (0)
    __syncthreads();
    XA_LOAD(0); XA_STORE(lds); __syncthreads();
    const unsigned ka = r * XA_KP + hh * 16;
    const int i16 = lane & 15;
    const unsigned va = XA_VOFF + (4 * hh + (i16 >> 2)) * XA_VP + (dvh * 128 + 16 * ((lane >> 4) & 1) + 4 * (i16 & 3)) * 2;
    u32x4 st2[4];
#define XA_LOAD2(t_) do { const bf16_t* s_ = gk + (size_t)(t_) * 32 * 2048; st2[0] = *(const u32x4*)s_; st2[1] = *(const u32x4*)(s_ + 16 * 2048); st2[2] = *(const u32x4*)(s_ + 1024); st2[3] = *(const u32x4*)(s_ + 16 * 2048 + 1024); } while (0)
#define XA_STORE2(bufp) do { *(LAS u32x4*)((bufp) + lk) = st2[0]; *(LAS u32x4*)((bufp) + lk + 16 * XA_KP) = st2[1]; *(LAS u32x4*)((bufp) + lv) = st2[2]; *(LAS u32x4*)((bufp) + lv + 16 * XA_VP) = st2[3]; } while (0)
    XA_LOAD2(1);
#pragma unroll 1
    for (int t = 0; t < 8; t += 2) {
        if (t + 2 < 8) XA_LOAD(t + 2);
        xattn_tile(lds, ka, va, qf, O, mrun, lrun);
        XA_STORE2(lds + XA_BUF);
        lds_barrier();
        if (t + 3 < 8) XA_LOAD2(t + 3);
        xattn_tile(lds + XA_BUF, ka, va, qf, O, mrun, lrun);
        if (t + 2 < 8) XA_STORE(lds);
        lds_barrier();
    }
#undef XA_LOAD2
#undef XA_STORE2
#undef XA_LOAD
#undef XA_STORE
    const float inv = 1.f / xhalf_sum(lrun);
    bf16_t* yp = WSP(bf16_t, WS_Y) + qrow * 3072 + 2048 + h * 256 + dvh * 128;
#pragma unroll
    for (int dt = 0; dt < 4; ++dt)
#pragma unroll
        for (int g4 = 0; g4 < 4; ++g4) { const int dv = dt * 32 + 8 * g4 + 4 * hh;
            u32x2 w; w.x = pk_bf16(O[dt][4 * g4] * inv, O[dt][4 * g4 + 1] * inv); w.y = pk_bf16(O[dt][4 * g4 + 2] * inv, O[dt][4 * g4 + 3] * inv);
            *(u32x2*)(yp + dv) = w; }
}
#ifndef ATTN_NAIVE
#define ATTN_NAIVE 0
#endif
#ifndef XATTN_NAIVE
#define XATTN_NAIVE 0
#endif
#ifndef MLSTM_NAIVE
#define MLSTM_NAIVE 0
#endif
DI void wd_item(PP pk_, int e, LAS unsigned char* lds);
DI void ph_mix(PP pk_, int g, int rep, LAS unsigned char* lds) { const P p = load_args(pk_);
    constexpr int N_ML = BG * 4 * 2, N_AT = BG * 8 * 16, N_XA = BG * 4 * 16;
    const int N_XC = (g + 1 < NGRP) ? TG / 256 : 0;
    const int wd0 = (257 * g) / NGRP, N_WD = (257 * (g + 1)) / NGRP - wd0;
    unsigned* ctr = WSP(unsigned, WS_CTL) + CW_Q + 64 * (g + NGRP * rep);
    for (;;) {
        const int it = next_item(ctr, lds);
        if (it >= N_ML + N_AT + N_XA + N_XC + N_WD) break;
#ifdef PROBE_MIX_ONLY
        if (rep > 0 && PROBE_MIX_ONLY >= 0) { const int ty = it < N_ML ? 0 : (it < N_ML + N_AT ? 1 : 2); if (ty != PROBE_MIX_ONLY) continue; }
#endif
        if (it < N_ML) mlstm_half_item(pk_, g, it, lds);
        else if (it < N_ML + N_AT) { const int ix = it - N_ML; attn_mfma_item(pk_, ((ix & 63) << 4) | (15 - (ix >> 6)), lds); }
        else if (it < N_ML + N_AT + N_XA) xattn_mfma_item(pk_, g, it - N_ML - N_AT, lds);
        else if (it < N_ML + N_AT + N_XA + N_XC) xconv_item(pk_, g + 1, it - (N_ML + N_AT + N_XA), lds);
        else wd_item(pk_, wd0 + it - (N_ML + N_AT + N_XA + N_XC), lds);
    }
}

DI void ph_mlstm_out(PP pk_, int g, LAS unsigned char* lds) { const P p = load_args(pk_);
    const int tid = tid_local(), lane = tid & 63, wave = tid >> 6, gw = bid_local() * 8 + wave, NGW = gridDim.x * 8;
    const bf16_t* HB = WSP(bf16_t, WS_MRG); const bf16_t* U = WSP(bf16_t, WS_U); bf16_t* Y = WSP(bf16_t, WS_Y);
    for (int r = gw; r < TG; r += NGW) {
        u32x2 hw[4], ow[4]; f32x4 gn[4];
#pragma unroll
        for (int h = 0; h < 4; ++h) { hw[h] = *((const u32x2*)(HB + (size_t)r * 1024 + h * 256) + lane); ow[h] = *((const u32x2*)(U + (size_t)r * NU + UMO + h * 256) + lane); gn[h] = *((const f32x4*)(p.mlstm_norm_g + h * 256) + lane); }
#pragma unroll
        for (int h = 0; h < 4; ++h) {
            const f32x4 v = {bf_lo(hw[h].x), bf_hi(hw[h].x), bf_lo(hw[h].y), bf_hi(hw[h].y)};
            const float mu = wave_sum_fast((v[0] + v[1]) + (v[2] + v[3])) * (1.f / 256.f); const f32x4 d = v - mu;
            const float rstd = rsqrtf(wave_sum_fast((d[0] * d[0] + d[1] * d[1]) + (d[2] * d[2] + d[3] * d[3])) * (1.f / 256.f) + LN_EPS);
            u32x2 o; o.x = cvt_pk_bf16(d[0] * rstd * gn[h][0] * sigm(bf_lo(ow[h].x)), d[1] * rstd * gn[h][1] * sigm(bf_hi(ow[h].x))); o.y = cvt_pk_bf16(d[2] * rstd * gn[h][2] * sigm(bf_lo(ow[h].y)), d[3] * rstd * gn[h][3] * sigm(bf_hi(ow[h].y)));
            *((u32x2*)(Y + (size_t)r * 3072 + 1024 + h * 256) + lane) = o; }
    }
}

DI void ph_ln1(PP pk_, int g, LAS unsigned char* lds) { const P p = load_args(pk_);
    const int tid = tid_local(), lane = tid & 63, wave = tid >> 6, gw = bid_local() * 8 + wave, NGW = gridDim.x * 8;
    const float* Z = WSP(float, WS_Z); bf16_t* X1 = WSP(bf16_t, WS_X1B) + (size_t)g * TG * 1024;
    for (int r0 = gw * 2; r0 < TG; r0 += NGW * 2) {
        f32x4 v[2][4];
#pragma unroll
        for (int q = 0; q < 2; ++q)
#pragma unroll
            for (int j = 0; j < 4; ++j) v[q][j] = *((const f32x4*)(Z + (size_t)(r0 + q) * 1024) + lane + 64 * j);
#pragma unroll
        for (int q = 0; q < 2; ++q) { float s = 0.f;
#pragma unroll
            for (int j = 0; j < 4; ++j) s += (v[q][j][0] + v[q][j][1]) + (v[q][j][2] + v[q][j][3]);
            const float mu = wave_sum(s) * (1.f / 1024.f); float s2 = 0.f;
#pragma unroll
            for (int j = 0; j < 4; ++j) { v[q][j] = v[q][j] - mu; s2 += (v[q][j][0] * v[q][j][0] + v[q][j][1] * v[q][j][1]) + (v[q][j][2] * v[q][j][2] + v[q][j][3] * v[q][j][3]); }
            const float rstd = rsqrtf(wave_sum(s2) * (1.f / 1024.f) + LN_EPS);
            u32x2* d = (u32x2*)(X1 + (size_t)(r0 + q) * 1024) + lane;
#pragma unroll
            for (int j = 0; j < 4; ++j) { const f32x4 gn = *((const f32x4*)p.ln1_g + lane + 64 * j), bb = *((const f32x4*)p.ln1_b + lane + 64 * j); const f32x4 o = v[q][j] * rstd * gn + bb;
                u32x2 w; w.x = cvt_pk_bf16(o[0], o[1]); w.y = cvt_pk_bf16(o[2], o[3]); d[64 * j] = w; } }
    }
}
DI void ph_expert_weights(PP pk_, LAS unsigned char* lds) { const P p = load_args(pk_);
    const int tid = tid_local(), lane = tid & 63, wave = tid >> 6, gw = bid_local() * 8 + wave, NGW = gridDim.x * 8;
    LAS float* scr = (LAS float*)(lds + wave * 16384);
    bf16_t* WGU = WSP(bf16_t, WS_WGU); bf16_t* WD = WSP(bf16_t, WS_WD);
    for (int it = gw; it < 257 * 256; it += NGW) { const int e = it >> 8, r = it & 255, isup = r >> 7, kb = (r >> 3) & 15, nb = r & 7;
        const float* W = (e < 256) ? ((isup ? p.w_e_up : p.w_e_gate) + (size_t)e * 1024 * 256) : (isup ? p.w_s_up : p.w_s_gate);
        const int n0 = nb * 32, drow = (n0 >> 7) * 256 + (n0 & 127) + isup * 128;
        transpose_item(W, 256, n0, WGU + (size_t)e * 512 * 1024, 1024, drow, kb * 64, scr, lane); }
}
DI void wd_item(PP pk_, int e, LAS unsigned char* lds) { const P p = load_args(pk_);
    const int tid = tid_local(), lane = tid & 63, wave = tid >> 6;
    __syncthreads();
    LAS float* scr = (LAS float*)(lds + wave * 16384);
    bf16_t* WD = WSP(bf16_t, WS_WD);
    const float* W = (e < 256) ? (p.w_e_down + (size_t)e * 256 * 1024) : p.w_s_down;
#pragma unroll 1
    for (int r = wave; r < 128; r += 8) { const int kb = r >> 5, nb = r & 31; transpose_item(W, 1024, nb * 32, WD + (size_t)e * 1024 * 256, 256, nb * 32, kb * 64, scr, lane); }
}

template <int CTRL> DI int dppi(int v) { return __builtin_amdgcn_update_dpp(0, v, CTRL, 0xf, 0xf, true); }
#define ARGMAX_STEP(CTRL) do { const float ov_ = dppf<CTRL>(bv); const int oi_ = dppi<CTRL>(bi); if (ov_ > bv || (ov_ == bv && oi_ < bi)) { bv = ov_; bi = oi_; } } while (0)
DI void ph_topk(PP pk_, LAS unsigned char* lds) { const P p = load_args(pk_);
    const int tid = tid_local(), lane = tid & 63, wave = tid >> 6, gw = bid_local() * 8 + wave, NGW = gridDim.x * 8;
    const float* LG = WSP(float, WS_LOGIT); int* TKI = WSP(int, WS_TKI); float* TKW = WSP(float, WS_TKW); unsigned* cnt = WSP(unsigned, WS_CTL) + CW_CNT;
    int* tokof = WSP(int, WS_TOKOF); float* wof = WSP(float, WS_WOF);
    for (int i = bid_local() * 512 + tid; i < MAXRT * 256; i += gridDim.x * 512) { tokof[i] = 0; wof[i] = 0.f; }
    const f32x4 rb = *((const f32x4*)p.router_bias + lane);
    f32x4 lgn = *((const f32x4*)(LG + (size_t)gw * 256) + lane);
    for (int t = gw; t < T_ALL; t += NGW) {
        const f32x4 lg = lgn; if (t + NGW < T_ALL) lgn = *((const f32x4*)(LG + (size_t)(t + NGW) * 256) + lane);
        float sc[4], ch[4];
#pragma unroll
        for (int j = 0; j < 4; ++j) { sc[j] = 1.f / (1.f + expf(-lg[j])); ch[j] = sc[j] + rb[j]; }
        const float m01 = fmaxf(ch[0], ch[1]), n01 = fminf(ch[0], ch[1]), m23 = fmaxf(ch[2], ch[3]), n23 = fminf(ch[2], ch[3]);
        float a1 = fmaxf(m01, m23), a2 = fmaxf(fminf(m01, m23), fmaxf(n01, n23));
        { float b1 = dppf<0xB1>(a1), b2 = dppf<0xB1>(a2); float n1 = fmaxf(a1, b1), n2 = fmaxf(fminf(a1, b1), fmaxf(a2, b2)); a1 = n1; a2 = n2;
          b1 = dppf<0x4E>(a1); b2 = dppf<0x4E>(a2); n1 = fmaxf(a1, b1); n2 = fmaxf(fminf(a1, b1), fmaxf(a2, b2)); a1 = n1; a2 = n2;
          b1 = dppf<0x141>(a1); b2 = dppf<0x141>(a2); n1 = fmaxf(a1, b1); n2 = fmaxf(fminf(a1, b1), fmaxf(a2, b2)); a1 = n1; a2 = n2; }
        const float gs = a1 + a2; const int myg = lane >> 3; int rank = 0;
#pragma unroll
        for (int g2 = 0; g2 < 8; ++g2) { const float og = rdlane(gs, 8 * g2); rank += (og > gs || (og == gs && g2 < myg)) ? 1 : 0; }
        if (rank >= 4) { ch[0] = -INFINITY; ch[1] = -INFINITY; ch[2] = -INFINITY; ch[3] = -INFINITY; }
        int myidx = 0; float mys = 0.f, ssum = 0.f;
#pragma unroll
        for (int r = 0; r < 8; ++r) {
            float bv = ch[0]; int bi = 4 * lane;
#pragma unroll
            for (int j = 1; j < 4; ++j) if (ch[j] > bv) { bv = ch[j]; bi = 4 * lane + j; }
            ARGMAX_STEP(0xB1); ARGMAX_STEP(0x4E); ARGMAX_STEP(0x124); ARGMAX_STEP(0x128);
            { float v0 = rdlane(bv, 0), v1 = rdlane(bv, 16), v2 = rdlane(bv, 32), v3 = rdlane(bv, 48);
              int i0 = __builtin_amdgcn_readlane(bi, 0), i1 = __builtin_amdgcn_readlane(bi, 16), i2 = __builtin_amdgcn_readlane(bi, 32), i3 = __builtin_amdgcn_readlane(bi, 48);
              if (v1 > v0 || (v1 == v0 && i1 < i0)) { v0 = v1; i0 = i1; } if (v3 > v2 || (v3 == v2 && i3 < i2)) { v2 = v3; i2 = i3; } if (v2 > v0 || (v2 == v0 && i2 < i0)) { v0 = v2; i0 = i2; }
              bv = v0; bi = i0; }
            const int jl = bi & 3; const float scsel = jl == 0 ? sc[0] : (jl == 1 ? sc[1] : (jl == 2 ? sc[2] : sc[3]));
            const float sv = __builtin_bit_cast(float, __builtin_amdgcn_readlane(__builtin_bit_cast(int, scsel), bi >> 2));
            if ((bi >> 2) == lane) { if (jl == 0) ch[0] = -INFINITY; else if (jl == 1) ch[1] = -INFINITY; else if (jl == 2) ch[2] = -INFINITY; else ch[3] = -INFINITY; }
            ssum += sv; if (lane == r) { myidx = bi; mys = sv; }
        }
        if (lane < 8) { TKI[(size_t)t * 8 + lane] = myidx; TKW[(size_t)t * 8 + lane] = mys / (ssum + 1e-20f) * 2.5f; atomicAdd(cnt + myidx, 1u); }
    }
}
#undef ARGMAX_STEP

DI void ph_slots(PP pk_, LAS unsigned char* lds) { const P p = load_args(pk_);
    const int tid = tid_local();
    const unsigned* cnt = WSP(unsigned, WS_CTL) + CW_CNT; int* tbase = WSP(int, WS_MISC + MS_TBASE); int* nt = WSP(int, WS_MISC + MS_NT); int* tile_e = WSP(int, WS_MISC + MS_TILEE);
    LAS int* sb = (LAS int*)lds;
    __syncthreads();
    if (tid < 256) sb[tid] = (int)((cnt[tid] + 255u) >> 8);
    __syncthreads();
    if (tid == 0) { int a = 0; for (int e = 0; e < 256; ++e) { const int n = sb[e]; sb[e] = a; a += n; } sb[256] = a; }
    __syncthreads();
    const int nrt = sb[256];
    if (bid_local() == 0) {
        if (tid < 256) { const int b0 = sb[tid], b1 = sb[tid + 1]; tbase[tid] = b0; for (int t = b0; t < b1; ++t) tile_e[t] = tid; tile_e[nrt + tid] = 256; }
        if (tid == 0) { tbase[256] = nrt; nt[0] = nrt; nt[1] = nrt + 256; }
    }
    const int* TKI = WSP(int, WS_TKI); const float* TKW = WSP(float, WS_TKW); unsigned* cur = WSP(unsigned, WS_CTL) + CW_CUR;
    int* tokof = WSP(int, WS_TOKOF); float* wof = WSP(float, WS_WOF); int* slotof = WSP(int, WS_SLOTOF);
    const int s0 = nrt * 256;
    for (int i = bid_local() * 512 + tid; i < T_ALL * 8; i += gridDim.x * 512) { const int e = TKI[i]; const int slot = sb[e] * 256 + (int)atomicAdd(cur + e, 1u); tokof[slot] = i >> 3; wof[slot] = TKW[i]; slotof[i] = slot; }
    for (int t = bid_local() * 512 + tid; t < T_ALL; t += gridDim.x * 512) { tokof[s0 + t] = t; wof[s0 + t] = 1.f; }
    __syncthreads();
}

DI void ph_combine(PP pk_, int round, LAS unsigned char* lds) { const P p = load_args(pk_);
    const int tid = tid_local();
    const unsigned char* Y = WSP(unsigned char, WS_YCH); const bf16_t* X1 = WSP(bf16_t, WS_X1B); const int* slotof = WSP(int, WS_SLOTOF); const int s0 = WSP(int, WS_MISC + MS_TBASE)[256] * 256;
    for (int i0 = bid_local() * 512 + tid; i0 < T_ALL * 32; i0 += gridDim.x * 512) {
        int slot[2][9]; u32x4 xw[2];
#pragma unroll
        for (int q = 0; q < 2; ++q) { const int i = i0 + q * (T_ALL * 32), t = i >> 6, c8 = (i & 63) * 8; xw[q] = *(const u32x4*)(X1 + (size_t)t * 1024 + round * 512 + c8);
            const u32x4 sa = *(const u32x4*)(slotof + (size_t)t * 8), sb = *(const u32x4*)(slotof + (size_t)t * 8 + 4);
            slot[q][0] = sa.x; slot[q][1] = sa.y; slot[q][2] = sa.z; slot[q][3] = sa.w; slot[q][4] = sb.x; slot[q][5] = sb.y; slot[q][6] = sb.z; slot[q][7] = sb.w; slot[q][8] = s0 + t; }
        u32x2 yw[2][9];
#pragma unroll
        for (int q = 0; q < 2; ++q) { const int c8 = ((i0 + q * (T_ALL * 32)) & 63) * 8;
#pragma unroll
            for (int k = 0; k < 9; ++k) yw[q][k] = *(const u32x2*)(Y + (size_t)slot[q][k] * 512 + c8); }
#pragma unroll
        for (int q = 0; q < 2; ++q) { const int i = i0 + q * (T_ALL * 32), t = i >> 6, c8 = (i & 63) * 8;
            float a[8];
#pragma unroll
            for (int e = 0; e < 8; ++e) a[e] = 0.f;
#pragma unroll
            for (int k = 0; k < 9; ++k) { const u32x2 w = yw[q][k];
                const f32x2 v0 = __builtin_amdgcn_cvt_pk_f32_fp8((int)w.x, false), v1 = __builtin_amdgcn_cvt_pk_f32_fp8((int)w.x, true), v2 = __builtin_amdgcn_cvt_pk_f32_fp8((int)w.y, false), v3 = __builtin_amdgcn_cvt_pk_f32_fp8((int)w.y, true);
                a[0] += v0[0]; a[1] += v0[1]; a[2] += v1[0]; a[3] += v1[1]; a[4] += v2[0]; a[5] += v2[1]; a[6] += v3[0]; a[7] += v3[1]; }
            constexpr float is = 1.f / Y8_SCALE; const u32x4 x = xw[q];
            float* op = p.out + (size_t)t * 1024 + round * 512 + c8;
            *(f32x4*)op = (f32x4){bf_lo(x.x) * ALPHA + a[0] * is, bf_hi(x.x) * ALPHA + a[1] * is, bf_lo(x.y) * ALPHA + a[2] * is, bf_hi(x.y) * ALPHA + a[3] * is};
            *(f32x4*)(op + 4) = (f32x4){bf_lo(x.z) * ALPHA + a[4] * is, bf_hi(x.z) * ALPHA + a[5] * is, bf_lo(x.w) * ALPHA + a[6] * is, bf_hi(x.w) * ALPHA + a[7] * is}; }
    }
}

DI void ph_ln2(PP pk_, LAS unsigned char* lds) { const P p = load_args(pk_);
    const int tid = tid_local(), lane = tid & 63, wave = tid >> 6, gw = bid_local() * 8 + wave, NGW = gridDim.x * 8;
    for (int r0 = gw * 2; r0 < T_ALL; r0 += NGW * 2) {
        f32x4 v[2][4];
#pragma unroll
        for (int q = 0; q < 2; ++q)
#pragma unroll
            for (int j = 0; j < 4; ++j) v[q][j] = *((const f32x4*)(p.out + (size_t)(r0 + q) * 1024) + lane + 64 * j);
#pragma unroll
        for (int q = 0; q < 2; ++q) { float s = 0.f;
#pragma unroll
            for (int j = 0; j < 4; ++j) s += (v[q][j][0] + v[q][j][1]) + (v[q][j][2] + v[q][j][3]);
            const float mu = wave_sum(s) * (1.f / 1024.f); float s2 = 0.f;
#pragma unroll
            for (int j = 0; j < 4; ++j) { v[q][j] = v[q][j] - mu; s2 += (v[q][j][0] * v[q][j][0] + v[q][j][1] * v[q][j][1]) + (v[q][j][2] * v[q][j][2] + v[q][j][3] * v[q][j][3]); }
            const float rstd = rsqrtf(wave_sum(s2) * (1.f / 1024.f) + LN_EPS);
            f32x4* zr = (f32x4*)(p.out + (size_t)(r0 + q) * 1024) + lane;
#pragma unroll
            for (int j = 0; j < 4; ++j) { const f32x4 gn = *((const f32x4*)p.ln2_g + lane + 64 * j), bb = *((const f32x4*)p.ln2_b + lane + 64 * j); zr[64 * j] = v[q][j] * rstd * gn + bb; } }
    }
}

__global__ void __launch_bounds__(512, 2) fwd(P p_unused) {
    extern __shared__ __attribute__((aligned(16))) unsigned char lds_raw[];
    LAS unsigned char* lds = (LAS unsigned char*)lds_raw;
    const int tid = threadIdx.x, G = gridDim.x;
#define bid bid_local()
    volatile LAS unsigned* MISC = (volatile LAS unsigned*)(lds + LDS_MISC);
    if (tid < 32) MISC[tid] = 0u;
    __syncthreads();
    XcdBarrier bar; { unsigned* bw = (unsigned*)(kargs()->ws + WS_CTL) + CW_BAR; bar.bar = bw; bar.x = 0; bar.st = nullptr; bar = xcd_barrier_post(bw, MISC + 8); }
#ifndef PROBE_TYPE
#define PROBE_TYPE -1
#define PROBE_REPS 1
#endif
#define STEP_BEGIN(type) { const int reps_ = ((type) == PROBE_TYPE) ? PROBE_REPS : 1; for (int rep_ = 0; rep_ < reps_; ++rep_) { PP pk_ = kargs(); const P p = load_args(pk_);
#define STEP_END xcd_barrier(bar); } }
#define STEP_END_LAST if (rep_ + 1 < reps_) xcd_barrier(bar); } }

    STEP_BEGIN(0) ph_prologue(pk_, lds); __syncthreads(); ph_xconv(pk_, 0, lds); STEP_END
    for (int g = 0; g < NGRP; ++g) {
        STEP_BEGIN(2) {
            if (g > 0) { ph_ln1(pk_, g - 1, lds); __syncthreads(); }
            pg8::Gemm gm{WSP(bf16_t, WS_XB), WSP(bf16_t, WS_WIN), 1024, 1024, 1024, nullptr}; pg8::StaticOrder S; S.init(TG, NU, G, bid);
            EpiInProj E{WSP(bf16_t, WS_U), WSP(float, WS_MISC + MS_BIAS)};
            pg8::gemm_phase<EpiInProj, pg8::StaticOrder, true>(lds, gm, S, E);
            if (g == 0) {
                pg8::Gemm gk{WSP(bf16_t, WS_MEMB), WSP(bf16_t, WS_WKV), 1024, 1024, 1024, nullptr}; pg8::StaticOrder S2; S2.init(NBATCH * 256, 2048, G, bid);
                EpiPlain E2{WSP(bf16_t, WS_KVM), 2048};
                pg8::gemm_phase<EpiPlain, pg8::StaticOrder, true>(lds, gk, S2, E2);
            }
        } STEP_END
        STEP_BEGIN(4) ph_conv(pk_, g, lds); STEP_END
        STEP_BEGIN(3) ph_mix(pk_, g, rep_, lds); STEP_END
        STEP_BEGIN(16) ph_mlstm_out(pk_, g, lds); STEP_END
        STEP_BEGIN(5) {
            pg8::Gemm gm{WSP(bf16_t, WS_Y), WSP(bf16_t, WS_WBR), 3072, 3072, 3072, nullptr}; pg8::StaticOrder S; S.init(TG, 1024, G, bid);
            EpiBranch2 E{WSP(bf16_t, WS_U), WSP(bf16_t, WS_MRG)}; MidBranch MB{WSP(bf16_t, WS_U)};
            pg8::gemm_phase<EpiBranch2, pg8::StaticOrder, true, false, MidBranch>(lds, gm, S, E, MB);
        } STEP_END
        STEP_BEGIN(6) {
            pg8::Gemm gm{WSP(bf16_t, WS_MRG), WSP(bf16_t, WS_WOUT), 1024, 1024, 1024, nullptr}; pg8::StaticOrder S; S.init(TG, 1024, G, bid);
            EpiOutProj E{p.x + (size_t)g * TG * 1024, WSP(float, WS_Z)};
            pg8::gemm_phase<EpiOutProj, pg8::StaticOrder, true>(lds, gm, S, E);
        } STEP_END
        if (g == NGRP - 1) { STEP_BEGIN(7) ph_ln1(pk_, g, lds); STEP_END }
    }
    STEP_BEGIN(8) {
        pg8::Gemm gm{WSP(bf16_t, WS_X1B), WSP(bf16_t, WS_WR), 1024, 1024, 1024, nullptr}; pg8::StaticOrder S; S.init(T_ALL, 256, G, bid);
        EpiF32 E{WSP(float, WS_LOGIT), 256};
        pg8::gemm_phase<EpiF32, pg8::StaticOrder, true>(lds, gm, S, E);
        ph_expert_weights(pk_, lds);
    } STEP_END
    STEP_BEGIN(9) ph_topk(pk_, lds); STEP_END
    STEP_BEGIN(11) ph_slots(pk_, lds); STEP_END
    STEP_BEGIN(12) {
        const int* ntp = WSP(int, WS_MISC + MS_NT);
        pg8::Gemm gm{WSP(bf16_t, WS_X1B), WSP(bf16_t, WS_WGU), 1024, 1024, 1024, WSP(int, WS_TOKOF)}; ExpertGUOrder S{WSP(int, WS_MISC + MS_TILEE), ntp[1] * 2, G, (G % 8 == 0) ? (bid % 8) * (G / 8) + bid / 8 : bid};
        EpiGateUp E{WSP(bf16_t, WS_ACT)};
        pg8::gemm_phase<EpiGateUp, ExpertGUOrder, true, true>(lds, gm, S, E);
    } STEP_END
    for (int r = 0; r < 2; ++r) {
        STEP_BEGIN(13) {
            const int* ntp = WSP(int, WS_MISC + MS_NT);
            pg8::Gemm gm{WSP(bf16_t, WS_ACT), WSP(bf16_t, WS_WD), 256, 256, 256, nullptr}; ExpertDownOrder S{WSP(int, WS_MISC + MS_TILEE), ntp[1] * 2, G, (G % 8 == 0) ? (bid % 8) * (G / 8) + bid / 8 : bid, r};
            EpiDown E{WSP(unsigned char, WS_YCH), WSP(float, WS_WOF)};
            pg8::gemm_phase<EpiDown, ExpertDownOrder, true>(lds, gm, S, E);
        } STEP_END
        STEP_BEGIN(14) ph_combine(pk_, r, lds); STEP_END
    }
#if PROBE_TYPE == 99
    for (int xb = 0; xb < 20; ++xb) xcd_barrier(bar);
#endif
    STEP_BEGIN(15) ph_ln2(pk_, lds); STEP_END_LAST
}
constexpr int NSTEPS = 1 + NGRP * 6 + 1 + 4 + 4 + 1;

extern "C" void kernel_launch(void* const* d_in, const int* in_sizes, int n_in, void* d_out, int out_size, void* d_ws, size_t ws_size, hipStream_t stream) {
    static int grid = 0;
    if (grid == 0) {
        int dev = 0, cus = 0;
        if (hipGetDevice(&dev) != hipSuccess || hipDeviceGetAttribute(&cus, hipDeviceAttributeMultiprocessorCount, dev) != hipSuccess) { fprintf(stderr, "kernel_launch: device query failed\n"); grid = -1; return; }
        if (hipFuncSetAttribute((const void*)fwd, hipFuncAttributeMaxDynamicSharedMemorySize, LDS_BYTES) != hipSuccess) { fprintf(stderr, "kernel_launch: hipFuncSetAttribute failed\n"); grid = -1; return; }
        if (n_in != 24 || ws_size < WS_END) fprintf(stderr, "kernel_launch: n_in %d ws %zu (need %zu)\n", n_in, ws_size, (size_t)WS_END);
        grid = cus;
    }
    if (grid < 0) return;
    (void)hipMemsetAsync((char*)d_ws + WS_CTL, 0, CTL_BYTES, stream);
    P p{};
    const float** pp = (const float**)&p;
    for (int i = 0; i < 24; ++i) pp[i] = (const float*)d_in[i];
    p.out = (float*)d_out; p.ws = (unsigned char*)d_ws;
    p.s_lo = 0; p.s_hi = NSTEPS; hipLaunchKernelGGL(fwd, dim3(grid), dim3(512), LDS_BYTES, stream, p);
}
```

```cpp
#define ONE_LAUNCH 1
#include <hip/hip_runtime.h>
#include <cstdio>
#include <cstdint>
#define DI __device__ __forceinline__
#define LAS __attribute__((address_space(3)))
#define GAS __attribute__((address_space(1)))
typedef unsigned short bf16_t;
typedef short bf16x8 __attribute__((ext_vector_type(8)));
typedef float f32x4 __attribute__((ext_vector_type(4)));
typedef float f32x2 __attribute__((ext_vector_type(2)));
typedef unsigned u32x4 __attribute__((ext_vector_type(4)));
typedef unsigned u32x2 __attribute__((ext_vector_type(2)));

constexpr int T_ALL = 65536, DM = 1024, SEQ = 2048, NBATCH = 32, NGRP = 4, TG = T_ALL / NGRP, BG = NBATCH / NGRP;
constexpr int NU = 11264, CIN = 11272;
constexpr int UQ = 0, UK = 1024, UV = 2048, UMQ = 3072, UMK = 4096, UMV = 5120, UMO = 6144, UCQ = 7168, UGT = 8192;
constexpr int NEXP = 256, MAXRT = 2304, MAXTILES = MAXRT + 256, MAXSLOTS = MAXTILES * 256;
constexpr float ALPHA = 1.189207115002721f;
constexpr float LN_EPS = 1e-5f;

constexpr size_t MiB = 1ull << 20;
constexpr size_t WS_CTL = 0, CTL_BYTES = 1 * MiB;
constexpr size_t WS_MISC = 1 * MiB;
constexpr size_t WS_WIN = 2 * MiB, WS_WKV = 24 * MiB, WS_WBR = 28 * MiB, WS_WOUT = 34 * MiB, WS_WR = 36 * MiB;
constexpr size_t WS_GIF = 38 * MiB, WS_MEMB = 40 * MiB, WS_KVM = 56 * MiB, WS_X1B = 88 * MiB, WS_R = 216 * MiB;
constexpr size_t WS_XB = WS_R, WS_U = WS_R + 32 * MiB, WS_Y = WS_R + 384 * MiB, WS_F32 = WS_R + 480 * MiB, WS_MRG = WS_R + 544 * MiB, WS_Z = WS_R + 576 * MiB, WS_QKC = WS_R + 640 * MiB;
constexpr size_t WS_TKI = WS_R, WS_TKW = WS_R + 2 * MiB, WS_SLOTOF = WS_R + 4 * MiB, WS_TOKOF = WS_R + 6 * MiB, WS_WOF = WS_R + 9 * MiB;
constexpr size_t WS_LOGIT = WS_R + 16 * MiB, WS_WGU = WS_R + 80 * MiB, WS_WD = WS_R + 704 * MiB  , WS_ACT = WS_R + 337 * MiB, WS_YCH = WS_R + 16 * MiB;
constexpr size_t WS_END = WS_R + 900 * MiB;
constexpr size_t MS_BIAS = 0, MS_LAM = 48 * 1024, MS_TBASE = 52 * 1024, MS_NT = 56 * 1024, MS_TILEE = 64 * 1024;
constexpr int CW_CNT = 1024, CW_CUR = 2048, CW_BAR = 8192, CW_Q = 16384;

constexpr int LDS_RING = 147456, LDS_MISC = LDS_RING + 320, LDS_BYTES = 155648;

DI float bf_lo(unsigned w) { return __uint_as_float(w << 16); }
DI float bf_hi(unsigned w) { return __uint_as_float(w & 0xffff0000u); }
DI float bf2f(bf16_t b) { return __uint_as_float((unsigned)b << 16); }
DI unsigned cvt_pk_bf16(float lo, float hi) { unsigned r; asm("v_cvt_pk_bf16_f32 %0, %1, %2" : "=v"(r) : "v"(lo), "v"(hi)); return r; }
template <int CTRL> DI float dppf(float v) { return __builtin_bit_cast(float, __builtin_amdgcn_update_dpp(0, __builtin_bit_cast(int, v), CTRL, 0xf, 0xf, true)); }
DI float row16_sum(float v) { v += dppf<0xB1>(v); v += dppf<0x4E>(v); v += dppf<0x124>(v); v += dppf<0x128>(v); return v; }
DI float rdlane(float v, int l) { return __builtin_bit_cast(float, __builtin_amdgcn_readlane(__builtin_bit_cast(int, v), l)); }
DI float wave_sum_fast(float v) { v = row16_sum(v); return (rdlane(v, 0) + rdlane(v, 16)) + (rdlane(v, 32) + rdlane(v, 48)); }
DI float wave_sum(float v) { return wave_sum_fast(v); }
DI float row16_max(float v) { v = fmaxf(v, dppf<0xB1>(v)); v = fmaxf(v, dppf<0x4E>(v)); v = fmaxf(v, dppf<0x124>(v)); v = fmaxf(v, dppf<0x128>(v)); return v; }
DI float wave_max(float v) { v = row16_max(v); return fmaxf(fmaxf(rdlane(v, 0), rdlane(v, 16)), fmaxf(rdlane(v, 32), rdlane(v, 48))); }
DI float bperm(float v, int src) { return __builtin_bit_cast(float, __builtin_amdgcn_ds_bpermute(src << 2, __builtin_bit_cast(int, v))); }
DI int bperm_i(int v, int src) { return __builtin_amdgcn_ds_bpermute(src << 2, v); }
DI float sigm(float x) { return 1.f / (1.f + __expf(-x)); }
DI float silu(float x) { return x / (1.f + __expf(-x)); }
DI float zero_local() { float z = 0.f; asm volatile("" : "+v"(z)); return z; }
DI int bid_local() { int b = blockIdx.x; asm volatile("" : "+s"(b)); return b; }
DI int tid_local() { int t = threadIdx.x; asm volatile("" : "+v"(t)); return t; }
DI void lds_barrier() { asm volatile("s_waitcnt lgkmcnt(0)" ::: "memory"); __builtin_amdgcn_s_barrier(); asm volatile("" ::: "memory"); }
#define LDS_WAIT() asm volatile("s_waitcnt lgkmcnt(0)" ::: "memory")
namespace pg8 {
constexpr int BM = 256, BK = 64, HALF = 128, HTB = HALF * BK * 2, STAGE_BYTES = 8 * HTB, NXCD = 8, WGM = 8;
__host__ __device__ __forceinline__ int lds_byte(int r, int c) { const int st = (r >> 4) * 2 + (c >> 5), rr = r & 15, cc = c & 31, ob = rr * 64 + cc * 2; return st * 1024 + (ob ^ (((ob >> 9) & 1) << 5)); }
__host__ __device__ __forceinline__ void stage_rc(int b, int& R, int& C) { const int st = b / 1024, sb = b % 1024, swz = sb ^ (((sb >> 9) & 1) << 5); R = (st >> 1) * 16 + swz / 64; C = (st & 1) * 32 + (swz % 64) / 2; }
__host__ __device__ __forceinline__ int perm32(int rho) { const int n = rho >> 4, i = rho & 15; return 8 * (i >> 2) + 4 * n + (i & 3); }

struct Unit { int pm, pn, pb, acol, aux; };
struct Gemm { const bf16_t* A; const bf16_t* Bt; int lda, ldb, K; const int* arow; };

struct StaticOrder {
    int nM, nN, nwg, G, c;
    DI void init(int M, int N, int G_, int c_) { nM = M / BM; nN = N / BM; nwg = nM * nN; G = G_; c = c_; }
    DI bool next(int i, Unit& u) const {
        const long L = (long)i * G + c; if (L >= nwg) return false;
        int wgid = (int)L; { const int q = nwg / NXCD, r = nwg % NXCD, xcd = wgid % NXCD, off = wgid / NXCD; wgid = (xcd < r ? xcd * (q + 1) : r * (q + 1) + (xcd - r) * q) + off; }
        const int nig = WGM * nN, gid = wgid / nig, fm = gid * WGM, gsz = (nM - fm) < WGM ? (nM - fm) : WGM;
        u.pm = fm + ((wgid % nig) % gsz); u.pn = (wgid % nig) / gsz; u.pb = u.pn; u.acol = 0; u.aux = 0; return true;
    }
};

struct NoMid { static constexpr int EVERY = 0; DI void operator()(f32x4 (&)[2][2][4][2], const Unit&, int, int, int, int, int) const {} };
template <class Epi, class Sched, bool ALIGN_EPI, bool GATHER = false, class Mid = NoMid>
DI void gemm_phase(LAS unsigned char* lds, const Gemm g, const Sched& S, const Epi& E, const Mid& mid = Mid()) {
    const int tid = tid_local(), wid = __builtin_amdgcn_readfirstlane(tid >> 6), lane = tid & 63, wr = wid >> 2, wc = wid & 3, fr = lane & 15, fq = lane >> 4;
    const int nt = g.K / BK;
    int Ra[2], Ca[2], Rb[2];
#pragma unroll
    for (int i = 0; i < 2; ++i) { int R, C; stage_rc(tid * 16 + i * 8192, R, C); Ra[i] = R; Ca[i] = C; Rb[i] = (R & ~31) + perm32(R & 31); }
    const size_t kstep = (size_t)(BK * 2);
    const unsigned ldsw = (unsigned)wid * 1024u;
    const int aoff = lds_byte(wr * 64 + fr, fq * 8), boff = lds_byte(wc * 32 + fr, fq * 8);
#define PG8_SA(b, h) (((b) * 2 + (h)) * HTB)
#define PG8_SB(b, h) ((4 + (b) * 2 + (h)) * HTB)
#define PG8_STAGE(bufoff, gptr, offs) do { _Pragma("unroll") for (int _i = 0; _i < 2; ++_i) \
        __builtin_amdgcn_global_load_lds((const unsigned*)((gptr) + (offs)[_i]), (LAS unsigned*)(lds + (bufoff) + ldsw + _i * 8192), 16, 0, 0); } while (0)
#define PG8_LDA(dst, b, h) do { _Pragma("unroll") for (int m = 0; m < 4; ++m) _Pragma("unroll") for (int k = 0; k < 2; ++k) dst[m][k] = *(const LAS bf16x8*)(lds + PG8_SA(b, h) + aoff + m * 2048 + k * 1024); } while (0)
#define PG8_LDB(dst, b, h) do { _Pragma("unroll") for (int n = 0; n < 2; ++n) _Pragma("unroll") for (int k = 0; k < 2; ++k) dst[n][k] = *(const LAS bf16x8*)(lds + PG8_SB(b, h) + boff + n * 2048 + k * 1024); } while (0)
#define PG8_MMA(ai, bj, At, Bt) do { __builtin_amdgcn_s_setprio(1); _Pragma("unroll") for (int m = 0; m < 4; ++m) _Pragma("unroll") for (int n = 0; n < 2; ++n) _Pragma("unroll") for (int k = 0; k < 2; ++k) \
        acc[ai][bj][m][n] = __builtin_amdgcn_mfma_f32_16x16x32_bf16(Bt[n][k], At[m][k], acc[ai][bj][m][n], 0, 0, 0); __builtin_amdgcn_s_setprio(0); } while (0)
#define PG8_WAIT_V(n) asm volatile("s_waitcnt vmcnt(" #n ")" ::: "memory")
#define PG8_WAIT_L(n) asm volatile("s_waitcnt lgkmcnt(" #n ")" ::: "memory")
#define PG8_BAR __builtin_amdgcn_s_barrier()
#define PG8_SCHED __builtin_amdgcn_sched_barrier(0)
#define PG8_OFFS(u, oa) do { _Pragma("unroll") for (int h_ = 0; h_ < 2; ++h_) _Pragma("unroll") for (int i_ = 0; i_ < 2; ++i_) { \
        const int ar_ = g.arow[(u).pm * BM + h_ * HALF + Ra[i_]]; oa[h_][i_] = (unsigned)(ar_ * g.lda + (u).acol + Ca[i_]) * 2u; } } while (0)
    unsigned voffA[2], voffB[2];
#pragma unroll
    for (int i = 0; i < 2; ++i) { voffA[i] = (unsigned)(Ra[i] * g.lda + Ca[i]) * 2u; voffB[i] = (unsigned)(Rb[i] * g.ldb + Ca[i]) * 2u; }
    const size_t hstepA = (size_t)HALF * g.lda * 2, hstepB = (size_t)HALF * g.ldb * 2;
#define PG8_ABASE(u) ((const char*)g.A + (GATHER ? (size_t)0 : ((size_t)(u).pm * BM * g.lda + (u).acol) * 2))
#define PG8_BBASE(u) ((const char*)g.Bt + (size_t)(u).pb * BM * g.ldb * 2)
#define PG8_STAGE_A(bufoff, ab, oa, h) do { if constexpr (GATHER) { PG8_STAGE(bufoff, ab, (oa)[h]); } else { PG8_STAGE(bufoff, (ab) + (h) * hstepA, voffA); } } while (0)
#define PG8_STAGE_B(bufoff, bb, h) PG8_STAGE(bufoff, (bb) + (h) * hstepB, voffB)
#define PG8_STAGE_A2(bufoff, ab, h) do { if constexpr (GATHER) { if (last) { unsigned on_[2]; _Pragma("unroll") for (int i_ = 0; i_ < 2; ++i_) { int ar_ = arN[h][i_]; asm volatile("" : "+v"(ar_));   on_[i_] = ar_ < 0 ? oaC[h][i_] : (unsigned)(ar_ * g.lda + nxt.acol + Ca[i_]) * 2u; } PG8_STAGE(bufoff, ab, on_); } else { PG8_STAGE(bufoff, ab, oaC[h]); } } else { PG8_STAGE(bufoff, (ab) + (h) * hstepA, voffA); } } while (0)
    Unit cur, nxt; int ui = 0;
    if (!S.next(0, cur)) return;
    f32x4 acc[2][2][4][2];
    if constexpr (Epi::HAS_INIT) E.init(acc, cur, wr, wc, fr, fq); else {
#pragma unroll
    for (int a = 0; a < 2; ++a)
#pragma unroll
        for (int b = 0; b < 2; ++b)
#pragma unroll
            for (int m = 0; m < 4; ++m)
#pragma unroll
                for (int n = 0; n < 2; ++n) acc[a][b][m][n] = (f32x4){0.f, 0.f, 0.f, 0.f}; }
    bf16x8 At[4][2], B0[2][2], B1[2][2];
    unsigned oaC[2][2];
    if constexpr (GATHER) { PG8_OFFS(cur, oaC); }
    const char* cA = PG8_ABASE(cur); const char* cB = PG8_BBASE(cur);
    PG8_STAGE_B(PG8_SB(0, 0), cB, 0); PG8_STAGE_B(PG8_SB(0, 1), cB, 1); PG8_STAGE_A(PG8_SA(0, 0), cA, oaC, 0); PG8_STAGE_A(PG8_SA(0, 1), cA, oaC, 1);
    if (wr == 1) PG8_BAR;
    PG8_WAIT_V(2); PG8_BAR;
    PG8_STAGE_B(PG8_SB(1, 0), cB + kstep, 0); PG8_STAGE_A(PG8_SA(1, 0), cA + kstep, oaC, 0); PG8_STAGE_B(PG8_SB(1, 1), cB + kstep, 1);
    PG8_WAIT_V(6); PG8_BAR;
    bool has_next = S.next(1, nxt); Unit nx2; bool has_nx2 = false;
    int arN[2][2];
    if constexpr (GATHER) {
#pragma unroll
        for (int h_ = 0; h_ < 2; ++h_)
#pragma unroll
            for (int i_ = 0; i_ < 2; ++i_) arN[h_][i_] = has_next ? g.arow[nxt.pm * BM + h_ * HALF + Ra[i_]] : -1;
    }
    for (;;) {
        const char* nA = has_next ? PG8_ABASE(nxt) : cA; const char* nB = has_next ? PG8_BBASE(nxt) : cB;
#pragma unroll 1
        for (int t = 0; t < nt; t += 2) {
            const bool last = (t == nt - 2);
            const char* a1 = cA + (size_t)(t + 1) * kstep;
            const char* a2 = last ? nA : cA + (size_t)(t + 2) * kstep; const char* b2 = last ? nB : cB + (size_t)(t + 2) * kstep;
            const char* a3 = a2 + kstep; const char* b3 = b2 + kstep;
            PG8_LDB(B0, 0, 0); PG8_LDB(B1, 0, 1); PG8_SCHED; PG8_LDA(At, 0, 0); PG8_STAGE_A(PG8_SA(1, 1), a1, oaC, 1);
            PG8_WAIT_V(8); PG8_WAIT_L(0); PG8_BAR; PG8_MMA(0, 0, At, B0); PG8_MMA(0, 1, At, B1); PG8_BAR; PG8_SCHED;
            PG8_LDA(At, 0, 1); PG8_STAGE_B(PG8_SB(0, 0), b2, 0); PG8_STAGE_B(PG8_SB(0, 1), b2, 1); PG8_STAGE_A2(PG8_SA(0, 0), a2, 0);
            PG8_WAIT_V(8); PG8_WAIT_L(0); PG8_BAR; PG8_MMA(1, 0, At, B0); PG8_MMA(1, 1, At, B1); PG8_BAR; PG8_SCHED;
            PG8_LDB(B0, 1, 0); PG8_LDB(B1, 1, 1); PG8_SCHED; PG8_LDA(At, 1, 0); PG8_STAGE_A2(PG8_SA(0, 1), a2, 1);
            PG8_WAIT_V(8); PG8_WAIT_L(0); PG8_BAR; PG8_MMA(0, 0, At, B0); PG8_MMA(0, 1, At, B1); PG8_BAR; PG8_SCHED;
            PG8_LDA(At, 1, 1); PG8_STAGE_B(PG8_SB(1, 0), b3, 0); PG8_STAGE_B(PG8_SB(1, 1), b3, 1); PG8_STAGE_A2(PG8_SA(1, 0), a3, 0);
            PG8_WAIT_V(8); PG8_WAIT_L(0); PG8_BAR; PG8_MMA(1, 0, At, B0); PG8_MMA(1, 1, At, B1); PG8_BAR; PG8_SCHED;
            if constexpr (Mid::EVERY > 0) { if (((t + 2) % Mid::EVERY) == 0 && (t + 2) < nt) mid(acc, cur, (t + 2) / Mid::EVERY - 1, wr, wc, fr, fq); }
        }
        has_nx2 = has_next && S.next(ui + 2, nx2);
        if constexpr (GATHER) {
            if (has_next) {
#pragma unroll
                for (int h_ = 0; h_ < 2; ++h_)
#pragma unroll
                    for (int i_ = 0; i_ < 2; ++i_) oaC[h_][i_] = (unsigned)(arN[h_][i_] * g.lda + nxt.acol + Ca[i_]) * 2u;
            }
#pragma unroll
            for (int h_ = 0; h_ < 2; ++h_)
#pragma unroll
                for (int i_ = 0; i_ < 2; ++i_) arN[h_][i_] = has_nx2 ? g.arow[nx2.pm * BM + h_ * HALF + Ra[i_]] : -1;
            PG8_SCHED;
        }
        if constexpr (ALIGN_EPI) { if (wr == 0) PG8_BAR; }
        E(acc, cur, wr, wc, fr, fq);
        if (!has_next) break;
        if constexpr (Epi::HAS_INIT) E.init(acc, nxt, wr, wc, fr, fq); else {
#pragma unroll
        for (int a = 0; a < 2; ++a)
#pragma unroll
            for (int b = 0; b < 2; ++b)
#pragma unroll
                for (int m = 0; m < 4; ++m)
#pragma unroll
                    for (int n = 0; n < 2; ++n) acc[a][b][m][n] = (f32x4){0.f, 0.f, 0.f, 0.f}; }
        cur = nxt; cA = nA; cB = nB; ++ui; nxt = nx2; has_next = has_nx2;
        if constexpr (ALIGN_EPI) { if (wr == 1) PG8_BAR; }
    }
    PG8_WAIT_V(0);
    if constexpr (!ALIGN_EPI) { if (wr == 0) PG8_BAR; }
    PG8_BAR;
#undef PG8_SA
#undef PG8_SB
#undef PG8_STAGE
#undef PG8_LDA
#undef PG8_LDB
#undef PG8_MMA
#undef PG8_WAIT_V
#undef PG8_WAIT_L
#undef PG8_BAR
#undef PG8_SCHED
#undef PG8_OFFS
#undef PG8_ABASE
#undef PG8_BBASE
#undef PG8_STAGE_A
#undef PG8_STAGE_A2
#undef PG8_STAGE_B
}
}
using pg8::Unit; using pg8::BM; using pg8::HALF;

struct BranchOrder {
    int ntile, G, c;
    DI bool next(int i, Unit& u) const {
        const int L = (i / 3) * G + c; if (L >= ntile) return false;
        const int n = i % 3; u.pm = L >> 2; u.pn = L & 3; u.pb = n * 4 + u.pn; u.acol = n * 1024; u.aux = n; return true;
    }
};
#define CAS __attribute__((address_space(4)))
DI int sload_i(const int* p, int i) { return ((const CAS int*)(unsigned long long)p)[i]; }
struct ExpertGUOrder {
    const int* tile_e; int nunits, G, c;
    DI bool next(int i, Unit& u) const {
        const int L = i * G + c; if (L >= nunits) return false;
        const int t = L >> 1, hf = L & 1; const int e = sload_i(tile_e, t);
        u.pm = t; u.pn = hf; u.pb = e * 2 + hf; u.acol = 0; u.aux = e; return true;
    }
};
struct ExpertDownOrder {
    const int* tile_e; int nunits, G, c, round;
    DI bool next(int i, Unit& u) const {
        const int L = i * G + c; if (L >= nunits) return false;
        const int t = L >> 1, cn = L & 1; const int e = sload_i(tile_e, t);
        u.pm = t; u.pn = cn; u.pb = e * 4 + round * 2 + cn; u.acol = 0; u.aux = e; return true;
    }
};

#define EPI_ARGS const f32x4 (&acc)[2][2][4][2], const Unit& u, int wr, int wc, int fr, int fq
DI u32x4 pack8(const f32x4 v0, const f32x4 v1) { u32x4 w; w.x = cvt_pk_bf16(v0[0], v0[1]); w.y = cvt_pk_bf16(v0[2], v0[3]); w.z = cvt_pk_bf16(v1[0], v1[1]); w.w = cvt_pk_bf16(v1[2], v1[3]); return w; }

struct EpiInProj {
    static constexpr bool HAS_INIT = true;
    bf16_t* O; const float* bias;
    DI void init(f32x4 (&acc)[2][2][4][2], const Unit& u, int wr, int wc, int fr, int fq) const {
        const int col0 = u.pn * BM + wc * 32 + 8 * fq;
#pragma unroll
        for (int bj = 0; bj < 2; ++bj)
#pragma unroll
            for (int n = 0; n < 2; ++n) { const f32x4 bv = *(const f32x4*)(bias + col0 + bj * HALF + 4 * n);
#pragma unroll
                for (int ai = 0; ai < 2; ++ai)
#pragma unroll
                    for (int m = 0; m < 4; ++m) acc[ai][bj][m][n] = bv; }
    }
    DI void operator()(EPI_ARGS) const {
        const int row0 = u.pm * BM + wr * 64 + fr, col0 = u.pn * BM + wc * 32 + 8 * fq;
        const float sc = (u.pn < 4) ? 0.125f * 1.4426950408889634f : ((u.pn >= 28 && u.pn < 32) ? 0.0625f * 1.4426950408889634f : 1.f);
#pragma unroll
        for (int ai = 0; ai < 2; ++ai)
#pragma unroll
            for (int m = 0; m < 4; ++m) { bf16_t* rowp = O + (size_t)(row0 + ai * HALF + m * 16) * NU + col0;
#pragma unroll
                for (int bj = 0; bj < 2; ++bj) *(u32x4*)(rowp + bj * HALF) = pack8(acc[ai][bj][m][0] * sc, acc[ai][bj][m][1] * sc); }
    }
};
struct EpiPlain { static constexpr bool HAS_INIT = false;
    bf16_t* O; int ldc;
    DI void operator()(EPI_ARGS) const {
        const int row0 = u.pm * BM + wr * 64 + fr, col0 = u.pn * BM + wc * 32 + 8 * fq;
#pragma unroll
        for (int ai = 0; ai < 2; ++ai)
#pragma unroll
            for (int m = 0; m < 4; ++m) { bf16_t* rowp = O + (size_t)(row0 + ai * HALF + m * 16) * ldc + col0;
#pragma unroll
                for (int bj = 0; bj < 2; ++bj) *(u32x4*)(rowp + bj * HALF) = pack8(acc[ai][bj][m][0], acc[ai][bj][m][1]); }
    }
};
struct EpiBranch { static constexpr bool HAS_INIT = false;
    const bf16_t* U; float* F; bf16_t* M;
    DI void operator()(EPI_ARGS) const {
        const int row0 = u.pm * BM + wr * 64 + fr, col0 = u.pn * BM + wc * 32 + 8 * fq, n = u.aux;
#pragma unroll
        for (int ai = 0; ai < 2; ++ai)
#pragma unroll
            for (int m = 0; m < 4; ++m) { const size_t row = (size_t)(row0 + ai * HALF + m * 16);
#pragma unroll
                for (int bj = 0; bj < 2; ++bj) { const int col = col0 + bj * HALF;
                    const u32x4 gw = *(const u32x4*)(U + row * NU + UGT + n * 1024 + col);
                    f32x4 g0 = {sigm(bf_lo(gw.x)), sigm(bf_hi(gw.x)), sigm(bf_lo(gw.y)), sigm(bf_hi(gw.y))};
                    f32x4 g1 = {sigm(bf_lo(gw.z)), sigm(bf_hi(gw.z)), sigm(bf_lo(gw.w)), sigm(bf_hi(gw.w))};
                    f32x4 v0 = acc[ai][bj][m][0] * g0, v1 = acc[ai][bj][m][1] * g1;
                    float* fp = F + row * 1024 + col;
                    if (n > 0) { v0 += *(const f32x4*)fp; v1 += *(const f32x4*)(fp + 4); }
                    if (n < 2) { *(f32x4*)fp = v0; *(f32x4*)(fp + 4) = v1; }
                    else *(u32x4*)(M + row * 1024 + col) = pack8(v0, v1); }
                asm volatile("" ::: "memory"); }
    }
};
DI f32x4 sig_ratio4(float a0, float a1, float a2, float a3, float b0, float b1, float b2, float b3) {
    return (f32x4){(1.f + __expf(-b0)) / (1.f + __expf(-a0)), (1.f + __expf(-b1)) / (1.f + __expf(-a1)), (1.f + __expf(-b2)) / (1.f + __expf(-a2)), (1.f + __expf(-b3)) / (1.f + __expf(-a3))};
}
struct MidBranch { static constexpr int EVERY = 16; const bf16_t* U;
    DI void operator()(f32x4 (&acc)[2][2][4][2], const Unit& u, int n, int wr, int wc, int fr_, int fq_) const {
        int fr = fr_, fq = fq_; asm volatile("" : "+v"(fr), "+v"(fq));
        const int row0 = u.pm * BM + wr * 64 + fr, col0 = u.pn * BM + wc * 32 + 8 * fq;
#pragma unroll
        for (int ai = 0; ai < 2; ++ai) { u32x4 ga[4][2], gb[4][2];
#pragma unroll
            for (int m = 0; m < 4; ++m) { const bf16_t* gp = U + (size_t)(row0 + ai * HALF + m * 16) * NU + UGT + n * 1024 + col0;
#pragma unroll
                for (int bj = 0; bj < 2; ++bj) { ga[m][bj] = *(const u32x4*)(gp + bj * HALF); gb[m][bj] = *(const u32x4*)(gp + bj * HALF + 1024); } }
#pragma unroll
            for (int m = 0; m < 4; ++m)
#pragma unroll
                for (int bj = 0; bj < 2; ++bj) { const u32x4 a = ga[m][bj], b = gb[m][bj];
                    acc[ai][bj][m][0] *= sig_ratio4(bf_lo(a.x), bf_hi(a.x), bf_lo(a.y), bf_hi(a.y), bf_lo(b.x), bf_hi(b.x), bf_lo(b.y), bf_hi(b.y));
                    acc[ai][bj][m][1] *= sig_ratio4(bf_lo(a.z), bf_hi(a.z), bf_lo(a.w), bf_hi(a.w), bf_lo(b.z), bf_hi(b.z), bf_lo(b.w), bf_hi(b.w)); }
            asm volatile("" ::: "memory"); }
    }
};
struct EpiBranch2 { static constexpr bool HAS_INIT = false;
    const bf16_t* U; bf16_t* M;
    DI void operator()(EPI_ARGS) const {
        const int row0 = u.pm * BM + wr * 64 + fr, col0 = u.pn * BM + wc * 32 + 8 * fq;
#pragma unroll
        for (int ai = 0; ai < 2; ++ai) { u32x4 gw[4][2];
#pragma unroll
            for (int m = 0; m < 4; ++m)
#pragma unroll
                for (int bj = 0; bj < 2; ++bj) gw[m][bj] = *(const u32x4*)(U + (size_t)(row0 + ai * HALF + m * 16) * NU + UGT + 2048 + col0 + bj * HALF);
#pragma unroll
            for (int m = 0; m < 4; ++m) { const size_t row = (size_t)(row0 + ai * HALF + m * 16);
#pragma unroll
                for (int bj = 0; bj < 2; ++bj) { const u32x4 g = gw[m][bj];
                    const f32x4 g0 = {sigm(bf_lo(g.x)), sigm(bf_hi(g.x)), sigm(bf_lo(g.y)), sigm(bf_hi(g.y))}, g1 = {sigm(bf_lo(g.z)), sigm(bf_hi(g.z)), sigm(bf_lo(g.w)), sigm(bf_hi(g.w))};
                    *(u32x4*)(M + row * 1024 + col0 + bj * HALF) = pack8(acc[ai][bj][m][0] * g0, acc[ai][bj][m][1] * g1); } }
            asm volatile("" ::: "memory"); }
    }
};
struct EpiOutProj { static constexpr bool HAS_INIT = false;
    const float* X; float* Z;
    DI void operator()(EPI_ARGS) const {
        const int row0 = u.pm * BM + wr * 64 + fr, col0 = u.pn * BM + wc * 32 + 8 * fq;
#pragma unroll
        for (int ai = 0; ai < 2; ++ai) { f32x4 xv[4][2][2];
#pragma unroll
            for (int m = 0; m < 4; ++m)
#pragma unroll
                for (int bj = 0; bj < 2; ++bj) { const float* xp = X + (size_t)(row0 + ai * HALF + m * 16) * 1024 + col0 + bj * HALF; xv[m][bj][0] = *(const f32x4*)xp; xv[m][bj][1] = *(const f32x4*)(xp + 4); }
#pragma unroll
            for (int m = 0; m < 4; ++m)
#pragma unroll
                for (int bj = 0; bj < 2; ++bj) { float* zp = Z + (size_t)(row0 + ai * HALF + m * 16) * 1024 + col0 + bj * HALF;
                    *(f32x4*)zp = xv[m][bj][0] * ALPHA + acc[ai][bj][m][0]; *(f32x4*)(zp + 4) = xv[m][bj][1] * ALPHA + acc[ai][bj][m][1]; }
            asm volatile("" ::: "memory"); }
    }
};
struct EpiF32 { static constexpr bool HAS_INIT = false;
    float* O; int ldc;
    DI void operator()(EPI_ARGS) const {
        const int row0 = u.pm * BM + wr * 64 + fr, col0 = u.pn * BM + wc * 32 + 8 * fq;
#pragma unroll
        for (int ai = 0; ai < 2; ++ai)
#pragma unroll
            for (int m = 0; m < 4; ++m) { float* rowp = O + (size_t)(row0 + ai * HALF + m * 16) * ldc + col0;
#pragma unroll
                for (int bj = 0; bj < 2; ++bj) { *(f32x4*)(rowp + bj * HALF) = acc[ai][bj][m][0]; *(f32x4*)(rowp + bj * HALF + 4) = acc[ai][bj][m][1]; } }
    }
};
struct EpiGateUp { static constexpr bool HAS_INIT = false;
    bf16_t* ACT;
    DI void operator()(EPI_ARGS) const {
        const int row0 = u.pm * BM + wr * 64 + fr, col0 = u.pn * HALF + wc * 32 + 8 * fq;
#pragma unroll
        for (int ai = 0; ai < 2; ++ai)
#pragma unroll
            for (int m = 0; m < 4; ++m) { f32x4 v[2];
#pragma unroll
                for (int n = 0; n < 2; ++n) { const f32x4 gt = acc[ai][0][m][n], up = acc[ai][1][m][n];
                    v[n] = (f32x4){silu(gt[0]) * up[0], silu(gt[1]) * up[1], silu(gt[2]) * up[2], silu(gt[3]) * up[3]}; }
                *(u32x4*)(ACT + (size_t)(row0 + ai * HALF + m * 16) * 256 + col0) = pack8(v[0], v[1]); }
    }
};
DI unsigned pk4_fp8(float a, float b, float c, float d) { int p = __builtin_amdgcn_cvt_pk_fp8_f32(a, b, 0, false); return (unsigned)__builtin_amdgcn_cvt_pk_fp8_f32(c, d, p, true); }
constexpr float Y8_SCALE = 32.f, Y8_MAX = 400.f;
struct EpiDown { static constexpr bool HAS_INIT = false;
    unsigned char* Y; const float* W;
    DI void operator()(EPI_ARGS) const {
        const int row0 = u.pm * BM + wr * 64 + fr, col0 = u.pn * BM + wc * 32 + 8 * fq;
        float wv[2][4];
#pragma unroll
        for (int ai = 0; ai < 2; ++ai)
#pragma unroll
            for (int m = 0; m < 4; ++m) wv[ai][m] = W[row0 + ai * HALF + m * 16];
#pragma unroll
        for (int ai = 0; ai < 2; ++ai)
#pragma unroll
            for (int m = 0; m < 4; ++m) { const int row = row0 + ai * HALF + m * 16; const float w = wv[ai][m] * Y8_SCALE;
#pragma unroll
                for (int bj = 0; bj < 2; ++bj) { f32x4 v0 = acc[ai][bj][m][0] * w, v1 = acc[ai][bj][m][1] * w;
#pragma unroll
                    for (int e = 0; e < 4; ++e) { v0[e] = __builtin_amdgcn_fmed3f(v0[e], -Y8_MAX, Y8_MAX); v1[e] = __builtin_amdgcn_fmed3f(v1[e], -Y8_MAX, Y8_MAX); }
                    u32x2 o; o.x = pk4_fp8(v0[0], v0[1], v0[2], v0[3]); o.y = pk4_fp8(v1[0], v1[1], v1[2], v1[3]);
                    *(u32x2*)(Y + (size_t)row * 512 + col0 + bj * HALF) = o; } }
    }
};
#define RLX_AGENT __ATOMIC_RELAXED, __HIP_MEMORY_SCOPE_AGENT
#define XB_TMO      128
#define XB_XCNT(j)  (256  + 64 * (j))
#define XB_XSUB(j)  (1280 + 64 * (j))
#define XB_XGEN(j)  (2304 + 64 * (j))
#define XB_TOP      3328
#define XB_TOPGEN   3392
#define XCD_BAR_WORDS 3456
#define XB_SPIN_CAP (1u << 18)

__device__ __forceinline__ unsigned xb_ld(unsigned* p)              { return __hip_atomic_load(p, __ATOMIC_RELAXED, __HIP_MEMORY_SCOPE_AGENT); }
__device__ __forceinline__ unsigned xb_add(unsigned* p, unsigned v) { return __hip_atomic_fetch_add(p, v, __ATOMIC_RELAXED, __HIP_MEMORY_SCOPE_AGENT); }
__device__ __forceinline__ unsigned xb_xcc_id() { return (unsigned)__builtin_amdgcn_s_getreg((3 << 11) | 20) & 0xFu; }
#define XB_SPIN(cond, bar) do { unsigned _sp = 0; while (cond) { __builtin_amdgcn_s_sleep(1); \
    if ((++_sp & 255u) == 0u) { if (xb_ld(&(bar)[XB_TMO])) break; if (_sp > XB_SPIN_CAP) { atomicAdd(&(bar)[XB_TMO], 1u); break; } } } } while (0)

struct XcdBarrier {
    unsigned* bar; unsigned x;
    volatile LAS unsigned* st;
};

__device__ __forceinline__ XcdBarrier xcd_barrier_post(unsigned* bar, volatile LAS unsigned* st) {
    XcdBarrier b; b.bar = bar; b.x = xb_xcc_id(); b.st = st;
    if (threadIdx.x == 0) (void)xb_add(&bar[XB_XCNT(b.x)], 1u);
    return b;
}
__device__ __forceinline__ void xcd_barrier_complete(unsigned* bar, unsigned x, unsigned& nloc, unsigned& nx) {
    const unsigned G = gridDim.x * gridDim.y * gridDim.z;
    unsigned sum, cnt, mine, sp = 0u;
    for (;;) {
        sum = 0u; cnt = 0u; mine = 0u;
#pragma unroll
        for (unsigned j = 0; j < 16; ++j) { const unsigned c = xb_ld(&bar[XB_XCNT(j)]); sum += c; cnt += (c > 0u) ? 1u : 0u; mine = (j == x) ? c : mine; }
        if (sum == G) break;
        __builtin_amdgcn_s_sleep(1);
        if ((++sp & 255u) == 0u) { if (xb_ld(&bar[XB_TMO])) break; if (sp > XB_SPIN_CAP) { atomicAdd(&bar[XB_TMO], 1u); break; } }
    }
    nloc = mine > 0u ? mine : 1u; nx = cnt > 0u ? cnt : 1u;
}

__device__ __forceinline__ void xcd_barrier(const XcdBarrier& b) {
    asm volatile("s_waitcnt vmcnt(0)" ::: "memory");
    __syncthreads();
    if (threadIdx.x == 0) {
        unsigned* bar = b.bar; asm volatile("" : "+s"(bar));
        __builtin_amdgcn_s_waitcnt(0);
        volatile LAS unsigned* stp = b.st; asm volatile("" : "+s"(stp));
        unsigned nloc = stp[0], nx = stp[1];
        if (nloc == 0u) { xcd_barrier_complete(bar, b.x, nloc, nx); stp[0] = nloc; stp[1] = nx; }
        const unsigned old = xb_add(&bar[XB_XSUB(b.x)], 1u);
        const unsigned gen = old / nloc;
        if (old + 1u == (gen + 1u) * nloc) {
            __builtin_amdgcn_fence(__ATOMIC_RELEASE, "agent");
            asm volatile("s_waitcnt vmcnt(0)" ::: "memory");
            const unsigned og = xb_add(&bar[XB_TOP], 1u);
            const unsigned tg = og / nx;
            if (og + 1u == (tg + 1u) * nx) xb_add(&bar[XB_TOPGEN], 1u);
            else XB_SPIN(xb_ld(&bar[XB_TOPGEN]) == tg, bar);
            __builtin_amdgcn_fence(__ATOMIC_ACQUIRE, "agent");
            xb_add(&bar[XB_XGEN(b.x)], 1u);
            asm volatile("s_waitcnt vmcnt(0)" ::: "memory");
        } else {
            XB_SPIN(xb_ld(&bar[XB_XGEN(b.x)]) == gen, bar);
            __builtin_amdgcn_fence(__ATOMIC_ACQUIRE, "agent");
            asm volatile("s_waitcnt vmcnt(0)" ::: "memory");
        }
    }
    __syncthreads();
}

struct P {
    const float *x, *mem, *rel_bias, *w_in, *b_in, *conv_w, *diff_lambda, *subln_g, *mlstm_norm_g, *w_mem_kv, *w_branch, *w_out, *ln1_g, *ln1_b,
                *w_router, *router_bias, *w_e_gate, *w_e_up, *w_e_down, *w_s_gate, *w_s_up, *w_s_down, *ln2_g, *ln2_b;
    float* out; unsigned char* ws; int s_lo, s_hi;
};
typedef const P __attribute__((address_space(4)))* PP;
DI PP kargs() { PP k = (PP)__builtin_amdgcn_kernarg_segment_ptr(); asm volatile("" : "+s"(k)); return k; }
DI P load_args(PP k) { P r; const unsigned long long __attribute__((address_space(4)))* s = (const unsigned long long __attribute__((address_space(4)))*)k;
    void** d = (void**)&r;
#pragma unroll
    for (int i = 0; i < 26; ++i) d[i] = (void*)(GAS char*)s[i];
    ((unsigned long long*)&r)[26] = s[26];
    return r; }
static_assert(sizeof(P) == 27 * 8, "P = 26 pointers + 2 ints");
#define WSP(T, off) ((T*)(p.ws + (off)))

DI void transpose_item(const float* W, int ldw, int src_col0, bf16_t* WT, int ldt, int dst_row0, int k0, LAS float* scr, int lane) {
    float v[32];
    const float* src = W + (size_t)(k0 + (lane >> 5)) * ldw + src_col0 + (lane & 31);
#pragma unroll
    for (int i = 0; i < 32; ++i) v[i] = src[(size_t)(2 * i) * ldw];
#pragma unroll
    for (int i = 0; i < 32; ++i) scr[(2 * i + (lane >> 5)) * 33 + (lane & 31)] = v[i];
    LDS_WAIT();
    const int c = lane & 7;
#pragma unroll
    for (int j = 0; j < 4; ++j) { const int n = (lane >> 3) + 8 * j; const LAS float* s = scr + (8 * c) * 33 + n;
        u32x4 o; o.x = cvt_pk_bf16(s[0 * 33], s[1 * 33]); o.y = cvt_pk_bf16(s[2 * 33], s[3 * 33]); o.z = cvt_pk_bf16(s[4 * 33], s[5 * 33]); o.w = cvt_pk_bf16(s[6 * 33], s[7 * 33]);
        *(u32x4*)(WT + (size_t)(dst_row0 + n) * ldt + k0 + 8 * c) = o; }
    LDS_WAIT();
}
DI void transpose_mat(const float* W, int ldw, int src_col0, int K, int N, bf16_t* WT, int ldt, int dst_row0, int gw, int NGW, LAS float* scr, int lane) {
    const int nblk = N / 32, items = (K / 64) * nblk;
    for (int it = gw; it < items; it += NGW) { const int kb = it / nblk, nb = it % nblk; transpose_item(W, ldw, src_col0 + nb * 32, WT, ldt, dst_row0 + nb * 32, kb * 64, scr, lane); }
}
DI void row_to_bf16(const float* src, bf16_t* dst, int lane) {
    const f32x4* s = (const f32x4*)src + lane; u32x2* d = (u32x2*)dst + lane;
#pragma unroll
    for (int j = 0; j < 4; ++j) { const f32x4 v = s[64 * j]; u32x2 o; o.x = cvt_pk_bf16(v[0], v[1]); o.y = cvt_pk_bf16(v[2], v[3]); d[64 * j] = o; }
}

DI void ph_prologue(PP pk_, LAS unsigned char* lds) { const P p = load_args(pk_);
    const int tid = tid_local(), lane = tid & 63, wave = tid >> 6, gw = bid_local() * 8 + wave, NGW = gridDim.x * 8;
    LAS float* scr = (LAS float*)(lds + wave * 16384);
    bf16_t* WinT = WSP(bf16_t, WS_WIN);
    transpose_mat(p.w_in, CIN, 0, 1024, 7168, WinT, 1024, 0, gw, NGW, scr, lane);
    transpose_mat(p.w_in, CIN, 7176, 1024, 4096, WinT, 1024, 7168, gw, NGW, scr, lane);
    transpose_mat(p.w_mem_kv, 2048, 0, 1024, 2048, WSP(bf16_t, WS_WKV), 1024, 0, gw, NGW, scr, lane);
    for (int n = 0; n < 3; ++n) transpose_mat(p.w_branch + (size_t)n * 1024 * 1024, 1024, 0, 1024, 1024, WSP(bf16_t, WS_WBR) + n * 1024, 3072, 0, gw, NGW, scr, lane);
    transpose_mat(p.w_out, 1024, 0, 1024, 1024, WSP(bf16_t, WS_WOUT), 1024, 0, gw, NGW, scr, lane);
    transpose_mat(p.w_router, 256, 0, 1024, 256, WSP(bf16_t, WS_WR), 1024, 0, gw, NGW, scr, lane);
    bf16_t* memb = WSP(bf16_t, WS_MEMB);
    for (int r = gw; r < NBATCH * 256; r += NGW) row_to_bf16(p.mem + (size_t)r * 1024, memb + (size_t)r * 1024, lane);
    float* bias = WSP(float, WS_MISC + MS_BIAS);
    for (int j = bid_local() * 512 + tid; j < NU; j += gridDim.x * 512) bias[j] = p.b_in[j + (j >= 7168 ? 8 : 0)];
    if (gw == 0) {
        const float* lv = p.diff_lambda;
        const float s1 = wave_sum(lv[lane] * lv[64 + lane]), s2 = wave_sum(lv[128 + lane] * lv[192 + lane]);
        if (lane == 0) *WSP(float, WS_MISC + MS_LAM) = expf(s1) - expf(s2) + 0.2f;
    }
}

DI void xconv_item(PP pk_, int g, int item, LAS unsigned char* lds) { const P p = load_args(pk_);
    const int tid = tid_local(), lane = tid & 63, wave = tid >> 6;
    LAS float* wg = (LAS float*)lds;
    __syncthreads();
    for (int i = tid; i < 2048; i += 512) { const int c = i >> 1, hf = i & 1; *(LAS f32x4*)(wg + c * 8 + hf * 4) = *(const f32x4*)(p.w_in + (size_t)c * CIN + 7168 + hf * 4); }
    __syncthreads();
    bf16_t* xb = WSP(bf16_t, WS_XB); float* gif = WSP(float, WS_GIF);
#pragma unroll 2
    for (int rr = 0; rr < 32; ++rr) { const int r = item * 256 + wave * 32 + rr;
        const size_t t = (size_t)g * TG + r;
        const f32x4* xr = (const f32x4*)(p.x + t * 1024) + lane; u32x2* d = (u32x2*)(xb + (size_t)r * 1024) + lane;
        float gs[8];
#pragma unroll
        for (int q = 0; q < 8; ++q) gs[q] = 0.f;
#pragma unroll
        for (int j = 0; j < 4; ++j) { const f32x4 v = xr[64 * j]; u32x2 o; o.x = cvt_pk_bf16(v[0], v[1]); o.y = cvt_pk_bf16(v[2], v[3]); d[64 * j] = o;
#pragma unroll
            for (int e = 0; e < 4; ++e) { const int c = 4 * lane + 256 * j + e; const f32x4 wl = *(const LAS f32x4*)(wg + c * 8), wh = *(const LAS f32x4*)(wg + c * 8 + 4);
                gs[0] += v[e] * wl[0]; gs[1] += v[e] * wl[1]; gs[2] += v[e] * wl[2]; gs[3] += v[e] * wl[3]; gs[4] += v[e] * wh[0]; gs[5] += v[e] * wh[1]; gs[6] += v[e] * wh[2]; gs[7] += v[e] * wh[3]; } }
        float mine = 0.f;
#pragma unroll
        for (int q = 0; q < 8; ++q) { const float s = wave_sum_fast(gs[q]); if (lane == q) mine = s; }
        if (lane < 8) gif[t * 8 + lane] = mine + p.b_in[7168 + lane];
    }
}
DI void ph_xconv(PP pk_, int g, LAS unsigned char* lds) { for (int it = bid_local(); it < TG / 256; it += gridDim.x) xconv_item(pk_, g, it, lds); __syncthreads(); }

DI int t5_bucket(int n) { return n < 16 ? n : min(31, 16 + (int)(__log2f((float)n * 0.0625f) * (16.f / 3.f))); }

typedef float f32x16 __attribute__((ext_vector_type(16)));
typedef __bf16 bf16x2_t __attribute__((ext_vector_type(2)));
typedef short s16x4 __attribute__((ext_vector_type(4)));
constexpr float LOG2E = 1.4426950408889634f;
DI unsigned pk_bf16(float a, float b) { const f32x2 v = {a, b}; return __builtin_bit_cast(unsigned, __builtin_convertvector(v, bf16x2_t)); }
DI int crow(int reg, int hh) { return (reg & 3) + 8 * (reg >> 2) + 4 * hh; }
#define MFMA32(a, b, c) __builtin_amdgcn_mfma_f32_32x32x16_bf16((a), (b), (c), 0, 0, 0)
DI bf16x8 tr_pair(const LAS unsigned char* a0, const LAS unsigned char* a1) {
    const s16x4 lo = __builtin_amdgcn_ds_read_tr16_b64_v4i16((LAS s16x4*)a0), hi = __builtin_amdgcn_ds_read_tr16_b64_v4i16((LAS s16x4*)a1);
    return __builtin_shufflevector(lo, hi, 0, 1, 2, 3, 4, 5, 6, 7);
}
DI bf16x8 pack_half(const f32x16& x, int s2) {
    u32x4 w;
#pragma unroll
    for (int k = 0; k < 4; ++k) w[k] = pk_bf16(x[8 * s2 + 2 * k], x[8 * s2 + 2 * k + 1]);
    return __builtin_bit_cast(bf16x8, w);
}
DI float xhalf_max(float x) { const auto r = __builtin_amdgcn_permlane32_swap(__builtin_bit_cast(int, x), __builtin_bit_cast(int, x), false, false); return fmaxf(__builtin_bit_cast(float, (int)r[0]), __builtin_bit_cast(float, (int)r[1])); }
DI float xhalf_sum(float x) { const auto r = __builtin_amdgcn_permlane32_swap(__builtin_bit_cast(int, x), __builtin_bit_cast(int, x), false, false); return __builtin_bit_cast(float, (int)r[0]) + __builtin_bit_cast(float, (int)r[1]); }
DI int next_item(unsigned* ctr, LAS unsigned char* lds) {
    volatile LAS int* slot = (volatile LAS int*)(lds + LDS_MISC + 64);
    __syncthreads();
    if (threadIdx.x == 0) *slot = (int)__hip_atomic_fetch_add(ctr, 1u, __ATOMIC_RELAXED, __HIP_MEMORY_SCOPE_AGENT);
    __syncthreads();
    return *slot;
}

constexpr int AT_KPITCH = 144, AT_VPITCH = 320, AT_KBYTES = 64 * AT_KPITCH, AT_VOFF = 2 * AT_KBYTES, AT_BUF = AT_VOFF + 64 * AT_VPITCH, AT_BT = 2 * AT_BUF;
DI void attn_tile(const LAS unsigned char* buf, int k0, int qw, int r, int hh, unsigned ka, unsigned va, const LAS float* bt, float cfar, const bf16x8 (&qf)[4], f32x16 (&O)[4], float& mrun, float& lrun) {
    if (k0 <= qw + 31) {
            const bool far = (qw - k0 - 63) >= 128, first = (k0 == 0);
            float sinit = (far ? cfar : 0.f) - (first ? 0.f : mrun); asm volatile("" : "+v"(sinit));
            f32x16 S[2];
#pragma unroll
            for (int sub = 0; sub < 2; ++sub)
#pragma unroll
                for (int i = 0; i < 16; ++i) S[sub][i] = sinit;
#pragma unroll
            for (int s = 0; s < 4; ++s)
#pragma unroll
                for (int sub = 0; sub < 2; ++sub) S[sub] = MFMA32(*(const LAS bf16x8*)(buf + ka + sub * 32 * AT_KPITCH + s * 32), qf[s], S[sub]);
            if (!far) {
#pragma unroll
                for (int sub = 0; sub < 2; ++sub) { float bv[16];
#pragma unroll
                    for (int i = 0; i < 16; ++i) { const int dist = (qw + r) - (k0 + sub * 32 + crow(i, hh)); bv[i] = bt[min(max(dist, 0), 128)]; }
#pragma unroll
                    for (int i = 0; i < 16; ++i) asm volatile("" : "+v"(bv[i]));
#pragma unroll
                    for (int i = 0; i < 16; ++i) { const int dist = (qw + r) - (k0 + sub * 32 + crow(i, hh)); S[sub][i] = dist < 0 ? -INFINITY : S[sub][i] + bv[i]; } }
            }
            float mx = fmaxf(S[0][0], S[1][0]);
#pragma unroll
            for (int i = 1; i < 16; ++i) mx = fmaxf(mx, fmaxf(S[0][i], S[1][i]));
            mx = xhalf_max(mx);
            if (first || __builtin_amdgcn_ballot_w64(mx > 6.f) != 0ull) {
                const float delta = first ? mx : fmaxf(mx, 0.f), alpha = first ? 1.f : __builtin_amdgcn_exp2f(-delta);
                mrun = (first ? 0.f : mrun) + delta; lrun *= alpha;
#pragma unroll
                for (int dt = 0; dt < 4; ++dt) O[dt] *= alpha;
#pragma unroll
                for (int sub = 0; sub < 2; ++sub)
#pragma unroll
                    for (int i = 0; i < 16; ++i) S[sub][i] -= delta;
            }
#pragma unroll
            for (int sub = 0; sub < 2; ++sub)
#pragma unroll
                for (int i = 0; i < 16; ++i) { S[sub][i] = __builtin_amdgcn_exp2f(S[sub][i]); lrun += S[sub][i]; }
#pragma unroll
            for (int sub = 0; sub < 2; ++sub)
#pragma unroll
                for (int s2 = 0; s2 < 2; ++s2) { const bf16x8 pb = pack_half(S[sub], s2); const LAS unsigned char* vb = buf + va + (sub * 32 + 16 * s2) * AT_VPITCH;
#pragma unroll
                    for (int dt = 0; dt < 4; ++dt) O[dt] = MFMA32(tr_pair(vb + dt * 64, vb + dt * 64 + 8 * AT_VPITCH), pb, O[dt]); }
        }
}
DI void attn_mfma_item(PP pk_, int item, LAS unsigned char* lds) { const P p = load_args(pk_);
    const int tid = tid_local(), lane = tid & 63, wave = __builtin_amdgcn_readfirstlane(tid >> 6), mp = wave & 1, rq = wave >> 1, hh = lane >> 5, r = lane & 31;
    const int qb = item & 15, h = (item >> 4) & 7, b = item >> 7;
    const int q0 = qb * 128, qw = q0 + rq * 32, nt = 2 * qb + 2;
    const bf16_t* U = WSP(bf16_t, WS_U); const size_t rbase = (size_t)b * SEQ;
    LAS float* bt = (LAS float*)(lds + AT_BT);
    __syncthreads();
    if (tid <= 128) bt[tid] = p.rel_bias[t5_bucket(tid) * 8 + h] * LOG2E;
    bf16x8 qf[4];
    { const bf16_t* qp = U + (rbase + qw + r) * NU + UQ + h * 128 + mp * 64 + 8 * hh;
#pragma unroll
      for (int s = 0; s < 4; ++s) qf[s] = *(const bf16x8*)(qp + 16 * s); }
    f32x16 O[4]; { const float z0 = zero_local();
#pragma unroll
    for (int dt = 0; dt < 4; ++dt)
#pragma unroll
        for (int i = 0; i < 16; ++i) O[dt][i] = z0; }
    float mrun = -INFINITY, lrun = 0.f;
    const int row0 = tid >> 4, c16 = tid & 15;
    const bf16_t* gk = U + (rbase + row0) * NU + UK + h * 128 + c16 * 8;
    const bf16_t* gv = U + (rbase + row0) * NU + UV + h * 128 + c16 * 8;
    const unsigned lk = (c16 >> 3) * AT_KBYTES + row0 * AT_KPITCH + (c16 & 7) * 16, lv = AT_VOFF + row0 * AT_VPITCH + c16 * 16;
    u32x4 st[4];
#define AT_LOAD(t_) do { const size_t o_ = (size_t)(t_) * 64 * NU; st[0] = *(const u32x4*)(gk + o_); st[1] = *(const u32x4*)(gk + o_ + (size_t)32 * NU); st[2] = *(const u32x4*)(gv + o_); st[3] = *(const u32x4*)(gv + o_ + (size_t)32 * NU); } while (0)
#define AT_STORE(bufp) do { *(LAS u32x4*)((bufp) + lk) = st[0]; *(LAS u32x4*)((bufp) + lk + 32 * AT_KPITCH) = st[1]; *(LAS u32x4*)((bufp) + lv) = st[2]; *(LAS u32x4*)((bufp) + lv + 32 * AT_VPITCH) = st[3]; } while (0)
    AT_LOAD(0); AT_STORE(lds); __syncthreads();
    const float cfar = bt[128];
    const unsigned ka = mp * AT_KBYTES + r * AT_KPITCH + hh * 16;
    const int i16 = lane & 15;
    const unsigned va = AT_VOFF + (4 * hh + (i16 >> 2)) * AT_VPITCH + (16 * ((lane >> 4) & 1) + 4 * (i16 & 3)) * 2;
    u32x4 st2[4];
#define AT_LOAD2(t_) do { const size_t o_ = (size_t)(t_) * 64 * NU; st2[0] = *(const u32x4*)(gk + o_); st2[1] = *(const u32x4*)(gk + o_ + (size_t)32 * NU); st2[2] = *(const u32x4*)(gv + o_); st2[3] = *(const u32x4*)(gv + o_ + (size_t)32 * NU); } while (0)
#define AT_STORE2(bufp) do { *(LAS u32x4*)((bufp) + lk) = st2[0]; *(LAS u32x4*)((bufp) + lk + 32 * AT_KPITCH) = st2[1]; *(LAS u32x4*)((bufp) + lv) = st2[2]; *(LAS u32x4*)((bufp) + lv + 32 * AT_VPITCH) = st2[3]; } while (0)
    AT_LOAD2(1);
    for (int t = 0; t < nt; t += 2) {
        if (t + 2 < nt) AT_LOAD(t + 2);
        attn_tile(lds, t * 64, qw, r, hh, ka, va, bt, cfar, qf, O, mrun, lrun);
        AT_STORE2(lds + AT_BUF);
        lds_barrier();
        if (t + 3 < nt) AT_LOAD2(t + 3);
        attn_tile(lds + AT_BUF, t * 64 + 64, qw, r, hh, ka, va, bt, cfar, qf, O, mrun, lrun);
        if (t + 2 < nt) AT_STORE(lds);
        lds_barrier();
    }
#undef AT_LOAD2
#undef AT_STORE2
#undef AT_LOAD
#undef AT_STORE
    const float inv = 1.f / xhalf_sum(lrun);
    LAS float* X = (LAS float*)lds;
    if (mp == 1) {
#pragma unroll
        for (int dt = 0; dt < 4; ++dt)
#pragma unroll
            for (int i = 0; i < 16; ++i) X[(rq * 64 + dt * 16 + i) * 64 + lane] = O[dt][i] * inv;
    }
    __syncthreads();
    if (mp == 0) {
        const float lam = *WSP(float, WS_MISC + MS_LAM); float ss = 0.f;
#pragma unroll
        for (int dt = 0; dt < 4; ++dt)
#pragma unroll
            for (int i = 0; i < 16; ++i) { const float v = O[dt][i] * inv - lam * X[(rq * 64 + dt * 16 + i) * 64 + lane]; O[dt][i] = v; ss += v * v; }
        ss = xhalf_sum(ss);
        const float rs = rsqrtf(ss * (1.f / 128.f) + LN_EPS) * 0.8f;
        bf16_t* yp = WSP(bf16_t, WS_Y) + (rbase + qw + r) * 3072 + h * 128;
#pragma unroll
        for (int dt = 0; dt < 4; ++dt)
#pragma unroll
            for (int g4 = 0; g4 < 4; ++g4) { const int dv = dt * 32 + 8 * g4 + 4 * hh; const f32x4 gn = *(const f32x4*)(p.subln_g + dv);
                u32x2 w; w.x = pk_bf16(O[dt][4 * g4] * rs * gn[0], O[dt][4 * g4 + 1] * rs * gn[1]); w.y = pk_bf16(O[dt][4 * g4 + 2] * rs * gn[2], O[dt][4 * g4 + 3] * rs * gn[3]);
                *(u32x2*)(yp + dv) = w; }
    }
}
DI void gate_tables(PP pk_, int g, int chain, LAS unsigned char* lds);
DI void ph_conv(PP pk_, int g, LAS unsigned char* lds) { const P p = load_args(pk_);
    if (bid_local() < BG * 4) gate_tables(pk_, g, bid_local(), lds);
    const int tid = tid_local();
    const bf16_t* U = WSP(bf16_t, WS_U); bf16_t* QKC = WSP(bf16_t, WS_QKC);
    for (int t = bid_local() * 512 + tid; t < (TG / 32) * 256; t += gridDim.x * 512) {
        const int c8 = t & 255, r0 = (t >> 8) * 32, isk = c8 >> 7; const float sc = isk ? 0.0625f : 1.f;
        f32x4 cw[4][2];
#pragma unroll
        for (int j = 0; j < 4; ++j) { cw[j][0] = *(const f32x4*)(p.conv_w + j * 2048 + c8 * 8); cw[j][1] = *(const f32x4*)(p.conv_w + j * 2048 + c8 * 8 + 4); }
        const bf16_t* src = U + (size_t)r0 * NU + UMQ + c8 * 8; bf16_t* dst = QKC + (size_t)r0 * 2048 + c8 * 8;
        const bool head = (r0 & (SEQ - 1)) == 0;
        u32x4 x0 = {0u, 0u, 0u, 0u}, x1 = x0, x2 = x0, x3;
        if (!head) { x0 = *(const u32x4*)(src - 3 * (size_t)NU); x1 = *(const u32x4*)(src - 2 * (size_t)NU); x2 = *(const u32x4*)(src - (size_t)NU); }
#define CONV_OUT(a_, b_, c_, d_, row_) do { float o_[8]; \
        o_[0] = cw[0][0][0] * bf_lo(a_.x) + cw[1][0][0] * bf_lo(b_.x) + cw[2][0][0] * bf_lo(c_.x) + cw[3][0][0] * bf_lo(d_.x); \
        o_[1] = cw[0][0][1] * bf_hi(a_.x) + cw[1][0][1] * bf_hi(b_.x) + cw[2][0][1] * bf_hi(c_.x) + cw[3][0][1] * bf_hi(d_.x); \
        o_[2] = cw[0][0][2] * bf_lo(a_.y) + cw[1][0][2] * bf_lo(b_.y) + cw[2][0][2] * bf_lo(c_.y) + cw[3][0][2] * bf_lo(d_.y); \
        o_[3] = cw[0][0][3] * bf_hi(a_.y) + cw[1][0][3] * bf_hi(b_.y) + cw[2][0][3] * bf_hi(c_.y) + cw[3][0][3] * bf_hi(d_.y); \
        o_[4] = cw[0][1][0] * bf_lo(a_.z) + cw[1][1][0] * bf_lo(b_.z) + cw[2][1][0] * bf_lo(c_.z) + cw[3][1][0] * bf_lo(d_.z); \
        o_[5] = cw[0][1][1] * bf_hi(a_.z) + cw[1][1][1] * bf_hi(b_.z) + cw[2][1][1] * bf_hi(c_.z) + cw[3][1][1] * bf_hi(d_.z); \
        o_[6] = cw[0][1][2] * bf_lo(a_.w) + cw[1][1][2] * bf_lo(b_.w) + cw[2][1][2] * bf_lo(c_.w) + cw[3][1][2] * bf_lo(d_.w); \
        o_[7] = cw[0][1][3] * bf_hi(a_.w) + cw[1][1][3] * bf_hi(b_.w) + cw[2][1][3] * bf_hi(c_.w) + cw[3][1][3] * bf_hi(d_.w); \
        u32x4 w_; w_.x = pk_bf16(silu(o_[0]) * sc, silu(o_[1]) * sc); w_.y = pk_bf16(silu(o_[2]) * sc, silu(o_[3]) * sc); w_.z = pk_bf16(silu(o_[4]) * sc, silu(o_[5]) * sc); w_.w = pk_bf16(silu(o_[6]) * sc, silu(o_[7]) * sc); \
        *(u32x4*)(dst + (size_t)(row_) * 2048) = w_; } while (0)
        u32x4 y0 = *(const u32x4*)(src), y1 = *(const u32x4*)(src + (size_t)NU), y2 = *(const u32x4*)(src + (size_t)2 * NU), y3 = *(const u32x4*)(src + (size_t)3 * NU);
#pragma unroll 1
        for (int i = 0; i < 32; i += 4) {
            u32x4 n0 = y0, n1 = y1, n2 = y2, n3 = y3;
            if (i + 4 < 32) { n0 = *(const u32x4*)(src + (size_t)(i + 4) * NU); n1 = *(const u32x4*)(src + (size_t)(i + 5) * NU); n2 = *(const u32x4*)(src + (size_t)(i + 6) * NU); n3 = *(const u32x4*)(src + (size_t)(i + 7) * NU); }
            x3 = y0; CONV_OUT(x0, x1, x2, x3, i);
            CONV_OUT(x1, x2, y0, y1, i + 1);
            CONV_OUT(x2, y0, y1, y2, i + 2);
            CONV_OUT(y0, y1, y2, y3, i + 3);
            x0 = y1; x1 = y2; x2 = y3; y0 = n0; y1 = n1; y2 = n2; y3 = n3;
        }
#undef CONV_OUT
    }
}
constexpr int ML_QP = 528, ML_KP = 576, ML_VP = 576, ML_WP = 144;
constexpr int ML_Q = 0, ML_K = ML_Q + 64 * ML_QP, ML_V = ML_K + 64 * ML_KP, ML_W = ML_V + 64 * ML_VP, ML_TAB = ML_W + 64 * ML_WP;
constexpr int T_BCUM = 0, T_A = 256, T_MROW = 512, T_IW = 768, T_WS = 1024, T_RS = 1280, T_ND = 2304, T_GI = 2560, T_GF = 2816, T_N = 3072, T_SC = 4096, T_INVD = 4352, T_NP = 4608;
static_assert(ML_TAB + 4608 + 2048 <= LDS_RING, "mLSTM LDS map");
#ifndef ML_NSEG
#define ML_NSEG 1
#endif
constexpr int NSEG = ML_NSEG, SEGCH = (SEQ / 64) / NSEG;
constexpr size_t WS_GT = WS_R + 836 * MiB, WS_LST = WS_R + 840 * MiB;
constexpr int GT_STRIDE = 384, LST_STRIDE = 128 * 512 + 256;
static_assert(WS_LST + (size_t)BG * 4 * (NSEG - 1) * LST_STRIDE * 4 <= WS_END, "segment states fit");
DI void gate_tables(PP pk_, int g, int chain, LAS unsigned char* lds) { const P p = load_args(pk_);
    const int tid = tid_local(), lane = tid & 63, w = tid >> 6, h = chain & 3, b = chain >> 2;
    const float* gif = WSP(float, WS_GIF); float* GT = WSP(float, WS_GT) + (size_t)chain * 32 * GT_STRIDE;
    const size_t tbase = ((size_t)g * BG + b) * SEQ;
    LAS float* tot = (LAS float*)lds; LAS float* amx = tot + 32;
    float bc[4], aa[4], pm[4];
    __syncthreads();
#pragma unroll
    for (int k = 0; k < 4; ++k) { const int c = w + 8 * k; const float ip = gif[(tbase + c * 64 + lane) * 8 + h], fp = gif[(tbase + c * 64 + lane) * 8 + 4 + h];
        float x = fminf(fp, 0.f) - log1pf(expf(-fabsf(fp)));
#pragma unroll
        for (int o = 1; o < 64; o <<= 1) { const float t = bperm(x, lane - o); if (lane >= o) x += t; }
        float y = ip - x; const float a0 = y;
#pragma unroll
        for (int o = 1; o < 64; o <<= 1) { const float t = bperm(y, lane - o); if (lane >= o) y = fmaxf(y, t); }
        bc[k] = x; aa[k] = a0; pm[k] = y;
        if (lane == 63) { tot[c] = x; amx[c] = y; } }
    __syncthreads();
    float mst = 0.f, min_[4];
    for (int c = 0; c < 32; ++c) {
#pragma unroll
        for (int k = 0; k < 4; ++k) if (c == w + 8 * k) min_[k] = mst;
        mst = tot[c] + fmaxf(mst, amx[c]); }
#pragma unroll
    for (int k = 0; k < 4; ++k) { const int c = w + 8 * k; const float m0 = min_[k], total = tot[c], amax = amx[c];
        const float mrow = bc[k] + fmaxf(m0, pm[k]), iw = expf(bc[k] + m0 - mrow), mnew = total + fmaxf(m0, amax), decay = expf(total + m0 - mnew), ws = expf(total + aa[k] - mnew);
        float* o = GT + (size_t)c * GT_STRIDE; o[lane] = bc[k]; o[64 + lane] = aa[k]; o[128 + lane] = mrow; o[192 + lane] = iw; o[256 + lane] = ws; if (lane == 0) o[320] = decay; }
    __syncthreads();
}

template <int mode> DI void mlstm_seg_item(PP pk_, int g, int chain, int seg, LAS unsigned char* lds) { const P p = load_args(pk_);
    const int tid0 = tid_local(), w = __builtin_amdgcn_readfirstlane(tid0 >> 6);
    const int h = chain & 3, b = chain >> 2;
    const bf16_t* U = WSP(bf16_t, WS_U); bf16_t* HB = WSP(bf16_t, WS_MRG); const bf16_t* QKC = WSP(bf16_t, WS_QKC);
    const float* GT = WSP(float, WS_GT) + (size_t)chain * 32 * GT_STRIDE; float* LS = WSP(float, WS_LST) + (size_t)chain * (NSEG - 1) * LST_STRIDE;
    const size_t rbase = (size_t)b * SEQ;
    LAS unsigned char* TB = lds + ML_TAB;
#define TABF(off) ((LAS float*)(TB + (off)))
    f32x16 C[8]; { const float z0 = zero_local();
#pragma unroll
    for (int kt = 0; kt < 8; ++kt)
#pragma unroll
        for (int i = 0; i < 16; ++i) C[kt][i] = z0; }
    __syncthreads();
    { float nn = 0.f;
      if (mode == 1 && seg > 0) {
          const f32x4* Lq = (const f32x4*)(LS + (size_t)(seg - 1) * LST_STRIDE + (size_t)tid0 * 128);
#pragma unroll
          for (int kt = 0; kt < 8; ++kt)
#pragma unroll
              for (int i4 = 0; i4 < 4; ++i4) { const f32x4 l = Lq[kt * 4 + i4]; C[kt][4 * i4] = l[0]; C[kt][4 * i4 + 1] = l[1]; C[kt][4 * i4 + 2] = l[2]; C[kt][4 * i4 + 3] = l[3]; }
          if (tid0 < 256) nn = LS[(size_t)(seg - 1) * LST_STRIDE + 128 * 512 + tid0]; }
      if (tid0 < 256) TABF(T_N)[tid0] = nn; }
    const int ch0 = mode == 1 ? seg * SEGCH : 0, nch = mode == 1 ? SEGCH : SEQ / 64;
    u32x4 pq[2]; float tq[6] = {0.f, 0.f, 0.f, 0.f, 0.f, 0.f};
#define ML_PQ(ch_, tv_) do { if ((tv_) < 64) { const float* gt_ = GT + (size_t)(ch_) * GT_STRIDE + (tv_); tq[0] = gt_[0]; tq[1] = gt_[64]; tq[2] = gt_[128]; tq[3] = gt_[192]; tq[4] = gt_[256]; tq[5] = GT[(size_t)(ch_) * GT_STRIDE + 320]; } _Pragma("unroll") for (int i_ = 0; i_ < 2; ++i_) { const int pc_ = (tv_) + 512 * i_, s_ = pc_ >> 5, cc_ = pc_ & 31; pq[i_] = *(const u32x4*)(QKC + (rbase + (ch_) * 64 + s_) * 2048 + h * 256 + cc_ * 8); } } while (0)
    if (mode == 1) ML_PQ(ch0, tid0);
    u32x4 pk[4], pv[4];
#define ML_PF(ch_, tv_) do { _Pragma("unroll") for (int i_ = 0; i_ < 4; ++i_) { const int pc_ = (tv_) + 512 * i_, s_ = pc_ >> 5, cc_ = pc_ & 31; const size_t row_ = rbase + (ch_) * 64 + s_; \
        pk[i_] = *(const u32x4*)(QKC + row_ * 2048 + 1024 + h * 256 + cc_ * 8); pv[i_] = *(const u32x4*)(U + row_ * NU + UMV + h * 256 + cc_ * 8); } } while (0)
    if (mode == 0) ML_PF(0, tid0);
    for (int ch = ch0; ch < ch0 + nch; ++ch) {
        int tid = tid0; asm volatile("" : "+v"(tid));
        const int lane = tid & 63, hh = lane >> 5, r = lane & 31, i16 = lane & 15, l4 = lane >> 4;
        lds_barrier();
        if (mode == 0 && ch > 0 && (ch % SEGCH) == 0) {
            const int sg = ch / SEGCH - 1;
            f32x4* Lq = (f32x4*)(LS + (size_t)sg * LST_STRIDE + (size_t)tid * 128);
#pragma unroll
            for (int kt = 0; kt < 8; ++kt)
#pragma unroll
                for (int i4 = 0; i4 < 4; ++i4) Lq[kt * 4 + i4] = (f32x4){C[kt][4 * i4], C[kt][4 * i4 + 1], C[kt][4 * i4 + 2], C[kt][4 * i4 + 3]};
            if (tid < 256) LS[(size_t)sg * LST_STRIDE + 128 * 512 + tid] = TABF(T_N)[tid];
        }
        {
#pragma unroll
            for (int i = 0; i < 4; ++i) { const int pc = tid + 512 * i, s = pc >> 5, cc = pc & 31;
                if (mode == 1) *(LAS u32x4*)(lds + ML_Q + s * ML_QP + cc * 16) = i < 2 ? pq[i & 1] : *(const u32x4*)(QKC + (rbase + ch * 64 + s) * 2048 + h * 256 + cc * 8);
                *(LAS u32x4*)(lds + ML_K + s * ML_KP + cc * 16) = mode == 0 ? pk[i] : *(const u32x4*)(QKC + (rbase + ch * 64 + s) * 2048 + 1024 + h * 256 + cc * 8); }
            if (mode == 1) { if (tid < 64) { TABF(T_BCUM)[tid] = tq[0]; TABF(T_A)[tid] = tq[1]; TABF(T_MROW)[tid] = tq[2]; TABF(T_IW)[tid] = tq[3]; TABF(T_WS)[tid] = tq[4]; if (tid == 0) TABF(T_SC)[1] = tq[5]; } }
            else if (tid < 64) { const float* gt = GT + (size_t)ch * GT_STRIDE + tid; TABF(T_BCUM)[tid] = gt[0]; TABF(T_A)[tid] = gt[64]; TABF(T_MROW)[tid] = gt[128]; TABF(T_IW)[tid] = gt[192]; TABF(T_WS)[tid] = gt[256]; if (tid == 0) TABF(T_SC)[1] = gt[320]; }
        }
        u32x4 vf[4];
#pragma unroll
        for (int i = 0; i < 4; ++i) { const int pc = tid + 512 * i, s = pc >> 5, cc = pc & 31; vf[i] = mode == 0 ? pv[i] : *(const u32x4*)(U + (rbase + ch * 64 + s) * NU + UMV + h * 256 + cc * 8); }
        if (mode == 0 && ch + 1 < ch0 + nch) ML_PF(ch + 1, tid);
        const unsigned vtr = ML_V + (8 * hh + (i16 >> 2)) * ML_VP + (32 * w + 16 * (l4 & 1) + 4 * (i16 & 3)) * 2;
        if (mode == 1) {
        lds_barrier();
        f32x4 S2[2];
#pragma unroll
        for (int tt = 0; tt < 2; ++tt) { const int tile = 2 * w + tt, jt = tile >> 2, st = tile & 3; f32x4 s = {0.f, 0.f, 0.f, 0.f};
            const LAS unsigned char* qa = lds + ML_Q + (jt * 16 + i16) * ML_QP + l4 * 16; const LAS unsigned char* ka = lds + ML_K + (st * 16 + i16) * ML_KP + l4 * 16;
#pragma unroll
            for (int c = 0; c < 8; ++c) s = __builtin_amdgcn_mfma_f32_16x16x32_bf16(*(const LAS bf16x8*)(qa + c * 64), *(const LAS bf16x8*)(ka + c * 64), s, 0, 0, 0);
            S2[tt] = s; }
        { const f32x4 nv = *(const LAS f32x4*)(TABF(T_N) + 4 * lane);
#pragma unroll
          for (int jj = 0; jj < 8; ++jj) { const int j = 8 * w + jj; const u32x2 qw = *(const LAS u32x2*)(lds + ML_Q + j * ML_QP + lane * 8);
              const float d = wave_sum_fast(bf_lo(qw.x) * nv[0] + bf_hi(qw.x) * nv[1] + bf_lo(qw.y) * nv[2] + bf_hi(qw.y) * nv[3]); if (lane == 0) TABF(T_ND)[j] = d; } }
#pragma unroll
        for (int tt = 0; tt < 2; ++tt) { const int tile = 2 * w + tt, jt = tile >> 2, st = tile & 3, s = st * 16 + i16; const float as = TABF(T_A)[s];
#pragma unroll
            for (int rg = 0; rg < 4; ++rg) { const int j = jt * 16 + l4 * 4 + rg;
                float val = s <= j ? __expf(TABF(T_BCUM)[j] + as - TABF(T_MROW)[j]) * S2[tt][rg] : 0.f;
                *(LAS bf16_t*)(lds + ML_W + j * ML_WP + s * 2) = (bf16_t)(pk_bf16(val, 0.f) & 0xffffu);
                val = row16_sum(val);
                if (i16 == 0) TABF(T_RS)[j * 4 + st] = val; } }
        }
#pragma unroll
        for (int i = 0; i < 4; ++i) { const int pc = tid + 512 * i, s = pc >> 5, cc = pc & 31; *(LAS u32x4*)(lds + ML_V + s * ML_VP + cc * 16) = vf[i]; }
        lds_barrier();
        if (mode == 1) {
        if (tid < 64) { const int j = tid; const f32x4 rs = *(const LAS f32x4*)(TABF(T_RS) + 4 * j);
            const float den = TABF(T_IW)[j] * TABF(T_ND)[j] + ((rs[0] + rs[1]) + (rs[2] + rs[3]));
            TABF(T_INVD)[j] = 1.f / fmaxf(fabsf(den), expf(-TABF(T_MROW)[j])); }
        f32x16 acc[2]; { const float z0 = zero_local();
#pragma unroll
        for (int jt2 = 0; jt2 < 2; ++jt2)
#pragma unroll
            for (int i = 0; i < 16; ++i) acc[jt2][i] = z0; }
#pragma unroll
        for (int kt = 0; kt < 8; ++kt) { __builtin_amdgcn_sched_barrier(0);
#pragma unroll
            for (int s = 0; s < 2; ++s) { const bf16x8 bfr = pack_half(C[kt], s);
#pragma unroll
                for (int jt2 = 0; jt2 < 2; ++jt2) { const LAS unsigned char* qa = lds + ML_Q + (jt2 * 32 + r) * ML_QP + (kt * 32 + 16 * s + 4 * hh) * 2;
                    const s16x4 lo = *(const LAS s16x4*)qa, hi = *(const LAS s16x4*)(qa + 16);
                    acc[jt2] = MFMA32(__builtin_shufflevector(lo, hi, 0, 1, 2, 3, 4, 5, 6, 7), bfr, acc[jt2]); } } }
        __builtin_amdgcn_sched_barrier(0);
#pragma unroll
        for (int jt2 = 0; jt2 < 2; ++jt2)
#pragma unroll
            for (int i = 0; i < 16; ++i) acc[jt2][i] *= TABF(T_IW)[jt2 * 32 + crow(i, hh)];
#pragma unroll
        for (int ks = 0; ks < 4; ++ks) { const bf16x8 bv = tr_pair(lds + vtr + 16 * ks * ML_VP, lds + vtr + (16 * ks + 4) * ML_VP);
#pragma unroll
            for (int jt2 = 0; jt2 < 2; ++jt2) acc[jt2] = MFMA32(*(const LAS bf16x8*)(lds + ML_W + (jt2 * 32 + r) * ML_WP + (16 * ks + 8 * hh) * 2), bv, acc[jt2]); }
        lds_barrier();
#pragma unroll
        for (int jt2 = 0; jt2 < 2; ++jt2)
#pragma unroll
            for (int i = 0; i < 16; ++i) { const int j = jt2 * 32 + crow(i, hh); *(LAS bf16_t*)(lds + ML_Q + j * 512 + (32 * w + r) * 2) = (bf16_t)(pk_bf16(acc[jt2][i] * TABF(T_INVD)[j], 0.f) & 0xffffu); }
        }
        const float decay = TABF(T_SC)[1];
        { const int dk = tid & 255, sh = tid >> 8; float nn = 0.f;
#pragma unroll 8
          for (int s = 32 * sh; s < 32 * sh + 32; ++s) nn += TABF(T_WS)[s] * bf2f(*(const LAS bf16_t*)(lds + ML_K + s * ML_KP + dk * 2));
          TABF(T_NP)[tid] = nn; }
#pragma unroll
        for (int kt = 0; kt < 8; ++kt) C[kt] *= decay;
        const unsigned ktr = ML_K + (8 * hh + (i16 >> 2)) * ML_KP + (16 * (l4 & 1) + 4 * (i16 & 3)) * 2;
#pragma unroll
        for (int ks = 0; ks < 4; ++ks) { __builtin_amdgcn_sched_barrier(0); const bf16x8 bv = tr_pair(lds + vtr + 16 * ks * ML_VP, lds + vtr + (16 * ks + 4) * ML_VP);
            const u32x4 bw = __builtin_bit_cast(u32x4, bv); const f32x4 w0 = *(const LAS f32x4*)(TABF(T_WS) + 16 * ks + 8 * hh), w1 = *(const LAS f32x4*)(TABF(T_WS) + 16 * ks + 8 * hh + 4);
            u32x4 sw; sw.x = pk_bf16(bf_lo(bw.x) * w0[0], bf_hi(bw.x) * w0[1]); sw.y = pk_bf16(bf_lo(bw.y) * w0[2], bf_hi(bw.y) * w0[3]); sw.z = pk_bf16(bf_lo(bw.z) * w1[0], bf_hi(bw.z) * w1[1]); sw.w = pk_bf16(bf_lo(bw.w) * w1[2], bf_hi(bw.w) * w1[3]);
            const bf16x8 bs = __builtin_bit_cast(bf16x8, sw);
#pragma unroll
            for (int kt = 0; kt < 8; ++kt) C[kt] = MFMA32(tr_pair(lds + ktr + 16 * ks * ML_KP + kt * 64, lds + ktr + (16 * ks + 4) * ML_KP + kt * 64), bs, C[kt]); }
        lds_barrier();
        if (tid < 256) TABF(T_N)[tid] = TABF(T_N)[tid] * decay + (TABF(T_NP)[tid] + TABF(T_NP)[tid + 256]);
        if (mode == 1) {
#pragma unroll
            for (int i = 0; i < 4; ++i) { const int pc = tid + 512 * i, s = pc >> 5, cc = pc & 31; *(u32x4*)(HB + (rbase + ch * 64 + s) * 1024 + h * 256 + cc * 8) = *(const LAS u32x4*)(lds + ML_Q + s * 512 + cc * 16); }
            if (ch + 1 < ch0 + nch) ML_PQ(ch + 1, tid);
        }
    }
#undef TABF
#undef ML_PF
#undef ML_PQ
}
constexpr int M2_QP = 528, M2_KP = 576, M2_VP = 320, M2_WP = 144;
constexpr int M2_Q = 0, M2_K = M2_Q + 64 * M2_QP, M2_V = M2_K + 64 * M2_KP, M2_W = M2_V + 64 * M2_VP, M2_TAB = M2_W + 64 * M2_WP, M2_X = M2_TAB + 7168;
static_assert(M2_X + 32768 <= LDS_RING, "split-mLSTM LDS map");
DI void mlstm_half_item(PP pk_, int g, int item, LAS unsigned char* lds) { const P p = load_args(pk_);
    const int tid0 = tid_local(), w = __builtin_amdgcn_readfirstlane(tid0 >> 6), vs = w & 3, kh = w >> 2;
    const int half = item & 1, chain = item >> 1, h = chain & 3, b = chain >> 2;
    const bf16_t* U = WSP(bf16_t, WS_U); bf16_t* HB = WSP(bf16_t, WS_MRG); const bf16_t* QKC = WSP(bf16_t, WS_QKC);
    const float* GT = WSP(float, WS_GT) + (size_t)chain * 32 * GT_STRIDE;
    const size_t rbase = (size_t)b * SEQ;
    LAS unsigned char* TB = lds + M2_TAB;
#define TABF(off) ((LAS float*)(TB + (off)))
    f32x16 C[4]; { const float z0 = zero_local();
#pragma unroll
    for (int kt = 0; kt < 4; ++kt)
#pragma unroll
        for (int i = 0; i < 16; ++i) C[kt][i] = z0; }
    __syncthreads();
    if (tid0 < 256) TABF(T_N)[tid0] = 0.f;
    u32x4 pq[4], pk[4], pv[2]; float tq[6] = {0.f, 0.f, 0.f, 0.f, 0.f, 0.f};
#define M2_PF(ch_, tv_) do { if ((tv_) < 64) { const float* gt_ = GT + (size_t)(ch_) * GT_STRIDE + (tv_); tq[0] = gt_[0]; tq[1] = gt_[64]; tq[2] = gt_[128]; tq[3] = gt_[192]; tq[4] = gt_[256]; tq[5] = GT[(size_t)(ch_) * GT_STRIDE + 320]; } \
        _Pragma("unroll") for (int i_ = 0; i_ < 4; ++i_) { const int pc_ = (tv_) + 512 * i_, s_ = pc_ >> 5, cc_ = pc_ & 31; const bf16_t* r_ = QKC + (rbase + (ch_) * 64 + s_) * 2048 + h * 256 + cc_ * 8; pq[i_] = *(const u32x4*)r_; pk[i_] = *(const u32x4*)(r_ + 1024); } \
        _Pragma("unroll") for (int i_ = 0; i_ < 2; ++i_) { const int pc_ = (tv_) + 512 * i_, s_ = pc_ >> 4, cc_ = pc_ & 15; pv[i_] = *(const u32x4*)(U + (rbase + (ch_) * 64 + s_) * NU + UMV + h * 256 + half * 128 + cc_ * 8); } } while (0)
    M2_PF(0, tid0);
    for (int ch = 0; ch < SEQ / 64; ++ch) {
        int tid = tid0; asm volatile("" : "+v"(tid));
        const int lane = tid & 63, hh = lane >> 5, r = lane & 31, i16 = lane & 15, l4 = lane >> 4;
        lds_barrier();
#pragma unroll
        for (int i = 0; i < 4; ++i) { const int pc = tid + 512 * i, s = pc >> 5, cc = pc & 31; *(LAS u32x4*)(lds + M2_Q + s * M2_QP + cc * 16) = pq[i]; *(LAS u32x4*)(lds + M2_K + s * M2_KP + cc * 16) = pk[i]; }
#pragma unroll
        for (int i = 0; i < 2; ++i) { const int pc = tid + 512 * i, s = pc >> 4, cc = pc & 15; *(LAS u32x4*)(lds + M2_V + s * M2_VP + cc * 16) = pv[i]; }
        if (tid < 64) { TABF(T_BCUM)[tid] = tq[0]; TABF(T_A)[tid] = tq[1]; TABF(T_MROW)[tid] = tq[2]; TABF(T_IW)[tid] = tq[3]; TABF(T_WS)[tid] = tq[4]; if (tid == 0) TABF(T_SC)[1] = tq[5]; }
        if (ch + 1 < SEQ / 64) M2_PF(ch + 1, tid);
        lds_barrier();
        f32x4 S2[2];
#pragma unroll
        for (int tt = 0; tt < 2; ++tt) { const int tile = 2 * w + tt, jt = tile >> 2, st = tile & 3; f32x4 s = {0.f, 0.f, 0.f, 0.f};
            const LAS unsigned char* qa = lds + M2_Q + (jt * 16 + i16) * M2_QP + l4 * 16; const LAS unsigned char* ka = lds + M2_K + (st * 16 + i16) * M2_KP + l4 * 16;
#pragma unroll
            for (int c = 0; c < 8; ++c) s = __builtin_amdgcn_mfma_f32_16x16x32_bf16(*(const LAS bf16x8*)(qa + c * 64), *(const LAS bf16x8*)(ka + c * 64), s, 0, 0, 0);
            S2[tt] = s; }
        { const f32x4 nv = *(const LAS f32x4*)(TABF(T_N) + 4 * lane);
#pragma unroll
          for (int jj = 0; jj < 8; ++jj) { const int j = 8 * w + jj; const u32x2 qw = *(const LAS u32x2*)(lds + M2_Q + j * M2_QP + lane * 8);
              const float d = wave_sum_fast(bf_lo(qw.x) * nv[0] + bf_hi(qw.x) * nv[1] + bf_lo(qw.y) * nv[2] + bf_hi(qw.y) * nv[3]); if (lane == 0) TABF(T_ND)[j] = d; } }
#pragma unroll
        for (int tt = 0; tt < 2; ++tt) { const int tile = 2 * w + tt, jt = tile >> 2, st = tile & 3, s = st * 16 + i16; const float as = TABF(T_A)[s];
#pragma unroll
            for (int rg = 0; rg < 4; ++rg) { const int j = jt * 16 + l4 * 4 + rg;
                float val = s <= j ? __expf(TABF(T_BCUM)[j] + as - TABF(T_MROW)[j]) * S2[tt][rg] : 0.f;
                *(LAS bf16_t*)(lds + M2_W + j * M2_WP + s * 2) = (bf16_t)(pk_bf16(val, 0.f) & 0xffffu);
                val = row16_sum(val);
                if (i16 == 0) TABF(T_RS)[j * 4 + st] = val; } }
        lds_barrier();
        if (tid < 64) { const int j = tid; const f32x4 rs = *(const LAS f32x4*)(TABF(T_RS) + 4 * j);
            const float den = TABF(T_IW)[j] * TABF(T_ND)[j] + ((rs[0] + rs[1]) + (rs[2] + rs[3]));
            TABF(T_INVD)[j] = 1.f / fmaxf(fabsf(den), expf(-TABF(T_MROW)[j])); }
        f32x16 acc[2]; { const float z0 = zero_local();
#pragma unroll
        for (int jt2 = 0; jt2 < 2; ++jt2)
#pragma unroll
            for (int i = 0; i < 16; ++i) acc[jt2][i] = z0; }
#pragma unroll
        for (int kt = 0; kt < 4; ++kt)
#pragma unroll
            for (int s = 0; s < 2; ++s) { const bf16x8 bfr = pack_half(C[kt], s);
#pragma unroll
                for (int jt2 = 0; jt2 < 2; ++jt2) { const LAS unsigned char* qa = lds + M2_Q + (jt2 * 32 + r) * M2_QP + (128 * kh + kt * 32 + 16 * s + 4 * hh) * 2;
                    const s16x4 lo = *(const LAS s16x4*)qa, hi = *(const LAS s16x4*)(qa + 16);
                    acc[jt2] = MFMA32(__builtin_shufflevector(lo, hi, 0, 1, 2, 3, 4, 5, 6, 7), bfr, acc[jt2]); } }
        { LAS float* X = (LAS float*)(lds + M2_X);
#pragma unroll
          for (int i = 0; i < 16; ++i) X[(w * 16 + i) * 64 + lane] = kh == 0 ? acc[1][i] : acc[0][i]; }
        lds_barrier();
        f32x16 num;
        { const LAS float* X = (const LAS float*)(lds + M2_X);
#pragma unroll
          for (int i = 0; i < 16; ++i) num[i] = ((kh == 0 ? acc[0][i] : acc[1][i]) + X[((w ^ 4) * 16 + i) * 64 + lane]) * TABF(T_IW)[kh * 32 + crow(i, hh)]; }
        const unsigned vtr = M2_V + (8 * hh + (i16 >> 2)) * M2_VP + (32 * vs + 16 * (l4 & 1) + 4 * (i16 & 3)) * 2;
#pragma unroll
        for (int ks = 0; ks < 4; ++ks) num = MFMA32(*(const LAS bf16x8*)(lds + M2_W + (kh * 32 + r) * M2_WP + (16 * ks + 8 * hh) * 2), tr_pair(lds + vtr + 16 * ks * M2_VP, lds + vtr + (16 * ks + 4) * M2_VP), num);
        lds_barrier();
#pragma unroll
        for (int i = 0; i < 16; ++i) { const int j = kh * 32 + crow(i, hh); *(LAS bf16_t*)(lds + M2_Q + j * 256 + (32 * vs + r) * 2) = (bf16_t)(pk_bf16(num[i] * TABF(T_INVD)[j], 0.f) & 0xffffu); }
        const float decay = TABF(T_SC)[1];
        { const int dk = tid & 255, sh = tid >> 8; float nn = 0.f;
#pragma unroll 8
          for (int s = 32 * sh; s < 32 * sh + 32; ++s) nn += TABF(T_WS)[s] * bf2f(*(const LAS bf16_t*)(lds + M2_K + s * M2_KP + dk * 2));
          TABF(T_NP)[tid] = nn; }
#pragma unroll
        for (int kt = 0; kt < 4; ++kt) C[kt] *= decay;
        const unsigned ktr = M2_K + (8 * hh + (i16 >> 2)) * M2_KP + (128 * kh + 16 * (l4 & 1) + 4 * (i16 & 3)) * 2;
#pragma unroll
        for (int ks = 0; ks < 4; ++ks) { const bf16x8 bv = tr_pair(lds + vtr + 16 * ks * M2_VP, lds + vtr + (16 * ks + 4) * M2_VP);
            const u32x4 bw = __builtin_bit_cast(u32x4, bv); const f32x4 w0 = *(const LAS f32x4*)(TABF(T_WS) + 16 * ks + 8 * hh), w1 = *(const LAS f32x4*)(TABF(T_WS) + 16 * ks + 8 * hh + 4);
            u32x4 sw; sw.x = pk_bf16(bf_lo(bw.x) * w0[0], bf_hi(bw.x) * w0[1]); sw.y = pk_bf16(bf_lo(bw.y) * w0[2], bf_hi(bw.y) * w0[3]); sw.z = pk_bf16(bf_lo(bw.z) * w1[0], bf_hi(bw.z) * w1[1]); sw.w = pk_bf16(bf_lo(bw.w) * w1[2], bf_hi(bw.w) * w1[3]);
            const bf16x8 bs = __builtin_bit_cast(bf16x8, sw);
#pragma unroll
            for (int kt = 0; kt < 4; ++kt) C[kt] = MFMA32(tr_pair(lds + ktr + 16 * ks * M2_KP + kt * 64, lds + ktr + (16 * ks + 4) * M2_KP + kt * 64), bs, C[kt]); }
        lds_barrier();
        if (tid < 256) TABF(T_N)[tid] = TABF(T_N)[tid] * decay + (TABF(T_NP)[tid] + TABF(T_NP)[tid + 256]);
#pragma unroll
        for (int i = 0; i < 2; ++i) { const int pc = tid + 512 * i, s = pc >> 4, cc = pc & 15; *(u32x4*)(HB + (rbase + ch * 64 + s) * 1024 + h * 256 + half * 128 + cc * 8) = *(const LAS u32x4*)(lds + M2_Q + s * 256 + cc * 16); }
    }
#undef TABF
#undef M2_PF
}
constexpr int XA_KP = 528, XA_VP = 576, XA_VOFF = 32 * XA_KP, XA_BUF = XA_VOFF + 32 * XA_VP;
static_assert(2 * XA_BUF <= LDS_RING, "xattn LDS map");
DI void xattn_tile(const LAS unsigned char* buf, unsigned ka, unsigned va, const bf16x8 (&qf)[16], f32x16 (&O)[4], float& mrun, float& lrun) {
        f32x16 S, S1; { const float z0 = zero_local();
#pragma unroll
        for (int i = 0; i < 16; ++i) { S[i] = z0; S1[i] = z0; } }
#pragma unroll
        for (int s = 0; s < 16; s += 2) { S = MFMA32(*(const LAS bf16x8*)(buf + ka + s * 32), qf[s], S); S1 = MFMA32(*(const LAS bf16x8*)(buf + ka + (s + 1) * 32), qf[s + 1], S1); }
        S += S1;
        float mx = S[0];
#pragma unroll
        for (int i = 1; i < 16; ++i) mx = fmaxf(mx, S[i]);
        mx = xhalf_max(mx);
        const float mnew = fmaxf(mrun, mx);
        if (__builtin_amdgcn_ballot_w64(mnew > mrun) != 0ull) { const float alpha = __builtin_amdgcn_exp2f(mrun - mnew); lrun *= alpha;
#pragma unroll
            for (int dt = 0; dt < 4; ++dt) O[dt] *= alpha; }
        mrun = mnew;
#pragma unroll
        for (int i = 0; i < 16; ++i) { S[i] = __builtin_amdgcn_exp2f(S[i] - mnew); lrun += S[i]; }
#pragma unroll
        for (int s2 = 0; s2 < 2; ++s2) { const bf16x8 pb = pack_half(S, s2); const LAS unsigned char* vb = buf + va + 16 * s2 * XA_VP;
#pragma unroll
            for (int dt = 0; dt < 4; ++dt) O[dt] = MFMA32(tr_pair(vb + dt * 64, vb + dt * 64 + 8 * XA_VP), pb, O[dt]); }
}
DI void xattn_mfma_item(PP pk_, int g, int item, LAS unsigned char* lds) { const P p = load_args(pk_);
    const int tid = tid_local(), lane = tid & 63, wave = __builtin_amdgcn_readfirstlane(tid >> 6), dvh = wave & 1, rq = wave >> 1, hh = lane >> 5, r = lane & 31;
    const int qb = item & 15, h = (item >> 4) & 3, b = item >> 6;
    const bf16_t* U = WSP(bf16_t, WS_U); const bf16_t* KV = WSP(bf16_t, WS_KVM) + (size_t)(g * BG + b) * 256 * 2048 + h * 256;
    const size_t qrow = (size_t)b * SEQ + qb * 128 + rq * 32 + r;
    bf16x8 qf[16];
    { const bf16_t* qp = U + qrow * NU + UCQ + h * 256 + 8 * hh;
#pragma unroll
      for (int s = 0; s < 16; ++s) qf[s] = *(const bf16x8*)(qp + 16 * s); }
    f32x16 O[4]; { const float z0 = zero_local();
#pragma unroll
    for (int dt = 0; dt < 4; ++dt)
#pragma unroll
        for (int i = 0; i < 16; ++i) O[dt][i] = z0; }
    float mrun = -INFINITY, lrun = 0.f;
    const int row0 = tid >> 5, c32 = tid & 31;
    const bf16_t* gk = KV + (size_t)row0 * 2048 + c32 * 8;
    const unsigned lk = row0 * XA_KP + c32 * 16, lv = XA_VOFF + row0 * XA_VP + c32 * 16;
    u32x4 st[4];
#define XA_LOAD(t_) do { const bf16_t* s_ = gk + (size_t)(t_) * 32 * 2048; st[0] = *(const u32x4*)s_; st[1] = *(const u32x4*)(s_ + 16 * 2048); st[2] = *(const u32x4*)(s_ + 1024); st[3] = *(const u32x4*)(s_ + 16 * 2048 + 1024); } while (0)
#define XA_STORE(bufp) do { *(LAS u32x4*)((bufp) + lk) = st[0]; *(LAS u32x4*)((bufp) + lk + 16 * XA_KP) = st[1]; *(LAS u32x4*)((bufp) + lv) = st[2]; *(LAS u32x4*)((bufp) + lv + 16 * XA_VP) = st[3]; } while (0)
    __syncthreads();
    XA_LOAD(0); XA_STORE(lds); __syncthreads();
    const unsigned ka = r * XA_KP + hh * 16;
    const int i16 = lane & 15;
    const unsigned va = XA_VOFF + (4 * hh + (i16 >> 2)) * XA_VP + (dvh * 128 + 16 * ((lane >> 4) & 1) + 4 * (i16 & 3)) * 2;
    u32x4 st2[4];
#define XA_LOAD2(t_) do { const bf16_t* s_ = gk + (size_t)(t_) * 32 * 2048; st2[0] = *(const u32x4*)s_; st2[1] = *(const u32x4*)(s_ + 16 * 2048); st2[2] = *(const u32x4*)(s_ + 1024); st2[3] = *(const u32x4*)(s_ + 16 * 2048 + 1024); } while (0)
#define XA_STORE2(bufp) do { *(LAS u32x4*)((bufp) + lk) = st2[0]; *(LAS u32x4*)((bufp) + lk + 16 * XA_KP) = st2[1]; *(LAS u32x4*)((bufp) + lv) = st2[2]; *(LAS u32x4*)((bufp) + lv + 16 * XA_VP) = st2[3]; } while (0)
    XA_LOAD2(1);
#pragma unroll 1
    for (int t = 0; t < 8; t += 2) {
        if (t + 2 < 8) XA_LOAD(t + 2);
        xattn_tile(lds, ka, va, qf, O, mrun, lrun);
        XA_STORE2(lds + XA_BUF);
        lds_barrier();
        if (t + 3 < 8) XA_LOAD2(t + 3);
        xattn_tile(lds + XA_BUF, ka, va, qf, O, mrun, lrun);
        if (t + 2 < 8) XA_STORE(lds);
        lds_barrier();
    }
#undef XA_LOAD2
#undef XA_STORE2
#undef XA_LOAD
#undef XA_STORE
    const float inv = 1.f / xhalf_sum(lrun);
    bf16_t* yp = WSP(bf16_t, WS_Y) + qrow * 3072 + 2048 + h * 256 + dvh * 128;
#pragma unroll
    for (int dt = 0; dt < 4; ++dt)
#pragma unroll
        for (int g4 = 0; g4 < 4; ++g4) { const int dv = dt * 32 + 8 * g4 + 4 * hh;
            u32x2 w; w.x = pk_bf16(O[dt][4 * g4] * inv, O[dt][4 * g4 + 1] * inv); w.y = pk_bf16(O[dt][4 * g4 + 2] * inv, O[dt][4 * g4 + 3] * inv);
            *(u32x2*)(yp + dv) = w; }
}
#ifndef ATTN_NAIVE
#define ATTN_NAIVE 0
#endif
#ifndef XATTN_NAIVE
#define XATTN_NAIVE 0
#endif
#ifndef MLSTM_NAIVE
#define MLSTM_NAIVE 0
#endif
DI void wd_item(PP pk_, int e, LAS unsigned char* lds);
DI void ph_mix(PP pk_, int g, int rep, LAS unsigned char* lds) { const P p = load_args(pk_);
    constexpr int N_ML = BG * 4 * 2, N_AT = BG * 8 * 16, N_XA = BG * 4 * 16;
    const int N_XC = (g + 1 < NGRP) ? TG / 256 : 0;
    const int wd0 = (257 * g) / NGRP, N_WD = (257 * (g + 1)) / NGRP - wd0;
    unsigned* ctr = WSP(unsigned, WS_CTL) + CW_Q + 64 * (g + NGRP * rep);
    for (;;) {
        const int it = next_item(ctr, lds);
        if (it >= N_ML + N_AT + N_XA + N_XC + N_WD) break;
        if (it < N_ML) mlstm_half_item(pk_, g, it, lds);
        else if (it < N_ML + N_AT) { const int ix = it - N_ML; attn_mfma_item(pk_, ((ix & 63) << 4) | (15 - (ix >> 6)), lds); }
        else if (it < N_ML + N_AT + N_XA) xattn_mfma_item(pk_, g, it - N_ML - N_AT, lds);
        else if (it < N_ML + N_AT + N_XA + N_XC) xconv_item(pk_, g + 1, it - (N_ML + N_AT + N_XA), lds);
        else wd_item(pk_, wd0 + it - (N_ML + N_AT + N_XA + N_XC), lds);
    }
}

DI void ph_mlstm_out(PP pk_, int g, LAS unsigned char* lds) { const P p = load_args(pk_);
    const int tid = tid_local(), lane = tid & 63, wave = tid >> 6, gw = bid_local() * 8 + wave, NGW = gridDim.x * 8;
    const bf16_t* HB = WSP(bf16_t, WS_MRG); const bf16_t* U = WSP(bf16_t, WS_U); bf16_t* Y = WSP(bf16_t, WS_Y);
    for (int r0 = gw * 2; r0 < TG; r0 += NGW * 2) {
        u32x2 hw[2][4], ow[2][4]; f32x4 gn[4];
#pragma unroll
        for (int h = 0; h < 4; ++h) gn[h] = *((const f32x4*)(p.mlstm_norm_g + h * 256) + lane);
#pragma unroll
        for (int q = 0; q < 2; ++q)
#pragma unroll
            for (int h = 0; h < 4; ++h) { hw[q][h] = *((const u32x2*)(HB + (size_t)(r0 + q) * 1024 + h * 256) + lane); ow[q][h] = *((const u32x2*)(U + (size_t)(r0 + q) * NU + UMO + h * 256) + lane); }
#pragma unroll
        for (int q = 0; q < 2; ++q)
#pragma unroll
            for (int h = 0; h < 4; ++h) {
                const f32x4 v = {bf_lo(hw[q][h].x), bf_hi(hw[q][h].x), bf_lo(hw[q][h].y), bf_hi(hw[q][h].y)};
                const float mu = wave_sum_fast((v[0] + v[1]) + (v[2] + v[3])) * (1.f / 256.f); const f32x4 d = v - mu;
                const float rstd = rsqrtf(wave_sum_fast((d[0] * d[0] + d[1] * d[1]) + (d[2] * d[2] + d[3] * d[3])) * (1.f / 256.f) + LN_EPS);
                u32x2 o; o.x = cvt_pk_bf16(d[0] * rstd * gn[h][0] * sigm(bf_lo(ow[q][h].x)), d[1] * rstd * gn[h][1] * sigm(bf_hi(ow[q][h].x))); o.y = cvt_pk_bf16(d[2] * rstd * gn[h][2] * sigm(bf_lo(ow[q][h].y)), d[3] * rstd * gn[h][3] * sigm(bf_hi(ow[q][h].y)));
                *((u32x2*)(Y + (size_t)(r0 + q) * 3072 + 1024 + h * 256) + lane) = o; }
    }
}

DI void ph_ln1(PP pk_, int g, LAS unsigned char* lds) { const P p = load_args(pk_);
    const int tid = tid_local(), lane = tid & 63, wave = tid >> 6, gw = bid_local() * 8 + wave, NGW = gridDim.x * 8;
    const float* Z = WSP(float, WS_Z); bf16_t* X1 = WSP(bf16_t, WS_X1B) + (size_t)g * TG * 1024;
    for (int r0 = gw * 2; r0 < TG; r0 += NGW * 2) {
        f32x4 v[2][4];
#pragma unroll
        for (int q = 0; q < 2; ++q)
#pragma unroll
            for (int j = 0; j < 4; ++j) v[q][j] = *((const f32x4*)(Z + (size_t)(r0 + q) * 1024) + lane + 64 * j);
#pragma unroll
        for (int q = 0; q < 2; ++q) { float s = 0.f;
#pragma unroll
            for (int j = 0; j < 4; ++j) s += (v[q][j][0] + v[q][j][1]) + (v[q][j][2] + v[q][j][3]);
            const float mu = wave_sum(s) * (1.f / 1024.f); float s2 = 0.f;
#pragma unroll
            for (int j = 0; j < 4; ++j) { v[q][j] = v[q][j] - mu; s2 += (v[q][j][0] * v[q][j][0] + v[q][j][1] * v[q][j][1]) + (v[q][j][2] * v[q][j][2] + v[q][j][3] * v[q][j][3]); }
            const float rstd = rsqrtf(wave_sum(s2) * (1.f / 1024.f) + LN_EPS);
            u32x2* d = (u32x2*)(X1 + (size_t)(r0 + q) * 1024) + lane;
#pragma unroll
            for (int j = 0; j < 4; ++j) { const f32x4 gn = *((const f32x4*)p.ln1_g + lane + 64 * j), bb = *((const f32x4*)p.ln1_b + lane + 64 * j); const f32x4 o = v[q][j] * rstd * gn + bb;
                u32x2 w; w.x = cvt_pk_bf16(o[0], o[1]); w.y = cvt_pk_bf16(o[2], o[3]); d[64 * j] = w; } }
    }
}
DI void ph_expert_weights(PP pk_, LAS unsigned char* lds) { const P p = load_args(pk_);
    const int tid = tid_local(), lane = tid & 63, wave = tid >> 6, gw = bid_local() * 8 + wave, NGW = gridDim.x * 8;
    LAS float* scr = (LAS float*)(lds + wave * 16384);
    bf16_t* WGU = WSP(bf16_t, WS_WGU); bf16_t* WD = WSP(bf16_t, WS_WD);
    for (int it = gw; it < 257 * 256; it += NGW) { const int e = it >> 8, r = it & 255, isup = r >> 7, kb = (r >> 3) & 15, nb = r & 7;
        const float* W = (e < 256) ? ((isup ? p.w_e_up : p.w_e_gate) + (size_t)e * 1024 * 256) : (isup ? p.w_s_up : p.w_s_gate);
        const int n0 = nb * 32, drow = (n0 >> 7) * 256 + (n0 & 127) + isup * 128;
        transpose_item(W, 256, n0, WGU + (size_t)e * 512 * 1024, 1024, drow, kb * 64, scr, lane); }
}
DI void wd_item(PP pk_, int e, LAS unsigned char* lds) { const P p = load_args(pk_);
    const int tid = tid_local(), lane = tid & 63, wave = tid >> 6;
    __syncthreads();
    LAS float* scr = (LAS float*)(lds + wave * 16384);
    bf16_t* WD = WSP(bf16_t, WS_WD);
    const float* W = (e < 256) ? (p.w_e_down + (size_t)e * 256 * 1024) : p.w_s_down;
#pragma unroll 1
    for (int r = wave; r < 128; r += 8) { const int kb = r >> 5, nb = r & 31; transpose_item(W, 1024, nb * 32, WD + (size_t)e * 1024 * 256, 256, nb * 32, kb * 64, scr, lane); }
}

template <int CTRL> DI int dppi(int v) { return __builtin_amdgcn_update_dpp(0, v, CTRL, 0xf, 0xf, true); }
#define ARGMAX_STEP(CTRL) do { const float ov_ = dppf<CTRL>(bv); const int oi_ = dppi<CTRL>(bi); if (ov_ > bv || (ov_ == bv && oi_ < bi)) { bv = ov_; bi = oi_; } } while (0)
DI void ph_topk(PP pk_, LAS unsigned char* lds) { const P p = load_args(pk_);
    const int tid = tid_local(), lane = tid & 63, wave = tid >> 6, gw = bid_local() * 8 + wave, NGW = gridDim.x * 8;
    const float* LG = WSP(float, WS_LOGIT); int* TKI = WSP(int, WS_TKI); float* TKW = WSP(float, WS_TKW); unsigned* cnt = WSP(unsigned, WS_CTL) + CW_CNT;
    int* tokof = WSP(int, WS_TOKOF); float* wof = WSP(float, WS_WOF);
    for (int i = bid_local() * 512 + tid; i < MAXRT * 256; i += gridDim.x * 512) { tokof[i] = 0; wof[i] = 0.f; }
    const f32x4 rb = *((const f32x4*)p.router_bias + lane);
    f32x4 lgn = *((const f32x4*)(LG + (size_t)gw * 256) + lane);
    for (int t = gw; t < T_ALL; t += NGW) {
        const f32x4 lg = lgn; if (t + NGW < T_ALL) lgn = *((const f32x4*)(LG + (size_t)(t + NGW) * 256) + lane);
        float sc[4], ch[4];
#pragma unroll
        for (int j = 0; j < 4; ++j) { sc[j] = 1.f / (1.f + expf(-lg[j])); ch[j] = sc[j] + rb[j]; }
        const float m01 = fmaxf(ch[0], ch[1]), n01 = fminf(ch[0], ch[1]), m23 = fmaxf(ch[2], ch[3]), n23 = fminf(ch[2], ch[3]);
        float a1 = fmaxf(m01, m23), a2 = fmaxf(fminf(m01, m23), fmaxf(n01, n23));
        { float b1 = dppf<0xB1>(a1), b2 = dppf<0xB1>(a2); float n1 = fmaxf(a1, b1), n2 = fmaxf(fminf(a1, b1), fmaxf(a2, b2)); a1 = n1; a2 = n2;
          b1 = dppf<0x4E>(a1); b2 = dppf<0x4E>(a2); n1 = fmaxf(a1, b1); n2 = fmaxf(fminf(a1, b1), fmaxf(a2, b2)); a1 = n1; a2 = n2;
          b1 = dppf<0x141>(a1); b2 = dppf<0x141>(a2); n1 = fmaxf(a1, b1); n2 = fmaxf(fminf(a1, b1), fmaxf(a2, b2)); a1 = n1; a2 = n2; }
        const float gs = a1 + a2; const int myg = lane >> 3; int rank = 0;
#pragma unroll
        for (int g2 = 0; g2 < 8; ++g2) { const float og = rdlane(gs, 8 * g2); rank += (og > gs || (og == gs && g2 < myg)) ? 1 : 0; }
        if (rank >= 4) { ch[0] = -INFINITY; ch[1] = -INFINITY; ch[2] = -INFINITY; ch[3] = -INFINITY; }
        int myidx = 0; float mys = 0.f, ssum = 0.f;
#pragma unroll
        for (int r = 0; r < 8; ++r) {
            float bv = ch[0]; int bi = 4 * lane;
#pragma unroll
            for (int j = 1; j < 4; ++j) if (ch[j] > bv) { bv = ch[j]; bi = 4 * lane + j; }
            ARGMAX_STEP(0xB1); ARGMAX_STEP(0x4E); ARGMAX_STEP(0x124); ARGMAX_STEP(0x128);
            { float v0 = rdlane(bv, 0), v1 = rdlane(bv, 16), v2 = rdlane(bv, 32), v3 = rdlane(bv, 48);
              int i0 = __builtin_amdgcn_readlane(bi, 0), i1 = __builtin_amdgcn_readlane(bi, 16), i2 = __builtin_amdgcn_readlane(bi, 32), i3 = __builtin_amdgcn_readlane(bi, 48);
              if (v1 > v0 || (v1 == v0 && i1 < i0)) { v0 = v1; i0 = i1; } if (v3 > v2 || (v3 == v2 && i3 < i2)) { v2 = v3; i2 = i3; } if (v2 > v0 || (v2 == v0 && i2 < i0)) { v0 = v2; i0 = i2; }
              bv = v0; bi = i0; }
            const int jl = bi & 3; const float scsel = jl == 0 ? sc[0] : (jl == 1 ? sc[1] : (jl == 2 ? sc[2] : sc[3]));
            const float sv = __builtin_bit_cast(float, __builtin_amdgcn_readlane(__builtin_bit_cast(int, scsel), bi >> 2));
            if ((bi >> 2) == lane) { if (jl == 0) ch[0] = -INFINITY; else if (jl == 1) ch[1] = -INFINITY; else if (jl == 2) ch[2] = -INFINITY; else ch[3] = -INFINITY; }
            ssum += sv; if (lane == r) { myidx = bi; mys = sv; }
        }
        if (lane < 8) { TKI[(size_t)t * 8 + lane] = myidx; TKW[(size_t)t * 8 + lane] = mys / (ssum + 1e-20f) * 2.5f; atomicAdd(cnt + myidx, 1u); }
    }
}
#undef ARGMAX_STEP

DI void ph_slots(PP pk_, LAS unsigned char* lds) { const P p = load_args(pk_);
    const int tid = tid_local();
    const unsigned* cnt = WSP(unsigned, WS_CTL) + CW_CNT; int* tbase = WSP(int, WS_MISC + MS_TBASE); int* nt = WSP(int, WS_MISC + MS_NT); int* tile_e = WSP(int, WS_MISC + MS_TILEE);
    LAS int* sb = (LAS int*)lds;
    __syncthreads();
    if (tid < 256) sb[tid] = (int)((cnt[tid] + 255u) >> 8);
    __syncthreads();
    if (tid == 0) { int a = 0; for (int e = 0; e < 256; ++e) { const int n = sb[e]; sb[e] = a; a += n; } sb[256] = a; }
    __syncthreads();
    const int nrt = sb[256];
    if (bid_local() == 0) {
        if (tid < 256) { const int b0 = sb[tid], b1 = sb[tid + 1]; tbase[tid] = b0; for (int t = b0; t < b1; ++t) tile_e[t] = tid; tile_e[nrt + tid] = 256; }
        if (tid == 0) { tbase[256] = nrt; nt[0] = nrt; nt[1] = nrt + 256; }
    }
    const int* TKI = WSP(int, WS_TKI); const float* TKW = WSP(float, WS_TKW); unsigned* cur = WSP(unsigned, WS_CTL) + CW_CUR;
    int* tokof = WSP(int, WS_TOKOF); float* wof = WSP(float, WS_WOF); int* slotof = WSP(int, WS_SLOTOF);
    const int s0 = nrt * 256;
    for (int i0 = bid_local() * 512 + tid; i0 < T_ALL * 2; i0 += gridDim.x * 512) {
        int e[4]; float wv[4]; int sl[4];
#pragma unroll
        for (int q = 0; q < 4; ++q) { e[q] = TKI[i0 + q * (T_ALL * 2)]; wv[q] = TKW[i0 + q * (T_ALL * 2)]; }
#pragma unroll
        for (int q = 0; q < 4; ++q) sl[q] = sb[e[q]] * 256 + (int)atomicAdd(cur + e[q], 1u);
#pragma unroll
        for (int q = 0; q < 4; ++q) { const int i = i0 + q * (T_ALL * 2); tokof[sl[q]] = i >> 3; wof[sl[q]] = wv[q]; slotof[i] = sl[q]; } }
    for (int t = bid_local() * 512 + tid; t < T_ALL; t += gridDim.x * 512) { tokof[s0 + t] = t; wof[s0 + t] = 1.f; }
    __syncthreads();
}

DI void ph_combine(PP pk_, int round, LAS unsigned char* lds) { const P p = load_args(pk_);
    const int tid = tid_local();
    const unsigned char* Y = WSP(unsigned char, WS_YCH); const bf16_t* X1 = WSP(bf16_t, WS_X1B); const int* slotof = WSP(int, WS_SLOTOF); const int s0 = WSP(int, WS_MISC + MS_TBASE)[256] * 256;
    for (int i0 = bid_local() * 512 + tid; i0 < T_ALL * 32; i0 += gridDim.x * 512) {
        int slot[2][9]; u32x4 xw[2];
#pragma unroll
        for (int q = 0; q < 2; ++q) { const int i = i0 + q * (T_ALL * 32), t = i >> 6, c8 = (i & 63) * 8; xw[q] = *(const u32x4*)(X1 + (size_t)t * 1024 + round * 512 + c8);
            const u32x4 sa = *(const u32x4*)(slotof + (size_t)t * 8), sb = *(const u32x4*)(slotof + (size_t)t * 8 + 4);
            slot[q][0] = sa.x; slot[q][1] = sa.y; slot[q][2] = sa.z; slot[q][3] = sa.w; slot[q][4] = sb.x; slot[q][5] = sb.y; slot[q][6] = sb.z; slot[q][7] = sb.w; slot[q][8] = s0 + t; }
        u32x2 yw[2][9];
#pragma unroll
        for (int q = 0; q < 2; ++q) { const int c8 = ((i0 + q * (T_ALL * 32)) & 63) * 8;
#pragma unroll
            for (int k = 0; k < 9; ++k) yw[q][k] = *(const u32x2*)(Y + (size_t)slot[q][k] * 512 + c8); }
#pragma unroll
        for (int q = 0; q < 2; ++q) { const int i = i0 + q * (T_ALL * 32), t = i >> 6, c8 = (i & 63) * 8;
            float a[8];
#pragma unroll
            for (int e = 0; e < 8; ++e) a[e] = 0.f;
#pragma unroll
            for (int k = 0; k < 9; ++k) { const u32x2 w = yw[q][k];
                const f32x2 v0 = __builtin_amdgcn_cvt_pk_f32_fp8((int)w.x, false), v1 = __builtin_amdgcn_cvt_pk_f32_fp8((int)w.x, true), v2 = __builtin_amdgcn_cvt_pk_f32_fp8((int)w.y, false), v3 = __builtin_amdgcn_cvt_pk_f32_fp8((int)w.y, true);
                a[0] += v0[0]; a[1] += v0[1]; a[2] += v1[0]; a[3] += v1[1]; a[4] += v2[0]; a[5] += v2[1]; a[6] += v3[0]; a[7] += v3[1]; }
            constexpr float is = 1.f / Y8_SCALE; const u32x4 x = xw[q];
            float* op = p.out + (size_t)t * 1024 + round * 512 + c8;
            *(f32x4*)op = (f32x4){bf_lo(x.x) * ALPHA + a[0] * is, bf_hi(x.x) * ALPHA + a[1] * is, bf_lo(x.y) * ALPHA + a[2] * is, bf_hi(x.y) * ALPHA + a[3] * is};
            *(f32x4*)(op + 4) = (f32x4){bf_lo(x.z) * ALPHA + a[4] * is, bf_hi(x.z) * ALPHA + a[5] * is, bf_lo(x.w) * ALPHA + a[6] * is, bf_hi(x.w) * ALPHA + a[7] * is}; }
    }
}

DI void ph_combine_ln2(PP pk_, LAS unsigned char* lds) { const P p = load_args(pk_);
    const int tid = tid_local(), lane = tid & 63, wave = tid >> 6, gw = bid_local() * 8 + wave, NGW = gridDim.x * 8;
    const unsigned char* Y = WSP(unsigned char, WS_YCH); const bf16_t* X1 = WSP(bf16_t, WS_X1B); const int* slotof = WSP(int, WS_SLOTOF); const int s0 = WSP(int, WS_MISC + MS_TBASE)[256] * 256;
    const f32x4 ga0 = *((const f32x4*)p.ln2_g + 2 * lane), ga1 = *((const f32x4*)p.ln2_g + 2 * lane + 1), gb0 = *((const f32x4*)p.ln2_g + 128 + 2 * lane), gb1 = *((const f32x4*)p.ln2_g + 128 + 2 * lane + 1);
    const f32x4 ba0 = *((const f32x4*)p.ln2_b + 2 * lane), ba1 = *((const f32x4*)p.ln2_b + 2 * lane + 1), bb0 = *((const f32x4*)p.ln2_b + 128 + 2 * lane), bb1 = *((const f32x4*)p.ln2_b + 128 + 2 * lane + 1);
    for (int t0 = gw * 2; t0 < T_ALL; t0 += NGW * 2) {
        int slot[2][9]; u32x4 xw[2]; f32x4 z0[2][2]; u32x2 yw[2][9];
#pragma unroll
        for (int q = 0; q < 2; ++q) { const int t = t0 + q; xw[q] = *(const u32x4*)(X1 + (size_t)t * 1024 + 512 + 8 * lane);
            z0[q][0] = *((const f32x4*)(p.out + (size_t)t * 1024) + 2 * lane); z0[q][1] = *((const f32x4*)(p.out + (size_t)t * 1024) + 2 * lane + 1);
            const u32x4 sa = *(const u32x4*)(slotof + (size_t)t * 8), sb = *(const u32x4*)(slotof + (size_t)t * 8 + 4);
            slot[q][0] = sa.x; slot[q][1] = sa.y; slot[q][2] = sa.z; slot[q][3] = sa.w; slot[q][4] = sb.x; slot[q][5] = sb.y; slot[q][6] = sb.z; slot[q][7] = sb.w; slot[q][8] = s0 + t; }
#pragma unroll
        for (int q = 0; q < 2; ++q)
#pragma unroll
            for (int k = 0; k < 9; ++k) yw[q][k] = *(const u32x2*)(Y + (size_t)slot[q][k] * 512 + 8 * lane);
#pragma unroll
        for (int q = 0; q < 2; ++q) { const int t = t0 + q;
            float a[8];
#pragma unroll
            for (int e = 0; e < 8; ++e) a[e] = 0.f;
#pragma unroll
            for (int k = 0; k < 9; ++k) { const u32x2 w = yw[q][k];
                const f32x2 v0 = __builtin_amdgcn_cvt_pk_f32_fp8((int)w.x, false), v1 = __builtin_amdgcn_cvt_pk_f32_fp8((int)w.x, true), v2 = __builtin_amdgcn_cvt_pk_f32_fp8((int)w.y, false), v3 = __builtin_amdgcn_cvt_pk_f32_fp8((int)w.y, true);
                a[0] += v0[0]; a[1] += v0[1]; a[2] += v1[0]; a[3] += v1[1]; a[4] += v2[0]; a[5] += v2[1]; a[6] += v3[0]; a[7] += v3[1]; }
            constexpr float is = 1.f / Y8_SCALE; const u32x4 x = xw[q];
            f32x4 c0 = {bf_lo(x.x) * ALPHA + a[0] * is, bf_hi(x.x) * ALPHA + a[1] * is, bf_lo(x.y) * ALPHA + a[2] * is, bf_hi(x.y) * ALPHA + a[3] * is};
            f32x4 c1 = {bf_lo(x.z) * ALPHA + a[4] * is, bf_hi(x.z) * ALPHA + a[5] * is, bf_lo(x.w) * ALPHA + a[6] * is, bf_hi(x.w) * ALPHA + a[7] * is};
            f32x4 d0 = z0[q][0], d1 = z0[q][1];
            const float mu = wave_sum(((c0[0] + c0[1]) + (c0[2] + c0[3])) + ((c1[0] + c1[1]) + (c1[2] + c1[3])) + ((d0[0] + d0[1]) + (d0[2] + d0[3])) + ((d1[0] + d1[1]) + (d1[2] + d1[3]))) * (1.f / 1024.f);
            c0 = c0 - mu; c1 = c1 - mu; d0 = d0 - mu; d1 = d1 - mu;
            const float rstd = rsqrtf(wave_sum(((c0[0] * c0[0] + c0[1] * c0[1]) + (c0[2] * c0[2] + c0[3] * c0[3])) + ((c1[0] * c1[0] + c1[1] * c1[1]) + (c1[2] * c1[2] + c1[3] * c1[3]))
                                             + ((d0[0] * d0[0] + d0[1] * d0[1]) + (d0[2] * d0[2] + d0[3] * d0[3])) + ((d1[0] * d1[0] + d1[1] * d1[1]) + (d1[2] * d1[2] + d1[3] * d1[3]))) * (1.f / 1024.f) + LN_EPS);
            f32x4* o = (f32x4*)(p.out + (size_t)t * 1024);
            o[2 * lane] = d0 * rstd * ga0 + ba0; o[2 * lane + 1] = d1 * rstd * ga1 + ba1; o[128 + 2 * lane] = c0 * rstd * gb0 + bb0; o[128 + 2 * lane + 1] = c1 * rstd * gb1 + bb1; }
    }
}

DI void ph_ln2(PP pk_, LAS unsigned char* lds) { const P p = load_args(pk_);
    const int tid = tid_local(), lane = tid & 63, wave = tid >> 6, gw = bid_local() * 8 + wave, NGW = gridDim.x * 8;
    for (int r0 = gw * 2; r0 < T_ALL; r0 += NGW * 2) {
        f32x4 v[2][4];
#pragma unroll
        for (int q = 0; q < 2; ++q)
#pragma unroll
            for (int j = 0; j < 4; ++j) v[q][j] = *((const f32x4*)(p.out + (size_t)(r0 + q) * 1024) + lane + 64 * j);
#pragma unroll
        for (int q = 0; q < 2; ++q) { float s = 0.f;
#pragma unroll
            for (int j = 0; j < 4; ++j) s += (v[q][j][0] + v[q][j][1]) + (v[q][j][2] + v[q][j][3]);
            const float mu = wave_sum(s) * (1.f / 1024.f); float s2 = 0.f;
#pragma unroll
            for (int j = 0; j < 4; ++j) { v[q][j] = v[q][j] - mu; s2 += (v[q][j][0] * v[q][j][0] + v[q][j][1] * v[q][j][1]) + (v[q][j][2] * v[q][j][2] + v[q][j][3] * v[q][j][3]); }
            const float rstd = rsqrtf(wave_sum(s2) * (1.f / 1024.f) + LN_EPS);
            f32x4* zr = (f32x4*)(p.out + (size_t)(r0 + q) * 1024) + lane;
#pragma unroll
            for (int j = 0; j < 4; ++j) { const f32x4 gn = *((const f32x4*)p.ln2_g + lane + 64 * j), bb = *((const f32x4*)p.ln2_b + lane + 64 * j); zr[64 * j] = v[q][j] * rstd * gn + bb; } }
    }
}

__global__ void __launch_bounds__(512, 2) fwd(P p_unused) {
    extern __shared__ __attribute__((aligned(16))) unsigned char lds_raw[];
    LAS unsigned char* lds = (LAS unsigned char*)lds_raw;
    const int tid = threadIdx.x, G = gridDim.x;
#define bid bid_local()
    volatile LAS unsigned* MISC = (volatile LAS unsigned*)(lds + LDS_MISC);
    if (tid < 32) MISC[tid] = 0u;
    __syncthreads();
    XcdBarrier bar; { unsigned* bw = (unsigned*)(kargs()->ws + WS_CTL) + CW_BAR; bar.bar = bw; bar.x = 0; bar.st = nullptr; bar = xcd_barrier_post(bw, MISC + 8); }
#ifndef PROBE_TYPE
#define PROBE_TYPE -1
#define PROBE_REPS 1
#endif
#define STEP_BEGIN(type) { const int reps_ = ((type) == PROBE_TYPE) ? PROBE_REPS : 1; for (int rep_ = 0; rep_ < reps_; ++rep_) { PP pk_ = kargs(); const P p = load_args(pk_);
#define STEP_END xcd_barrier(bar); } }
#define STEP_END_LAST if (rep_ + 1 < reps_) xcd_barrier(bar); } }

    STEP_BEGIN(0) ph_prologue(pk_, lds); __syncthreads(); ph_xconv(pk_, 0, lds); STEP_END
    for (int g = 0; g < NGRP; ++g) {
        STEP_BEGIN(2) {
            if (g > 0) { ph_ln1(pk_, g - 1, lds); __syncthreads(); }
            pg8::Gemm gm{WSP(bf16_t, WS_XB), WSP(bf16_t, WS_WIN), 1024, 1024, 1024, nullptr}; pg8::StaticOrder S; S.init(TG, NU, G, bid);
            EpiInProj E{WSP(bf16_t, WS_U), WSP(float, WS_MISC + MS_BIAS)};
            pg8::gemm_phase<EpiInProj, pg8::StaticOrder, true>(lds, gm, S, E);
            if (g == 0) {
                pg8::Gemm gk{WSP(bf16_t, WS_MEMB), WSP(bf16_t, WS_WKV), 1024, 1024, 1024, nullptr}; pg8::StaticOrder S2; S2.init(NBATCH * 256, 2048, G, bid);
                EpiPlain E2{WSP(bf16_t, WS_KVM), 2048};
                pg8::gemm_phase<EpiPlain, pg8::StaticOrder, true>(lds, gk, S2, E2);
            }
        } STEP_END
        STEP_BEGIN(4) ph_conv(pk_, g, lds); STEP_END
        STEP_BEGIN(3) ph_mix(pk_, g, rep_, lds); STEP_END
        STEP_BEGIN(16) ph_mlstm_out(pk_, g, lds); STEP_END
        STEP_BEGIN(5) {
            pg8::Gemm gm{WSP(bf16_t, WS_Y), WSP(bf16_t, WS_WBR), 3072, 3072, 3072, nullptr}; pg8::StaticOrder S; S.init(TG, 1024, G, bid);
            EpiBranch2 E{WSP(bf16_t, WS_U), WSP(bf16_t, WS_MRG)}; MidBranch MB{WSP(bf16_t, WS_U)};
            pg8::gemm_phase<EpiBranch2, pg8::StaticOrder, true, false, MidBranch>(lds, gm, S, E, MB);
        } STEP_END
        STEP_BEGIN(6) {
            pg8::Gemm gm{WSP(bf16_t, WS_MRG), WSP(bf16_t, WS_WOUT), 1024, 1024, 1024, nullptr}; pg8::StaticOrder S; S.init(TG, 1024, G, bid);
            EpiOutProj E{p.x + (size_t)g * TG * 1024, WSP(float, WS_Z)};
            pg8::gemm_phase<EpiOutProj, pg8::StaticOrder, true>(lds, gm, S, E);
        } STEP_END
        if (g == NGRP - 1) { STEP_BEGIN(7) ph_ln1(pk_, g, lds); STEP_END }
    }
    STEP_BEGIN(8) {
        pg8::Gemm gm{WSP(bf16_t, WS_X1B), WSP(bf16_t, WS_WR), 1024, 1024, 1024, nullptr}; pg8::StaticOrder S; S.init(T_ALL, 256, G, bid);
        EpiF32 E{WSP(float, WS_LOGIT), 256};
        pg8::gemm_phase<EpiF32, pg8::StaticOrder, true>(lds, gm, S, E);
        ph_expert_weights(pk_, lds);
    } STEP_END
    STEP_BEGIN(9) ph_topk(pk_, lds); STEP_END
    STEP_BEGIN(11) ph_slots(pk_, lds); STEP_END
    STEP_BEGIN(12) {
        const int* ntp = WSP(int, WS_MISC + MS_NT);
        pg8::Gemm gm{WSP(bf16_t, WS_X1B), WSP(bf16_t, WS_WGU), 1024, 1024, 1024, WSP(int, WS_TOKOF)}; ExpertGUOrder S{WSP(int, WS_MISC + MS_TILEE), ntp[1] * 2, G, (G % 8 == 0) ? (bid % 8) * (G / 8) + bid / 8 : bid};
        EpiGateUp E{WSP(bf16_t, WS_ACT)};
        pg8::gemm_phase<EpiGateUp, ExpertGUOrder, true, true>(lds, gm, S, E);
    } STEP_END
    for (int r = 0; r < 2; ++r) {
        STEP_BEGIN(13) {
            const int* ntp = WSP(int, WS_MISC + MS_NT);
            pg8::Gemm gm{WSP(bf16_t, WS_ACT), WSP(bf16_t, WS_WD), 256, 256, 256, nullptr}; ExpertDownOrder S{WSP(int, WS_MISC + MS_TILEE), ntp[1] * 2, G, (G % 8 == 0) ? (bid % 8) * (G / 8) + bid / 8 : bid, r};
            EpiDown E{WSP(unsigned char, WS_YCH), WSP(float, WS_WOF)};
            pg8::gemm_phase<EpiDown, ExpertDownOrder, true>(lds, gm, S, E);
        } STEP_END
        if (r == 0) { STEP_BEGIN(14) ph_combine(pk_, 0, lds); STEP_END }
    }
#if PROBE_TYPE == 99
    for (int xb = 0; xb < 20; ++xb) xcd_barrier(bar);
#endif
    STEP_BEGIN(15) ph_combine_ln2(pk_, lds); STEP_END_LAST
}
constexpr int NSTEPS = 1 + NGRP * 6 + 1 + 4 + 3 + 1;

extern "C" void kernel_launch(void* const* d_in, const int* in_sizes, int n_in, void* d_out, int out_size, void* d_ws, size_t ws_size, hipStream_t stream) {
    static int grid = 0;
    if (grid == 0) {
        int dev = 0, cus = 0;
        if (hipGetDevice(&dev) != hipSuccess || hipDeviceGetAttribute(&cus, hipDeviceAttributeMultiprocessorCount, dev) != hipSuccess) { fprintf(stderr, "kernel_launch: device query failed\n"); grid = -1; return; }
        if (hipFuncSetAttribute((const void*)fwd, hipFuncAttributeMaxDynamicSharedMemorySize, LDS_BYTES) != hipSuccess) { fprintf(stderr, "kernel_launch: hipFuncSetAttribute failed\n"); grid = -1; return; }
        if (n_in != 24 || ws_size < WS_END) fprintf(stderr, "kernel_launch: n_in %d ws %zu (need %zu)\n", n_in, ws_size, (size_t)WS_END);
        grid = cus;
    }
    if (grid < 0) return;
    (void)hipMemsetAsync((char*)d_ws + WS_CTL, 0, CTL_BYTES, stream);
    P p{};
    const float** pp = (const float**)&p;
    for (int i = 0; i < 24; ++i) pp[i] = (const float*)d_in[i];
    p.out = (float*)d_out; p.ws = (unsigned char*)d_ws;
    p.s_lo = 0; p.s_hi = NSTEPS; hipLaunchKernelGGL(fwd, dim3(grid), dim3(512), LDS_BYTES, stream, p);
}
```

```cpp
#include <hip/hip_runtime.h>
#include <cstdio>
#include <cstdint>
#define DI __device__ __forceinline__
#define LAS __attribute__((address_space(3)))
#define GAS __attribute__((address_space(1)))
typedef unsigned short bf16_t;
typedef short bf16x8 __attribute__((ext_vector_type(8)));
typedef float f32x4 __attribute__((ext_vector_type(4)));
typedef float f32x2 __attribute__((ext_vector_type(2)));
typedef unsigned u32x4 __attribute__((ext_vector_type(4)));
typedef unsigned u32x2 __attribute__((ext_vector_type(2)));

constexpr int T_ALL = 65536, DM = 1024, SEQ = 2048, NBATCH = 32, NGRP = 4, TG = T_ALL / NGRP, BG = NBATCH / NGRP;
constexpr int NU = 11264, CIN = 11272;
constexpr int UQ = 0, UK = 1024, UV = 2048, UMQ = 3072, UMK = 4096, UMV = 5120, UMO = 6144, UCQ = 7168, UGT = 8192;
constexpr int NEXP = 256, MAXRT = 2304, MAXTILES = MAXRT + 256, MAXSLOTS = MAXTILES * 256;
constexpr float ALPHA = 1.189207115002721f;
constexpr float LN_EPS = 1e-5f;

constexpr size_t MiB = 1ull << 20;
constexpr size_t WS_CTL = 0, CTL_BYTES = 1 * MiB;
constexpr size_t WS_MISC = 1 * MiB;
constexpr size_t WS_WIN = 2 * MiB, WS_WKV = 24 * MiB, WS_WBR = 28 * MiB, WS_WOUT = 34 * MiB, WS_WR = 36 * MiB;
constexpr size_t WS_GIF = 38 * MiB, WS_MEMB = 40 * MiB, WS_KVM = 56 * MiB, WS_X1B = 88 * MiB, WS_R = 216 * MiB;
constexpr size_t WS_XB = WS_R, WS_U = WS_R + 32 * MiB, WS_Y = WS_R + 384 * MiB, WS_F32 = WS_R + 480 * MiB, WS_MRG = WS_R + 544 * MiB, WS_Z = WS_R + 576 * MiB, WS_QKC = WS_R + 640 * MiB;
constexpr size_t WS_TKI = WS_R, WS_TKW = WS_R + 2 * MiB, WS_SLOTOF = WS_R + 4 * MiB, WS_TOKOF = WS_R + 6 * MiB, WS_WOF = WS_R + 9 * MiB;
constexpr size_t WS_LOGIT = WS_R + 16 * MiB, WS_WGU = WS_R + 80 * MiB, WS_WD = WS_R + 704 * MiB  , WS_ACT = WS_R + 337 * MiB, WS_YCH = WS_R + 16 * MiB;
constexpr size_t WS_END = WS_R + 900 * MiB;
constexpr size_t MS_BIAS = 0, MS_LAM = 48 * 1024, MS_TBASE = 52 * 1024, MS_NT = 56 * 1024, MS_TILEE = 64 * 1024;
constexpr int CW_CNT = 1024, CW_CUR = 2048, CW_BAR = 8192, CW_Q = 16384;

constexpr int LDS_RING = 147456, LDS_MISC = LDS_RING + 320, LDS_BYTES = 155648;

DI float bf_lo(unsigned w) { return __uint_as_float(w << 16); }
DI float bf_hi(unsigned w) { return __uint_as_float(w & 0xffff0000u); }
DI float bf2f(bf16_t b) { return __uint_as_float((unsigned)b << 16); }
DI unsigned cvt_pk_bf16(float lo, float hi) { unsigned r; asm("v_cvt_pk_bf16_f32 %0, %1, %2" : "=v"(r) : "v"(lo), "v"(hi)); return r; }
template <int CTRL> DI float dppf(float v) { return __builtin_bit_cast(float, __builtin_amdgcn_update_dpp(0, __builtin_bit_cast(int, v), CTRL, 0xf, 0xf, true)); }
DI float row16_sum(float v) { v += dppf<0xB1>(v); v += dppf<0x4E>(v); v += dppf<0x124>(v); v += dppf<0x128>(v); return v; }
DI float rdlane(float v, int l) { return __builtin_bit_cast(float, __builtin_amdgcn_readlane(__builtin_bit_cast(int, v), l)); }
DI float wave_sum_fast(float v) { v = row16_sum(v); return (rdlane(v, 0) + rdlane(v, 16)) + (rdlane(v, 32) + rdlane(v, 48)); }
DI float wave_sum(float v) { return wave_sum_fast(v); }
DI float row16_max(float v) { v = fmaxf(v, dppf<0xB1>(v)); v = fmaxf(v, dppf<0x4E>(v)); v = fmaxf(v, dppf<0x124>(v)); v = fmaxf(v, dppf<0x128>(v)); return v; }
DI float wave_max(float v) { v = row16_max(v); return fmaxf(fmaxf(rdlane(v, 0), rdlane(v, 16)), fmaxf(rdlane(v, 32), rdlane(v, 48))); }
DI float bperm(float v, int src) { return __builtin_bit_cast(float, __builtin_amdgcn_ds_bpermute(src << 2, __builtin_bit_cast(int, v))); }
DI int bperm_i(int v, int src) { return __builtin_amdgcn_ds_bpermute(src << 2, v); }
DI float sigm(float x) { return 1.f / (1.f + __expf(-x)); }
DI float silu(float x) { return x / (1.f + __expf(-x)); }
DI float zero_local() { float z = 0.f; asm volatile("" : "+v"(z)); return z; }
DI int bid_local() { int b = blockIdx.x; asm volatile("" : "+s"(b)); return b; }
DI int tid_local() { int t = threadIdx.x; asm volatile("" : "+v"(t)); return t; }
DI void lds_barrier() { asm volatile("s_waitcnt lgkmcnt(0)" ::: "memory"); __builtin_amdgcn_s_barrier(); asm volatile("" ::: "memory"); }
#define LDS_WAIT() asm volatile("s_waitcnt lgkmcnt(0)" ::: "memory")
namespace pg8 {
constexpr int BM = 256, BK = 64, HALF = 128, HTB = HALF * BK * 2, STAGE_BYTES = 8 * HTB, NXCD = 8, WGM = 8;
__host__ __device__ __forceinline__ int lds_byte(int r, int c) { const int st = (r >> 4) * 2 + (c >> 5), rr = r & 15, cc = c & 31, ob = rr * 64 + cc * 2; return st * 1024 + (ob ^ (((ob >> 9) & 1) << 5)); }
__host__ __device__ __forceinline__ void stage_rc(int b, int& R, int& C) { const int st = b / 1024, sb = b % 1024, swz = sb ^ (((sb >> 9) & 1) << 5); R = (st >> 1) * 16 + swz / 64; C = (st & 1) * 32 + (swz % 64) / 2; }
__host__ __device__ __forceinline__ int perm32(int rho) { const int n = rho >> 4, i = rho & 15; return 8 * (i >> 2) + 4 * n + (i & 3); }

struct Unit { int pm, pn, pb, acol, aux; };
struct Gemm { const bf16_t* A; const bf16_t* Bt; int lda, ldb, K; const int* arow; };

struct StaticOrder {
    int nM, nN, nwg, G, c;
    DI void init(int M, int N, int G_, int c_) { nM = M / BM; nN = N / BM; nwg = nM * nN; G = G_; c = c_; }
    DI bool next(int i, Unit& u) const {
        const long L = (long)i * G + c; if (L >= nwg) return false;
        int wgid = (int)L; { const int q = nwg / NXCD, r = nwg % NXCD, xcd = wgid % NXCD, off = wgid / NXCD; wgid = (xcd < r ? xcd * (q + 1) : r * (q + 1) + (xcd - r) * q) + off; }
        const int nig = WGM * nN, gid = wgid / nig, fm = gid * WGM, gsz = (nM - fm) < WGM ? (nM - fm) : WGM;
        u.pm = fm + ((wgid % nig) % gsz); u.pn = (wgid % nig) / gsz; u.pb = u.pn; u.acol = 0; u.aux = 0; return true;
    }
};

struct NoMid { static constexpr int EVERY = 0; DI void operator()(f32x4 (&)[2][2][4][2], const Unit&, int, int, int, int, int) const {} };
template <class Epi, class Sched, bool ALIGN_EPI, bool GATHER = false, class Mid = NoMid>
DI void gemm_phase(LAS unsigned char* lds, const Gemm g, const Sched& S, const Epi& E, const Mid& mid = Mid()) {
    const int tid = tid_local(), wid = __builtin_amdgcn_readfirstlane(tid >> 6), lane = tid & 63, wr = wid >> 2, wc = wid & 3, fr = lane & 15, fq = lane >> 4;
    const int nt = g.K / BK;
    int Ra[2], Ca[2], Rb[2];
#pragma unroll
    for (int i = 0; i < 2; ++i) { int R, C; stage_rc(tid * 16 + i * 8192, R, C); Ra[i] = R; Ca[i] = C; Rb[i] = (R & ~31) + perm32(R & 31); }
    const size_t kstep = (size_t)(BK * 2);
    const unsigned ldsw = (unsigned)wid * 1024u;
    const int aoff = lds_byte(wr * 64 + fr, fq * 8), boff = lds_byte(wc * 32 + fr, fq * 8);
#define PG8_SA(b, h) (((b) * 2 + (h)) * HTB)
#define PG8_SB(b, h) ((4 + (b) * 2 + (h)) * HTB)
#define PG8_STAGE(bufoff, gptr, offs) do { _Pragma("unroll") for (int _i = 0; _i < 2; ++_i) \
        __builtin_amdgcn_global_load_lds((const unsigned*)((gptr) + (offs)[_i]), (LAS unsigned*)(lds + (bufoff) + ldsw + _i * 8192), 16, 0, 0); } while (0)
#define PG8_LDA(dst, b, h) do { _Pragma("unroll") for (int m = 0; m < 4; ++m) _Pragma("unroll") for (int k = 0; k < 2; ++k) dst[m][k] = *(const LAS bf16x8*)(lds + PG8_SA(b, h) + aoff + m * 2048 + k * 1024); } while (0)
#define PG8_LDB(dst, b, h) do { _Pragma("unroll") for (int n = 0; n < 2; ++n) _Pragma("unroll") for (int k = 0; k < 2; ++k) dst[n][k] = *(const LAS bf16x8*)(lds + PG8_SB(b, h) + boff + n * 2048 + k * 1024); } while (0)
#define PG8_MMA(ai, bj, At, Bt) do { __builtin_amdgcn_s_setprio(1); _Pragma("unroll") for (int m = 0; m < 4; ++m) _Pragma("unroll") for (int n = 0; n < 2; ++n) _Pragma("unroll") for (int k = 0; k < 2; ++k) \
        acc[ai][bj][m][n] = __builtin_amdgcn_mfma_f32_16x16x32_bf16(Bt[n][k], At[m][k], acc[ai][bj][m][n], 0, 0, 0); __builtin_amdgcn_s_setprio(0); } while (0)
#define PG8_WAIT_V(n) asm volatile("s_waitcnt vmcnt(" #n ")" ::: "memory")
#define PG8_WAIT_L(n) asm volatile("s_waitcnt lgkmcnt(" #n ")" ::: "memory")
#define PG8_BAR __builtin_amdgcn_s_barrier()
#define PG8_SCHED __builtin_amdgcn_sched_barrier(0)
#define PG8_OFFS(u, oa) do { _Pragma("unroll") for (int h_ = 0; h_ < 2; ++h_) _Pragma("unroll") for (int i_ = 0; i_ < 2; ++i_) { \
        const int ar_ = g.arow[(u).pm * BM + h_ * HALF + Ra[i_]]; oa[h_][i_] = (unsigned)(ar_ * g.lda + (u).acol + Ca[i_]) * 2u; } } while (0)
    unsigned voffA[2], voffB[2];
#pragma unroll
    for (int i = 0; i < 2; ++i) { voffA[i] = (unsigned)(Ra[i] * g.lda + Ca[i]) * 2u; voffB[i] = (unsigned)(Rb[i] * g.ldb + Ca[i]) * 2u; }
    const size_t hstepA = (size_t)HALF * g.lda * 2, hstepB = (size_t)HALF * g.ldb * 2;
#define PG8_ABASE(u) ((const char*)g.A + (GATHER ? (size_t)0 : ((size_t)(u).pm * BM * g.lda + (u).acol) * 2))
#define PG8_BBASE(u) ((const char*)g.Bt + (size_t)(u).pb * BM * g.ldb * 2)
#define PG8_STAGE_A(bufoff, ab, oa, h) do { if constexpr (GATHER) { PG8_STAGE(bufoff, ab, (oa)[h]); } else { PG8_STAGE(bufoff, (ab) + (h) * hstepA, voffA); } } while (0)
#define PG8_STAGE_B(bufoff, bb, h) PG8_STAGE(bufoff, (bb) + (h) * hstepB, voffB)
#define PG8_STAGE_A2(bufoff, ab, h) do { if constexpr (GATHER) { if (last) { unsigned on_[2]; _Pragma("unroll") for (int i_ = 0; i_ < 2; ++i_) { int ar_ = arN[h][i_]; asm volatile("" : "+v"(ar_));   on_[i_] = ar_ < 0 ? oaC[h][i_] : (unsigned)(ar_ * g.lda + nxt.acol + Ca[i_]) * 2u; } PG8_STAGE(bufoff, ab, on_); } else { PG8_STAGE(bufoff, ab, oaC[h]); } } else { PG8_STAGE(bufoff, (ab) + (h) * hstepA, voffA); } } while (0)
    Unit cur, nxt; int ui = 0;
    if (!S.next(0, cur)) return;
    f32x4 acc[2][2][4][2];
    if constexpr (Epi::HAS_INIT) E.init(acc, cur, wr, wc, fr, fq); else {
#pragma unroll
    for (int a = 0; a < 2; ++a)
#pragma unroll
        for (int b = 0; b < 2; ++b)
#pragma unroll
            for (int m = 0; m < 4; ++m)
#pragma unroll
                for (int n = 0; n < 2; ++n) acc[a][b][m][n] = (f32x4){0.f, 0.f, 0.f, 0.f}; }
    bf16x8 At[4][2], B0[2][2], B1[2][2];
    unsigned oaC[2][2];
    if constexpr (GATHER) { PG8_OFFS(cur, oaC); }
    const char* cA = PG8_ABASE(cur); const char* cB = PG8_BBASE(cur);
    PG8_STAGE_B(PG8_SB(0, 0), cB, 0); PG8_STAGE_B(PG8_SB(0, 1), cB, 1); PG8_STAGE_A(PG8_SA(0, 0), cA, oaC, 0); PG8_STAGE_A(PG8_SA(0, 1), cA, oaC, 1);
    if (wr == 1) PG8_BAR;
    PG8_WAIT_V(2); PG8_BAR;
    PG8_STAGE_B(PG8_SB(1, 0), cB + kstep, 0); PG8_STAGE_A(PG8_SA(1, 0), cA + kstep, oaC, 0); PG8_STAGE_B(PG8_SB(1, 1), cB + kstep, 1);
    PG8_WAIT_V(6); PG8_BAR;
    bool has_next = S.next(1, nxt); Unit nx2; bool has_nx2 = false;
    int arN[2][2];
    if constexpr (GATHER) {
#pragma unroll
        for (int h_ = 0; h_ < 2; ++h_)
#pragma unroll
            for (int i_ = 0; i_ < 2; ++i_) arN[h_][i_] = has_next ? g.arow[nxt.pm * BM + h_ * HALF + Ra[i_]] : -1;
    }
    for (;;) {
        const char* nA = has_next ? PG8_ABASE(nxt) : cA; const char* nB = has_next ? PG8_BBASE(nxt) : cB;
#pragma unroll 1
        for (int t = 0; t < nt; t += 2) {
            const bool last = (t == nt - 2);
            const char* a1 = cA + (size_t)(t + 1) * kstep;
            const char* a2 = last ? nA : cA + (size_t)(t + 2) * kstep; const char* b2 = last ? nB : cB + (size_t)(t + 2) * kstep;
            const char* a3 = a2 + kstep; const char* b3 = b2 + kstep;
            PG8_LDB(B0, 0, 0); PG8_LDB(B1, 0, 1); PG8_SCHED; PG8_LDA(At, 0, 0); PG8_STAGE_A(PG8_SA(1, 1), a1, oaC, 1);
            PG8_WAIT_V(8); PG8_WAIT_L(0); PG8_BAR; PG8_MMA(0, 0, At, B0); PG8_MMA(0, 1, At, B1); PG8_BAR; PG8_SCHED;
            PG8_LDA(At, 0, 1); PG8_STAGE_B(PG8_SB(0, 0), b2, 0); PG8_STAGE_B(PG8_SB(0, 1), b2, 1); PG8_STAGE_A2(PG8_SA(0, 0), a2, 0);
            PG8_WAIT_V(8); PG8_WAIT_L(0); PG8_BAR; PG8_MMA(1, 0, At, B0); PG8_MMA(1, 1, At, B1); PG8_BAR; PG8_SCHED;
            PG8_LDB(B0, 1, 0); PG8_LDB(B1, 1, 1); PG8_SCHED; PG8_LDA(At, 1, 0); PG8_STAGE_A2(PG8_SA(0, 1), a2, 1);
            PG8_WAIT_V(8); PG8_WAIT_L(0); PG8_BAR; PG8_MMA(0, 0, At, B0); PG8_MMA(0, 1, At, B1); PG8_BAR; PG8_SCHED;
            PG8_LDA(At, 1, 1); PG8_STAGE_B(PG8_SB(1, 0), b3, 0); PG8_STAGE_B(PG8_SB(1, 1), b3, 1); PG8_STAGE_A2(PG8_SA(1, 0), a3, 0);
            PG8_WAIT_V(8); PG8_WAIT_L(0); PG8_BAR; PG8_MMA(1, 0, At, B0); PG8_MMA(1, 1, At, B1); PG8_BAR; PG8_SCHED;
            if constexpr (Mid::EVERY > 0) { if (((t + 2) % Mid::EVERY) == 0 && (t + 2) < nt) mid(acc, cur, (t + 2) / Mid::EVERY - 1, wr, wc, fr, fq); }
        }
        has_nx2 = has_next && S.next(ui + 2, nx2);
        if constexpr (GATHER) {
            if (has_next) {
#pragma unroll
                for (int h_ = 0; h_ < 2; ++h_)
#pragma unroll
                    for (int i_ = 0; i_ < 2; ++i_) oaC[h_][i_] = (unsigned)(arN[h_][i_] * g.lda + nxt.acol + Ca[i_]) * 2u;
            }
#pragma unroll
            for (int h_ = 0; h_ < 2; ++h_)
#pragma unroll
                for (int i_ = 0; i_ < 2; ++i_) arN[h_][i_] = has_nx2 ? g.arow[nx2.pm * BM + h_ * HALF + Ra[i_]] : -1;
            PG8_SCHED;
        }
        if constexpr (ALIGN_EPI) { if (wr == 0) PG8_BAR; }
        E(acc, cur, wr, wc, fr, fq);
        if (!has_next) break;
        if constexpr (Epi::HAS_INIT) E.init(acc, nxt, wr, wc, fr, fq); else {
#pragma unroll
        for (int a = 0; a < 2; ++a)
#pragma unroll
            for (int b = 0; b < 2; ++b)
#pragma unroll
                for (int m = 0; m < 4; ++m)
#pragma unroll
                    for (int n = 0; n < 2; ++n) acc[a][b][m][n] = (f32x4){0.f, 0.f, 0.f, 0.f}; }
        cur = nxt; cA = nA; cB = nB; ++ui; nxt = nx2; has_next = has_nx2;
        if constexpr (ALIGN_EPI) { if (wr == 1) PG8_BAR; }
    }
    PG8_WAIT_V(0);
    if constexpr (!ALIGN_EPI) { if (wr == 0) PG8_BAR; }
    PG8_BAR;
#undef PG8_SA
#undef PG8_SB
#undef PG8_STAGE
#undef PG8_LDA
#undef PG8_LDB
#undef PG8_MMA
#undef PG8_WAIT_V
#undef PG8_WAIT_L
#undef PG8_BAR
#undef PG8_SCHED
#undef PG8_OFFS
#undef PG8_ABASE
#undef PG8_BBASE
#undef PG8_STAGE_A
#undef PG8_STAGE_A2
#undef PG8_STAGE_B
}
}
using pg8::Unit; using pg8::BM; using pg8::HALF;

struct BranchOrder {
    int ntile, G, c;
    DI bool next(int i, Unit& u) const {
        const int L = (i / 3) * G + c; if (L >= ntile) return false;
        const int n = i % 3; u.pm = L >> 2; u.pn = L & 3; u.pb = n * 4 + u.pn; u.acol = n * 1024; u.aux = n; return true;
    }
};
#define CAS __attribute__((address_space(4)))
DI int sload_i(const int* p, int i) { return ((const CAS int*)(unsigned long long)p)[i]; }
struct ExpertGUOrder {
    const int* tile_e; int nunits, G, c;
    DI bool next(int i, Unit& u) const {
        const int L = i * G + c; if (L >= nunits) return false;
        const int t = L >> 1, hf = L & 1; const int e = sload_i(tile_e, t);
        u.pm = t; u.pn = hf; u.pb = e * 2 + hf; u.acol = 0; u.aux = e; return true;
    }
};
struct ExpertDownOrder {
    const int* tile_e; int nunits, G, c, round;
    DI bool next(int i, Unit& u) const {
        const int L = i * G + c; if (L >= nunits) return false;
        const int t = L >> 1, cn = L & 1; const int e = sload_i(tile_e, t);
        u.pm = t; u.pn = cn; u.pb = e * 4 + round * 2 + cn; u.acol = 0; u.aux = e; return true;
    }
};

#define EPI_ARGS const f32x4 (&acc)[2][2][4][2], const Unit& u, int wr, int wc, int fr, int fq
DI u32x4 pack8(const f32x4 v0, const f32x4 v1) { u32x4 w; w.x = cvt_pk_bf16(v0[0], v0[1]); w.y = cvt_pk_bf16(v0[2], v0[3]); w.z = cvt_pk_bf16(v1[0], v1[1]); w.w = cvt_pk_bf16(v1[2], v1[3]); return w; }

struct EpiInProj {
    static constexpr bool HAS_INIT = true;
    bf16_t* O; const float* bias;
    DI void init(f32x4 (&acc)[2][2][4][2], const Unit& u, int wr, int wc, int fr, int fq) const {
        const int col0 = u.pn * BM + wc * 32 + 8 * fq;
#pragma unroll
        for (int bj = 0; bj < 2; ++bj)
#pragma unroll
            for (int n = 0; n < 2; ++n) { const f32x4 bv = *(const f32x4*)(bias + col0 + bj * HALF + 4 * n);
#pragma unroll
                for (int ai = 0; ai < 2; ++ai)
#pragma unroll
                    for (int m = 0; m < 4; ++m) acc[ai][bj][m][n] = bv; }
    }
    DI void operator()(EPI_ARGS) const {
        const int row0 = u.pm * BM + wr * 64 + fr, col0 = u.pn * BM + wc * 32 + 8 * fq;
        const float sc = (u.pn < 4) ? 0.125f * 1.4426950408889634f : ((u.pn >= 28 && u.pn < 32) ? 0.0625f * 1.4426950408889634f : 1.f);
#pragma unroll
        for (int ai = 0; ai < 2; ++ai)
#pragma unroll
            for (int m = 0; m < 4; ++m) { bf16_t* rowp = O + (size_t)(row0 + ai * HALF + m * 16) * NU + col0;
#pragma unroll
                for (int bj = 0; bj < 2; ++bj) *(u32x4*)(rowp + bj * HALF) = pack8(acc[ai][bj][m][0] * sc, acc[ai][bj][m][1] * sc); }
    }
};
struct EpiPlain { static constexpr bool HAS_INIT = false;
    bf16_t* O; int ldc;
    DI void operator()(EPI_ARGS) const {
        const int row0 = u.pm * BM + wr * 64 + fr, col0 = u.pn * BM + wc * 32 + 8 * fq;
#pragma unroll
        for (int ai = 0; ai < 2; ++ai)
#pragma unroll
            for (int m = 0; m < 4; ++m) { bf16_t* rowp = O + (size_t)(row0 + ai * HALF + m * 16) * ldc + col0;
#pragma unroll
                for (int bj = 0; bj < 2; ++bj) *(u32x4*)(rowp + bj * HALF) = pack8(acc[ai][bj][m][0], acc[ai][bj][m][1]); }
    }
};
struct EpiBranch { static constexpr bool HAS_INIT = false;
    const bf16_t* U; float* F; bf16_t* M;
    DI void operator()(EPI_ARGS) const {
        const int row0 = u.pm * BM + wr * 64 + fr, col0 = u.pn * BM + wc * 32 + 8 * fq, n = u.aux;
#pragma unroll
        for (int ai = 0; ai < 2; ++ai)
#pragma unroll
            for (int m = 0; m < 4; ++m) { const size_t row = (size_t)(row0 + ai * HALF + m * 16);
#pragma unroll
                for (int bj = 0; bj < 2; ++bj) { const int col = col0 + bj * HALF;
                    const u32x4 gw = *(const u32x4*)(U + row * NU + UGT + n * 1024 + col);
                    f32x4 g0 = {sigm(bf_lo(gw.x)), sigm(bf_hi(gw.x)), sigm(bf_lo(gw.y)), sigm(bf_hi(gw.y))};
                    f32x4 g1 = {sigm(bf_lo(gw.z)), sigm(bf_hi(gw.z)), sigm(bf_lo(gw.w)), sigm(bf_hi(gw.w))};
                    f32x4 v0 = acc[ai][bj][m][0] * g0, v1 = acc[ai][bj][m][1] * g1;
                    float* fp = F + row * 1024 + col;
                    if (n > 0) { v0 += *(const f32x4*)fp; v1 += *(const f32x4*)(fp + 4); }
                    if (n < 2) { *(f32x4*)fp = v0; *(f32x4*)(fp + 4) = v1; }
                    else *(u32x4*)(M + row * 1024 + col) = pack8(v0, v1); }
                asm volatile("" ::: "memory"); }
    }
};
DI f32x4 sig_ratio4(float a0, float a1, float a2, float a3, float b0, float b1, float b2, float b3) {
    return (f32x4){(1.f + __expf(-b0)) / (1.f + __expf(-a0)), (1.f + __expf(-b1)) / (1.f + __expf(-a1)), (1.f + __expf(-b2)) / (1.f + __expf(-a2)), (1.f + __expf(-b3)) / (1.f + __expf(-a3))};
}
struct MidBranch { static constexpr int EVERY = 16; const bf16_t* U;
    DI void operator()(f32x4 (&acc)[2][2][4][2], const Unit& u, int n, int wr, int wc, int fr_, int fq_) const {
        int fr = fr_, fq = fq_; asm volatile("" : "+v"(fr), "+v"(fq));
        const int row0 = u.pm * BM + wr * 64 + fr, col0 = u.pn * BM + wc * 32 + 8 * fq;
#pragma unroll
        for (int ai = 0; ai < 2; ++ai) { u32x4 ga[4][2], gb[4][2];
#pragma unroll
            for (int m = 0; m < 4; ++m) { const bf16_t* gp = U + (size_t)(row0 + ai * HALF + m * 16) * NU + UGT + n * 1024 + col0;
#pragma unroll
                for (int bj = 0; bj < 2; ++bj) { ga[m][bj] = *(const u32x4*)(gp + bj * HALF); gb[m][bj] = *(const u32x4*)(gp + bj * HALF + 1024); } }
#pragma unroll
            for (int m = 0; m < 4; ++m)
#pragma unroll
                for (int bj = 0; bj < 2; ++bj) { const u32x4 a = ga[m][bj], b = gb[m][bj];
                    acc[ai][bj][m][0] *= sig_ratio4(bf_lo(a.x), bf_hi(a.x), bf_lo(a.y), bf_hi(a.y), bf_lo(b.x), bf_hi(b.x), bf_lo(b.y), bf_hi(b.y));
                    acc[ai][bj][m][1] *= sig_ratio4(bf_lo(a.z), bf_hi(a.z), bf_lo(a.w), bf_hi(a.w), bf_lo(b.z), bf_hi(b.z), bf_lo(b.w), bf_hi(b.w)); }
            asm volatile("" ::: "memory"); }
    }
};
struct EpiBranch2 { static constexpr bool HAS_INIT = false;
    const bf16_t* U; bf16_t* M;
    DI void operator()(EPI_ARGS) const {
        const int row0 = u.pm * BM + wr * 64 + fr, col0 = u.pn * BM + wc * 32 + 8 * fq;
#pragma unroll
        for (int ai = 0; ai < 2; ++ai) { u32x4 gw[4][2];
#pragma unroll
            for (int m = 0; m < 4; ++m)
#pragma unroll
                for (int bj = 0; bj < 2; ++bj) gw[m][bj] = *(const u32x4*)(U + (size_t)(row0 + ai * HALF + m * 16) * NU + UGT + 2048 + col0 + bj * HALF);
#pragma unroll
            for (int m = 0; m < 4; ++m) { const size_t row = (size_t)(row0 + ai * HALF + m * 16);
#pragma unroll
                for (int bj = 0; bj < 2; ++bj) { const u32x4 g = gw[m][bj];
                    const f32x4 g0 = {sigm(bf_lo(g.x)), sigm(bf_hi(g.x)), sigm(bf_lo(g.y)), sigm(bf_hi(g.y))}, g1 = {sigm(bf_lo(g.z)), sigm(bf_hi(g.z)), sigm(bf_lo(g.w)), sigm(bf_hi(g.w))};
                    *(u32x4*)(M + row * 1024 + col0 + bj * HALF) = pack8(acc[ai][bj][m][0] * g0, acc[ai][bj][m][1] * g1); } }
            asm volatile("" ::: "memory"); }
    }
};
struct EpiOutProj { static constexpr bool HAS_INIT = false;
    const float* X; float* Z;
    DI void operator()(EPI_ARGS) const {
        const int row0 = u.pm * BM + wr * 64 + fr, col0 = u.pn * BM + wc * 32 + 8 * fq;
#pragma unroll
        for (int ai = 0; ai < 2; ++ai) { f32x4 xv[4][2][2];
#pragma unroll
            for (int m = 0; m < 4; ++m)
#pragma unroll
                for (int bj = 0; bj < 2; ++bj) { const float* xp = X + (size_t)(row0 + ai * HALF + m * 16) * 1024 + col0 + bj * HALF; xv[m][bj][0] = *(const f32x4*)xp; xv[m][bj][1] = *(const f32x4*)(xp + 4); }
#pragma unroll
            for (int m = 0; m < 4; ++m)
#pragma unroll
                for (int bj = 0; bj < 2; ++bj) { float* zp = Z + (size_t)(row0 + ai * HALF + m * 16) * 1024 + col0 + bj * HALF;
                    *(f32x4*)zp = xv[m][bj][0] * ALPHA + acc[ai][bj][m][0]; *(f32x4*)(zp + 4) = xv[m][bj][1] * ALPHA + acc[ai][bj][m][1]; }
            asm volatile("" ::: "memory"); }
    }
};
struct EpiF32 { static constexpr bool HAS_INIT = false;
    float* O; int ldc;
    DI void operator()(EPI_ARGS) const {
        const int row0 = u.pm * BM + wr * 64 + fr, col0 = u.pn * BM + wc * 32 + 8 * fq;
#pragma unroll
        for (int ai = 0; ai < 2; ++ai)
#pragma unroll
            for (int m = 0; m < 4; ++m) { float* rowp = O + (size_t)(row0 + ai * HALF + m * 16) * ldc + col0;
#pragma unroll
                for (int bj = 0; bj < 2; ++bj) { *(f32x4*)(rowp + bj * HALF) = acc[ai][bj][m][0]; *(f32x4*)(rowp + bj * HALF + 4) = acc[ai][bj][m][1]; } }
    }
};
struct EpiGateUp { static constexpr bool HAS_INIT = false;
    bf16_t* ACT;
    DI void operator()(EPI_ARGS) const {
        const int row0 = u.pm * BM + wr * 64 + fr, col0 = u.pn * HALF + wc * 32 + 8 * fq;
#pragma unroll
        for (int ai = 0; ai < 2; ++ai)
#pragma unroll
            for (int m = 0; m < 4; ++m) { f32x4 v[2];
#pragma unroll
                for (int n = 0; n < 2; ++n) { const f32x4 gt = acc[ai][0][m][n], up = acc[ai][1][m][n];
                    v[n] = (f32x4){silu(gt[0]) * up[0], silu(gt[1]) * up[1], silu(gt[2]) * up[2], silu(gt[3]) * up[3]}; }
                *(u32x4*)(ACT + (size_t)(row0 + ai * HALF + m * 16) * 256 + col0) = pack8(v[0], v[1]); }
    }
};
DI unsigned pk4_fp8(float a, float b, float c, float d) { int p = __builtin_amdgcn_cvt_pk_fp8_f32(a, b, 0, false); return (unsigned)__builtin_amdgcn_cvt_pk_fp8_f32(c, d, p, true); }
constexpr float Y8_SCALE = 32.f, Y8_MAX = 400.f;
struct EpiDown { static constexpr bool HAS_INIT = false;
    unsigned char* Y; const float* W;
    DI void operator()(EPI_ARGS) const {
        const int row0 = u.pm * BM + wr * 64 + fr, col0 = u.pn * BM + wc * 32 + 8 * fq;
        float wv[2][4];
#pragma unroll
        for (int ai = 0; ai < 2; ++ai)
#pragma unroll
            for (int m = 0; m < 4; ++m) wv[ai][m] = W[row0 + ai * HALF + m * 16];
#pragma unroll
        for (int ai = 0; ai < 2; ++ai)
#pragma unroll
            for (int m = 0; m < 4; ++m) { const int row = row0 + ai * HALF + m * 16; const float w = wv[ai][m] * Y8_SCALE;
#pragma unroll
                for (int bj = 0; bj < 2; ++bj) { f32x4 v0 = acc[ai][bj][m][0] * w, v1 = acc[ai][bj][m][1] * w;
#pragma unroll
                    for (int e = 0; e < 4; ++e) { v0[e] = __builtin_amdgcn_fmed3f(v0[e], -Y8_MAX, Y8_MAX); v1[e] = __builtin_amdgcn_fmed3f(v1[e], -Y8_MAX, Y8_MAX); }
                    u32x2 o; o.x = pk4_fp8(v0[0], v0[1], v0[2], v0[3]); o.y = pk4_fp8(v1[0], v1[1], v1[2], v1[3]);
                    *(u32x2*)(Y + (size_t)row * 512 + col0 + bj * HALF) = o; } }
    }
};
#define RLX_AGENT __ATOMIC_RELAXED, __HIP_MEMORY_SCOPE_AGENT
#define XB_TMO      128
#define XB_XCNT(j)  (256  + 64 * (j))
#define XB_XSUB(j)  (1280 + 64 * (j))
#define XB_XGEN(j)  (2304 + 64 * (j))
#define XB_TOP      3328
#define XB_TOPGEN   3392
#define XCD_BAR_WORDS 3456
#define XB_SPIN_CAP (1u << 18)

__device__ __forceinline__ unsigned xb_ld(unsigned* p)              { return __hip_atomic_load(p, __ATOMIC_RELAXED, __HIP_MEMORY_SCOPE_AGENT); }
__device__ __forceinline__ unsigned xb_add(unsigned* p, unsigned v) { return __hip_atomic_fetch_add(p, v, __ATOMIC_RELAXED, __HIP_MEMORY_SCOPE_AGENT); }
__device__ __forceinline__ unsigned xb_xcc_id() { return (unsigned)__builtin_amdgcn_s_getreg((3 << 11) | 20) & 0xFu; }
#define XB_SPIN(cond, bar) do { unsigned _sp = 0; while (cond) { __builtin_amdgcn_s_sleep(1); \
    if ((++_sp & 255u) == 0u) { if (xb_ld(&(bar)[XB_TMO])) break; if (_sp > XB_SPIN_CAP) { atomicAdd(&(bar)[XB_TMO], 1u); break; } } } } while (0)

struct XcdBarrier {
    unsigned* bar; unsigned x;
    volatile LAS unsigned* st;
};

__device__ __forceinline__ XcdBarrier xcd_barrier_post(unsigned* bar, volatile LAS unsigned* st) {
    XcdBarrier b; b.bar = bar; b.x = xb_xcc_id(); b.st = st;
    if (threadIdx.x == 0) (void)xb_add(&bar[XB_XCNT(b.x)], 1u);
    return b;
}
__device__ __forceinline__ void xcd_barrier_complete(unsigned* bar, unsigned x, unsigned& nloc, unsigned& nx) {
    const unsigned G = gridDim.x * gridDim.y * gridDim.z;
    unsigned sum, cnt, mine, sp = 0u;
    for (;;) {
        sum = 0u; cnt = 0u; mine = 0u;
#pragma unroll
        for (unsigned j = 0; j < 16; ++j) { const unsigned c = xb_ld(&bar[XB_XCNT(j)]); sum += c; cnt += (c > 0u) ? 1u : 0u; mine = (j == x) ? c : mine; }
        if (sum == G) break;
        __builtin_amdgcn_s_sleep(1);
        if ((++sp & 255u) == 0u) { if (xb_ld(&bar[XB_TMO])) break; if (sp > XB_SPIN_CAP) { atomicAdd(&bar[XB_TMO], 1u); break; } }
    }
    nloc = mine > 0u ? mine : 1u; nx = cnt > 0u ? cnt : 1u;
}

__device__ __forceinline__ void xcd_barrier(const XcdBarrier& b) {
    asm volatile("s_waitcnt vmcnt(0)" ::: "memory");
    __syncthreads();
    if (threadIdx.x == 0) {
        unsigned* bar = b.bar; asm volatile("" : "+s"(bar));
        __builtin_amdgcn_s_waitcnt(0);
        volatile LAS unsigned* stp = b.st; asm volatile("" : "+s"(stp));
        unsigned nloc = stp[0], nx = stp[1];
        if (nloc == 0u) { xcd_barrier_complete(bar, b.x, nloc, nx); stp[0] = nloc; stp[1] = nx; }
        const unsigned old = xb_add(&bar[XB_XSUB(b.x)], 1u);
        const unsigned gen = old / nloc;
        if (old + 1u == (gen + 1u) * nloc) {
            __builtin_amdgcn_fence(__ATOMIC_RELEASE, "agent");
            asm volatile("s_waitcnt vmcnt(0)" ::: "memory");
            const unsigned og = xb_add(&bar[XB_TOP], 1u);
            const unsigned tg = og / nx;
            if (og + 1u == (tg + 1u) * nx) xb_add(&bar[XB_TOPGEN], 1u);
            else XB_SPIN(xb_ld(&bar[XB_TOPGEN]) == tg, bar);
            __builtin_amdgcn_fence(__ATOMIC_ACQUIRE, "agent");
            xb_add(&bar[XB_XGEN(b.x)], 1u);
            asm volatile("s_waitcnt vmcnt(0)" ::: "memory");
        } else {
            XB_SPIN(xb_ld(&bar[XB_XGEN(b.x)]) == gen, bar);
            __builtin_amdgcn_fence(__ATOMIC_ACQUIRE, "agent");
            asm volatile("s_waitcnt vmcnt(0)" ::: "memory");
        }
    }
    __syncthreads();
}

struct P {
    const float *x, *mem, *rel_bias, *w_in, *b_in, *conv_w, *diff_lambda, *subln_g, *mlstm_norm_g, *w_mem_kv, *w_branch, *w_out, *ln1_g, *ln1_b,
                *w_router, *router_bias, *w_e_gate, *w_e_up, *w_e_down, *w_s_gate, *w_s_up, *w_s_down, *ln2_g, *ln2_b;
    float* out; unsigned char* ws; int s_lo, s_hi;
};
typedef const P __attribute__((address_space(4)))* PP;
DI PP kargs() { PP k = (PP)__builtin_amdgcn_kernarg_segment_ptr(); asm volatile("" : "+s"(k)); return k; }
DI P load_args(PP k) { P r; const unsigned long long __attribute__((address_space(4)))* s = (const unsigned long long __attribute__((address_space(4)))*)k;
    void** d = (void**)&r;
#pragma unroll
    for (int i = 0; i < 26; ++i) d[i] = (void*)(GAS char*)s[i];
    ((unsigned long long*)&r)[26] = s[26];
    return r; }
static_assert(sizeof(P) == 27 * 8, "P = 26 pointers + 2 ints");
#define WSP(T, off) ((T*)(p.ws + (off)))

DI void transpose_item(const float* W, int ldw, int src_col0, bf16_t* WT, int ldt, int dst_row0, int k0, LAS float* scr, int lane) {
    float v[32];
    const float* src = W + (size_t)(k0 + (lane >> 5)) * ldw + src_col0 + (lane & 31);
#pragma unroll
    for (int i = 0; i < 32; ++i) v[i] = src[(size_t)(2 * i) * ldw];
#pragma unroll
    for (int i = 0; i < 32; ++i) scr[(2 * i + (lane >> 5)) * 33 + (lane & 31)] = v[i];
    LDS_WAIT();
    const int c = lane & 7;
#pragma unroll
    for (int j = 0; j < 4; ++j) { const int n = (lane >> 3) + 8 * j; const LAS float* s = scr + (8 * c) * 33 + n;
        u32x4 o; o.x = cvt_pk_bf16(s[0 * 33], s[1 * 33]); o.y = cvt_pk_bf16(s[2 * 33], s[3 * 33]); o.z = cvt_pk_bf16(s[4 * 33], s[5 * 33]); o.w = cvt_pk_bf16(s[6 * 33], s[7 * 33]);
        *(u32x4*)(WT + (size_t)(dst_row0 + n) * ldt + k0 + 8 * c) = o; }
    LDS_WAIT();
}
DI void transpose_mat(const float* W, int ldw, int src_col0, int K, int N, bf16_t* WT, int ldt, int dst_row0, int gw, int NGW, LAS float* scr, int lane) {
    const int nblk = N / 32, items = (K / 64) * nblk;
    for (int it = gw; it < items; it += NGW) { const int kb = it / nblk, nb = it % nblk; transpose_item(W, ldw, src_col0 + nb * 32, WT, ldt, dst_row0 + nb * 32, kb * 64, scr, lane); }
}
DI void row_to_bf16(const float* src, bf16_t* dst, int lane) {
    const f32x4* s = (const f32x4*)src + lane; u32x2* d = (u32x2*)dst + lane;
#pragma unroll
    for (int j = 0; j < 4; ++j) { const f32x4 v = s[64 * j]; u32x2 o; o.x = cvt_pk_bf16(v[0], v[1]); o.y = cvt_pk_bf16(v[2], v[3]); d[64 * j] = o; }
}

DI void ph_prologue(PP pk_, LAS unsigned char* lds) { const P p = load_args(pk_);
    const int tid = tid_local(), lane = tid & 63, wave = tid >> 6, gw = bid_local() * 8 + wave, NGW = gridDim.x * 8;
    LAS float* scr = (LAS float*)(lds + wave * 16384);
    bf16_t* WinT = WSP(bf16_t, WS_WIN);
    transpose_mat(p.w_in, CIN, 0, 1024, 7168, WinT, 1024, 0, gw, NGW, scr, lane);
    transpose_mat(p.w_in, CIN, 7176, 1024, 4096, WinT, 1024, 7168, gw, NGW, scr, lane);
    transpose_mat(p.w_mem_kv, 2048, 0, 1024, 2048, WSP(bf16_t, WS_WKV), 1024, 0, gw, NGW, scr, lane);
    for (int n = 0; n < 3; ++n) transpose_mat(p.w_branch + (size_t)n * 1024 * 1024, 1024, 0, 1024, 1024, WSP(bf16_t, WS_WBR) + n * 1024, 3072, 0, gw, NGW, scr, lane);
    transpose_mat(p.w_out, 1024, 0, 1024, 1024, WSP(bf16_t, WS_WOUT), 1024, 0, gw, NGW, scr, lane);
    transpose_mat(p.w_router, 256, 0, 1024, 256, WSP(bf16_t, WS_WR), 1024, 0, gw, NGW, scr, lane);
    bf16_t* memb = WSP(bf16_t, WS_MEMB);
    for (int r = gw; r < NBATCH * 256; r += NGW) row_to_bf16(p.mem + (size_t)r * 1024, memb + (size_t)r * 1024, lane);
    float* bias = WSP(float, WS_MISC + MS_BIAS);
    for (int j = bid_local() * 512 + tid; j < NU; j += gridDim.x * 512) bias[j] = p.b_in[j + (j >= 7168 ? 8 : 0)];
    if (gw == 0) {
        const float* lv = p.diff_lambda;
        const float s1 = wave_sum(lv[lane] * lv[64 + lane]), s2 = wave_sum(lv[128 + lane] * lv[192 + lane]);
        if (lane == 0) *WSP(float, WS_MISC + MS_LAM) = expf(s1) - expf(s2) + 0.2f;
    }
}

DI void xconv_item(PP pk_, int g, int item, LAS unsigned char* lds) { const P p = load_args(pk_);
    const int tid = tid_local(), lane = tid & 63, wave = tid >> 6;
    LAS float* wg = (LAS float*)lds;
    __syncthreads();
    for (int i = tid; i < 2048; i += 512) { const int c = i >> 1, hf = i & 1; *(LAS f32x4*)(wg + c * 8 + hf * 4) = *(const f32x4*)(p.w_in + (size_t)c * CIN + 7168 + hf * 4); }
    __syncthreads();
    bf16_t* xb = WSP(bf16_t, WS_XB); float* gif = WSP(float, WS_GIF);
#pragma unroll 2
    for (int rr = 0; rr < 32; ++rr) { const int r = item * 256 + wave * 32 + rr;
        const size_t t = (size_t)g * TG + r;
        const f32x4* xr = (const f32x4*)(p.x + t * 1024) + lane; u32x2* d = (u32x2*)(xb + (size_t)r * 1024) + lane;
        float gs[8];
#pragma unroll
        for (int q = 0; q < 8; ++q) gs[q] = 0.f;
#pragma unroll
        for (int j = 0; j < 4; ++j) { const f32x4 v = xr[64 * j]; u32x2 o; o.x = cvt_pk_bf16(v[0], v[1]); o.y = cvt_pk_bf16(v[2], v[3]); d[64 * j] = o;
#pragma unroll
            for (int e = 0; e < 4; ++e) { const int c = 4 * lane + 256 * j + e; const f32x4 wl = *(const LAS f32x4*)(wg + c * 8), wh = *(const LAS f32x4*)(wg + c * 8 + 4);
                gs[0] += v[e] * wl[0]; gs[1] += v[e] * wl[1]; gs[2] += v[e] * wl[2]; gs[3] += v[e] * wl[3]; gs[4] += v[e] * wh[0]; gs[5] += v[e] * wh[1]; gs[6] += v[e] * wh[2]; gs[7] += v[e] * wh[3]; } }
        float mine = 0.f;
#pragma unroll
        for (int q = 0; q < 8; ++q) { const float s = wave_sum_fast(gs[q]); if (lane == q) mine = s; }
        if (lane < 8) gif[t * 8 + lane] = mine + p.b_in[7168 + lane];
    }
}
DI void ph_xconv(PP pk_, int g, LAS unsigned char* lds) { for (int it = bid_local(); it < TG / 256; it += gridDim.x) xconv_item(pk_, g, it, lds); __syncthreads(); }

DI int t5_bucket(int n) { return n < 16 ? n : min(31, 16 + (int)(__log2f((float)n * 0.0625f) * (16.f / 3.f))); }

typedef float f32x16 __attribute__((ext_vector_type(16)));
typedef __bf16 bf16x2_t __attribute__((ext_vector_type(2)));
typedef short s16x4 __attribute__((ext_vector_type(4)));
constexpr float LOG2E = 1.4426950408889634f;
DI unsigned pk_bf16(float a, float b) { const f32x2 v = {a, b}; return __builtin_bit_cast(unsigned, __builtin_convertvector(v, bf16x2_t)); }
DI int crow(int reg, int hh) { return (reg & 3) + 8 * (reg >> 2) + 4 * hh; }
#define MFMA32(a, b, c) __builtin_amdgcn_mfma_f32_32x32x16_bf16((a), (b), (c), 0, 0, 0)
DI bf16x8 tr_pair(const LAS unsigned char* a0, const LAS unsigned char* a1) {
    const s16x4 lo = __builtin_amdgcn_ds_read_tr16_b64_v4i16((LAS s16x4*)a0), hi = __builtin_amdgcn_ds_read_tr16_b64_v4i16((LAS s16x4*)a1);
    return __builtin_shufflevector(lo, hi, 0, 1, 2, 3, 4, 5, 6, 7);
}
DI bf16x8 pack_half(const f32x16& x, int s2) {
    u32x4 w;
#pragma unroll
    for (int k = 0; k < 4; ++k) w[k] = pk_bf16(x[8 * s2 + 2 * k], x[8 * s2 + 2 * k + 1]);
    return __builtin_bit_cast(bf16x8, w);
}
DI float xhalf_max(float x) { const auto r = __builtin_amdgcn_permlane32_swap(__builtin_bit_cast(int, x), __builtin_bit_cast(int, x), false, false); return fmaxf(__builtin_bit_cast(float, (int)r[0]), __builtin_bit_cast(float, (int)r[1])); }
DI float xhalf_sum(float x) { const auto r = __builtin_amdgcn_permlane32_swap(__builtin_bit_cast(int, x), __builtin_bit_cast(int, x), false, false); return __builtin_bit_cast(float, (int)r[0]) + __builtin_bit_cast(float, (int)r[1]); }
DI int next_item(unsigned* ctr, LAS unsigned char* lds) {
    volatile LAS int* slot = (volatile LAS int*)(lds + LDS_MISC + 64);
    __syncthreads();
    if (threadIdx.x == 0) *slot = (int)__hip_atomic_fetch_add(ctr, 1u, __ATOMIC_RELAXED, __HIP_MEMORY_SCOPE_AGENT);
    __syncthreads();
    return *slot;
}

constexpr int AT_KPITCH = 144, AT_VPITCH = 320, AT_KBYTES = 64 * AT_KPITCH, AT_VOFF = 2 * AT_KBYTES, AT_BUF = AT_VOFF + 64 * AT_VPITCH, AT_BT = 2 * AT_BUF;
DI void attn_tile(const LAS unsigned char* buf, int k0, int qw, int r, int hh, unsigned ka, unsigned va, const LAS float* bt, float cfar, const bf16x8 (&qf)[4], f32x16 (&O)[4], float& mrun, float& lrun) {
    if (k0 <= qw + 31) {
            const bool far = (qw - k0 - 63) >= 128, first = (k0 == 0);
            float sinit = (far ? cfar : 0.f) - (first ? 0.f : mrun); asm volatile("" : "+v"(sinit));
            f32x16 S[2];
#pragma unroll
            for (int sub = 0; sub < 2; ++sub)
#pragma unroll
                for (int i = 0; i < 16; ++i) S[sub][i] = sinit;
#pragma unroll
            for (int s = 0; s < 4; ++s)
#pragma unroll
                for (int sub = 0; sub < 2; ++sub) S[sub] = MFMA32(*(const LAS bf16x8*)(buf + ka + sub * 32 * AT_KPITCH + s * 32), qf[s], S[sub]);
            if (!far) {
#pragma unroll
                for (int sub = 0; sub < 2; ++sub) { float bv[16];
#pragma unroll
                    for (int i = 0; i < 16; ++i) { const int dist = (qw + r) - (k0 + sub * 32 + crow(i, hh)); bv[i] = bt[min(max(dist, 0), 128)]; }
#pragma unroll
                    for (int i = 0; i < 16; ++i) asm volatile("" : "+v"(bv[i]));
#pragma unroll
                    for (int i = 0; i < 16; ++i) { const int dist = (qw + r) - (k0 + sub * 32 + crow(i, hh)); S[sub][i] = dist < 0 ? -INFINITY : S[sub][i] + bv[i]; } }
            }
            float mx = fmaxf(S[0][0], S[1][0]);
#pragma unroll
            for (int i = 1; i < 16; ++i) mx = fmaxf(mx, fmaxf(S[0][i], S[1][i]));
            mx = xhalf_max(mx);
            if (first || __builtin_amdgcn_ballot_w64(mx > 6.f) != 0ull) {
                const float delta = first ? mx : fmaxf(mx, 0.f), alpha = first ? 1.f : __builtin_amdgcn_exp2f(-delta);
                mrun = (first ? 0.f : mrun) + delta; lrun *= alpha;
#pragma unroll
                for (int dt = 0; dt < 4; ++dt) O[dt] *= alpha;
#pragma unroll
                for (int sub = 0; sub < 2; ++sub)
#pragma unroll
                    for (int i = 0; i < 16; ++i) S[sub][i] -= delta;
            }
#pragma unroll
            for (int sub = 0; sub < 2; ++sub)
#pragma unroll
                for (int i = 0; i < 16; ++i) { S[sub][i] = __builtin_amdgcn_exp2f(S[sub][i]); lrun += S[sub][i]; }
#pragma unroll
            for (int sub = 0; sub < 2; ++sub)
#pragma unroll
                for (int s2 = 0; s2 < 2; ++s2) { const bf16x8 pb = pack_half(S[sub], s2); const LAS unsigned char* vb = buf + va + (sub * 32 + 16 * s2) * AT_VPITCH;
#pragma unroll
                    for (int dt = 0; dt < 4; ++dt) O[dt] = MFMA32(tr_pair(vb + dt * 64, vb + dt * 64 + 8 * AT_VPITCH), pb, O[dt]); }
        }
}
DI void attn_mfma_item(PP pk_, int item, LAS unsigned char* lds) { const P p = load_args(pk_);
    const int tid = tid_local(), lane = tid & 63, wave = __builtin_amdgcn_readfirstlane(tid >> 6), mp = wave & 1, rq = wave >> 1, hh = lane >> 5, r = lane & 31;
    const int qb = item & 15, h = (item >> 4) & 7, b = item >> 7;
    const int q0 = qb * 128, qw = q0 + rq * 32, nt = 2 * qb + 2;
    const bf16_t* U = WSP(bf16_t, WS_U); const size_t rbase = (size_t)b * SEQ;
    LAS float* bt = (LAS float*)(lds + AT_BT);
    __syncthreads();
    if (tid <= 128) bt[tid] = p.rel_bias[t5_bucket(tid) * 8 + h] * LOG2E;
    bf16x8 qf[4];
    { const bf16_t* qp = U + (rbase + qw + r) * NU + UQ + h * 128 + mp * 64 + 8 * hh;
#pragma unroll
      for (int s = 0; s < 4; ++s) qf[s] = *(const bf16x8*)(qp + 16 * s); }
    f32x16 O[4]; { const float z0 = zero_local();
#pragma unroll
    for (int dt = 0; dt < 4; ++dt)
#pragma unroll
        for (int i = 0; i < 16; ++i) O[dt][i] = z0; }
    float mrun = -INFINITY, lrun = 0.f;
    const int row0 = tid >> 4, c16 = tid & 15;
    const bf16_t* gk = U + (rbase + row0) * NU + UK + h * 128 + c16 * 8;
    const bf16_t* gv = U + (rbase + row0) * NU + UV + h * 128 + c16 * 8;
    const unsigned lk = (c16 >> 3) * AT_KBYTES + row0 * AT_KPITCH + (c16 & 7) * 16, lv = AT_VOFF + row0 * AT_VPITCH + c16 * 16;
    u32x4 st[4];
#define AT_LOAD(t_) do { const size_t o_ = (size_t)(t_) * 64 * NU; st[0] = *(const u32x4*)(gk + o_); st[1] = *(const u32x4*)(gk + o_ + (size_t)32 * NU); st[2] = *(const u32x4*)(gv + o_); st[3] = *(const u32x4*)(gv + o_ + (size_t)32 * NU); } while (0)
#define AT_STORE(bufp) do { *(LAS u32x4*)((bufp) + lk) = st[0]; *(LAS u32x4*)((bufp) + lk + 32 * AT_KPITCH) = st[1]; *(LAS u32x4*)((bufp) + lv) = st[2]; *(LAS u32x4*)((bufp) + lv + 32 * AT_VPITCH) = st[3]; } while (0)
    AT_LOAD(0); AT_STORE(lds); __syncthreads();
    const float cfar = bt[128];
    const unsigned ka = mp * AT_KBYTES + r * AT_KPITCH + hh * 16;
    const int i16 = lane & 15;
    const unsigned va = AT_VOFF + (4 * hh + (i16 >> 2)) * AT_VPITCH + (16 * ((lane >> 4) & 1) + 4 * (i16 & 3)) * 2;
    u32x4 st2[4];
#define AT_LOAD2(t_) do { const size_t o_ = (size_t)(t_) * 64 * NU; st2[0] = *(const u32x4*)(gk + o_); st2[1] = *(const u32x4*)(gk + o_ + (size_t)32 * NU); st2[2] = *(const u32x4*)(gv + o_); st2[3] = *(const u32x4*)(gv + o_ + (size_t)32 * NU); } while (0)
#define AT_STORE2(bufp) do { *(LAS u32x4*)((bufp) + lk) = st2[0]; *(LAS u32x4*)((bufp) + lk + 32 * AT_KPITCH) = st2[1]; *(LAS u32x4*)((bufp) + lv) = st2[2]; *(LAS u32x4*)((bufp) + lv + 32 * AT_VPITCH) = st2[3]; } while (0)
    AT_LOAD2(1);
    for (int t = 0; t < nt; t += 2) {
        if (t + 2 < nt) AT_LOAD(t + 2);
        attn_tile(lds, t * 64, qw, r, hh, ka, va, bt, cfar, qf, O, mrun, lrun);
        AT_STORE2(lds + AT_BUF);
        lds_barrier();
        if (t + 3 < nt) AT_LOAD2(t + 3);
        attn_tile(lds + AT_BUF, t * 64 + 64, qw, r, hh, ka, va, bt, cfar, qf, O, mrun, lrun);
        if (t + 2 < nt) AT_STORE(lds);
        lds_barrier();
    }
#undef AT_LOAD2
#undef AT_STORE2
#undef AT_LOAD
#undef AT_STORE
    const float inv = 1.f / xhalf_sum(lrun);
    LAS float* X = (LAS float*)lds;
    if (mp == 1) {
#pragma unroll
        for (int dt = 0; dt < 4; ++dt)
#pragma unroll
            for (int i = 0; i < 16; ++i) X[(rq * 64 + dt * 16 + i) * 64 + lane] = O[dt][i] * inv;
    }
    __syncthreads();
    if (mp == 0) {
        const float lam = *WSP(float, WS_MISC + MS_LAM); float ss = 0.f;
#pragma unroll
        for (int dt = 0; dt < 4; ++dt)
#pragma unroll
            for (int i = 0; i < 16; ++i) { const float v = O[dt][i] * inv - lam * X[(rq * 64 + dt * 16 + i) * 64 + lane]; O[dt][i] = v; ss += v * v; }
        ss = xhalf_sum(ss);
        const float rs = rsqrtf(ss * (1.f / 128.f) + LN_EPS) * 0.8f;
        bf16_t* yp = WSP(bf16_t, WS_Y) + (rbase + qw + r) * 3072 + h * 128;
#pragma unroll
        for (int dt = 0; dt < 4; ++dt)
#pragma unroll
            for (int g4 = 0; g4 < 4; ++g4) { const int dv = dt * 32 + 8 * g4 + 4 * hh; const f32x4 gn = *(const f32x4*)(p.subln_g + dv);
                u32x2 w; w.x = pk_bf16(O[dt][4 * g4] * rs * gn[0], O[dt][4 * g4 + 1] * rs * gn[1]); w.y = pk_bf16(O[dt][4 * g4 + 2] * rs * gn[2], O[dt][4 * g4 + 3] * rs * gn[3]);
                *(u32x2*)(yp + dv) = w; }
    }
}
DI void gate_tables(PP pk_, int g, int chain, LAS unsigned char* lds);
DI void ph_conv(PP pk_, int g, LAS unsigned char* lds) { const P p = load_args(pk_);
    if (g == 0 && bid_local() < BG * 4) gate_tables(pk_, g, bid_local(), lds);
    const int tid = tid_local();
    const bf16_t* U = WSP(bf16_t, WS_U); bf16_t* QKC = WSP(bf16_t, WS_QKC);
    for (int t = bid_local() * 512 + tid; t < (TG / 32) * 256; t += gridDim.x * 512) {
        const int c8 = t & 255, r0 = (t >> 8) * 32, isk = c8 >> 7; const float sc = isk ? 0.0625f : 1.f;
        f32x4 cw[4][2];
#pragma unroll
        for (int j = 0; j < 4; ++j) { cw[j][0] = *(const f32x4*)(p.conv_w + j * 2048 + c8 * 8); cw[j][1] = *(const f32x4*)(p.conv_w + j * 2048 + c8 * 8 + 4); }
        const bf16_t* src = U + (size_t)r0 * NU + UMQ + c8 * 8; bf16_t* dst = QKC + (size_t)r0 * 2048 + c8 * 8;
        const bool head = (r0 & (SEQ - 1)) == 0;
        u32x4 x0 = {0u, 0u, 0u, 0u}, x1 = x0, x2 = x0, x3;
        if (!head) { x0 = *(const u32x4*)(src - 3 * (size_t)NU); x1 = *(const u32x4*)(src - 2 * (size_t)NU); x2 = *(const u32x4*)(src - (size_t)NU); }
#define CONV_OUT(a_, b_, c_, d_, row_) do { float o_[8]; \
        o_[0] = cw[0][0][0] * bf_lo(a_.x) + cw[1][0][0] * bf_lo(b_.x) + cw[2][0][0] * bf_lo(c_.x) + cw[3][0][0] * bf_lo(d_.x); \
        o_[1] = cw[0][0][1] * bf_hi(a_.x) + cw[1][0][1] * bf_hi(b_.x) + cw[2][0][1] * bf_hi(c_.x) + cw[3][0][1] * bf_hi(d_.x); \
        o_[2] = cw[0][0][2] * bf_lo(a_.y) + cw[1][0][2] * bf_lo(b_.y) + cw[2][0][2] * bf_lo(c_.y) + cw[3][0][2] * bf_lo(d_.y); \
        o_[3] = cw[0][0][3] * bf_hi(a_.y) + cw[1][0][3] * bf_hi(b_.y) + cw[2][0][3] * bf_hi(c_.y) + cw[3][0][3] * bf_hi(d_.y); \
        o_[4] = cw[0][1][0] * bf_lo(a_.z) + cw[1][1][0] * bf_lo(b_.z) + cw[2][1][0] * bf_lo(c_.z) + cw[3][1][0] * bf_lo(d_.z); \
        o_[5] = cw[0][1][1] * bf_hi(a_.z) + cw[1][1][1] * bf_hi(b_.z) + cw[2][1][1] * bf_hi(c_.z) + cw[3][1][1] * bf_hi(d_.z); \
        o_[6] = cw[0][1][2] * bf_lo(a_.w) + cw[1][1][2] * bf_lo(b_.w) + cw[2][1][2] * bf_lo(c_.w) + cw[3][1][2] * bf_lo(d_.w); \
        o_[7] = cw[0][1][3] * bf_hi(a_.w) + cw[1][1][3] * bf_hi(b_.w) + cw[2][1][3] * bf_hi(c_.w) + cw[3][1][3] * bf_hi(d_.w); \
        u32x4 w_; w_.x = pk_bf16(silu(o_[0]) * sc, silu(o_[1]) * sc); w_.y = pk_bf16(silu(o_[2]) * sc, silu(o_[3]) * sc); w_.z = pk_bf16(silu(o_[4]) * sc, silu(o_[5]) * sc); w_.w = pk_bf16(silu(o_[6]) * sc, silu(o_[7]) * sc); \
        *(u32x4*)(dst + (size_t)(row_) * 2048) = w_; } while (0)
        u32x4 y0 = *(const u32x4*)(src), y1 = *(const u32x4*)(src + (size_t)NU), y2 = *(const u32x4*)(src + (size_t)2 * NU), y3 = *(const u32x4*)(src + (size_t)3 * NU);
#pragma unroll 1
        for (int i = 0; i < 32; i += 4) {
            u32x4 n0 = y0, n1 = y1, n2 = y2, n3 = y3;
            if (i + 4 < 32) { n0 = *(const u32x4*)(src + (size_t)(i + 4) * NU); n1 = *(const u32x4*)(src + (size_t)(i + 5) * NU); n2 = *(const u32x4*)(src + (size_t)(i + 6) * NU); n3 = *(const u32x4*)(src + (size_t)(i + 7) * NU); }
            x3 = y0; CONV_OUT(x0, x1, x2, x3, i);
            CONV_OUT(x1, x2, y0, y1, i + 1);
            CONV_OUT(x2, y0, y1, y2, i + 2);
            CONV_OUT(y0, y1, y2, y3, i + 3);
            x0 = y1; x1 = y2; x2 = y3; y0 = n0; y1 = n1; y2 = n2; y3 = n3;
        }
#undef CONV_OUT
    }
}
constexpr int ML_QP = 528, ML_KP = 576, ML_VP = 576, ML_WP = 144;
constexpr int ML_Q = 0, ML_K = ML_Q + 64 * ML_QP, ML_V = ML_K + 64 * ML_KP, ML_W = ML_V + 64 * ML_VP, ML_TAB = ML_W + 64 * ML_WP;
constexpr int T_BCUM = 0, T_A = 256, T_MROW = 512, T_IW = 768, T_WS = 1024, T_RS = 1280, T_ND = 2304, T_GI = 2560, T_GF = 2816, T_N = 3072, T_SC = 4096, T_INVD = 4352, T_NP = 4608;
static_assert(ML_TAB + 4608 + 2048 <= LDS_RING, "mLSTM LDS map");
#ifndef ML_NSEG
#define ML_NSEG 1
#endif
constexpr int NSEG = ML_NSEG, SEGCH = (SEQ / 64) / NSEG;
constexpr size_t WS_GT = WS_R + 836 * MiB, WS_LST = WS_R + 840 * MiB;
constexpr int GT_STRIDE = 384, LST_STRIDE = 128 * 512 + 256;
static_assert(WS_LST + (size_t)BG * 4 * (NSEG - 1) * LST_STRIDE * 4 <= WS_END, "segment states fit");
DI void gate_tables(PP pk_, int g, int chain, LAS unsigned char* lds) { const P p = load_args(pk_);
    const int tid = tid_local(), lane = tid & 63, w = tid >> 6, h = chain & 3, b = chain >> 2;
    const float* gif = WSP(float, WS_GIF); float* GT = WSP(float, WS_GT) + (size_t)chain * 32 * GT_STRIDE;
    const size_t tbase = ((size_t)g * BG + b) * SEQ;
    LAS float* tot = (LAS float*)lds; LAS float* amx = tot + 32;
    float bc[4], aa[4], pm[4];
    __syncthreads();
#pragma unroll
    for (int k = 0; k < 4; ++k) { const int c = w + 8 * k; const float ip = gif[(tbase + c * 64 + lane) * 8 + h], fp = gif[(tbase + c * 64 + lane) * 8 + 4 + h];
        float x = fminf(fp, 0.f) - log1pf(expf(-fabsf(fp)));
#pragma unroll
        for (int o = 1; o < 64; o <<= 1) { const float t = bperm(x, lane - o); if (lane >= o) x += t; }
        float y = ip - x; const float a0 = y;
#pragma unroll
        for (int o = 1; o < 64; o <<= 1) { const float t = bperm(y, lane - o); if (lane >= o) y = fmaxf(y, t); }
        bc[k] = x; aa[k] = a0; pm[k] = y;
        if (lane == 63) { tot[c] = x; amx[c] = y; } }
    __syncthreads();
    float mst = 0.f, min_[4];
    for (int c = 0; c < 32; ++c) {
#pragma unroll
        for (int k = 0; k < 4; ++k) if (c == w + 8 * k) min_[k] = mst;
        mst = tot[c] + fmaxf(mst, amx[c]); }
#pragma unroll
    for (int k = 0; k < 4; ++k) { const int c = w + 8 * k; const float m0 = min_[k], total = tot[c], amax = amx[c];
        const float mrow = bc[k] + fmaxf(m0, pm[k]), iw = expf(bc[k] + m0 - mrow), mnew = total + fmaxf(m0, amax), decay = expf(total + m0 - mnew), ws = expf(total + aa[k] - mnew);
        float* o = GT + (size_t)c * GT_STRIDE; o[lane] = bc[k]; o[64 + lane] = aa[k]; o[128 + lane] = mrow; o[192 + lane] = iw; o[256 + lane] = ws; if (lane == 0) o[320] = decay; }
    __syncthreads();
}

template <int mode> DI void mlstm_seg_item(PP pk_, int g, int chain, int seg, LAS unsigned char* lds) { const P p = load_args(pk_);
    const int tid0 = tid_local(), w = __builtin_amdgcn_readfirstlane(tid0 >> 6);
    const int h = chain & 3, b = chain >> 2;
    const bf16_t* U = WSP(bf16_t, WS_U); bf16_t* HB = WSP(bf16_t, WS_MRG); const bf16_t* QKC = WSP(bf16_t, WS_QKC);
    const float* GT = WSP(float, WS_GT) + (size_t)chain * 32 * GT_STRIDE; float* LS = WSP(float, WS_LST) + (size_t)chain * (NSEG - 1) * LST_STRIDE;
    const size_t rbase = (size_t)b * SEQ;
    LAS unsigned char* TB = lds + ML_TAB;
#define TABF(off) ((LAS float*)(TB + (off)))
    f32x16 C[8]; { const float z0 = zero_local();
#pragma unroll
    for (int kt = 0; kt < 8; ++kt)
#pragma unroll
        for (int i = 0; i < 16; ++i) C[kt][i] = z0; }
    __syncthreads();
    { float nn = 0.f;
      if (mode == 1 && seg > 0) {
          const f32x4* Lq = (const f32x4*)(LS + (size_t)(seg - 1) * LST_STRIDE + (size_t)tid0 * 128);
#pragma unroll
          for (int kt = 0; kt < 8; ++kt)
#pragma unroll
              for (int i4 = 0; i4 < 4; ++i4) { const f32x4 l = Lq[kt * 4 + i4]; C[kt][4 * i4] = l[0]; C[kt][4 * i4 + 1] = l[1]; C[kt][4 * i4 + 2] = l[2]; C[kt][4 * i4 + 3] = l[3]; }
          if (tid0 < 256) nn = LS[(size_t)(seg - 1) * LST_STRIDE + 128 * 512 + tid0]; }
      if (tid0 < 256) TABF(T_N)[tid0] = nn; }
    const int ch0 = mode == 1 ? seg * SEGCH : 0, nch = mode == 1 ? SEGCH : SEQ / 64;
    u32x4 pq[2]; float tq[6] = {0.f, 0.f, 0.f, 0.f, 0.f, 0.f};
#define ML_PQ(ch_, tv_) do { if ((tv_) < 64) { const float* gt_ = GT + (size_t)(ch_) * GT_STRIDE + (tv_); tq[0] = gt_[0]; tq[1] = gt_[64]; tq[2] = gt_[128]; tq[3] = gt_[192]; tq[4] = gt_[256]; tq[5] = GT[(size_t)(ch_) * GT_STRIDE + 320]; } _Pragma("unroll") for (int i_ = 0; i_ < 2; ++i_) { const int pc_ = (tv_) + 512 * i_, s_ = pc_ >> 5, cc_ = pc_ & 31; pq[i_] = *(const u32x4*)(QKC + (rbase + (ch_) * 64 + s_) * 2048 + h * 256 + cc_ * 8); } } while (0)
    if (mode == 1) ML_PQ(ch0, tid0);
    u32x4 pk[4], pv[4];
#define ML_PF(ch_, tv_) do { _Pragma("unroll") for (int i_ = 0; i_ < 4; ++i_) { const int pc_ = (tv_) + 512 * i_, s_ = pc_ >> 5, cc_ = pc_ & 31; const size_t row_ = rbase + (ch_) * 64 + s_; \
        pk[i_] = *(const u32x4*)(QKC + row_ * 2048 + 1024 + h * 256 + cc_ * 8); pv[i_] = *(const u32x4*)(U + row_ * NU + UMV + h * 256 + cc_ * 8); } } while (0)
    if (mode == 0) ML_PF(0, tid0);
    for (int ch = ch0; ch < ch0 + nch; ++ch) {
        int tid = tid0; asm volatile("" : "+v"(tid));
        const int lane = tid & 63, hh = lane >> 5, r = lane & 31, i16 = lane & 15, l4 = lane >> 4;
        lds_barrier();
        if (mode == 0 && ch > 0 && (ch % SEGCH) == 0) {
            const int sg = ch / SEGCH - 1;
            f32x4* Lq = (f32x4*)(LS + (size_t)sg * LST_STRIDE + (size_t)tid * 128);
#pragma unroll
            for (int kt = 0; kt < 8; ++kt)
#pragma unroll
                for (int i4 = 0; i4 < 4; ++i4) Lq[kt * 4 + i4] = (f32x4){C[kt][4 * i4], C[kt][4 * i4 + 1], C[kt][4 * i4 + 2], C[kt][4 * i4 + 3]};
            if (tid < 256) LS[(size_t)sg * LST_STRIDE + 128 * 512 + tid] = TABF(T_N)[tid];
        }
        {
#pragma unroll
            for (int i = 0; i < 4; ++i) { const int pc = tid + 512 * i, s = pc >> 5, cc = pc & 31;
                if (mode == 1) *(LAS u32x4*)(lds + ML_Q + s * ML_QP + cc * 16) = i < 2 ? pq[i & 1] : *(const u32x4*)(QKC + (rbase + ch * 64 + s) * 2048 + h * 256 + cc * 8);
                *(LAS u32x4*)(lds + ML_K + s * ML_KP + cc * 16) = mode == 0 ? pk[i] : *(const u32x4*)(QKC + (rbase + ch * 64 + s) * 2048 + 1024 + h * 256 + cc * 8); }
            if (mode == 1) { if (tid < 64) { TABF(T_BCUM)[tid] = tq[0]; TABF(T_A)[tid] = tq[1]; TABF(T_MROW)[tid] = tq[2]; TABF(T_IW)[tid] = tq[3]; TABF(T_WS)[tid] = tq[4]; if (tid == 0) TABF(T_SC)[1] = tq[5]; } }
            else if (tid < 64) { const float* gt = GT + (size_t)ch * GT_STRIDE + tid; TABF(T_BCUM)[tid] = gt[0]; TABF(T_A)[tid] = gt[64]; TABF(T_MROW)[tid] = gt[128]; TABF(T_IW)[tid] = gt[192]; TABF(T_WS)[tid] = gt[256]; if (tid == 0) TABF(T_SC)[1] = gt[320]; }
        }
        u32x4 vf[4];
#pragma unroll
        for (int i = 0; i < 4; ++i) { const int pc = tid + 512 * i, s = pc >> 5, cc = pc & 31; vf[i] = mode == 0 ? pv[i] : *(const u32x4*)(U + (rbase + ch * 64 + s) * NU + UMV + h * 256 + cc * 8); }
        if (mode == 0 && ch + 1 < ch0 + nch) ML_PF(ch + 1, tid);
        const unsigned vtr = ML_V + (8 * hh + (i16 >> 2)) * ML_VP + (32 * w + 16 * (l4 & 1) + 4 * (i16 & 3)) * 2;
        if (mode == 1) {
        lds_barrier();
        f32x4 S2[2];
#pragma unroll
        for (int tt = 0; tt < 2; ++tt) { const int tile = 2 * w + tt, jt = tile >> 2, st = tile & 3; f32x4 s = {0.f, 0.f, 0.f, 0.f};
            const LAS unsigned char* qa = lds + ML_Q + (jt * 16 + i16) * ML_QP + l4 * 16; const LAS unsigned char* ka = lds + ML_K + (st * 16 + i16) * ML_KP + l4 * 16;
#pragma unroll
            for (int c = 0; c < 8; ++c) s = __builtin_amdgcn_mfma_f32_16x16x32_bf16(*(const LAS bf16x8*)(qa + c * 64), *(const LAS bf16x8*)(ka + c * 64), s, 0, 0, 0);
            S2[tt] = s; }
        { const f32x4 nv = *(const LAS f32x4*)(TABF(T_N) + 4 * lane);
#pragma unroll
          for (int jj = 0; jj < 8; ++jj) { const int j = 8 * w + jj; const u32x2 qw = *(const LAS u32x2*)(lds + ML_Q + j * ML_QP + lane * 8);
              const float d = wave_sum_fast(bf_lo(qw.x) * nv[0] + bf_hi(qw.x) * nv[1] + bf_lo(qw.y) * nv[2] + bf_hi(qw.y) * nv[3]); if (lane == 0) TABF(T_ND)[j] = d; } }
#pragma unroll
        for (int tt = 0; tt < 2; ++tt) { const int tile = 2 * w + tt, jt = tile >> 2, st = tile & 3, s = st * 16 + i16; const float as = TABF(T_A)[s];
#pragma unroll
            for (int rg = 0; rg < 4; ++rg) { const int j = jt * 16 + l4 * 4 + rg;
                float val = s <= j ? __expf(TABF(T_BCUM)[j] + as - TABF(T_MROW)[j]) * S2[tt][rg] : 0.f;
                *(LAS bf16_t*)(lds + ML_W + j * ML_WP + s * 2) = (bf16_t)(pk_bf16(val, 0.f) & 0xffffu);
                val = row16_sum(val);
                if (i16 == 0) TABF(T_RS)[j * 4 + st] = val; } }
        }
#pragma unroll
        for (int i = 0; i < 4; ++i) { const int pc = tid + 512 * i, s = pc >> 5, cc = pc & 31; *(LAS u32x4*)(lds + ML_V + s * ML_VP + cc * 16) = vf[i]; }
        lds_barrier();
        if (mode == 1) {
        if (tid < 64) { const int j = tid; const f32x4 rs = *(const LAS f32x4*)(TABF(T_RS) + 4 * j);
            const float den = TABF(T_IW)[j] * TABF(T_ND)[j] + ((rs[0] + rs[1]) + (rs[2] + rs[3]));
            TABF(T_INVD)[j] = 1.f / fmaxf(fabsf(den), expf(-TABF(T_MROW)[j])); }
        f32x16 acc[2]; { const float z0 = zero_local();
#pragma unroll
        for (int jt2 = 0; jt2 < 2; ++jt2)
#pragma unroll
            for (int i = 0; i < 16; ++i) acc[jt2][i] = z0; }
#pragma unroll
        for (int kt = 0; kt < 8; ++kt) { __builtin_amdgcn_sched_barrier(0);
#pragma unroll
            for (int s = 0; s < 2; ++s) { const bf16x8 bfr = pack_half(C[kt], s);
#pragma unroll
                for (int jt2 = 0; jt2 < 2; ++jt2) { const LAS unsigned char* qa = lds + ML_Q + (jt2 * 32 + r) * ML_QP + (kt * 32 + 16 * s + 4 * hh) * 2;
                    const s16x4 lo = *(const LAS s16x4*)qa, hi = *(const LAS s16x4*)(qa + 16);
                    acc[jt2] = MFMA32(__builtin_shufflevector(lo, hi, 0, 1, 2, 3, 4, 5, 6, 7), bfr, acc[jt2]); } } }
        __builtin_amdgcn_sched_barrier(0);
#pragma unroll
        for (int jt2 = 0; jt2 < 2; ++jt2)
#pragma unroll
            for (int i = 0; i < 16; ++i) acc[jt2][i] *= TABF(T_IW)[jt2 * 32 + crow(i, hh)];
#pragma unroll
        for (int ks = 0; ks < 4; ++ks) { const bf16x8 bv = tr_pair(lds + vtr + 16 * ks * ML_VP, lds + vtr + (16 * ks + 4) * ML_VP);
#pragma unroll
            for (int jt2 = 0; jt2 < 2; ++jt2) acc[jt2] = MFMA32(*(const LAS bf16x8*)(lds + ML_W + (jt2 * 32 + r) * ML_WP + (16 * ks + 8 * hh) * 2), bv, acc[jt2]); }
        lds_barrier();
#pragma unroll
        for (int jt2 = 0; jt2 < 2; ++jt2)
#pragma unroll
            for (int i = 0; i < 16; ++i) { const int j = jt2 * 32 + crow(i, hh); *(LAS bf16_t*)(lds + ML_Q + j * 512 + (32 * w + r) * 2) = (bf16_t)(pk_bf16(acc[jt2][i] * TABF(T_INVD)[j], 0.f) & 0xffffu); }
        }
        const float decay = TABF(T_SC)[1];
        { const int dk = tid & 255, sh = tid >> 8; float nn = 0.f;
#pragma unroll 8
          for (int s = 32 * sh; s < 32 * sh + 32; ++s) nn += TABF(T_WS)[s] * bf2f(*(const LAS bf16_t*)(lds + ML_K + s * ML_KP + dk * 2));
          TABF(T_NP)[tid] = nn; }
#pragma unroll
        for (int kt = 0; kt < 8; ++kt) C[kt] *= decay;
        const unsigned ktr = ML_K + (8 * hh + (i16 >> 2)) * ML_KP + (16 * (l4 & 1) + 4 * (i16 & 3)) * 2;
#pragma unroll
        for (int ks = 0; ks < 4; ++ks) { __builtin_amdgcn_sched_barrier(0); const bf16x8 bv = tr_pair(lds + vtr + 16 * ks * ML_VP, lds + vtr + (16 * ks + 4) * ML_VP);
            const u32x4 bw = __builtin_bit_cast(u32x4, bv); const f32x4 w0 = *(const LAS f32x4*)(TABF(T_WS) + 16 * ks + 8 * hh), w1 = *(const LAS f32x4*)(TABF(T_WS) + 16 * ks + 8 * hh + 4);
            u32x4 sw; sw.x = pk_bf16(bf_lo(bw.x) * w0[0], bf_hi(bw.x) * w0[1]); sw.y = pk_bf16(bf_lo(bw.y) * w0[2], bf_hi(bw.y) * w0[3]); sw.z = pk_bf16(bf_lo(bw.z) * w1[0], bf_hi(bw.z) * w1[1]); sw.w = pk_bf16(bf_lo(bw.w) * w1[2], bf_hi(bw.w) * w1[3]);
            const bf16x8 bs = __builtin_bit_cast(bf16x8, sw);
#pragma unroll
            for (int kt = 0; kt < 8; ++kt) C[kt] = MFMA32(tr_pair(lds + ktr + 16 * ks * ML_KP + kt * 64, lds + ktr + (16 * ks + 4) * ML_KP + kt * 64), bs, C[kt]); }
        lds_barrier();
        if (tid < 256) TABF(T_N)[tid] = TABF(T_N)[tid] * decay + (TABF(T_NP)[tid] + TABF(T_NP)[tid + 256]);
        if (mode == 1) {
#pragma unroll
            for (int i = 0; i < 4; ++i) { const int pc = tid + 512 * i, s = pc >> 5, cc = pc & 31; *(u32x4*)(HB + (rbase + ch * 64 + s) * 1024 + h * 256 + cc * 8) = *(const LAS u32x4*)(lds + ML_Q + s * 512 + cc * 16); }
            if (ch + 1 < ch0 + nch) ML_PQ(ch + 1, tid);
        }
    }
#undef TABF
#undef ML_PF
#undef ML_PQ
}
constexpr int M2_QP = 528, M2_KP = 576, M2_VP = 320, M2_WP = 144;
constexpr int M2_Q = 0, M2_K = M2_Q + 64 * M2_QP, M2_V = M2_K + 64 * M2_KP, M2_W = M2_V + 64 * M2_VP, M2_TAB = M2_W + 64 * M2_WP, M2_X = M2_TAB + 7168;
static_assert(M2_X + 32768 <= LDS_RING, "split-mLSTM LDS map");
DI void mlstm_half_item(PP pk_, int g, int item, LAS unsigned char* lds) { const P p = load_args(pk_);
    const int tid0 = tid_local(), w = __builtin_amdgcn_readfirstlane(tid0 >> 6), vs = w & 3, kh = w >> 2;
    const int half = item & 1, chain = item >> 1, h = chain & 3, b = chain >> 2;
    const bf16_t* U = WSP(bf16_t, WS_U); bf16_t* HB = WSP(bf16_t, WS_MRG); const bf16_t* QKC = WSP(bf16_t, WS_QKC);
    const float* GT = WSP(float, WS_GT) + (size_t)chain * 32 * GT_STRIDE;
    const size_t rbase = (size_t)b * SEQ;
    LAS unsigned char* TB = lds + M2_TAB;
#define TABF(off) ((LAS float*)(TB + (off)))
    f32x16 C[4]; { const float z0 = zero_local();
#pragma unroll
    for (int kt = 0; kt < 4; ++kt)
#pragma unroll
        for (int i = 0; i < 16; ++i) C[kt][i] = z0; }
    __syncthreads();
    if (tid0 < 256) TABF(T_N)[tid0] = 0.f;
    u32x4 pq[4], pk[4], pv[2]; float tq[6] = {0.f, 0.f, 0.f, 0.f, 0.f, 0.f};
#define M2_PF(ch_, tv_) do { if ((tv_) < 64) { const float* gt_ = GT + (size_t)(ch_) * GT_STRIDE + (tv_); tq[0] = gt_[0]; tq[1] = gt_[64]; tq[2] = gt_[128]; tq[3] = gt_[192]; tq[4] = gt_[256]; tq[5] = GT[(size_t)(ch_) * GT_STRIDE + 320]; } \
        _Pragma("unroll") for (int i_ = 0; i_ < 4; ++i_) { const int pc_ = (tv_) + 512 * i_, s_ = pc_ >> 5, cc_ = pc_ & 31; const bf16_t* r_ = QKC + (rbase + (ch_) * 64 + s_) * 2048 + h * 256 + cc_ * 8; pq[i_] = *(const u32x4*)r_; pk[i_] = *(const u32x4*)(r_ + 1024); } \
        _Pragma("unroll") for (int i_ = 0; i_ < 2; ++i_) { const int pc_ = (tv_) + 512 * i_, s_ = pc_ >> 4, cc_ = pc_ & 15; pv[i_] = *(const u32x4*)(U + (rbase + (ch_) * 64 + s_) * NU + UMV + h * 256 + half * 128 + cc_ * 8); } } while (0)
    M2_PF(0, tid0);
    for (int ch = 0; ch < SEQ / 64; ++ch) {
        int tid = tid0; asm volatile("" : "+v"(tid));
        const int lane = tid & 63, hh = lane >> 5, r = lane & 31, i16 = lane & 15, l4 = lane >> 4;
        lds_barrier();
#pragma unroll
        for (int i = 0; i < 4; ++i) { const int pc = tid + 512 * i, s = pc >> 5, cc = pc & 31; *(LAS u32x4*)(lds + M2_Q + s * M2_QP + cc * 16) = pq[i]; *(LAS u32x4*)(lds + M2_K + s * M2_KP + cc * 16) = pk[i]; }
#pragma unroll
        for (int i = 0; i < 2; ++i) { const int pc = tid + 512 * i, s = pc >> 4, cc = pc & 15; *(LAS u32x4*)(lds + M2_V + s * M2_VP + cc * 16) = pv[i]; }
        if (tid < 64) { TABF(T_BCUM)[tid] = tq[0]; TABF(T_A)[tid] = tq[1]; TABF(T_MROW)[tid] = tq[2]; TABF(T_IW)[tid] = tq[3]; TABF(T_WS)[tid] = tq[4]; if (tid == 0) TABF(T_SC)[1] = tq[5]; }
        if (ch + 1 < SEQ / 64) M2_PF(ch + 1, tid);
        lds_barrier();
        f32x4 S2[2];
#pragma unroll
        for (int tt = 0; tt < 2; ++tt) { const int tile = 2 * w + tt, jt = tile >> 2, st = tile & 3; f32x4 s = {0.f, 0.f, 0.f, 0.f};
            const LAS unsigned char* qa = lds + M2_Q + (jt * 16 + i16) * M2_QP + l4 * 16; const LAS unsigned char* ka = lds + M2_K + (st * 16 + i16) * M2_KP + l4 * 16;
#pragma unroll
            for (int c = 0; c < 8; ++c) s = __builtin_amdgcn_mfma_f32_16x16x32_bf16(*(const LAS bf16x8*)(qa + c * 64), *(const LAS bf16x8*)(ka + c * 64), s, 0, 0, 0);
            S2[tt] = s; }
        { const f32x4 nv = *(const LAS f32x4*)(TABF(T_N) + 4 * lane);
#pragma unroll
          for (int jj = 0; jj < 8; ++jj) { const int j = 8 * w + jj; const u32x2 qw = *(const LAS u32x2*)(lds + M2_Q + j * M2_QP + lane * 8);
              const float d = wave_sum_fast(bf_lo(qw.x) * nv[0] + bf_hi(qw.x) * nv[1] + bf_lo(qw.y) * nv[2] + bf_hi(qw.y) * nv[3]); if (lane == 0) TABF(T_ND)[j] = d; } }
#pragma unroll
        for (int tt = 0; tt < 2; ++tt) { const int tile = 2 * w + tt, jt = tile >> 2, st = tile & 3, s = st * 16 + i16; const float as = TABF(T_A)[s];
#pragma unroll
            for (int rg = 0; rg < 4; ++rg) { const int j = jt * 16 + l4 * 4 + rg;
                float val = s <= j ? __expf(TABF(T_BCUM)[j] + as - TABF(T_MROW)[j]) * S2[tt][rg] : 0.f;
                *(LAS bf16_t*)(lds + M2_W + j * M2_WP + s * 2) = (bf16_t)(pk_bf16(val, 0.f) & 0xffffu);
                val = row16_sum(val);
                if (i16 == 0) TABF(T_RS)[j * 4 + st] = val; } }
        lds_barrier();
        if (tid < 64) { const int j = tid; const f32x4 rs = *(const LAS f32x4*)(TABF(T_RS) + 4 * j);
            const float den = TABF(T_IW)[j] * TABF(T_ND)[j] + ((rs[0] + rs[1]) + (rs[2] + rs[3]));
            TABF(T_INVD)[j] = 1.f / fmaxf(fabsf(den), expf(-TABF(T_MROW)[j])); }
        f32x16 acc[2]; { const float z0 = zero_local();
#pragma unroll
        for (int jt2 = 0; jt2 < 2; ++jt2)
#pragma unroll
            for (int i = 0; i < 16; ++i) acc[jt2][i] = z0; }
#pragma unroll
        for (int kt = 0; kt < 4; ++kt)
#pragma unroll
            for (int s = 0; s < 2; ++s) { const bf16x8 bfr = pack_half(C[kt], s);
#pragma unroll
                for (int jt2 = 0; jt2 < 2; ++jt2) { const LAS unsigned char* qa = lds + M2_Q + (jt2 * 32 + r) * M2_QP + (128 * kh + kt * 32 + 16 * s + 4 * hh) * 2;
                    const s16x4 lo = *(const LAS s16x4*)qa, hi = *(const LAS s16x4*)(qa + 16);
                    acc[jt2] = MFMA32(__builtin_shufflevector(lo, hi, 0, 1, 2, 3, 4, 5, 6, 7), bfr, acc[jt2]); } }
        { LAS float* X = (LAS float*)(lds + M2_X);
#pragma unroll
          for (int i = 0; i < 16; ++i) X[(w * 16 + i) * 64 + lane] = kh == 0 ? acc[1][i] : acc[0][i]; }
        lds_barrier();
        f32x16 num;
        { const LAS float* X = (const LAS float*)(lds + M2_X);
#pragma unroll
          for (int i = 0; i < 16; ++i) num[i] = ((kh == 0 ? acc[0][i] : acc[1][i]) + X[((w ^ 4) * 16 + i) * 64 + lane]) * TABF(T_IW)[kh * 32 + crow(i, hh)]; }
        const unsigned vtr = M2_V + (8 * hh + (i16 >> 2)) * M2_VP + (32 * vs + 16 * (l4 & 1) + 4 * (i16 & 3)) * 2;
#pragma unroll
        for (int ks = 0; ks < 4; ++ks) num = MFMA32(*(const LAS bf16x8*)(lds + M2_W + (kh * 32 + r) * M2_WP + (16 * ks + 8 * hh) * 2), tr_pair(lds + vtr + 16 * ks * M2_VP, lds + vtr + (16 * ks + 4) * M2_VP), num);
        lds_barrier();
#pragma unroll
        for (int i = 0; i < 16; ++i) { const int j = kh * 32 + crow(i, hh); *(LAS bf16_t*)(lds + M2_Q + j * 256 + (32 * vs + r) * 2) = (bf16_t)(pk_bf16(num[i] * TABF(T_INVD)[j], 0.f) & 0xffffu); }
        const float decay = TABF(T_SC)[1];
        { const int dk = tid & 255, sh = tid >> 8; float nn = 0.f;
#pragma unroll 8
          for (int s = 32 * sh; s < 32 * sh + 32; ++s) nn += TABF(T_WS)[s] * bf2f(*(const LAS bf16_t*)(lds + M2_K + s * M2_KP + dk * 2));
          TABF(T_NP)[tid] = nn; }
#pragma unroll
        for (int kt = 0; kt < 4; ++kt) C[kt] *= decay;
        const unsigned ktr = M2_K + (8 * hh + (i16 >> 2)) * M2_KP + (128 * kh + 16 * (l4 & 1) + 4 * (i16 & 3)) * 2;
#pragma unroll
        for (int ks = 0; ks < 4; ++ks) { const bf16x8 bv = tr_pair(lds + vtr + 16 * ks * M2_VP, lds + vtr + (16 * ks + 4) * M2_VP);
            const u32x4 bw = __builtin_bit_cast(u32x4, bv); const f32x4 w0 = *(const LAS f32x4*)(TABF(T_WS) + 16 * ks + 8 * hh), w1 = *(const LAS f32x4*)(TABF(T_WS) + 16 * ks + 8 * hh + 4);
            u32x4 sw; sw.x = pk_bf16(bf_lo(bw.x) * w0[0], bf_hi(bw.x) * w0[1]); sw.y = pk_bf16(bf_lo(bw.y) * w0[2], bf_hi(bw.y) * w0[3]); sw.z = pk_bf16(bf_lo(bw.z) * w1[0], bf_hi(bw.z) * w1[1]); sw.w = pk_bf16(bf_lo(bw.w) * w1[2], bf_hi(bw.w) * w1[3]);
            const bf16x8 bs = __builtin_bit_cast(bf16x8, sw);
#pragma unroll
            for (int kt = 0; kt < 4; ++kt) C[kt] = MFMA32(tr_pair(lds + ktr + 16 * ks * M2_KP + kt * 64, lds + ktr + (16 * ks + 4) * M2_KP + kt * 64), bs, C[kt]); }
        lds_barrier();
        if (tid < 256) TABF(T_N)[tid] = TABF(T_N)[tid] * decay + (TABF(T_NP)[tid] + TABF(T_NP)[tid + 256]);
#pragma unroll
        for (int i = 0; i < 2; ++i) { const int pc = tid + 512 * i, s = pc >> 4, cc = pc & 15; *(u32x4*)(HB + (rbase + ch * 64 + s) * 1024 + h * 256 + half * 128 + cc * 8) = *(const LAS u32x4*)(lds + M2_Q + s * 256 + cc * 16); }
    }
#undef TABF
#undef M2_PF
}
constexpr int XA_KP = 528, XA_VP = 576, XA_VOFF = 32 * XA_KP, XA_BUF = XA_VOFF + 32 * XA_VP;
static_assert(2 * XA_BUF <= LDS_RING, "xattn LDS map");
DI void xattn_tile(const LAS unsigned char* buf, unsigned ka, unsigned va, const bf16x8 (&qf)[16], f32x16 (&O)[4], float& mrun, float& lrun) {
        f32x16 S, S1; { const float z0 = zero_local();
#pragma unroll
        for (int i = 0; i < 16; ++i) { S[i] = z0; S1[i] = z0; } }
#pragma unroll
        for (int s = 0; s < 16; s += 2) { S = MFMA32(*(const LAS bf16x8*)(buf + ka + s * 32), qf[s], S); S1 = MFMA32(*(const LAS bf16x8*)(buf + ka + (s + 1) * 32), qf[s + 1], S1); }
        S += S1;
        float mx = S[0];
#pragma unroll
        for (int i = 1; i < 16; ++i) mx = fmaxf(mx, S[i]);
        mx = xhalf_max(mx);
        const float mnew = fmaxf(mrun, mx);
        if (__builtin_amdgcn_ballot_w64(mnew > mrun) != 0ull) { const float alpha = __builtin_amdgcn_exp2f(mrun - mnew); lrun *= alpha;
#pragma unroll
            for (int dt = 0; dt < 4; ++dt) O[dt] *= alpha; }
        mrun = mnew;
#pragma unroll
        for (int i = 0; i < 16; ++i) { S[i] = __builtin_amdgcn_exp2f(S[i] - mnew); lrun += S[i]; }
#pragma unroll
        for (int s2 = 0; s2 < 2; ++s2) { const bf16x8 pb = pack_half(S, s2); const LAS unsigned char* vb = buf + va + 16 * s2 * XA_VP;
#pragma unroll
            for (int dt = 0; dt < 4; ++dt) O[dt] = MFMA32(tr_pair(vb + dt * 64, vb + dt * 64 + 8 * XA_VP), pb, O[dt]); }
}
DI void xattn_mfma_item(PP pk_, int g, int item, LAS unsigned char* lds) { const P p = load_args(pk_);
    const int tid = tid_local(), lane = tid & 63, wave = __builtin_amdgcn_readfirstlane(tid >> 6), dvh = wave & 1, rq = wave >> 1, hh = lane >> 5, r = lane & 31;
    const int qb = item & 15, h = (item >> 4) & 3, b = item >> 6;
    const bf16_t* U = WSP(bf16_t, WS_U); const bf16_t* KV = WSP(bf16_t, WS_KVM) + (size_t)(g * BG + b) * 256 * 2048 + h * 256;
    const size_t qrow = (size_t)b * SEQ + qb * 128 + rq * 32 + r;
    bf16x8 qf[16];
    { const bf16_t* qp = U + qrow * NU + UCQ + h * 256 + 8 * hh;
#pragma unroll
      for (int s = 0; s < 16; ++s) qf[s] = *(const bf16x8*)(qp + 16 * s); }
    f32x16 O[4]; { const float z0 = zero_local();
#pragma unroll
    for (int dt = 0; dt < 4; ++dt)
#pragma unroll
        for (int i = 0; i < 16; ++i) O[dt][i] = z0; }
    float mrun = -INFINITY, lrun = 0.f;
    const int row0 = tid >> 5, c32 = tid & 31;
    const bf16_t* gk = KV + (size_t)row0 * 2048 + c32 * 8;
    const unsigned lk = row0 * XA_KP + c32 * 16, lv = XA_VOFF + row0 * XA_VP + c32 * 16;
    u32x4 st[4];
#define XA_LOAD(t_) do { const bf16_t* s_ = gk + (size_t)(t_) * 32 * 2048; st[0] = *(const u32x4*)s_; st[1] = *(const u32x4*)(s_ + 16 * 2048); st[2] = *(const u32x4*)(s_ + 1024); st[3] = *(const u32x4*)(s_ + 16 * 2048 + 1024); } while (0)
#define XA_STORE(bufp) do { *(LAS u32x4*)((bufp) + lk) = st[0]; *(LAS u32x4*)((bufp) + lk + 16 * XA_KP) = st[1]; *(LAS u32x4*)((bufp) + lv) = st[2]; *(LAS u32x4*)((bufp) + lv + 16 * XA_VP) = st[3]; } while (0)
    __syncthreads();
    XA_LOAD(0); XA_STORE(lds); __syncthreads();
    const unsigned ka = r * XA_KP + hh * 16;
    const int i16 = lane & 15;
    const unsigned va = XA_VOFF + (4 * hh + (i16 >> 2)) * XA_VP + (dvh * 128 + 16 * ((lane >> 4) & 1) + 4 * (i16 & 3)) * 2;
    u32x4 st2[4];
#define XA_LOAD2(t_) do { const bf16_t* s_ = gk + (size_t)(t_) * 32 * 2048; st2[0] = *(const u32x4*)s_; st2[1] = *(const u32x4*)(s_ + 16 * 2048); st2[2] = *(const u32x4*)(s_ + 1024); st2[3] = *(const u32x4*)(s_ + 16 * 2048 + 1024); } while (0)
#define XA_STORE2(bufp) do { *(LAS u32x4*)((bufp) + lk) = st2[0]; *(LAS u32x4*)((bufp) + lk + 16 * XA_KP) = st2[1]; *(LAS u32x4*)((bufp) + lv) = st2[2]; *(LAS u32x4*)((bufp) + lv + 16 * XA_VP) = st2[3]; } while (0)
    XA_LOAD2(1);
#pragma unroll 1
    for (int t = 0; t < 8; t += 2) {
        if (t + 2 < 8) XA_LOAD(t + 2);
        xattn_tile(lds, ka, va, qf, O, mrun, lrun);
        XA_STORE2(lds + XA_BUF);
        lds_barrier();
        if (t + 3 < 8) XA_LOAD2(t + 3);
        xattn_tile(lds + XA_BUF, ka, va, qf, O, mrun, lrun);
        if (t + 2 < 8) XA_STORE(lds);
        lds_barrier();
    }
#undef XA_LOAD2
#undef XA_STORE2
#undef XA_LOAD
#undef XA_STORE
    const float inv = 1.f / xhalf_sum(lrun);
    bf16_t* yp = WSP(bf16_t, WS_Y) + qrow * 3072 + 2048 + h * 256 + dvh * 128;
#pragma unroll
    for (int dt = 0; dt < 4; ++dt)
#pragma unroll
        for (int g4 = 0; g4 < 4; ++g4) { const int dv = dt * 32 + 8 * g4 + 4 * hh;
            u32x2 w; w.x = pk_bf16(O[dt][4 * g4] * inv, O[dt][4 * g4 + 1] * inv); w.y = pk_bf16(O[dt][4 * g4 + 2] * inv, O[dt][4 * g4 + 3] * inv);
            *(u32x2*)(yp + dv) = w; }
}
#ifndef ATTN_NAIVE
#define ATTN_NAIVE 0
#endif
#ifndef XATTN_NAIVE
#define XATTN_NAIVE 0
#endif
#ifndef MLSTM_NAIVE
#define MLSTM_NAIVE 0
#endif
DI void wd_item(PP pk_, int e, LAS unsigned char* lds);
DI void ph_mix(PP pk_, int g, int rep, LAS unsigned char* lds) { const P p = load_args(pk_);
    constexpr int N_ML = BG * 4 * 2, N_AT = BG * 8 * 16, N_XA = BG * 4 * 16;
    const int N_XC = (g + 1 < NGRP) ? TG / 256 : 0;
    const int wd0 = (257 * g) / NGRP, N_WD = (257 * (g + 1)) / NGRP - wd0;
    unsigned* ctr = WSP(unsigned, WS_CTL) + CW_Q + 64 * (g + NGRP * rep);
    for (;;) {
        const int it = next_item(ctr, lds);
        if (it >= N_ML + N_XC + N_WD + N_AT + N_XA) break;
        if (it < N_ML) mlstm_half_item(pk_, g, it, lds);
        else if (it < N_ML + N_XC) xconv_item(pk_, g + 1, it - N_ML, lds);
        else if (it < N_ML + N_XC + N_WD) wd_item(pk_, wd0 + it - (N_ML + N_XC), lds);
        else if (it < N_ML + N_XC + N_WD + N_AT) { const int ix = it - (N_ML + N_XC + N_WD); attn_mfma_item(pk_, ((ix & 63) << 4) | (15 - (ix >> 6)), lds); }
        else xattn_mfma_item(pk_, g, it - (N_ML + N_XC + N_WD + N_AT), lds);
    }
}

DI void ph_mlstm_out(PP pk_, int g, LAS unsigned char* lds) { const P p = load_args(pk_);
    if (g + 1 < NGRP && bid_local() < BG * 4) gate_tables(pk_, g + 1, bid_local(), lds);
    const int tid = tid_local(), lane = tid & 63, wave = tid >> 6, gw = bid_local() * 8 + wave, NGW = gridDim.x * 8;
    const bf16_t* HB = WSP(bf16_t, WS_MRG); const bf16_t* U = WSP(bf16_t, WS_U); bf16_t* Y = WSP(bf16_t, WS_Y);
    for (int r0 = gw * 2; r0 < TG; r0 += NGW * 2) {
        u32x2 hw[2][4], ow[2][4]; f32x4 gn[4];
#pragma unroll
        for (int h = 0; h < 4; ++h) gn[h] = *((const f32x4*)(p.mlstm_norm_g + h * 256) + lane);
#pragma unroll
        for (int q = 0; q < 2; ++q)
#pragma unroll
            for (int h = 0; h < 4; ++h) { hw[q][h] = *((const u32x2*)(HB + (size_t)(r0 + q) * 1024 + h * 256) + lane); ow[q][h] = *((const u32x2*)(U + (size_t)(r0 + q) * NU + UMO + h * 256) + lane); }
#pragma unroll
        for (int q = 0; q < 2; ++q)
#pragma unroll
            for (int h = 0; h < 4; ++h) {
                const f32x4 v = {bf_lo(hw[q][h].x), bf_hi(hw[q][h].x), bf_lo(hw[q][h].y), bf_hi(hw[q][h].y)};
                const float mu = wave_sum_fast((v[0] + v[1]) + (v[2] + v[3])) * (1.f / 256.f); const f32x4 d = v - mu;
                const float rstd = rsqrtf(wave_sum_fast((d[0] * d[0] + d[1] * d[1]) + (d[2] * d[2] + d[3] * d[3])) * (1.f / 256.f) + LN_EPS);
                u32x2 o; o.x = cvt_pk_bf16(d[0] * rstd * gn[h][0] * sigm(bf_lo(ow[q][h].x)), d[1] * rstd * gn[h][1] * sigm(bf_hi(ow[q][h].x))); o.y = cvt_pk_bf16(d[2] * rstd * gn[h][2] * sigm(bf_lo(ow[q][h].y)), d[3] * rstd * gn[h][3] * sigm(bf_hi(ow[q][h].y)));
                *((u32x2*)(Y + (size_t)(r0 + q) * 3072 + 1024 + h * 256) + lane) = o; }
    }
}

DI void ph_ln1(PP pk_, int g, LAS unsigned char* lds) { const P p = load_args(pk_);
    const int tid = tid_local(), lane = tid & 63, wave = tid >> 6, gw = bid_local() * 8 + wave, NGW = gridDim.x * 8;
    const float* Z = WSP(float, WS_Z); bf16_t* X1 = WSP(bf16_t, WS_X1B) + (size_t)g * TG * 1024;
    for (int r0 = gw * 2; r0 < TG; r0 += NGW * 2) {
        f32x4 v[2][4];
#pragma unroll
        for (int q = 0; q < 2; ++q)
#pragma unroll
            for (int j = 0; j < 4; ++j) v[q][j] = *((const f32x4*)(Z + (size_t)(r0 + q) * 1024) + lane + 64 * j);
#pragma unroll
        for (int q = 0; q < 2; ++q) { float s = 0.f;
#pragma unroll
            for (int j = 0; j < 4; ++j) s += (v[q][j][0] + v[q][j][1]) + (v[q][j][2] + v[q][j][3]);
            const float mu = wave_sum(s) * (1.f / 1024.f); float s2 = 0.f;
#pragma unroll
            for (int j = 0; j < 4; ++j) { v[q][j] = v[q][j] - mu; s2 += (v[q][j][0] * v[q][j][0] + v[q][j][1] * v[q][j][1]) + (v[q][j][2] * v[q][j][2] + v[q][j][3] * v[q][j][3]); }
            const float rstd = rsqrtf(wave_sum(s2) * (1.f / 1024.f) + LN_EPS);
            u32x2* d = (u32x2*)(X1 + (size_t)(r0 + q) * 1024) + lane;
#pragma unroll
            for (int j = 0; j < 4; ++j) { const f32x4 gn = *((const f32x4*)p.ln1_g + lane + 64 * j), bb = *((const f32x4*)p.ln1_b + lane + 64 * j); const f32x4 o = v[q][j] * rstd * gn + bb;
                u32x2 w; w.x = cvt_pk_bf16(o[0], o[1]); w.y = cvt_pk_bf16(o[2], o[3]); d[64 * j] = w; } }
    }
}
DI void ph_expert_weights(PP pk_, LAS unsigned char* lds) { const P p = load_args(pk_);
    const int tid = tid_local(), lane = tid & 63, wave = tid >> 6, gw = bid_local() * 8 + wave, NGW = gridDim.x * 8;
    LAS float* scr = (LAS float*)(lds + wave * 16384);
    bf16_t* WGU = WSP(bf16_t, WS_WGU); bf16_t* WD = WSP(bf16_t, WS_WD);
    for (int it = gw; it < 257 * 256; it += NGW) { const int e = it >> 8, r = it & 255, isup = r >> 7, kb = (r >> 3) & 15, nb = r & 7;
        const float* W = (e < 256) ? ((isup ? p.w_e_up : p.w_e_gate) + (size_t)e * 1024 * 256) : (isup ? p.w_s_up : p.w_s_gate);
        const int n0 = nb * 32, drow = (n0 >> 7) * 256 + (n0 & 127) + isup * 128;
        transpose_item(W, 256, n0, WGU + (size_t)e * 512 * 1024, 1024, drow, kb * 64, scr, lane); }
}
DI void wd_item(PP pk_, int e, LAS unsigned char* lds) { const P p = load_args(pk_);
    const int tid = tid_local(), lane = tid & 63, wave = tid >> 6;
    __syncthreads();
    LAS float* scr = (LAS float*)(lds + wave * 16384);
    bf16_t* WD = WSP(bf16_t, WS_WD);
    const float* W = (e < 256) ? (p.w_e_down + (size_t)e * 256 * 1024) : p.w_s_down;
#pragma unroll 1
    for (int r = wave; r < 128; r += 8) { const int kb = r >> 5, nb = r & 31; transpose_item(W, 1024, nb * 32, WD + (size_t)e * 1024 * 256, 256, nb * 32, kb * 64, scr, lane); }
}

template <int CTRL> DI int dppi(int v) { return __builtin_amdgcn_update_dpp(0, v, CTRL, 0xf, 0xf, true); }
#define ARGMAX_STEP(CTRL) do { const float ov_ = dppf<CTRL>(bv); const int oi_ = dppi<CTRL>(bi); if (ov_ > bv || (ov_ == bv && oi_ < bi)) { bv = ov_; bi = oi_; } } while (0)
DI void ph_topk(PP pk_, LAS unsigned char* lds) { const P p = load_args(pk_);
    const int tid = tid_local(), lane = tid & 63, wave = tid >> 6, gw = bid_local() * 8 + wave, NGW = gridDim.x * 8;
    const float* LG = WSP(float, WS_LOGIT); int* TKI = WSP(int, WS_TKI); float* TKW = WSP(float, WS_TKW); unsigned* cnt = WSP(unsigned, WS_CTL) + CW_CNT;
    int* tokof = WSP(int, WS_TOKOF); float* wof = WSP(float, WS_WOF);
    for (int i = bid_local() * 512 + tid; i < MAXRT * 256; i += gridDim.x * 512) { tokof[i] = 0; wof[i] = 0.f; }
    const f32x4 rb = *((const f32x4*)p.router_bias + lane);
    f32x4 lgn = *((const f32x4*)(LG + (size_t)gw * 256) + lane);
    for (int t = gw; t < T_ALL; t += NGW) {
        const f32x4 lg = lgn; if (t + NGW < T_ALL) lgn = *((const f32x4*)(LG + (size_t)(t + NGW) * 256) + lane);
        float sc[4], ch[4];
#pragma unroll
        for (int j = 0; j < 4; ++j) { sc[j] = 1.f / (1.f + expf(-lg[j])); ch[j] = sc[j] + rb[j]; }
        const float m01 = fmaxf(ch[0], ch[1]), n01 = fminf(ch[0], ch[1]), m23 = fmaxf(ch[2], ch[3]), n23 = fminf(ch[2], ch[3]);
        float a1 = fmaxf(m01, m23), a2 = fmaxf(fminf(m01, m23), fmaxf(n01, n23));
        { float b1 = dppf<0xB1>(a1), b2 = dppf<0xB1>(a2); float n1 = fmaxf(a1, b1), n2 = fmaxf(fminf(a1, b1), fmaxf(a2, b2)); a1 = n1; a2 = n2;
          b1 = dppf<0x4E>(a1); b2 = dppf<0x4E>(a2); n1 = fmaxf(a1, b1); n2 = fmaxf(fminf(a1, b1), fmaxf(a2, b2)); a1 = n1; a2 = n2;
          b1 = dppf<0x141>(a1); b2 = dppf<0x141>(a2); n1 = fmaxf(a1, b1); n2 = fmaxf(fminf(a1, b1), fmaxf(a2, b2)); a1 = n1; a2 = n2; }
        const float gs = a1 + a2; const int myg = lane >> 3; int rank = 0;
#pragma unroll
        for (int g2 = 0; g2 < 8; ++g2) { const float og = rdlane(gs, 8 * g2); rank += (og > gs || (og == gs && g2 < myg)) ? 1 : 0; }
        if (rank >= 4) { ch[0] = -INFINITY; ch[1] = -INFINITY; ch[2] = -INFINITY; ch[3] = -INFINITY; }
        int myidx = 0; float mys = 0.f, ssum = 0.f;
#pragma unroll
        for (int r = 0; r < 8; ++r) {
            float bv = ch[0]; int bi = 4 * lane;
#pragma unroll
            for (int j = 1; j < 4; ++j) if (ch[j] > bv) { bv = ch[j]; bi = 4 * lane + j; }
            ARGMAX_STEP(0xB1); ARGMAX_STEP(0x4E); ARGMAX_STEP(0x124); ARGMAX_STEP(0x128);
            { float v0 = rdlane(bv, 0), v1 = rdlane(bv, 16), v2 = rdlane(bv, 32), v3 = rdlane(bv, 48);
              int i0 = __builtin_amdgcn_readlane(bi, 0), i1 = __builtin_amdgcn_readlane(bi, 16), i2 = __builtin_amdgcn_readlane(bi, 32), i3 = __builtin_amdgcn_readlane(bi, 48);
              if (v1 > v0 || (v1 == v0 && i1 < i0)) { v0 = v1; i0 = i1; } if (v3 > v2 || (v3 == v2 && i3 < i2)) { v2 = v3; i2 = i3; } if (v2 > v0 || (v2 == v0 && i2 < i0)) { v0 = v2; i0 = i2; }
              bv = v0; bi = i0; }
            const int jl = bi & 3; const float scsel = jl == 0 ? sc[0] : (jl == 1 ? sc[1] : (jl == 2 ? sc[2] : sc[3]));
            const float sv = __builtin_bit_cast(float, __builtin_amdgcn_readlane(__builtin_bit_cast(int, scsel), bi >> 2));
            if ((bi >> 2) == lane) { if (jl == 0) ch[0] = -INFINITY; else if (jl == 1) ch[1] = -INFINITY; else if (jl == 2) ch[2] = -INFINITY; else ch[3] = -INFINITY; }
            ssum += sv; if (lane == r) { myidx = bi; mys = sv; }
        }
        if (lane < 8) { TKI[(size_t)t * 8 + lane] = myidx; TKW[(size_t)t * 8 + lane] = mys / (ssum + 1e-20f) * 2.5f; atomicAdd(cnt + myidx, 1u); }
    }
}
#undef ARGMAX_STEP

DI void ph_slots(PP pk_, LAS unsigned char* lds) { const P p = load_args(pk_);
    const int tid = tid_local();
    const unsigned* cnt = WSP(unsigned, WS_CTL) + CW_CNT; int* tbase = WSP(int, WS_MISC + MS_TBASE); int* nt = WSP(int, WS_MISC + MS_NT); int* tile_e = WSP(int, WS_MISC + MS_TILEE);
    LAS int* sb = (LAS int*)lds;
    __syncthreads();
    if (tid < 256) sb[tid] = (int)((cnt[tid] + 255u) >> 8);
    __syncthreads();
    if (tid == 0) { int a = 0; for (int e = 0; e < 256; ++e) { const int n = sb[e]; sb[e] = a; a += n; } sb[256] = a; }
    __syncthreads();
    const int nrt = sb[256];
    if (bid_local() == 0) {
        if (tid < 256) { const int b0 = sb[tid], b1 = sb[tid + 1]; tbase[tid] = b0; for (int t = b0; t < b1; ++t) tile_e[t] = tid; tile_e[nrt + tid] = 256; }
        if (tid == 0) { tbase[256] = nrt; nt[0] = nrt; nt[1] = nrt + 256; }
    }
    const int* TKI = WSP(int, WS_TKI); const float* TKW = WSP(float, WS_TKW); unsigned* cur = WSP(unsigned, WS_CTL) + CW_CUR;
    int* tokof = WSP(int, WS_TOKOF); float* wof = WSP(float, WS_WOF); int* slotof = WSP(int, WS_SLOTOF);
    const int s0 = nrt * 256;
    for (int i0 = bid_local() * 512 + tid; i0 < T_ALL * 2; i0 += gridDim.x * 512) {
        int e[4]; float wv[4]; int sl[4];
#pragma unroll
        for (int q = 0; q < 4; ++q) { e[q] = TKI[i0 + q * (T_ALL * 2)]; wv[q] = TKW[i0 + q * (T_ALL * 2)]; }
#pragma unroll
        for (int q = 0; q < 4; ++q) sl[q] = sb[e[q]] * 256 + (int)atomicAdd(cur + e[q], 1u);
#pragma unroll
        for (int q = 0; q < 4; ++q) { const int i = i0 + q * (T_ALL * 2); tokof[sl[q]] = i >> 3; wof[sl[q]] = wv[q]; slotof[i] = sl[q]; } }
    for (int t = bid_local() * 512 + tid; t < T_ALL; t += gridDim.x * 512) { tokof[s0 + t] = t; wof[s0 + t] = 1.f; }
    __syncthreads();
}

DI void ph_combine(PP pk_, int round, LAS unsigned char* lds) { const P p = load_args(pk_);
    const int tid = tid_local();
    const unsigned char* Y = WSP(unsigned char, WS_YCH); const bf16_t* X1 = WSP(bf16_t, WS_X1B); const int* slotof = WSP(int, WS_SLOTOF); const int s0 = WSP(int, WS_MISC + MS_TBASE)[256] * 256;
    for (int i0 = bid_local() * 512 + tid; i0 < T_ALL * 32; i0 += gridDim.x * 512) {
        int slot[2][9]; u32x4 xw[2];
#pragma unroll
        for (int q = 0; q < 2; ++q) { const int i = i0 + q * (T_ALL * 32), t = i >> 6, c8 = (i & 63) * 8; xw[q] = *(const u32x4*)(X1 + (size_t)t * 1024 + round * 512 + c8);
            const u32x4 sa = *(const u32x4*)(slotof + (size_t)t * 8), sb = *(const u32x4*)(slotof + (size_t)t * 8 + 4);
            slot[q][0] = sa.x; slot[q][1] = sa.y; slot[q][2] = sa.z; slot[q][3] = sa.w; slot[q][4] = sb.x; slot[q][5] = sb.y; slot[q][6] = sb.z; slot[q][7] = sb.w; slot[q][8] = s0 + t; }
        u32x2 yw[2][9];
#pragma unroll
        for (int q = 0; q < 2; ++q) { const int c8 = ((i0 + q * (T_ALL * 32)) & 63) * 8;
#pragma unroll
            for (int k = 0; k < 9; ++k) yw[q][k] = *(const u32x2*)(Y + (size_t)slot[q][k] * 512 + c8); }
#pragma unroll
        for (int q = 0; q < 2; ++q) { const int i = i0 + q * (T_ALL * 32), t = i >> 6, c8 = (i & 63) * 8;
            float a[8];
#pragma unroll
            for (int e = 0; e < 8; ++e) a[e] = 0.f;
#pragma unroll
            for (int k = 0; k < 9; ++k) { const u32x2 w = yw[q][k];
                const f32x2 v0 = __builtin_amdgcn_cvt_pk_f32_fp8((int)w.x, false), v1 = __builtin_amdgcn_cvt_pk_f32_fp8((int)w.x, true), v2 = __builtin_amdgcn_cvt_pk_f32_fp8((int)w.y, false), v3 = __builtin_amdgcn_cvt_pk_f32_fp8((int)w.y, true);
                a[0] += v0[0]; a[1] += v0[1]; a[2] += v1[0]; a[3] += v1[1]; a[4] += v2[0]; a[5] += v2[1]; a[6] += v3[0]; a[7] += v3[1]; }
            constexpr float is = 1.f / Y8_SCALE; const u32x4 x = xw[q];
            float* op = p.out + (size_t)t * 1024 + round * 512 + c8;
            *(f32x4*)op = (f32x4){bf_lo(x.x) * ALPHA + a[0] * is, bf_hi(x.x) * ALPHA + a[1] * is, bf_lo(x.y) * ALPHA + a[2] * is, bf_hi(x.y) * ALPHA + a[3] * is};
            *(f32x4*)(op + 4) = (f32x4){bf_lo(x.z) * ALPHA + a[4] * is, bf_hi(x.z) * ALPHA + a[5] * is, bf_lo(x.w) * ALPHA + a[6] * is, bf_hi(x.w) * ALPHA + a[7] * is}; }
    }
}

DI void ph_combine_ln2(PP pk_, LAS unsigned char* lds) { const P p = load_args(pk_);
    const int tid = tid_local(), lane = tid & 63, wave = tid >> 6, gw = bid_local() * 8 + wave, NGW = gridDim.x * 8;
    const unsigned char* Y = WSP(unsigned char, WS_YCH); const bf16_t* X1 = WSP(bf16_t, WS_X1B); const int* slotof = WSP(int, WS_SLOTOF); const int s0 = WSP(int, WS_MISC + MS_TBASE)[256] * 256;
    const f32x4 ga0 = *((const f32x4*)p.ln2_g + 2 * lane), ga1 = *((const f32x4*)p.ln2_g + 2 * lane + 1), gb0 = *((const f32x4*)p.ln2_g + 128 + 2 * lane), gb1 = *((const f32x4*)p.ln2_g + 128 + 2 * lane + 1);
    const f32x4 ba0 = *((const f32x4*)p.ln2_b + 2 * lane), ba1 = *((const f32x4*)p.ln2_b + 2 * lane + 1), bb0 = *((const f32x4*)p.ln2_b + 128 + 2 * lane), bb1 = *((const f32x4*)p.ln2_b + 128 + 2 * lane + 1);
    for (int t0 = gw * 2; t0 < T_ALL; t0 += NGW * 2) {
        int slot[2][9]; u32x4 xw[2]; f32x4 z0[2][2]; u32x2 yw[2][9];
#pragma unroll
        for (int q = 0; q < 2; ++q) { const int t = t0 + q; xw[q] = *(const u32x4*)(X1 + (size_t)t * 1024 + 512 + 8 * lane);
            z0[q][0] = *((const f32x4*)(p.out + (size_t)t * 1024) + 2 * lane); z0[q][1] = *((const f32x4*)(p.out + (size_t)t * 1024) + 2 * lane + 1);
            const u32x4 sa = *(const u32x4*)(slotof + (size_t)t * 8), sb = *(const u32x4*)(slotof + (size_t)t * 8 + 4);
            slot[q][0] = sa.x; slot[q][1] = sa.y; slot[q][2] = sa.z; slot[q][3] = sa.w; slot[q][4] = sb.x; slot[q][5] = sb.y; slot[q][6] = sb.z; slot[q][7] = sb.w; slot[q][8] = s0 + t; }
#pragma unroll
        for (int q = 0; q < 2; ++q)
#pragma unroll
            for (int k = 0; k < 9; ++k) yw[q][k] = *(const u32x2*)(Y + (size_t)slot[q][k] * 512 + 8 * lane);
#pragma unroll
        for (int q = 0; q < 2; ++q) { const int t = t0 + q;
            float a[8];
#pragma unroll
            for (int e = 0; e < 8; ++e) a[e] = 0.f;
#pragma unroll
            for (int k = 0; k < 9; ++k) { const u32x2 w = yw[q][k];
                const f32x2 v0 = __builtin_amdgcn_cvt_pk_f32_fp8((int)w.x, false), v1 = __builtin_amdgcn_cvt_pk_f32_fp8((int)w.x, true), v2 = __builtin_amdgcn_cvt_pk_f32_fp8((int)w.y, false), v3 = __builtin_amdgcn_cvt_pk_f32_fp8((int)w.y, true);
                a[0] += v0[0]; a[1] += v0[1]; a[2] += v1[0]; a[3] += v1[1]; a[4] += v2[0]; a[5] += v2[1]; a[6] += v3[0]; a[7] += v3[1]; }
            constexpr float is = 1.f / Y8_SCALE; const u32x4 x = xw[q];
            f32x4 c0 = {bf_lo(x.x) * ALPHA + a[0] * is, bf_hi(x.x) * ALPHA + a[1] * is, bf_lo(x.y) * ALPHA + a[2] * is, bf_hi(x.y) * ALPHA + a[3] * is};
            f32x4 c1 = {bf_lo(x.z) * ALPHA + a[4] * is, bf_hi(x.z) * ALPHA + a[5] * is, bf_lo(x.w) * ALPHA + a[6] * is, bf_hi(x.w) * ALPHA + a[7] * is};
            f32x4 d0 = z0[q][0], d1 = z0[q][1];
            const float mu = wave_sum(((c0[0] + c0[1]) + (c0[2] + c0[3])) + ((c1[0] + c1[1]) + (c1[2] + c1[3])) + ((d0[0] + d0[1]) + (d0[2] + d0[3])) + ((d1[0] + d1[1]) + (d1[2] + d1[3]))) * (1.f / 1024.f);
            c0 = c0 - mu; c1 = c1 - mu; d0 = d0 - mu; d1 = d1 - mu;
            const float rstd = rsqrtf(wave_sum(((c0[0] * c0[0] + c0[1] * c0[1]) + (c0[2] * c0[2] + c0[3] * c0[3])) + ((c1[0] * c1[0] + c1[1] * c1[1]) + (c1[2] * c1[2] + c1[3] * c1[3]))
                                             + ((d0[0] * d0[0] + d0[1] * d0[1]) + (d0[2] * d0[2] + d0[3] * d0[3])) + ((d1[0] * d1[0] + d1[1] * d1[1]) + (d1[2] * d1[2] + d1[3] * d1[3]))) * (1.f / 1024.f) + LN_EPS);
            f32x4* o = (f32x4*)(p.out + (size_t)t * 1024);
            o[2 * lane] = d0 * rstd * ga0 + ba0; o[2 * lane + 1] = d1 * rstd * ga1 + ba1; o[128 + 2 * lane] = c0 * rstd * gb0 + bb0; o[128 + 2 * lane + 1] = c1 * rstd * gb1 + bb1; }
    }
}

DI void ph_ln2(PP pk_, LAS unsigned char* lds) { const P p = load_args(pk_);
    const int tid = tid_local(), lane = tid & 63, wave = tid >> 6, gw = bid_local() * 8 + wave, NGW = gridDim.x * 8;
    for (int r0 = gw * 2; r0 < T_ALL; r0 += NGW * 2) {
        f32x4 v[2][4];
#pragma unroll
        for (int q = 0; q < 2; ++q)
#pragma unroll
            for (int j = 0; j < 4; ++j) v[q][j] = *((const f32x4*)(p.out + (size_t)(r0 + q) * 1024) + lane + 64 * j);
#pragma unroll
        for (int q = 0; q < 2; ++q) { float s = 0.f;
#pragma unroll
            for (int j = 0; j < 4; ++j) s += (v[q][j][0] + v[q][j][1]) + (v[q][j][2] + v[q][j][3]);
            const float mu = wave_sum(s) * (1.f / 1024.f); float s2 = 0.f;
#pragma unroll
            for (int j = 0; j < 4; ++j) { v[q][j] = v[q][j] - mu; s2 += (v[q][j][0] * v[q][j][0] + v[q][j][1] * v[q][j][1]) + (v[q][j][2] * v[q][j][2] + v[q][j][3] * v[q][j][3]); }
            const float rstd = rsqrtf(wave_sum(s2) * (1.f / 1024.f) + LN_EPS);
            f32x4* zr = (f32x4*)(p.out + (size_t)(r0 + q) * 1024) + lane;
#pragma unroll
            for (int j = 0; j < 4; ++j) { const f32x4 gn = *((const f32x4*)p.ln2_g + lane + 64 * j), bb = *((const f32x4*)p.ln2_b + lane + 64 * j); zr[64 * j] = v[q][j] * rstd * gn + bb; } }
    }
}

__global__ void __launch_bounds__(512, 2) fwd(P p_unused) {
    extern __shared__ __attribute__((aligned(16))) unsigned char lds_raw[];
    LAS unsigned char* lds = (LAS unsigned char*)lds_raw;
    const int tid = threadIdx.x, G = gridDim.x;
#define bid bid_local()
    volatile LAS unsigned* MISC = (volatile LAS unsigned*)(lds + LDS_MISC);
    if (tid < 32) MISC[tid] = 0u;
    __syncthreads();
    XcdBarrier bar; { unsigned* bw = (unsigned*)(kargs()->ws + WS_CTL) + CW_BAR; bar.bar = bw; bar.x = 0; bar.st = nullptr; bar = xcd_barrier_post(bw, MISC + 8); }
#ifndef PROBE_TYPE
#define PROBE_TYPE -1
#define PROBE_REPS 1
#endif
#define STEP_BEGIN(type) { const int reps_ = ((type) == PROBE_TYPE) ? PROBE_REPS : 1; for (int rep_ = 0; rep_ < reps_; ++rep_) { PP pk_ = kargs(); const P p = load_args(pk_);
#define STEP_END xcd_barrier(bar); } }
#define STEP_END_LAST if (rep_ + 1 < reps_) xcd_barrier(bar); } }

    STEP_BEGIN(0) ph_prologue(pk_, lds); __syncthreads(); ph_xconv(pk_, 0, lds); STEP_END
    for (int g = 0; g < NGRP; ++g) {
        STEP_BEGIN(2) {
            if (g > 0) { ph_ln1(pk_, g - 1, lds); __syncthreads(); }
            pg8::Gemm gm{WSP(bf16_t, WS_XB), WSP(bf16_t, WS_WIN), 1024, 1024, 1024, nullptr}; pg8::StaticOrder S; S.init(TG, NU, G, bid);
            EpiInProj E{WSP(bf16_t, WS_U), WSP(float, WS_MISC + MS_BIAS)};
            pg8::gemm_phase<EpiInProj, pg8::StaticOrder, true>(lds, gm, S, E);
            if (g == 0) {
                pg8::Gemm gk{WSP(bf16_t, WS_MEMB), WSP(bf16_t, WS_WKV), 1024, 1024, 1024, nullptr}; pg8::StaticOrder S2; S2.init(NBATCH * 256, 2048, G, bid);
                EpiPlain E2{WSP(bf16_t, WS_KVM), 2048};
                pg8::gemm_phase<EpiPlain, pg8::StaticOrder, true>(lds, gk, S2, E2);
            }
        } STEP_END
        STEP_BEGIN(4) ph_conv(pk_, g, lds); STEP_END
        STEP_BEGIN(3) ph_mix(pk_, g, rep_, lds); STEP_END
        STEP_BEGIN(16) ph_mlstm_out(pk_, g, lds); STEP_END
        STEP_BEGIN(5) {
            pg8::Gemm gm{WSP(bf16_t, WS_Y), WSP(bf16_t, WS_WBR), 3072, 3072, 3072, nullptr}; pg8::StaticOrder S; S.init(TG, 1024, G, bid);
            EpiBranch2 E{WSP(bf16_t, WS_U), WSP(bf16_t, WS_MRG)}; MidBranch MB{WSP(bf16_t, WS_U)};
            pg8::gemm_phase<EpiBranch2, pg8::StaticOrder, true, false, MidBranch>(lds, gm, S, E, MB);
        } STEP_END
        STEP_BEGIN(6) {
            pg8::Gemm gm{WSP(bf16_t, WS_MRG), WSP(bf16_t, WS_WOUT), 1024, 1024, 1024, nullptr}; pg8::StaticOrder S; S.init(TG, 1024, G, bid);
            EpiOutProj E{p.x + (size_t)g * TG * 1024, WSP(float, WS_Z)};
            pg8::gemm_phase<EpiOutProj, pg8::StaticOrder, true>(lds, gm, S, E);
        } STEP_END
        if (g == NGRP - 1) { STEP_BEGIN(7) ph_ln1(pk_, g, lds); STEP_END }
    }
    STEP_BEGIN(8) {
        pg8::Gemm gm{WSP(bf16_t, WS_X1B), WSP(bf16_t, WS_WR), 1024, 1024, 1024, nullptr}; pg8::StaticOrder S; S.init(T_ALL, 256, G, bid);
        EpiF32 E{WSP(float, WS_LOGIT), 256};
        pg8::gemm_phase<EpiF32, pg8::StaticOrder, true>(lds, gm, S, E);
        ph_expert_weights(pk_, lds);
    } STEP_END
    STEP_BEGIN(9) ph_topk(pk_, lds); STEP_END
    STEP_BEGIN(11) ph_slots(pk_, lds); STEP_END
    STEP_BEGIN(12) {
        const int* ntp = WSP(int, WS_MISC + MS_NT);
        pg8::Gemm gm{WSP(bf16_t, WS_X1B), WSP(bf16_t, WS_WGU), 1024, 1024, 1024, WSP(int, WS_TOKOF)}; ExpertGUOrder S{WSP(int, WS_MISC + MS_TILEE), ntp[1] * 2, G, (G % 8 == 0) ? (bid % 8) * (G / 8) + bid / 8 : bid};
        EpiGateUp E{WSP(bf16_t, WS_ACT)};
        pg8::gemm_phase<EpiGateUp, ExpertGUOrder, true, true>(lds, gm, S, E);
    } STEP_END
    for (int r = 0; r < 2; ++r) {
        STEP_BEGIN(13) {
            const int* ntp = WSP(int, WS_MISC + MS_NT);
            pg8::Gemm gm{WSP(bf16_t, WS_ACT), WSP(bf16_t, WS_WD), 256, 256, 256, nullptr}; ExpertDownOrder S{WSP(int, WS_MISC + MS_TILEE), ntp[1] * 2, G, (G % 8 == 0) ? (bid % 8) * (G / 8) + bid / 8 : bid, r};
            EpiDown E{WSP(unsigned char, WS_YCH), WSP(float, WS_WOF)};
            pg8::gemm_phase<EpiDown, ExpertDownOrder, true>(lds, gm, S, E);
        } STEP_END
        if (r == 0) { STEP_BEGIN(14) ph_combine(pk_, 0, lds); STEP_END }
    }
#if PROBE_TYPE == 99
    for (int xb = 0; xb < 20; ++xb) xcd_barrier(bar);
#endif
    STEP_BEGIN(15) ph_combine_ln2(pk_, lds); STEP_END_LAST
}
constexpr int NSTEPS = 1 + NGRP * 6 + 1 + 4 + 3 + 1;

extern "C" void kernel_launch(void* const* d_in, const int* in_sizes, int n_in, void* d_out, int out_size, void* d_ws, size_t ws_size, hipStream_t stream) {
    static int grid = 0;
    if (grid == 0) {
        int dev = 0, cus = 0;
        if (hipGetDevice(&dev) != hipSuccess || hipDeviceGetAttribute(&cus, hipDeviceAttributeMultiprocessorCount, dev) != hipSuccess) { fprintf(stderr, "kernel_launch: device query failed\n"); grid = -1; return; }
        if (hipFuncSetAttribute((const void*)fwd, hipFuncAttributeMaxDynamicSharedMemorySize, LDS_BYTES) != hipSuccess) { fprintf(stderr, "kernel_launch: hipFuncSetAttribute failed\n"); grid = -1; return; }
        if (n_in != 24 || ws_size < WS_END) fprintf(stderr, "kernel_launch: n_in %d ws %zu (need %zu)\n", n_in, ws_size, (size_t)WS_END);
        grid = cus;
    }
    if (grid < 0) return;
    (void)hipMemsetAsync((char*)d_ws + WS_CTL, 0, CTL_BYTES, stream);
    P p{};
    const float** pp = (const float**)&p;
    for (int i = 0; i < 24; ++i) pp[i] = (const float*)d_in[i];
    p.out = (float*)d_out; p.ws = (unsigned char*)d_ws;
    p.s_lo = 0; p.s_hi = NSTEPS; hipLaunchKernelGGL(fwd, dim3(grid), dim3(512), LDS_BYTES, stream, p);
}
```
